# Optimizing an MI355X kernel written in HIP

```python
import jax, jax.numpy as jnp
from jax import lax
import numpy as np

D_MODEL = 2048
BATCH = 8
SEQ = 4096
DEPTH = 4
DEC_BATCH = 32
DEC_SEQ = 16
PAST_LEN = 2048

CHUNK = 64
Q_BLOCK = 128
N_HEADS = 16
Q_LORA = 512
KV_LORA = 512
D_NOPE = 128
D_ROPE = 64
D_V = 128
ROPE_BASE = 10000.0
ATTN_SCALE = (D_NOPE + D_ROPE) ** -0.5
POOL_WINDOWS = (2, 4, 8, 16)
N_POOL_GROUPS = len(POOL_WINDOWS)
POOL_GROUP_DIM = D_MODEL // N_POOL_GROUPS
POOL_HIST = max(POOL_WINDOWS) - 1
D_FF = 5632
CONV_WIDTH = 3
N_MLA_LAYERS = (DEPTH + 1) // 2
N_POOL_LAYERS = DEPTH // 2
EPS = 1e-6

kernel_name = "hybrid_mla_pool_convffn_stream_step"


def rms_norm(x, g):
    xf = x.astype(jnp.float32)
    y = xf * lax.rsqrt(jnp.mean(xf * xf, axis=-1, keepdims=True) + EPS)
    return (y * g.astype(jnp.float32)).astype(x.dtype)


def rope(x, pos):
    half = D_ROPE // 2
    inv = ROPE_BASE ** (-jnp.arange(half, dtype=jnp.float32) / half)
    ang = pos[:, None] * inv[None, :]
    shape = (1, pos.shape[0]) + (1,) * (x.ndim - 3) + (half,)
    c = jnp.cos(ang).reshape(shape)
    s = jnp.sin(ang).reshape(shape)
    xf = x.astype(jnp.float32)
    x1, x2 = xf[..., :half], xf[..., half:]
    return jnp.concatenate([x1 * c - x2 * s, x1 * s + x2 * c], axis=-1).astype(x.dtype)


def chunk_mask(qpos, kpos):
    return (kpos // CHUNK)[None, :] <= (qpos // CHUNK)[:, None]


def masked_softmax(s, mask):
    s = s.astype(jnp.float32) * ATTN_SCALE
    s = jnp.where(mask[None, None], s, -jnp.inf)
    return jax.nn.softmax(s, axis=-1)


def mla_project(h, pos, w_dq, q_norm, w_uq, w_dkv, kv_norm):
    B, S, _ = h.shape
    cq = rms_norm(h @ w_dq, q_norm)
    q = (cq @ w_uq).reshape(B, S, N_HEADS, D_NOPE + D_ROPE)
    q_nope = q[..., :D_NOPE]
    q_rope = rope(q[..., D_NOPE:], pos)
    kv = h @ w_dkv
    ckv = rms_norm(kv[..., :KV_LORA], kv_norm)
    kr = rope(kv[..., KV_LORA:], pos)
    return q_nope, q_rope, ckv, kr


def mla_prompt(h, w_dq, q_norm, w_uq, w_dkv, kv_norm, w_uk, w_uv, w_o):
    B, S, _ = h.shape
    pos_i = jnp.arange(S, dtype=jnp.int32)
    q_nope, q_rope, ckv, kr = mla_project(h, pos_i.astype(jnp.float32), w_dq, q_norm, w_uq, w_dkv, kv_norm)
    k_nope = jnp.einsum('bkc,chd->bkhd', ckv, w_uk)
    v = jnp.einsum('bkc,chd->bkhd', ckv, w_uv)
    outs = []
    for j in range(S // Q_BLOCK):
        q0, q1 = j * Q_BLOCK, (j + 1) * Q_BLOCK
        s = (jnp.einsum('bqhd,bkhd->bhqk', q_nope[:, q0:q1], k_nope[:, :q1])
             + jnp.einsum('bqhr,bkr->bhqk', q_rope[:, q0:q1], kr[:, :q1]))
        p = masked_softmax(s, chunk_mask(pos_i[q0:q1], pos_i[:q1])).astype(v.dtype)
        outs.append(jnp.einsum('bhqk,bkhd->bqhd', p, v[:, :q1]))
    o = jnp.concatenate(outs, axis=1).reshape(B, S, N_HEADS * D_V)
    return o @ w_o, ckv, kr


def mla_sample(h, cache_ckv, cache_kr, w_dq, q_norm, w_uq, w_dkv, kv_norm, w_uk, w_uv, w_o):
    B, S, _ = h.shape
    P = cache_ckv.shape[1]
    qpos = P + jnp.arange(S, dtype=jnp.int32)
    kpos = jnp.arange(P + S, dtype=jnp.int32)
    q_nope, q_rope, ckv, kr = mla_project(h, qpos.astype(jnp.float32), w_dq, q_norm, w_uq, w_dkv, kv_norm)
    ckv_all = jnp.concatenate([cache_ckv, ckv], axis=1)
    kr_all = jnp.concatenate([cache_kr, kr], axis=1)
    q_lat = jnp.einsum('bqhd,chd->bqhc', q_nope, w_uk)
    s = (jnp.einsum('bqhc,bkc->bhqk', q_lat, ckv_all)
         + jnp.einsum('bqhr,bkr->bhqk', q_rope, kr_all))
    p = masked_softmax(s, chunk_mask(qpos, kpos)).astype(ckv_all.dtype)
    o_lat = jnp.einsum('bhqk,bkc->bqhc', p, ckv_all)
    o = jnp.einsum('bqhc,chd->bqhd', o_lat, w_uv).reshape(B, S, N_HEADS * D_V)
    return o @ w_o, ckv, kr


def pool_mix(h, hist, pos0, w_pool, scale):
    B, S, D = h.shape
    Hh = hist.shape[1]
    xcat = jnp.concatenate([hist, h], axis=1)
    T = Hh + S
    pos = (pos0 - Hh) + jnp.arange(T, dtype=jnp.float32)
    xg = xcat.astype(jnp.float32).reshape(B, T, N_POOL_GROUPS, POOL_GROUP_DIM)
    cs = jnp.cumsum(xg, axis=1)
    means = []
    for g, w in enumerate(POOL_WINDOWS):
        csg = cs[:, :, g]
        lag = jnp.pad(csg, ((0, 0), (w, 0), (0, 0)))[:, :T]
        cnt = jnp.minimum(jnp.float32(w), pos + 1.0)
        means.append(((csg - lag) / cnt[None, :, None])[:, Hh:])
    mean = jnp.stack(means, axis=2)
    d = (mean - xg[:, Hh:]).astype(h.dtype)
    y = jnp.einsum('bsgc,gcd->bsgd', d, w_pool).reshape(B, S, D) * scale
    return y, xcat[:, T - POOL_HIST:]


def conv_ffn(h, hist, w_up, conv_w, conv_b, w_down):
    S = h.shape[1]
    up = h @ w_up
    upad = jnp.concatenate([hist, up], axis=1)
    c = conv_b
    for k in range(CONV_WIDTH):
        c = c + conv_w[k] * upad[:, k:k + S]
    gate, val = c[..., :D_FF], c[..., D_FF:]
    out = (jax.nn.silu(gate) * val) @ w_down
    return out, upad[:, upad.shape[1] - (CONV_WIDTH - 1):]


def setup_inputs(seed: int = 0) -> dict:
    key = jax.random.key(seed)
    ks = jax.random.split(key, 21)
    f32 = jnp.float32

    def nrm(k, shape, scale=1.0):
        return jax.random.normal(k, shape, f32) * scale

    NM, NP = N_MLA_LAYERS, N_POOL_LAYERS
    return {
        "x_prompt": nrm(ks[0], (BATCH, SEQ, D_MODEL)),
        "x_sample": nrm(ks[1], (DEC_BATCH, DEC_SEQ, D_MODEL)),
        "cache_ckv": nrm(ks[2], (NM, DEC_BATCH, PAST_LEN, KV_LORA)),
        "cache_krope": nrm(ks[3], (NM, DEC_BATCH, PAST_LEN, D_ROPE)),
        "state_pool": nrm(ks[4], (NP, DEC_BATCH, POOL_HIST, D_MODEL)),
        "state_conv": nrm(ks[5], (DEPTH, DEC_BATCH, CONV_WIDTH - 1, 2 * D_FF)),
        "norm_g": 1.0 + nrm(ks[6], (DEPTH, 4, D_MODEL), 0.05),
        "mla_w_dq": nrm(ks[7], (NM, D_MODEL, Q_LORA), D_MODEL ** -0.5),
        "mla_q_norm": 1.0 + nrm(ks[8], (NM, Q_LORA), 0.05),
        "mla_w_uq": nrm(ks[9], (NM, Q_LORA, N_HEADS * (D_NOPE + D_ROPE)), Q_LORA ** -0.5),
        "mla_w_dkv": nrm(ks[10], (NM, D_MODEL, KV_LORA + D_ROPE), D_MODEL ** -0.5),
        "mla_kv_norm": 1.0 + nrm(ks[11], (NM, KV_LORA), 0.05),
        "mla_w_uk": nrm(ks[12], (NM, KV_LORA, N_HEADS, D_NOPE), KV_LORA ** -0.5),
        "mla_w_uv": nrm(ks[13], (NM, KV_LORA, N_HEADS, D_V), KV_LORA ** -0.5),
        "mla_w_o": nrm(ks[14], (NM, N_HEADS * D_V, D_MODEL), (N_HEADS * D_V) ** -0.5),
        "pool_w": nrm(ks[15], (NP, N_POOL_GROUPS, POOL_GROUP_DIM, POOL_GROUP_DIM), POOL_GROUP_DIM ** -0.5),
        "pool_scale": 1.0 + nrm(ks[16], (NP, D_MODEL), 0.1),
        "ffn_w_up": nrm(ks[17], (DEPTH, D_MODEL, 2 * D_FF), D_MODEL ** -0.5),
        "ffn_conv_w": nrm(ks[18], (DEPTH, CONV_WIDTH, 2 * D_FF), CONV_WIDTH ** -0.5),
        "ffn_conv_b": nrm(ks[19], (DEPTH, 2 * D_FF), 0.01),
        "ffn_w_down": nrm(ks[20], (DEPTH, D_FF, D_MODEL), D_FF ** -0.5),
    }


def reference(x_prompt, x_sample, cache_ckv, cache_krope, state_pool, state_conv, norm_g,
              mla_w_dq, mla_q_norm, mla_w_uq, mla_w_dkv, mla_kv_norm, mla_w_uk, mla_w_uv, mla_w_o,
              pool_w, pool_scale, ffn_w_up, ffn_conv_w, ffn_conv_b, ffn_w_down):
    xp, xs = x_prompt, x_sample
    B = xp.shape[0]
    ckv_p, kr_p, ckv_s, kr_s = [], [], [], []
    pool_p, pool_s, conv_p, conv_s = [], [], [], []
    for i in range(DEPTH):
        g = norm_g[i]
        hp = rms_norm(xp, g[0])
        hs = rms_norm(xs, g[0])
        j = i // 2
        if i % 2 == 0:
            w = (mla_w_dq[j], mla_q_norm[j], mla_w_uq[j], mla_w_dkv[j], mla_kv_norm[j],
                 mla_w_uk[j], mla_w_uv[j], mla_w_o[j])
            mp, c_p, r_p = mla_prompt(hp, *w)
            ms, c_s, r_s = mla_sample(hs, cache_ckv[j], cache_krope[j], *w)
            ckv_p.append(c_p); kr_p.append(r_p); ckv_s.append(c_s); kr_s.append(r_s)
        else:
            mp, st_p = pool_mix(hp, hp[:, :0], 0, pool_w[j], pool_scale[j])
            ms, st_s = pool_mix(hs, state_pool[j], PAST_LEN, pool_w[j], pool_scale[j])
            pool_p.append(st_p); pool_s.append(st_s)
        xp = xp + rms_norm(mp, g[1])
        xs = xs + rms_norm(ms, g[1])
        hp = rms_norm(xp, g[2])
        hs = rms_norm(xs, g[2])
        zero_hist = jnp.zeros((B, CONV_WIDTH - 1, 2 * D_FF), hp.dtype)
        fp, cv_p = conv_ffn(hp, zero_hist, ffn_w_up[i], ffn_conv_w[i], ffn_conv_b[i], ffn_w_down[i])
        fs, cv_s = conv_ffn(hs, state_conv[i], ffn_w_up[i], ffn_conv_w[i], ffn_conv_b[i], ffn_w_down[i])
        conv_p.append(cv_p); conv_s.append(cv_s)
        xp = xp + rms_norm(fp, g[3])
        xs = xs + rms_norm(fs, g[3])
    return (xp, xs,
            jnp.stack(ckv_p), jnp.stack(kr_p), jnp.stack(pool_p), jnp.stack(conv_p),
            jnp.stack(ckv_s), jnp.stack(kr_s), jnp.stack(pool_s), jnp.stack(conv_s))
```

```cpp
#define DBL_MASK 0u
#ifndef MK_PER_PHASE
#define MK_PER_PHASE 0
#endif
#include <hip/hip_runtime.h>
#include <cstdio>
#include <cstdint>
namespace pg8 {
#define PG8_LAS __attribute__((address_space(3)))
#define PG8_GAS __attribute__((address_space(1)))
typedef unsigned short bf16_t;
typedef short bf16x8 __attribute__((ext_vector_type(8)));
typedef float f32x4 __attribute__((ext_vector_type(4)));
typedef unsigned u32x4 __attribute__((ext_vector_type(4)));
typedef unsigned u32x2 __attribute__((ext_vector_type(2)));
constexpr int BM = 256, BK = 64, HALF = 128, HTB = HALF * BK * 2  , STAGE_BYTES = 8 * HTB, NXCD = 8, WGM = 8;

__host__ __device__ __forceinline__ int lds_byte(int r, int c) { const int st = (r >> 4) * 2 + (c >> 5), rr = r & 15, cc = c & 31, ob = rr * 64 + cc * 2; return st * 1024 + (ob ^ (((ob >> 9) & 1) << 5)); }
__host__ __device__ __forceinline__ void stage_rc(int b, int& R, int& C) { const int st = b / 1024, sb = b % 1024, swz = sb ^ (((sb >> 9) & 1) << 5); R = (st >> 1) * 16 + swz / 64; C = (st & 1) * 32 + (swz % 64) / 2; }
__host__ __device__ __forceinline__ int perm32(int rho) { const int n = rho >> 4, i = rho & 15; return 8 * (i >> 2) + 4 * n + (i & 3); }

struct Unit { int pm, pn; };

struct OrderBase {
    int nM, nN, nwg, G, c;
    __device__ __forceinline__ void init(int nM_, int nN_, int G_, int c_) { nM = nM_; nN = nN_; nwg = nM * nN; G = G_; c = c_; }
    __device__ __forceinline__ bool next(int i, Unit& u) const {
        const long L = (long)i * G + c; if (L >= nwg) return false;
        int wgid = (int)L; { const int q = nwg / NXCD, r = nwg % NXCD, xcd = wgid % NXCD, off = wgid / NXCD; wgid = (xcd < r ? xcd * (q + 1) : r * (q + 1) + (xcd - r) * q) + off; }
        const int nig = WGM * nN, gid = wgid / nig, fm = gid * WGM, gsz = (nM - fm) < WGM ? (nM - fm) : WGM;
        u.pm = fm + ((wgid % nig) % gsz); u.pn = (wgid % nig) / gsz; return true;
    }
    __device__ __forceinline__ void a_ready(const Unit&) const {}
    __device__ __forceinline__ void done(const Unit&) const {}
};
struct SchedPlain : OrderBase {
    const char* A; const char* B; int lda, ldb, K;
    __device__ __forceinline__ const char* a_ptr(const Unit& u) const { return A + (size_t)u.pm * 256 * lda * 2; }
    __device__ __forceinline__ const char* b_ptr(const Unit& u) const { return B + (size_t)u.pn * 256 * ldb * 2; }
};
struct SchedBatch : OrderBase {
    const char* A; const char* B; int lda, ldb, K; size_t b_pm;
    __device__ __forceinline__ const char* a_ptr(const Unit& u) const { return A + (size_t)u.pm * 256 * lda * 2; }
    __device__ __forceinline__ const char* b_ptr(const Unit& u) const { return B + (size_t)u.pm * b_pm + (size_t)u.pn * 256 * ldb * 2; }
};
struct SchedQlat : OrderBase {
    const char* A; const char* B; int lda, ldb, K;
    __device__ __forceinline__ const char* a_ptr(const Unit& u) const { return A + ((size_t)(u.pm & 1) * 256 * lda + (size_t)(u.pm >> 1) * 192) * 2; }
    __device__ __forceinline__ const char* b_ptr(const Unit& u) const { return B + ((size_t)(u.pm >> 1) * 512 + (size_t)u.pn * 256) * ldb * 2; }
};
struct SchedOV : OrderBase {
    const char* A; const char* B; int lda, ldb, K;
    __device__ __forceinline__ const char* a_ptr(const Unit& u) const { return A + (size_t)u.pm * 256 * lda * 2; }
    __device__ __forceinline__ const char* b_ptr(const Unit& u) const { return B + (size_t)(u.pm >> 2) * 256 * ldb * 2; }
};
struct SchedPool : OrderBase {
    const char* A; const char* B; int lda, ldb, K;
    __device__ __forceinline__ const char* a_ptr(const Unit& u) const { return A + ((size_t)u.pm * 256 * lda + (size_t)(u.pn >> 1) * 512) * 2; }
    __device__ __forceinline__ const char* b_ptr(const Unit& u) const { return B + (size_t)u.pn * 256 * ldb * 2; }
};

struct SchedSplit : OrderBase {
    const char* A; const char* B; int lda, ldb, K;
    __device__ __forceinline__ const char* a_ptr(const Unit& u) const { return A + ((size_t)(u.pm & 1) * 256 * lda + (size_t)(u.pm >> 1) * K) * 2; }
    __device__ __forceinline__ const char* b_ptr(const Unit& u) const { return B + ((size_t)u.pn * 256 * ldb + (size_t)(u.pm >> 1) * K) * 2; }
};

__device__ __forceinline__ unsigned cvt_pk_bf16(float lo, float hi) { unsigned r; asm volatile("v_cvt_pk_bf16_f32 %0, %1, %2" : "=v"(r) : "v"(lo), "v"(hi)); return r; }

struct EpiF32 {
    static constexpr bool PERM = false, APERM = false, AFTER_DRAIN = false;
    float* C; int ldc;
    __device__ __forceinline__ void operator()(const f32x4 (&acc)[2][2][4][2], const Unit& u, int wr, int wc, int fr, int fq) const {
        const int row0 = u.pm * BM + wr * 64 + fr, col0 = u.pn * BM + wc * 32 + 4 * fq;
#pragma unroll
        for (int ai = 0; ai < 2; ++ai)
#pragma unroll
            for (int m = 0; m < 4; ++m) { float* rowp = C + (size_t)(row0 + ai * HALF + m * 16) * ldc + col0;
#pragma unroll
                for (int bj = 0; bj < 2; ++bj)
#pragma unroll
                    for (int n = 0; n < 2; ++n) *(PG8_GAS f32x4*)(rowp + bj * HALF + n * 16) = acc[ai][bj][m][n]; }
    }
};
struct EpiSlab {
    static constexpr bool PERM = false, APERM = false, AFTER_DRAIN = false;
    float* C;
    __device__ __forceinline__ void operator()(const f32x4 (&acc)[2][2][4][2], const Unit& u, int wr, int wc, int fr, int fq) const {
        float* base = C + ((size_t)(u.pm >> 1) * 512 + (u.pm & 1) * 256 + wr * 64 + fr) * 2048 + u.pn * BM + wc * 32 + 4 * fq;
#pragma unroll
        for (int ai = 0; ai < 2; ++ai)
#pragma unroll
            for (int m = 0; m < 4; ++m) { float* rowp = base + (size_t)(ai * HALF + m * 16) * 2048;
#pragma unroll
                for (int bj = 0; bj < 2; ++bj)
#pragma unroll
                    for (int n = 0; n < 2; ++n) *(PG8_GAS f32x4*)(rowp + bj * HALF + n * 16) = acc[ai][bj][m][n]; }
    }
};
template <int MODE> struct EpiB {
    static constexpr bool PERM = true, APERM = false, AFTER_DRAIN = false;
    bf16_t* O; int ldc; const float* scale;
    __device__ __forceinline__ void operator()(const f32x4 (&acc)[2][2][4][2], const Unit& u, int wr, int wc, int fr, int fq) const {
        f32x4 sv[2][2];
        if (MODE == 0) {
#pragma unroll
            for (int bj = 0; bj < 2; ++bj)
#pragma unroll
                for (int n = 0; n < 2; ++n) sv[bj][n] = scale ? *(const PG8_GAS f32x4*)(scale + u.pn * BM + bj * HALF + wc * 32 + 8 * fq + 4 * n) : (f32x4){1.f, 1.f, 1.f, 1.f};
        }
#pragma unroll
        for (int ai = 0; ai < 2; ++ai)
#pragma unroll
            for (int m = 0; m < 4; ++m) {
                const int r = ai * HALF + wr * 64 + m * 16 + fr;
#pragma unroll
                for (int bj = 0; bj < 2; ++bj) {
                    const int c = bj * HALF + wc * 32 + 8 * fq;
                    bf16_t* p;
                    if (MODE == 0) p = O + (size_t)(u.pm * BM + r) * ldc + u.pn * BM + c;
                    else if (MODE == 1) { const int tok = 256 * (u.pm & 1) + r; p = O + (size_t)((tok >> 4) * 256 + (u.pm >> 1) * 16 + (tok & 15)) * 640 + u.pn * BM + c; }
                    else if (MODE == 2) { p = O + (size_t)((r >> 4) * 512 + 16 * u.pm + (r & 15)) * 512 + u.pn * BM + c; }
                    else { const int tok = 256 * (u.pm & 1) + r; p = O + (size_t)(32768 + tok) * 2048 + (u.pm >> 1) * 128 + (c & 127); }
                    if (MODE == 3 && bj != ((u.pm >> 1) & 1)) continue;
                    f32x4 v0 = acc[ai][bj][m][0], v1 = acc[ai][bj][m][1];
                    if (MODE == 0) { v0 = v0 * sv[bj][0]; v1 = v1 * sv[bj][1]; }
                    u32x4 w; w.x = cvt_pk_bf16(v0[0], v0[1]); w.y = cvt_pk_bf16(v0[2], v0[3]); w.z = cvt_pk_bf16(v1[0], v1[1]); w.w = cvt_pk_bf16(v1[2], v1[3]);
                    *(PG8_GAS u32x4*)p = w;
                }
            }
    }
};
struct EpiKV {
    static constexpr bool PERM = true, APERM = false, AFTER_DRAIN = false;
    bf16_t* K2; bf16_t* V2;
    __device__ __forceinline__ void operator()(const f32x4 (&acc)[2][2][4][2], const Unit& u, int wr, int wc, int fr, int fq) const {
#pragma unroll
        for (int ai = 0; ai < 2; ++ai)
#pragma unroll
            for (int m = 0; m < 4; ++m) {
                const size_t t = (size_t)u.pm * BM + ai * HALF + wr * 64 + m * 16 + fr;
#pragma unroll
                for (int bj = 0; bj < 2; ++bj) {
                    const int d = wc * 32 + 8 * fq;
                    bf16_t* p = u.pn < 8 ? K2 + t * 3072 + (2 * u.pn + bj) * 192 + d : V2 + t * 2048 + (u.pn - 8) * BM + bj * HALF + d;
                    const f32x4 v0 = acc[ai][bj][m][0], v1 = acc[ai][bj][m][1];
                    u32x4 w; w.x = cvt_pk_bf16(v0[0], v0[1]); w.y = cvt_pk_bf16(v0[2], v0[3]); w.z = cvt_pk_bf16(v1[0], v1[1]); w.w = cvt_pk_bf16(v1[2], v1[3]);
                    *(PG8_GAS u32x4*)p = w;
                }
            }
    }
};
struct EpiQRope {
    static constexpr bool PERM = true, APERM = false, AFTER_DRAIN = false;
    bf16_t* O; const float* ctab; const float* stab;
    __device__ __forceinline__ void operator()(const f32x4 (&acc)[2][2][4][2], const Unit& u, int wr, int wc, int fr, int fq) const {
#pragma unroll
        for (int bj = 0; bj < 2; ++bj) {
            const int c = u.pn * BM + bj * HALF + wc * 32 + 8 * fq;
            const int k32 = (u.pn * 8 + bj * 4 + wc) % 6;
            const bool rope = k32 >= 4;
            const int i0 = ((k32 - 4) * 32 + 8 * fq) >> 1;
#pragma unroll
            for (int ai = 0; ai < 2; ++ai)
#pragma unroll
                for (int m = 0; m < 4; ++m) {
                    const int t = u.pm * BM + ai * HALF + wr * 64 + m * 16 + fr;
                    f32x4 v0 = acc[ai][bj][m][0], v1 = acc[ai][bj][m][1];
                    if (rope) {
                        const int pos = t < 32768 ? (t & 4095) : 2048 + ((t - 32768) & 15);
                        const f32x4 cs = *(const PG8_GAS f32x4*)(ctab + pos * 32 + i0), sn = *(const PG8_GAS f32x4*)(stab + pos * 32 + i0);
                        const float a0 = v0[0], b0 = v0[1], a1 = v0[2], b1 = v0[3], a2 = v1[0], b2 = v1[1], a3 = v1[2], b3 = v1[3];
                        v0[0] = a0 * cs[0] - b0 * sn[0]; v0[1] = a0 * sn[0] + b0 * cs[0];
                        v0[2] = a1 * cs[1] - b1 * sn[1]; v0[3] = a1 * sn[1] + b1 * cs[1];
                        v1[0] = a2 * cs[2] - b2 * sn[2]; v1[1] = a2 * sn[2] + b2 * cs[2];
                        v1[2] = a3 * cs[3] - b3 * sn[3]; v1[3] = a3 * sn[3] + b3 * cs[3];
                    }
                    u32x4 w; w.x = cvt_pk_bf16(v0[0], v0[1]); w.y = cvt_pk_bf16(v0[2], v0[3]); w.z = cvt_pk_bf16(v1[0], v1[1]); w.w = cvt_pk_bf16(v1[2], v1[3]);
                    *(PG8_GAS u32x4*)(O + (size_t)t * 3072 + c) = w;
                }
        }
    }
};
template <int CTRL> __device__ __forceinline__ float dppf(float x) { return __builtin_bit_cast(float, __builtin_amdgcn_update_dpp(0, __builtin_bit_cast(int, x), CTRL, 0xf, 0xf, false)); }
__device__ __forceinline__ f32x4 ror1(f32x4 x) { return (f32x4){dppf<0x121>(x[0]), dppf<0x121>(x[1]), dppf<0x121>(x[2]), dppf<0x121>(x[3])}; }
__device__ __forceinline__ f32x4 ror2(f32x4 x) { return (f32x4){dppf<0x122>(x[0]), dppf<0x122>(x[1]), dppf<0x122>(x[2]), dppf<0x122>(x[3])}; }
__device__ __forceinline__ f32x4 sel4(bool c, f32x4 a, f32x4 b) { return (f32x4){c ? a[0] : b[0], c ? a[1] : b[1], c ? a[2] : b[2], c ? a[3] : b[3]}; }
__device__ __forceinline__ float silu_mul(float g, float v) { const float e = __builtin_amdgcn_exp2f(g * -1.4426950408889634f); return g * __builtin_amdgcn_rcpf(1.0f + e) * v; }
template <int CTRL> __device__ __forceinline__ float dpp_old(float old, float x) { return __builtin_bit_cast(float, __builtin_amdgcn_update_dpp(__builtin_bit_cast(int, old), __builtin_bit_cast(int, x), CTRL, 0xf, 0xf, false)); }
__device__ __forceinline__ f32x4 shr1_old(f32x4 old, f32x4 x) { return (f32x4){dpp_old<0x111>(old[0], x[0]), dpp_old<0x111>(old[1], x[1]), dpp_old<0x111>(old[2], x[2]), dpp_old<0x111>(old[3], x[3])}; }
struct EpiUp {
    static constexpr bool PERM = true, APERM = true, AFTER_DRAIN = false;
    bf16_t* act; bf16_t* bnd_first; bf16_t* bnd_last; const float* cw; const float* cb; const float* hist; float* oconv_p; float* oconv_s; const float* rs;
    __device__ __forceinline__ void operator()(const f32x4 (&acc)[2][2][4][2], const Unit& u, int wr, int wc, int fr, int fq) const {
        const bool sample = u.pm >= 128;
        const int colh = wc * 32 + 8 * fq, jg = u.pn * 128 + colh, np = u.pn * 256 + colh;
        u32x2 stash[2][4];
        const f32x4 zero4 = (f32x4){0.f, 0.f, 0.f, 0.f};
#pragma unroll
        for (int n = 0; n < 2; ++n) {
            const int jc = jg + 4 * n;
            const f32x4 w0g = *(const PG8_GAS f32x4*)(cw + jc), w1g = *(const PG8_GAS f32x4*)(cw + 11264 + jc), w2g = *(const PG8_GAS f32x4*)(cw + 2 * 11264 + jc), bg = *(const PG8_GAS f32x4*)(cb + jc);
            const f32x4 w0v = *(const PG8_GAS f32x4*)(cw + 5632 + jc), w1v = *(const PG8_GAS f32x4*)(cw + 11264 + 5632 + jc), w2v = *(const PG8_GAS f32x4*)(cw + 2 * 11264 + 5632 + jc), bv = *(const PG8_GAS f32x4*)(cb + 5632 + jc);
#pragma unroll
            for (int ai = 0; ai < 2; ++ai) {
                const int strip = u.pm * 4 + ai * 2 + wr;
                const f32x4 r4 = *(const PG8_GAS f32x4*)(rs + u.pm * BM + ai * HALF + wr * 64 + 4 * fr);
                const f32x4 xg0 = acc[ai][0][0][n] * r4[0], xg1 = acc[ai][0][1][n] * r4[1], xg2 = acc[ai][0][2][n] * r4[2], xg3 = acc[ai][0][3][n] * r4[3];
                const f32x4 xv0 = acc[ai][1][0][n] * r4[0], xv1 = acc[ai][1][1][n] * r4[1], xv2 = acc[ai][1][2][n] * r4[2], xv3 = acc[ai][1][3][n] * r4[3];
                f32x4 pg3 = shr1_old(zero4, xg3), pg2 = shr1_old(zero4, xg2), pv3 = shr1_old(zero4, xv3), pv2 = shr1_old(zero4, xv2);
                if (sample) {
                    const int sb = (u.pm - 128) * 16 + ai * 8 + wr * 4 + (fr >> 2);
                    if ((fr & 3) == 0) { const float* hp = hist + (size_t)sb * 2 * 11264 + jc;
                        pg2 = *(const PG8_GAS f32x4*)(hp); pg3 = *(const PG8_GAS f32x4*)(hp + 11264); pv2 = *(const PG8_GAS f32x4*)(hp + 5632); pv3 = *(const PG8_GAS f32x4*)(hp + 11264 + 5632); }
                    if ((fr & 3) == 3) { float* op = oconv_s + (size_t)(sb * 2) * 11264 + jc; *(PG8_GAS f32x4*)op = xg2; *(PG8_GAS f32x4*)(op + 5632) = xv2; *(PG8_GAS f32x4*)(op + 11264) = xg3; *(PG8_GAS f32x4*)(op + 11264 + 5632) = xv3; }
                } else {
                    if (fr == 0) { bf16_t* bp = bnd_first + (size_t)(strip * 2) * 11264 + np + 4 * n;
                        u32x2 a; a.x = cvt_pk_bf16(xg0[0], xg0[1]); a.y = cvt_pk_bf16(xg0[2], xg0[3]); *(PG8_GAS u32x2*)bp = a;
                        u32x2 b; b.x = cvt_pk_bf16(xv0[0], xv0[1]); b.y = cvt_pk_bf16(xv0[2], xv0[3]); *(PG8_GAS u32x2*)(bp + 128) = b;
                        u32x2 c; c.x = cvt_pk_bf16(xg1[0], xg1[1]); c.y = cvt_pk_bf16(xg1[2], xg1[3]); *(PG8_GAS u32x2*)(bp + 11264) = c;
                        u32x2 d; d.x = cvt_pk_bf16(xv1[0], xv1[1]); d.y = cvt_pk_bf16(xv1[2], xv1[3]); *(PG8_GAS u32x2*)(bp + 11264 + 128) = d; }
                    if (fr == 15) { bf16_t* bp = bnd_last + (size_t)(strip * 2) * 11264 + np + 4 * n;
                        u32x2 a; a.x = cvt_pk_bf16(xg2[0], xg2[1]); a.y = cvt_pk_bf16(xg2[2], xg2[3]); *(PG8_GAS u32x2*)bp = a;
                        u32x2 b; b.x = cvt_pk_bf16(xv2[0], xv2[1]); b.y = cvt_pk_bf16(xv2[2], xv2[3]); *(PG8_GAS u32x2*)(bp + 128) = b;
                        u32x2 c; c.x = cvt_pk_bf16(xg3[0], xg3[1]); c.y = cvt_pk_bf16(xg3[2], xg3[3]); *(PG8_GAS u32x2*)(bp + 11264) = c;
                        u32x2 d; d.x = cvt_pk_bf16(xv3[0], xv3[1]); d.y = cvt_pk_bf16(xv3[2], xv3[3]); *(PG8_GAS u32x2*)(bp + 11264 + 128) = d;
                        if ((strip & 63) == 63) { float* op = oconv_p + (size_t)((strip >> 6) * 2) * 11264 + jc; *(PG8_GAS f32x4*)op = xg2; *(PG8_GAS f32x4*)(op + 5632) = xv2; *(PG8_GAS f32x4*)(op + 11264) = xg3; *(PG8_GAS f32x4*)(op + 11264 + 5632) = xv3; } }
                }
                const f32x4 cg0 = bg + w0g * pg2 + w1g * pg3 + w2g * xg0, cv0 = bv + w0v * pv2 + w1v * pv3 + w2v * xv0;
                const f32x4 cg1 = bg + w0g * pg3 + w1g * xg0 + w2g * xg1, cv1 = bv + w0v * pv3 + w1v * xv0 + w2v * xv1;
                const f32x4 cg2 = bg + w0g * xg0 + w1g * xg1 + w2g * xg2, cv2 = bv + w0v * xv0 + w1v * xv1 + w2v * xv2;
                const f32x4 cg3 = bg + w0g * xg1 + w1g * xg2 + w2g * xg3, cv3 = bv + w0v * xv1 + w1v * xv2 + w2v * xv3;
                const f32x4 cgs[4] = {cg0, cg1, cg2, cg3}, cvs[4] = {cv0, cv1, cv2, cv3};
#pragma unroll
                for (int m = 0; m < 4; ++m) {
                    u32x2 pk; pk.x = cvt_pk_bf16(silu_mul(cgs[m][0], cvs[m][0]), silu_mul(cgs[m][1], cvs[m][1])); pk.y = cvt_pk_bf16(silu_mul(cgs[m][2], cvs[m][2]), silu_mul(cgs[m][3], cvs[m][3]));
                    if (n == 0) stash[ai][m] = pk;
                    else if (sample || m >= 2 || fr != 0) { const int t = u.pm * BM + ai * HALF + wr * 64 + 4 * fr + m;
                        u32x4 w; w.x = stash[ai][m].x; w.y = stash[ai][m].y; w.z = pk.x; w.w = pk.y; *(PG8_GAS u32x4*)(act + (size_t)t * 5632 + jg) = w; }
                }
            }
        }
    }
};

template <class Epi, class Sched, bool ALIGN_EPI = true>
__device__ __forceinline__ void gemm_phase(PG8_LAS unsigned char* lds, const Sched& S, const Epi& E) {
    int tid_ = threadIdx.x; asm volatile("" : "+v"(tid_));
    const int tid = tid_, wid = __builtin_amdgcn_readfirstlane(tid >> 6), lane = tid & 63, wr = wid >> 2, wc = wid & 3, fr = lane & 15, fq = lane >> 4;
    const int K = S.K, nt = K / BK, lda = S.lda, ldb = S.ldb;
    unsigned voffA[2], voffB[2];
#pragma unroll
    for (int i = 0; i < 2; ++i) { int R, C; stage_rc(tid * 16 + i * 8192, R, C); const int Rb = Epi::PERM ? ((R & ~31) + perm32(R & 31)) : R;
        const int Ra = Epi::APERM ? ((R & ~63) + 4 * (R & 15) + ((R >> 4) & 3)) : R;
        voffA[i] = (unsigned)(Ra * lda + C) * 2u; voffB[i] = (unsigned)(Rb * ldb + C) * 2u; }
    const size_t kstep = (size_t)(BK * 2);
    const size_t hA = (size_t)HALF * lda * 2, hB = (size_t)HALF * ldb * 2;
    const unsigned ldsw = (unsigned)wid * 1024u;
    const int aoff = lds_byte(wr * 64 + fr, fq * 8), boff = lds_byte(wc * 32 + fr, fq * 8);
#define PG8_SA(b, h) (((b) * 2 + (h)) * HTB)
#define PG8_SB(b, h) ((4 + (b) * 2 + (h)) * HTB)
#define PG8_STAGE(bufoff, gbase, voff) do { _Pragma("unroll") for (int _i = 0; _i < 2; ++_i) \
        __builtin_amdgcn_global_load_lds((const unsigned*)((const char*)(gbase) + (voff)[_i]), (PG8_LAS unsigned*)(lds + (bufoff) + ldsw + _i * 8192), 16, 0, 0); } while (0)
#define PG8_LDA(dst, b, h) do { _Pragma("unroll") for (int m = 0; m < 4; ++m) _Pragma("unroll") for (int k = 0; k < 2; ++k) dst[m][k] = *(const PG8_LAS bf16x8*)(lds + PG8_SA(b, h) + aoff + m * 2048 + k * 1024); } while (0)
#define PG8_LDB(dst, b, h) do { _Pragma("unroll") for (int n = 0; n < 2; ++n) _Pragma("unroll") for (int k = 0; k < 2; ++k) dst[n][k] = *(const PG8_LAS bf16x8*)(lds + PG8_SB(b, h) + boff + n * 2048 + k * 1024); } while (0)
#define PG8_MMA(ai, bj, At, Bt) do { __builtin_amdgcn_s_setprio(1); _Pragma("unroll") for (int m = 0; m < 4; ++m) _Pragma("unroll") for (int n = 0; n < 2; ++n) _Pragma("unroll") for (int k = 0; k < 2; ++k) \
        acc[ai][bj][m][n] = __builtin_amdgcn_mfma_f32_16x16x32_bf16(Bt[n][k], At[m][k], acc[ai][bj][m][n], 0, 0, 0); __builtin_amdgcn_s_setprio(0); } while (0)
#define PG8_WAIT_V(n) asm volatile("s_waitcnt vmcnt(" #n ")" ::: "memory")
#define PG8_WAIT_L(n) asm volatile("s_waitcnt lgkmcnt(" #n ")" ::: "memory")
#define PG8_BAR __builtin_amdgcn_s_barrier()
#define PG8_SCHED __builtin_amdgcn_sched_barrier(0)
    Unit cur, nxt; int ui = 0;
    if (!S.next(0, cur)) return;
    f32x4 acc[2][2][4][2];
#pragma unroll
    for (int a = 0; a < 2; ++a)
#pragma unroll
        for (int b = 0; b < 2; ++b)
#pragma unroll
            for (int m = 0; m < 4; ++m)
#pragma unroll
                for (int n = 0; n < 2; ++n) acc[a][b][m][n] = (f32x4){0.f, 0.f, 0.f, 0.f};
    bf16x8 At[4][2], B0[2][2], B1[2][2];
    const char* cA = S.a_ptr(cur); const char* cB = S.b_ptr(cur);
    S.a_ready(cur);
    PG8_STAGE(PG8_SB(0, 0), cB, voffB); PG8_STAGE(PG8_SB(0, 1), cB + hB, voffB); PG8_STAGE(PG8_SA(0, 0), cA, voffA); PG8_STAGE(PG8_SA(0, 1), cA + hA, voffA);
    if (wr == 1) PG8_BAR;
    PG8_WAIT_V(2); PG8_BAR;
    PG8_STAGE(PG8_SB(1, 0), cB + kstep, voffB); PG8_STAGE(PG8_SA(1, 0), cA + kstep, voffA); PG8_STAGE(PG8_SB(1, 1), cB + hB + kstep, voffB);
    PG8_WAIT_V(6); PG8_BAR;
    for (;;) {
        const bool has_next = S.next(ui + 1, nxt);
        const char* nA = has_next ? S.a_ptr(nxt) : cA; const char* nB = has_next ? S.b_ptr(nxt) : cB;
        for (int t = 0; t < nt; t += 2) {
            const bool last = (t == nt - 2);
            const char* a1 = cA + (size_t)(t + 1) * kstep;
            const char* a2 = last ? nA : cA + (size_t)(t + 2) * kstep; const char* b2 = last ? nB : cB + (size_t)(t + 2) * kstep;
            const char* a3 = a2 + kstep; const char* b3 = b2 + kstep;
            if (last && has_next) S.a_ready(nxt);
            PG8_LDB(B0, 0, 0); PG8_LDB(B1, 0, 1); PG8_SCHED; PG8_LDA(At, 0, 0); PG8_STAGE(PG8_SA(1, 1), a1 + hA, voffA);
            PG8_WAIT_V(8); PG8_WAIT_L(0); PG8_BAR; PG8_MMA(0, 0, At, B0); PG8_MMA(0, 1, At, B1); PG8_BAR; PG8_SCHED;
            PG8_LDA(At, 0, 1); PG8_STAGE(PG8_SB(0, 0), b2, voffB); PG8_STAGE(PG8_SB(0, 1), b2 + hB, voffB); PG8_STAGE(PG8_SA(0, 0), a2, voffA);
            PG8_WAIT_V(8); PG8_WAIT_L(0); PG8_BAR; PG8_MMA(1, 0, At, B0); PG8_MMA(1, 1, At, B1); PG8_BAR; PG8_SCHED;
            PG8_LDB(B0, 1, 0); PG8_LDB(B1, 1, 1); PG8_SCHED; PG8_LDA(At, 1, 0); PG8_STAGE(PG8_SA(0, 1), a2 + hA, voffA);
            PG8_WAIT_V(8); PG8_WAIT_L(0); PG8_BAR; PG8_MMA(0, 0, At, B0); PG8_MMA(0, 1, At, B1); PG8_BAR; PG8_SCHED;
            PG8_LDA(At, 1, 1); PG8_STAGE(PG8_SB(1, 0), b3, voffB); PG8_STAGE(PG8_SB(1, 1), b3 + hB, voffB); PG8_STAGE(PG8_SA(1, 0), a3, voffA);
            PG8_WAIT_V(8); PG8_WAIT_L(0); PG8_BAR; PG8_MMA(1, 0, At, B0); PG8_MMA(1, 1, At, B1); PG8_BAR; PG8_SCHED;
        }
        if constexpr (ALIGN_EPI) { if (wr == 0) PG8_BAR; }
        E(acc, cur, wr, wc, fr, fq); S.done(cur);
        if (!has_next) break;
#pragma unroll
        for (int a = 0; a < 2; ++a)
#pragma unroll
            for (int b = 0; b < 2; ++b)
#pragma unroll
                for (int m = 0; m < 4; ++m)
#pragma unroll
                    for (int n = 0; n < 2; ++n) acc[a][b][m][n] = (f32x4){0.f, 0.f, 0.f, 0.f};
        cur = nxt; cA = nA; cB = nB; ++ui;
        if constexpr (ALIGN_EPI) { if (wr == 1) PG8_BAR; }
    }
    PG8_WAIT_V(0);
    if constexpr (!ALIGN_EPI) { if (wr == 0) PG8_BAR; }
    PG8_BAR;
#undef PG8_SA
#undef PG8_SB
#undef PG8_STAGE
#undef PG8_LDA
#undef PG8_LDB
#undef PG8_MMA
#undef PG8_WAIT_V
#undef PG8_WAIT_L
#undef PG8_BAR
#undef PG8_SCHED
}
}
namespace att {
#define ATT_LAS __attribute__((address_space(3)))
typedef unsigned short bf16;
using bf16x8 = __attribute__((ext_vector_type(8))) short;
using s16x4  = __attribute__((ext_vector_type(4))) short;
using f32x16 = __attribute__((ext_vector_type(16))) float;
using u32x4  = __attribute__((ext_vector_type(4))) unsigned;
constexpr int NW = 8, QBLK = 32, KVBLK = 64;
constexpr float SCALE = 0.07216878364870322f;
constexpr float THR = 8.f;
constexpr int LDQ = 3072, LDK = 3072, LDV = 2048, LDO = 2048;
constexpr int SHM_V = KVBLK * 128 * 2, SHM_K = KVBLK * 192 * 2, OFF_K = 0, OFF_V = 2 * SHM_K, OFF_WS = OFF_V + 3 * SHM_V, SHM_ATTN = OFF_WS + NW * 64 * 4;
#define KSWZ(row, colB) ((row) * 384 + ((colB) ^ (((row) & 7) << 4)))
#define SBAR() __builtin_amdgcn_sched_barrier(0)
__device__ __forceinline__ int crow(int r, int hi) { return (r & 3) + 8 * (r >> 2) + 4 * hi; }
__device__ __forceinline__ unsigned cvtpk(float lo, float hi) { unsigned r; asm volatile("v_cvt_pk_bf16_f32 %0, %1, %2" : "=v"(r) : "v"(lo), "v"(hi)); return r; }
__device__ __forceinline__ __amdgpu_buffer_rsrc_t mk_rsrc(const void* p) {
  const unsigned long a = (unsigned long)p; const unsigned lo = __builtin_amdgcn_readfirstlane((unsigned)a), hi = __builtin_amdgcn_readfirstlane((unsigned)(a >> 32));
  return __builtin_amdgcn_make_buffer_rsrc((void*)(((unsigned long)hi << 32) | lo), (short)0, 0x7fffffff, 0x00020000);
}
__device__ __forceinline__ bf16x8 ld8(const bf16* p) { return *(const __attribute__((address_space(1))) bf16x8*)p; }

__device__ __forceinline__ void partialSM(f32x16& p0, f32x16& p1, float& m_reg, float& mn, float& alpha, bool dead) {
  constexpr float C = SCALE * 1.4426950408889634f;
  if (dead) {
#pragma unroll
    for (int r = 0; r < 16; ++r) { p0[r] = -__builtin_inff(); p1[r] = -__builtin_inff(); }
  }
  float pmax = p0[0];
#pragma unroll
  for (int r = 1; r < 16; ++r) pmax = fmaxf(pmax, p0[r]);
#pragma unroll
  for (int r = 0; r < 16; ++r) pmax = fmaxf(pmax, p1[r]);
  { auto rr = __builtin_amdgcn_permlane32_swap(__float_as_uint(pmax), __float_as_uint(pmax), false, false);
    pmax = fmaxf(__uint_as_float(rr[0]), __uint_as_float(rr[1])); }
  if (__builtin_expect(__all(pmax - m_reg <= THR / SCALE), 1)) { mn = m_reg; alpha = 1.f; }
  else { mn = fmaxf(m_reg, pmax); alpha = __builtin_amdgcn_exp2f((m_reg - mn) * C); m_reg = mn; }
  float mnC = -mn * C;
#pragma unroll
  for (int r = 0; r < 16; ++r) p0[r] = fmaf(p0[r], C, mnC);
#pragma unroll
  for (int r = 0; r < 16; ++r) p1[r] = fmaf(p1[r], C, mnC);
#pragma unroll
  for (int r = 0; r < 16; ++r) p0[r] = __builtin_amdgcn_exp2f(p0[r]);
}
__device__ __forceinline__ void finishSM(f32x16& p0, f32x16& p1, float alpha, float& l_reg, bf16x8& pa0, bf16x8& pa1, bf16x8& pa2, bf16x8& pa3) {
#pragma unroll
  for (int r = 0; r < 16; ++r) p1[r] = __builtin_amdgcn_exp2f(p1[r]);
  float ps = 0;
#pragma unroll
  for (int r = 0; r < 16; ++r) ps += p0[r];
#pragma unroll
  for (int r = 0; r < 16; ++r) ps += p1[r];
  { auto rr = __builtin_amdgcn_permlane32_swap(__float_as_uint(ps), __float_as_uint(ps), false, false);
    ps = __uint_as_float(rr[0]) + __uint_as_float(rr[1]); }
  l_reg = l_reg * alpha + ps;
#define PK4(P, BASE, OUT) do { unsigned a0 = cvtpk(P[BASE + 0], P[BASE + 1]), a1 = cvtpk(P[BASE + 2], P[BASE + 3]);   \
    unsigned b0 = cvtpk(P[BASE + 4], P[BASE + 5]), b1 = cvtpk(P[BASE + 6], P[BASE + 7]);                              \
    auto r0 = __builtin_amdgcn_permlane32_swap(a0, b0, false, false); auto r1 = __builtin_amdgcn_permlane32_swap(a1, b1, false, false); \
    u32x4 w = {r0[0], r1[0], r0[1], r1[1]}; OUT = *reinterpret_cast<bf16x8*>(&w); } while (0)
  PK4(p0, 0, pa0); PK4(p0, 8, pa1); PK4(p1, 0, pa2); PK4(p1, 8, pa3);
#undef PK4
}
__device__ __forceinline__ void qkt(f32x16& p0, f32x16& p1, const ATT_LAS char* Ks, const bf16x8* qr, int r32, int hi) {
  p0 = f32x16{}; p1 = f32x16{};
  bf16x8 ka = *reinterpret_cast<const ATT_LAS bf16x8*>(Ks + KSWZ(r32, hi * 16)), kb = *reinterpret_cast<const ATT_LAS bf16x8*>(Ks + KSWZ(32 + r32, hi * 16));
#pragma unroll
  for (int d0 = 0; d0 < 12; ++d0) {
    bf16x8 na = ka, nb = kb;
    if (d0 < 11) { const int cb = ((d0 + 1) * 16 + hi * 8) * 2;
      na = *reinterpret_cast<const ATT_LAS bf16x8*>(Ks + KSWZ(r32, cb)); nb = *reinterpret_cast<const ATT_LAS bf16x8*>(Ks + KSWZ(32 + r32, cb)); }
    p0 = __builtin_amdgcn_mfma_f32_32x32x16_bf16(ka, qr[d0], p0, 0, 0, 0);
    p1 = __builtin_amdgcn_mfma_f32_32x32x16_bf16(kb, qr[d0], p1, 0, 0, 0);
    ka = na; kb = nb; }
}
__device__ __forceinline__ int v_st(int k, int c) { const int kk = (k & ~0xC) | ((k & 4) << 1) | ((k & 8) >> 1); return ((kk >> 3) * 4 + (c >> 5)) * 512 + ((kk & 7) * 32 + (c & 31)) * 2; }
__device__ __forceinline__ int v_rd_base(int lane) { return ((lane & 3) << 3) | (((lane >> 2) & 3) << 6) | (((lane >> 4) & 1) << 5) | (((lane >> 5) & 1) << 8); }
constexpr int v_rd_off(int d0, int ks, int half) { return d0 * 512 + ks * 4096 + half * 2048; }
template <int OFF> __device__ __forceinline__ s16x4 tr_read(int vb) {
  s16x4 r; asm volatile("ds_read_b64_tr_b16 %0, %1 offset:%2" : "=&v"(r) : "v"(vb), "i"(OFF) : "memory"); return r;
}
template <int D0> __device__ __forceinline__ void pv_one(f32x16& od, int vb, bf16x8 pa0, bf16x8 pa1, bf16x8 pa2, bf16x8 pa3) {
  const s16x4 l0 = tr_read<v_rd_off(D0, 0, 0)>(vb), h0 = tr_read<v_rd_off(D0, 0, 1)>(vb), l1 = tr_read<v_rd_off(D0, 1, 0)>(vb), h1 = tr_read<v_rd_off(D0, 1, 1)>(vb);
  const s16x4 l2 = tr_read<v_rd_off(D0, 2, 0)>(vb), h2 = tr_read<v_rd_off(D0, 2, 1)>(vb), l3 = tr_read<v_rd_off(D0, 3, 0)>(vb), h3 = tr_read<v_rd_off(D0, 3, 1)>(vb);
  asm volatile("s_waitcnt lgkmcnt(0)" ::: "memory"); SBAR();
#define PK(L, H) (bf16x8){L[0], L[1], L[2], L[3], H[0], H[1], H[2], H[3]}
  od = __builtin_amdgcn_mfma_f32_32x32x16_bf16(pa0, PK(l0, h0), od, 0, 0, 0);
  od = __builtin_amdgcn_mfma_f32_32x32x16_bf16(pa1, PK(l1, h1), od, 0, 0, 0);
  od = __builtin_amdgcn_mfma_f32_32x32x16_bf16(pa2, PK(l2, h2), od, 0, 0, 0);
  od = __builtin_amdgcn_mfma_f32_32x32x16_bf16(pa3, PK(l3, h3), od, 0, 0, 0);
#undef PK
}
__device__ __forceinline__ void pv_d0(f32x16* o, int vb, bf16x8 pa0, bf16x8 pa1, bf16x8 pa2, bf16x8 pa3) {
  pv_one<0>(o[0], vb, pa0, pa1, pa2, pa3); pv_one<1>(o[1], vb, pa0, pa1, pa2, pa3); pv_one<2>(o[2], vb, pa0, pa1, pa2, pa3); pv_one<3>(o[3], vb, pa0, pa1, pa2, pa3);
}

__device__ __forceinline__ void attn_unit(const bf16* __restrict__ Qb, const bf16* __restrict__ Kh, const bf16* __restrict__ Vh,
                                          bf16* __restrict__ Ob, int NT, int qb, ATT_LAS char* lds) {
  int tid_ = threadIdx.x; asm volatile("" : "+v"(tid_));
  const int tid = tid_, wid = __builtin_amdgcn_readfirstlane(tid >> 6), lane = tid & 63, r32 = lane & 31, hi = lane >> 5;
  const int lim = 4 * qb + (wid >> 1);
  ATT_LAS char* K_lds = lds + OFF_K; ATT_LAS char* V_lds = lds + OFF_V;
  ATT_LAS float* ws = (ATT_LAS float*)(lds + OFF_WS) + wid * 64; ATT_LAS float* li_l = ws; ATT_LAS float* al_l = ws + 32;
  unsigned ko[3], vo[2];
#pragma unroll
  for (int i = 0; i < 3; ++i) { const int s = i * 512 + tid, row = s / 24, cs = s - row * 24, c = (cs & ~7) | ((cs ^ row) & 7); ko[i] = (unsigned)(row * (LDK * 2) + c * 16); }
#pragma unroll
  for (int i = 0; i < 2; ++i) { const int B = (i * 512 + tid) * 16, sub = B >> 9, within = B & 511, kk = (sub >> 2) * 8 + (within >> 6), k = (kk & ~0xC) | ((kk & 4) << 1) | ((kk & 8) >> 1), col = (sub & 3) * 32 + ((within & 63) >> 1);
    vo[i] = (unsigned)(k * (LDV * 2) + col * 2); }
  const int ldsw = wid * 1024;
#define DMA(t, vs) do { const char* kt_ = (const char*)Kh + (size_t)(t) * (KVBLK * LDK * 2); const char* vt_ = (const char*)Vh + (size_t)(t) * (KVBLK * LDV * 2); \
    ATT_LAS char* kd_ = K_lds + ((t) & 1) * SHM_K + ldsw; ATT_LAS char* vd_ = V_lds + (vs) * SHM_V + ldsw; \
    _Pragma("unroll") for (int i_ = 0; i_ < 3; ++i_) __builtin_amdgcn_global_load_lds((const __attribute__((address_space(1))) unsigned*)(kt_ + ko[i_]), (ATT_LAS unsigned*)(kd_ + i_ * 8192), 16, 0, 0); \
    _Pragma("unroll") for (int i_ = 0; i_ < 2; ++i_) __builtin_amdgcn_global_load_lds((const __attribute__((address_space(1))) unsigned*)(vt_ + vo[i_]), (ATT_LAS unsigned*)(vd_ + i_ * 8192), 16, 0, 0); } while (0)
#define WAITBAR() do { asm volatile("s_waitcnt vmcnt(0)" ::: "memory"); __builtin_amdgcn_s_barrier(); asm volatile("" ::: "memory"); } while (0)
#define RESC(a) do { if (__any((a) < 1.f)) { if (hi == 0) al_l[r32] = (a); asm volatile("s_waitcnt lgkmcnt(0)" ::: "memory"); \
    _Pragma("unroll") for (int d = 0; d < 4; ++d) _Pragma("unroll") for (int r = 0; r < 16; ++r) o[d][r] *= al_l[crow(r, hi)]; } } while (0)
  DMA(0, 0);
  float m_reg = -1e30f, l_reg = 0; f32x16 o[4] = {}; bf16x8 qr[12];
  const bf16* Qw = Qb + (long)(wid * QBLK + r32) * LDQ + hi * 8;
#pragma unroll
  for (int d0 = 0; d0 < 12; ++d0) qr[d0] = ld8(Qw + d0 * 16);
  const int vb0 = (int)(unsigned)(unsigned long)V_lds + v_rd_base(lane);
  f32x16 pA0, pA1, pB0, pB1; float mnA, mnB, alA, alB; bf16x8 pa0, pa1, pa2, pa3;
  WAITBAR();
#pragma unroll
  for (int d0 = 0; d0 < 12; ++d0) asm volatile("" : "+v"(qr[d0]));
  DMA(1, 1);
  qkt(pA0, pA1, K_lds, qr, r32, hi); partialSM(pA0, pA1, m_reg, mnA, alA, false);
  int vsn = 2, vsp = 0;
  for (int j = 1; j + 1 < NT; j += 2) {
    WAITBAR();
    DMA(j + 1, vsn); vsn = vsn == 2 ? 0 : vsn + 1;
    SBAR(); qkt(pB0, pB1, K_lds + SHM_K, qr, r32, hi);
    finishSM(pA0, pA1, alA, l_reg, pa0, pa1, pa2, pa3); SBAR();
    pv_d0(o, vb0 + vsp * SHM_V, pa0, pa1, pa2, pa3); vsp = vsp == 2 ? 0 : vsp + 1; partialSM(pB0, pB1, m_reg, mnB, alB, j > lim);
    RESC(alB);
    WAITBAR();
    DMA(j + 2, vsn); vsn = vsn == 2 ? 0 : vsn + 1;
    SBAR(); qkt(pA0, pA1, K_lds, qr, r32, hi);
    finishSM(pB0, pB1, alB, l_reg, pa0, pa1, pa2, pa3); SBAR();
    pv_d0(o, vb0 + vsp * SHM_V, pa0, pa1, pa2, pa3); vsp = vsp == 2 ? 0 : vsp + 1; partialSM(pA0, pA1, m_reg, mnA, alA, j + 1 > lim);
    RESC(alA);
  }
  WAITBAR();
  SBAR(); qkt(pB0, pB1, K_lds + SHM_K, qr, r32, hi);
  finishSM(pA0, pA1, alA, l_reg, pa0, pa1, pa2, pa3); SBAR();
  pv_d0(o, vb0 + vsp * SHM_V, pa0, pa1, pa2, pa3); vsp = vsp == 2 ? 0 : vsp + 1; partialSM(pB0, pB1, m_reg, mnB, alB, NT - 1 > lim);
  RESC(alB);
  finishSM(pB0, pB1, alB, l_reg, pa0, pa1, pa2, pa3); SBAR();
  pv_d0(o, vb0 + vsp * SHM_V, pa0, pa1, pa2, pa3);
  if (hi == 0) li_l[r32] = l_reg; asm volatile("s_waitcnt lgkmcnt(0)" ::: "memory");
  float rli[16];
#pragma unroll
  for (int r = 0; r < 16; ++r) rli[r] = __builtin_amdgcn_rcpf(li_l[crow(r, hi)]);
  bf16* Ow = Ob + (long)(wid * QBLK) * LDO;
#pragma unroll
  for (int r = 0; r < 16; ++r) { const int orow = crow(r, hi);
#pragma unroll
    for (int d0 = 0; d0 < 4; ++d0) { const float v = o[d0][r] * rli[r]; unsigned u = __float_as_uint(v); u = (u + 0x7fffu + ((u >> 16) & 1u)) >> 16; ((__attribute__((address_space(1))) bf16*)Ow)[(long)orow * LDO + d0 * 32 + r32] = (bf16)u; } }
  asm volatile("s_waitcnt lgkmcnt(0)" ::: "memory"); __builtin_amdgcn_s_barrier(); asm volatile("" ::: "memory");
#undef DMA
#undef WAITBAR
#undef RESC
}
#undef KSWZ
#undef SBAR
}
constexpr int NWAVES = 8;
constexpr int TP = 32768, TS = 512, T = TP + TS, DM = 2048, DFF = 5632, NUP = 2 * DFF, SEQ = 4096;
constexpr float EPS = 1e-6f;
static_assert((2048 + 16 - 1) / 64 == 2048 / 64, "all cache keys and new keys of a sample stream lie in chunks <= the query chunk: the chunk mask is all-true for the sample streams");
constexpr size_t O_Y = 0, O_CKV_P = O_Y + (size_t)T * DM, O_KR_P = O_CKV_P + (size_t)2 * TP * 512, O_POOL_P = O_KR_P + (size_t)2 * TP * 64, O_CONV_P = O_POOL_P + (size_t)2 * 8 * 15 * DM,
                 O_CKV_S = O_CONV_P + (size_t)4 * 8 * 2 * NUP, O_KR_S = O_CKV_S + (size_t)2 * TS * 512, O_POOL_S = O_KR_S + (size_t)2 * TS * 64, O_CONV_S = O_POOL_S + (size_t)2 * 32 * 15 * DM,
                 O_END = O_CONV_S + (size_t)4 * 32 * 2 * NUP;
static_assert(O_END == 112558080, "d_out size");
constexpr size_t MiB = 1u << 20;
constexpr size_t WS_CTL = 0, CTL_ZERO_BYTES = 1 * MiB;
constexpr size_t WS_ROPE = 1 * MiB;
constexpr size_t WS_RS = 2 * MiB;
constexpr size_t WS_W = 3 * MiB;
constexpr size_t W_MLA = 24 * MiB;
constexpr size_t WO_DQKV = 0, WO_UQ = 5 * MiB, WO_UKV = 8 * MiB, WO_UK2 = 12 * MiB, WO_O = 16 * MiB;
constexpr size_t WS_WPOOL = WS_W + 2 * W_MLA;
constexpr size_t WS_WFFN = WS_WPOOL + 4 * MiB, WO_UP = 0, WO_DOWN = 44 * MiB;
constexpr size_t WS_HB = WS_WFFN + 66 * MiB;
constexpr size_t WS_MB = WS_HB + 130 * MiB;
constexpr size_t WS_S = WS_MB, WS_P = WS_MB + 72 * MiB;
constexpr size_t WS_BND = WS_MB + 130 * MiB;
constexpr size_t WS_XB = WS_BND + 44 * MiB;
constexpr size_t WS_SLAB = WS_XB + 130 * MiB;
constexpr size_t WS_BIG = WS_SLAB + 44 * MiB;
constexpr size_t WS_ACT = WS_BIG;
constexpr size_t WS_Q = WS_BIG, WS_CQ = WS_BIG + 196 * MiB, WS_CKVB = WS_BIG + 229 * MiB, WS_KRB = WS_BIG + 261 * MiB, WS_K2 = WS_BIG + 265 * MiB, WS_V2 = WS_K2 + 192 * MiB;
constexpr size_t WS_KALL = WS_K2, WS_VT = WS_K2 + 90 * MiB, WS_QLAT = WS_K2 + 162 * MiB, WS_OL = WS_K2 + 172 * MiB;
constexpr size_t WS_END = WS_V2 + 128 * MiB;
static_assert(WS_HB == 121 * MiB && WS_END == 1184 * MiB, "ws map");
static_assert((size_t)T * 1280 * 4 <= 174 * MiB && (size_t)T * 5632 * 2 <= WS_END - WS_BIG && (size_t)T * 3072 * 2 + 4096 <= 196 * MiB && (size_t)11 * 512 * 2048 * 4 <= 44 * MiB && WS_OL + 8 * MiB <= WS_V2, "ws aliases");
constexpr int CW_BAR = 4096;

#define GAS __attribute__((address_space(1)))
#define LAS __attribute__((address_space(3)))
typedef unsigned short bf16;
typedef unsigned v4u __attribute__((ext_vector_type(4)));
typedef unsigned v2u __attribute__((ext_vector_type(2)));
typedef float f32x4 __attribute__((ext_vector_type(4)));
typedef short bf16x8 __attribute__((ext_vector_type(8)));
#define LDS_WAIT() asm volatile("s_waitcnt lgkmcnt(0)" ::: "memory")
#define VM_WAIT() asm volatile("s_waitcnt vmcnt(0)" ::: "memory")
__device__ __forceinline__ unsigned f2bf(float f) { unsigned u = __builtin_bit_cast(unsigned, f); return (u + 0x7fffu + ((u >> 16) & 1u)) >> 16; }
__device__ __forceinline__ unsigned pk2(float lo, float hi) { return f2bf(lo) | (f2bf(hi) << 16); }
__device__ __forceinline__ float bflo(unsigned w) { return __builtin_bit_cast(float, w << 16); }
__device__ __forceinline__ float bfhi(unsigned w) { return __builtin_bit_cast(float, w & 0xffff0000u); }

#define XB_TMO      128
#define XB_XCNT(j)  (256  + 64 * (j))
#define XB_XSUB(j)  (1280 + 64 * (j))
#define XB_XGEN(j)  (2304 + 64 * (j))
#define XB_TOP      3328
#define XB_TOPGEN   3392
#define XCD_BAR_WORDS 3456
#define XB_SPIN_CAP (1u << 18)
__device__ __forceinline__ unsigned xb_ld(unsigned* p)              { return __hip_atomic_load(p, __ATOMIC_RELAXED, __HIP_MEMORY_SCOPE_AGENT); }
__device__ __forceinline__ unsigned xb_add(unsigned* p, unsigned v) { return __hip_atomic_fetch_add(p, v, __ATOMIC_RELAXED, __HIP_MEMORY_SCOPE_AGENT); }
__device__ __forceinline__ unsigned xb_xcc_id() { return (unsigned)__builtin_amdgcn_s_getreg((3 << 11) | 20) & 0xFu; }
#define XB_SPIN(cond, bar) do { unsigned _sp = 0; while (cond) { __builtin_amdgcn_s_sleep(1); \
    if ((++_sp & 255u) == 0u) { if (xb_ld(&(bar)[XB_TMO])) break; if (_sp > XB_SPIN_CAP) { atomicAdd(&(bar)[XB_TMO], 1u); break; } } } } while (0)
struct XcdBarrier { unsigned* bar; unsigned x; volatile LAS unsigned* st; };
__device__ __forceinline__ XcdBarrier xcd_barrier_post(unsigned* bar, volatile LAS unsigned* st) {
    XcdBarrier b; b.bar = bar; b.x = xb_xcc_id(); b.st = st;
    if (threadIdx.x == 0) (void)xb_add(&bar[XB_XCNT(b.x)], 1u);
    return b;
}
__device__ __forceinline__ void xcd_barrier_complete(unsigned* bar, unsigned x, unsigned& nloc, unsigned& nx) {
    const unsigned G = gridDim.x * gridDim.y * gridDim.z;
    unsigned sum, cnt, mine, sp = 0u;
    for (;;) {
        sum = 0u; cnt = 0u; mine = 0u;
#pragma unroll
        for (unsigned j = 0; j < 16; ++j) { const unsigned c = xb_ld(&bar[XB_XCNT(j)]); sum += c; cnt += (c > 0u) ? 1u : 0u; mine = (j == x) ? c : mine; }
        if (sum == G) break;
        __builtin_amdgcn_s_sleep(1);
        if ((++sp & 255u) == 0u) { if (xb_ld(&bar[XB_TMO])) break; if (sp > XB_SPIN_CAP) { atomicAdd(&bar[XB_TMO], 1u); break; } }
    }
    nloc = mine > 0u ? mine : 1u; nx = cnt > 0u ? cnt : 1u;
}
__device__ __forceinline__ void xcd_barrier(const XcdBarrier& b) {
    asm volatile("s_waitcnt vmcnt(0)" ::: "memory");
    __syncthreads();
    if (threadIdx.x == 0) {
        unsigned* bar = b.bar;
        __builtin_amdgcn_s_waitcnt(0);
        unsigned nloc = b.st[0], nx = b.st[1];
        if (nloc == 0u) { xcd_barrier_complete(bar, b.x, nloc, nx); b.st[0] = nloc; b.st[1] = nx; }
        const unsigned old = xb_add(&bar[XB_XSUB(b.x)], 1u);
        const unsigned gen = old / nloc;
        if (old + 1u == (gen + 1u) * nloc) {
            __builtin_amdgcn_fence(__ATOMIC_RELEASE, "agent");
            asm volatile("s_waitcnt vmcnt(0)" ::: "memory");
            const unsigned og = xb_add(&bar[XB_TOP], 1u);
            const unsigned tg = og / nx;
            if (og + 1u == (tg + 1u) * nx) xb_add(&bar[XB_TOPGEN], 1u);
            else XB_SPIN(xb_ld(&bar[XB_TOPGEN]) == tg, bar);
            __builtin_amdgcn_fence(__ATOMIC_ACQUIRE, "agent");
            xb_add(&bar[XB_XGEN(b.x)], 1u);
            asm volatile("s_waitcnt vmcnt(0)" ::: "memory");
        } else {
            XB_SPIN(xb_ld(&bar[XB_XGEN(b.x)]) == gen, bar);
            __builtin_amdgcn_fence(__ATOMIC_ACQUIRE, "agent");
            asm volatile("s_waitcnt vmcnt(0)" ::: "memory");
        }
    }
    __syncthreads();
}

constexpr int RING_OFF = 0, RING_BYTES = 131072;
constexpr int LDSCTL_OFF = RING_BYTES, MISC_OFF = LDSCTL_OFF + 320;
constexpr int LDS_BYTES = 147456;
static_assert(att::SHM_ATTN <= RING_BYTES, "attention scratch fits the ring");

struct Frame {
    LAS unsigned char* lds;
    int tid, lane, wave;
    int vcu, G;
    float* out; unsigned char* ws;
};
constexpr int PTR_OFF = MISC_OFF + 256;
__device__ __forceinline__ const float* inp(const Frame& F, int i) {
    int off = PTR_OFF + 8 * i; asm volatile("" : "+s"(off));
    const unsigned long long v = *(const LAS unsigned long long*)(F.lds + off);
    const unsigned lo = __builtin_amdgcn_readfirstlane((unsigned)v), hi = __builtin_amdgcn_readfirstlane((unsigned)(v >> 32));
    return (const float*)(((unsigned long long)hi << 32) | lo);
}
__device__ __forceinline__ void frame_lanes(Frame& F) {
    int t = threadIdx.x; asm volatile("" : "+v"(t)); F.tid = t; F.lane = t & 63; F.wave = __builtin_amdgcn_readfirstlane(t >> 6);
    unsigned long long w = (unsigned long long)F.ws, o = (unsigned long long)F.out; unsigned l = (unsigned)(unsigned long long)F.lds; int g = F.G, v = F.vcu;
    asm volatile("" : "+s"(w), "+s"(o), "+s"(l), "+s"(g), "+s"(v));
    F.ws = (unsigned char*)w; F.out = (float*)o; F.lds = (LAS unsigned char*)(unsigned long long)l; F.G = g; F.vcu = v;
}
__device__ __forceinline__ float shx(float v, int o, int lane) { return __builtin_bit_cast(float, __builtin_amdgcn_ds_bpermute((lane ^ o) << 2, __builtin_bit_cast(int, v))); }
__device__ __forceinline__ float wave_sum(float v, int lane) {
#pragma unroll
    for (int o = 1; o < 64; o <<= 1) v += shx(v, o, lane);
    return v;
}
__device__ __forceinline__ float wave_max(float v, int lane) {
#pragma unroll
    for (int o = 1; o < 64; o <<= 1) v = fmaxf(v, shx(v, o, lane));
    return v;
}

__device__ __forceinline__ int dest_row(int map, int row_off, int n) {
    if (map == 1) { return n < DFF ? ((n >> 7) * 256 + (n & 127)) : (((n - DFF) >> 7) * 256 + 128 + ((n - DFF) & 127)); }
    if (map == 2) { const int h = n / 192, d = n - h * 192; if (d < 128) return n; const int i = d - 128; return h * 192 + 128 + (i < 32 ? 2 * i : 2 * (i - 32) + 1); }
    return row_off + n;
}
__device__ __forceinline__ void transpose_item(const float* W, int ldw, bf16* WT, int ldt, int map, int row_off, int kb, int nb, LAS float* scr, int lane, const float* ks = nullptr) {
    const int k0 = 64 * kb, n0 = 32 * nb;
#pragma unroll
    for (int i = 0; i < 8; ++i) { const int kk = 8 * i + (lane >> 3), c4 = (lane & 7) * 4; f32x4 v = *(const GAS f32x4*)(W + (size_t)(k0 + kk) * ldw + n0 + c4);
        if (ks) v = v * ((const GAS float*)ks)[k0 + kk];
        LAS float* d = scr + kk * 33 + c4; d[0] = v.x; d[1] = v.y; d[2] = v.z; d[3] = v.w; }
    LDS_WAIT(); asm volatile("" ::: "memory");
    const int c = lane & 7;
#pragma unroll
    for (int j = 0; j < 4; ++j) { const int n = (lane >> 3) + 8 * j; const LAS float* s = scr + (8 * c) * 33 + n;
        v4u o; o.x = pk2(s[0 * 33], s[1 * 33]); o.y = pk2(s[2 * 33], s[3 * 33]); o.z = pk2(s[4 * 33], s[5 * 33]); o.w = pk2(s[6 * 33], s[7 * 33]);
        *(GAS v4u*)(WT + (size_t)dest_row(map, row_off, n0 + n) * ldt + k0 + 8 * c) = o; }
    LDS_WAIT(); asm volatile("" ::: "memory");
}

__device__ __forceinline__ void p0_prologue(Frame& F) {
    frame_lanes(F);
    LAS float* scr = (LAS float*)(F.lds + RING_OFF + F.wave * 16384);
    const int gw = F.vcu * NWAVES + F.wave, NGW = F.G * NWAVES;
    {
        float* ct = (float*)(F.ws + WS_ROPE); float* st = ct + 4096 * 32;
        for (int idx = (F.vcu * NWAVES + F.wave) * 64 + F.lane; idx < 4096 * 32; idx += NGW * 64) {
            const int pos = idx >> 5, i = idx & 31;
            double inv = 1.0; for (int k = 0; k < i; ++k) inv *= 0.7498942093324558273;
            double a = (double)pos * inv;
            const double twopi = 6.283185307179586476925287; a -= twopi * __builtin_rint(a / twopi);
            const double x = a * 0.125, x2 = x * x;
            double s = x * (1.0 + x2 * (-1.0 / 6 + x2 * (1.0 / 120 + x2 * (-1.0 / 5040 + x2 * (1.0 / 362880 + x2 * (-1.0 / 39916800))))));
            double c = 1.0 + x2 * (-0.5 + x2 * (1.0 / 24 + x2 * (-1.0 / 720 + x2 * (1.0 / 40320 + x2 * (-1.0 / 3628800 + x2 * (1.0 / 479001600))))));
#pragma unroll
            for (int k = 0; k < 3; ++k) { const double s2 = 2.0 * s * c, c2 = 1.0 - 2.0 * s * s; s = s2; c = c2; }
            ((GAS float*)ct)[idx] = (float)c; ((GAS float*)st)[idx] = (float)s;
        }
    }
    constexpr int I_DQ = 32 * 16, I_DKV = 32 * 18, I_UQ = 8 * 96, I_UK = 8 * 64, I_UV = 8 * 64, I_O = 32 * 64, I_MLA = I_DQ + I_DKV + I_UQ + I_UK + I_UV + I_O;
    constexpr int I_POOL = 4 * 8 * 16;
    constexpr int NITEMS = 2 * I_MLA + 2 * I_POOL;
    for (int it = gw; it < NITEMS; it += NGW) {
        const float* W; const float* ks = nullptr; int ldw, ldt, map = 0, row_off = 0, nnb, r; bf16* WT;
        if (it < 2 * I_MLA) {
            const int j = it / I_MLA; r = it - j * I_MLA; unsigned char* wb = F.ws + WS_W + j * W_MLA;
            if (r < I_DQ) { W = inp(F, 7) + (size_t)j * 2048 * 512; ldw = 512; WT = (bf16*)(wb + WO_DQKV); ldt = 2048; nnb = 16; ks = inp(F, 6) + (size_t)(2 * j) * 4 * DM; }
            else if ((r -= I_DQ) < I_DKV) { W = inp(F, 10) + (size_t)j * 2048 * 576; ldw = 576; WT = (bf16*)(wb + WO_DQKV); ldt = 2048; nnb = 18; row_off = 512; ks = inp(F, 6) + (size_t)(2 * j) * 4 * DM; }
            else if ((r -= I_DKV) < I_UQ) { W = inp(F, 9) + (size_t)j * 512 * 3072; ldw = 3072; WT = (bf16*)(wb + WO_UQ); ldt = 512; nnb = 96; map = 2; }
            else if ((r -= I_UQ) < I_UK) { W = inp(F, 12) + (size_t)j * 512 * 2048; ldw = 2048; WT = (bf16*)(wb + WO_UKV); ldt = 512; nnb = 64; }
            else if ((r -= I_UK) < I_UV) { W = inp(F, 13) + (size_t)j * 512 * 2048; ldw = 2048; WT = (bf16*)(wb + WO_UKV); ldt = 512; nnb = 64; row_off = 2048; }
            else { r -= I_UV; W = inp(F, 14) + (size_t)j * 2048 * 2048; ldw = 2048; WT = (bf16*)(wb + WO_O); ldt = 2048; nnb = 64; }
        } else {
            r = it - 2 * I_MLA; const int jg = r / (8 * 16); r -= jg * (8 * 16);
            W = inp(F, 15) + (size_t)jg * 512 * 512; ldw = 512; WT = (bf16*)(F.ws + WS_WPOOL + (size_t)(jg >> 2) * 2 * MiB); ldt = 512; nnb = 16; row_off = (jg & 3) * 512;
        }
        transpose_item(W, ldw, WT, ldt, map, row_off, r / nnb, r % nnb, scr, F.lane, ks);
    }
    for (int row = gw; row < 2 * 8192; row += NGW) {
        const int j = row >> 13, hc = row & 8191, h = hc >> 9, c = hc & 511;
        const GAS float* src = (const GAS float*)(inp(F, 12) + (size_t)j * 512 * 2048 + (size_t)c * 2048 + h * 128 + 2 * F.lane);
        GAS unsigned* dst = (GAS unsigned*)((unsigned*)(F.ws + WS_W + j * W_MLA + WO_UK2) + (size_t)hc * 128);
        dst[F.lane] = pk2(src[0], src[1]); dst[64 + F.lane] = 0u;
    }
}

__device__ __forceinline__ void convert_ffn(Frame& F, int L) {
    LAS float* scr = (LAS float*)(F.lds + RING_OFF + F.wave * 16384);
    const int gw = F.vcu * NWAVES + F.wave, NGW = F.G * NWAVES;
    constexpr int I_UP = 32 * 352, I_DN = 88 * 64;
    const float* wu = inp(F, 17) + (size_t)L * 2048 * NUP; const float* wd = inp(F, 20) + (size_t)L * DFF * 2048; const float* g2 = inp(F, 6) + (size_t)(L * 4 + 2) * DM;
    for (int it = gw; it < I_UP + I_DN; it += NGW) {
        if (it < I_UP) transpose_item(wu, NUP, (bf16*)(F.ws + WS_WFFN + WO_UP), 2048, 1, 0, it / 352, it % 352, scr, F.lane, g2);
        else { const int r = it - I_UP; transpose_item(wd, 2048, (bf16*)(F.ws + WS_WFFN + WO_DOWN), DFF, 0, 0, r / 64, r % 64, scr, F.lane); }
    }
}
__device__ __forceinline__ void norm0_phase(Frame& F) {
    frame_lanes(F);
    const int gw = F.vcu * NWAVES + F.wave, NGW = F.G * NWAVES;
    const float* xp = inp(F, 0); const float* xs = inp(F, 1);
    bf16* XB = (bf16*)(F.ws + WS_XB); float* RS = (float*)(F.ws + WS_RS);
    for (int row = gw; row < T; row += NGW) {
        const float* xin = row < TP ? xp + (size_t)row * DM : xs + (size_t)(row - TP) * DM;
        f32x4 x[8]; float s2 = 0.f;
#pragma unroll
        for (int j = 0; j < 8; ++j) x[j] = *(const GAS f32x4*)(xin + (F.lane + 64 * j) * 4);
#pragma unroll
        for (int j = 0; j < 8; ++j) s2 += (x[j].x * x[j].x + x[j].y * x[j].y) + (x[j].z * x[j].z + x[j].w * x[j].w);
        const float r2 = 1.0f / sqrtf(wave_sum(s2, F.lane) * (1.0f / DM) + EPS);
#pragma unroll
        for (int j = 0; j < 8; ++j) { v2u w; w.x = pk2(x[j].x, x[j].y); w.y = pk2(x[j].z, x[j].w); *(GAS v2u*)(XB + (size_t)row * DM + (F.lane + 64 * j) * 4) = w; }
        if (F.lane == 0) ((GAS float*)RS)[row] = r2;
    }
}
template <bool LAST, bool POOLST>
__device__ __forceinline__ void norm_phase(Frame& F, const bf16* mres, const float* slab, int ns, const float* g_post, const float* g_pre, float* pool_p, float* pool_s, bool poison, bool dry = false) {
    frame_lanes(F);
    const int gw = F.vcu * NWAVES + F.wave, NGW = F.G * NWAVES;
    bf16* XB = (bf16*)(F.ws + WS_XB); bf16* XBo = dry ? (bf16*)(F.ws + WS_BIG) : XB;
    float* RS = (float*)(F.ws + WS_RS);
    f32x4 gp[8];
#pragma unroll
    for (int j = 0; j < 8; ++j) gp[j] = *(const GAS f32x4*)(g_post + (F.lane + 64 * j) * 4);
    for (int row = gw; row < T; row += NGW) {
        f32x4 x[8], mv[8];
#pragma unroll
        for (int j = 0; j < 8; ++j) { const v2u w = *(const GAS v2u*)(XB + (size_t)row * DM + (F.lane + 64 * j) * 4); x[j] = (f32x4){bflo(w.x), bfhi(w.x), bflo(w.y), bfhi(w.y)}; }
        if (ns > 0 && row >= TP) {
#pragma unroll
            for (int j = 0; j < 8; ++j) mv[j] = (f32x4){0.f, 0.f, 0.f, 0.f};
            for (int k = 0; k < ns; ++k) {
#pragma unroll
                for (int j = 0; j < 8; ++j) mv[j] = mv[j] + *(const GAS f32x4*)(slab + ((size_t)k * TS + (row - TP)) * DM + (F.lane + 64 * j) * 4); }
        } else {
#pragma unroll
            for (int j = 0; j < 8; ++j) { const v2u w = *(const GAS v2u*)(mres + (size_t)row * DM + (F.lane + 64 * j) * 4); mv[j] = (f32x4){bflo(w.x), bfhi(w.x), bflo(w.y), bfhi(w.y)}; } }
        float ss = 0.f;
#pragma unroll
        for (int j = 0; j < 8; ++j) ss += (mv[j].x * mv[j].x + mv[j].y * mv[j].y) + (mv[j].z * mv[j].z + mv[j].w * mv[j].w);
        const float r1 = 1.0f / sqrtf(wave_sum(ss, F.lane) * (1.0f / DM) + EPS);
#pragma unroll
        for (int j = 0; j < 8; ++j) x[j] = x[j] + mv[j] * r1 * gp[j];
        if (LAST) {
            if (poison) {
#pragma unroll
                for (int j = 0; j < 8; ++j) x[j] = x[j] * __builtin_nanf("");
            }
#pragma unroll
            for (int j = 0; j < 8; ++j) *(GAS f32x4*)(F.out + (size_t)row * DM + (F.lane + 64 * j) * 4) = x[j];
        } else {
#pragma unroll
            for (int j = 0; j < 8; ++j) { v2u w; w.x = pk2(x[j].x, x[j].y); w.y = pk2(x[j].z, x[j].w); *(GAS v2u*)(XBo + (size_t)row * DM + (F.lane + 64 * j) * 4) = w; }
            float s2 = 0.f;
#pragma unroll
            for (int j = 0; j < 8; ++j) s2 += (x[j].x * x[j].x + x[j].y * x[j].y) + (x[j].z * x[j].z + x[j].w * x[j].w);
            const float r2 = 1.0f / sqrtf(wave_sum(s2, F.lane) * (1.0f / DM) + EPS);
            if (F.lane == 0) ((GAS float*)RS)[row] = r2;
            if (POOLST) {
                float* ps = nullptr;
                if (row < TP) { const int s = row & (SEQ - 1); if (s >= SEQ - 15) ps = pool_p + ((size_t)(row >> 12) * 15 + (s - (SEQ - 15))) * DM; }
                else { const int qi = (row - TP) & 15; if (qi >= 1) ps = pool_s + ((size_t)((row - TP) >> 4) * 15 + (qi - 1)) * DM; }
                if (ps) {
#pragma unroll
                    for (int j = 0; j < 8; ++j) { const int c = (F.lane + 64 * j) * 4; *(GAS f32x4*)(ps + c) = x[j] * r2 * *(const GAS f32x4*)(g_pre + c); } }
            }
        }
    }
}

__device__ __forceinline__ void s1_phase(Frame& F, int j) {
    frame_lanes(F);
    const int gw = F.vcu * NWAVES + F.wave, NGW = F.G * NWAVES, lane = F.lane;
    const float* raw = (const float*)(F.ws + WS_MB);
    const float* qn = inp(F, 8) + j * 512; const float* kn = inp(F, 11) + j * 512;
    const float* ct = (const float*)(F.ws + WS_ROPE); const float* st = ct + 4096 * 32;
    bf16* CQ = (bf16*)(F.ws + WS_CQ); bf16* CKVB = (bf16*)(F.ws + WS_CKVB); bf16* KRB = (bf16*)(F.ws + WS_KRB);
    bf16* KALL = (bf16*)(F.ws + WS_KALL); bf16* VT = (bf16*)(F.ws + WS_VT);
    f32x4 gqn[2], gkn[2];
#pragma unroll
    for (int i = 0; i < 2; ++i) { gqn[i] = *(const GAS f32x4*)(qn + (lane + 64 * i) * 4); gkn[i] = *(const GAS f32x4*)(kn + (lane + 64 * i) * 4); }
    for (int row = gw; row < T; row += NGW) {
        const float* rr = raw + (size_t)row * 1280;
        f32x4 a[2], b[2]; float ssa = 0.f, ssb = 0.f;
#pragma unroll
        for (int i = 0; i < 2; ++i) { a[i] = *(const GAS f32x4*)(rr + (lane + 64 * i) * 4); b[i] = *(const GAS f32x4*)(rr + 512 + (lane + 64 * i) * 4);
            ssa += (a[i].x * a[i].x + a[i].y * a[i].y) + (a[i].z * a[i].z + a[i].w * a[i].w); ssb += (b[i].x * b[i].x + b[i].y * b[i].y) + (b[i].z * b[i].z + b[i].w * b[i].w); }
        const float rs_row = ((const GAS float*)(F.ws + WS_RS))[row];
#pragma unroll
        for (int i = 0; i < 2; ++i) { a[i] = a[i] * rs_row; b[i] = b[i] * rs_row; }
        ssa *= rs_row * rs_row; ssb *= rs_row * rs_row;
        const float kv = ((const GAS float*)rr)[1024 + lane] * rs_row;
        const float ra = 1.0f / sqrtf(wave_sum(ssa, lane) * (1.0f / 512) + EPS), rb = 1.0f / sqrtf(wave_sum(ssb, lane) * (1.0f / 512) + EPS);
        const bool prompt = row < TP;
        const int sb = (row - TP) >> 4, qi = (row - TP) & 15;
        const int pos = prompt ? (row & (SEQ - 1)) : 2048 + qi;
        float* o_ckv = prompt ? F.out + O_CKV_P + ((size_t)j * TP + row) * 512 : F.out + O_CKV_S + ((size_t)j * TS + (row - TP)) * 512;
        float* o_kr = prompt ? F.out + O_KR_P + ((size_t)j * TP + row) * 64 : F.out + O_KR_S + ((size_t)j * TS + (row - TP)) * 64;
#pragma unroll
        for (int i = 0; i < 2; ++i) {
            const int c = (lane + 64 * i) * 4;
            const f32x4 q = a[i] * ra * gqn[i]; v2u w; w.x = pk2(q.x, q.y); w.y = pk2(q.z, q.w); *(GAS v2u*)(CQ + (size_t)row * 512 + c) = w;
            const f32x4 k = b[i] * rb * gkn[i]; *(GAS f32x4*)(o_ckv + c) = k; v2u wk; wk.x = pk2(k.x, k.y); wk.y = pk2(k.z, k.w);
            if (prompt) *(GAS v2u*)(CKVB + (size_t)row * 512 + c) = wk;
            else { *(GAS v2u*)(KALL + ((size_t)sb * 2304 + 2048 + qi) * 640 + c) = wk;
                GAS bf16* vt = (GAS bf16*)(VT + ((size_t)sb * 512 + c) * 2304 + 2048 + qi); vt[0] = (bf16)(wk.x & 0xffff); vt[2304] = (bf16)(wk.x >> 16); vt[2 * 2304] = (bf16)(wk.y & 0xffff); vt[3 * 2304] = (bf16)(wk.y >> 16); }
        }
        const float other = shx(kv, 32, lane); const int i5 = lane & 31; const float cs = ((const GAS float*)ct)[pos * 32 + i5], sn = ((const GAS float*)st)[pos * 32 + i5];
        const float rot = lane < 32 ? kv * cs - other * sn : other * sn + kv * cs;
        ((GAS float*)o_kr)[lane] = rot;
        const float rot_hi = shx(rot, 32, lane);
        if (lane < 32) { const unsigned w = pk2(rot, rot_hi);
            if (prompt) ((GAS unsigned*)(KRB + (size_t)row * 64))[lane] = w; else ((GAS unsigned*)(KALL + ((size_t)sb * 2304 + 2048 + qi) * 640 + 512))[lane] = w; }
        else if (!prompt) ((GAS unsigned*)(KALL + ((size_t)sb * 2304 + 2048 + qi) * 640 + 576))[lane - 32] = 0u;
    }
    const float* cck = inp(F, 2) + (size_t)j * 32 * 2048 * 512; const float* ckr = inp(F, 3) + (size_t)j * 32 * 2048 * 64;
    for (int r = gw; r < 32 * 2304; r += NGW) {
        const int b = r / 2304, key = r - b * 2304; GAS unsigned* dst = (GAS unsigned*)(KALL + (size_t)r * 640);
        if (key < 2048) {
            const float* s = cck + ((size_t)b * 2048 + key) * 512;
#pragma unroll
            for (int i = 0; i < 2; ++i) { const f32x4 v = *(const GAS f32x4*)(s + (lane + 64 * i) * 4); v2u w; w.x = pk2(v.x, v.y); w.y = pk2(v.z, v.w); *(GAS v2u*)(dst + (lane + 64 * i) * 2) = w; }
            const float kr = ((const GAS float*)ckr)[((size_t)b * 2048 + key) * 64 + lane]; const float kh = shx(kr, 32, lane);
            if (lane < 32) dst[256 + lane] = pk2(kr, kh); else dst[288 + lane - 32] = 0u;
        } else if (key >= 2064) {
#pragma unroll
            for (int i = 0; i < 5; ++i) dst[lane + 64 * i] = 0u;
        }
    }
    { LAS float* scr = (LAS float*)(F.lds + RING_OFF + F.wave * 16384);
      for (int it = gw; it < 32 * 512; it += NGW) { const int b = it >> 9, r = it & 511;
          transpose_item(cck + (size_t)b * 2048 * 512, 512, VT + (size_t)b * 512 * 2304, 2304, 0, 0, r >> 4, r & 15, scr, lane); }
      for (int r = gw; r < 32 * 512; r += NGW) { GAS unsigned* dst = (GAS unsigned*)(VT + (size_t)r * 2304 + 2064); dst[lane] = 0u; if (lane < 56) dst[64 + lane] = 0u; }
    }
}

__device__ __forceinline__ void qlat_rope_copy(Frame& F) {
    frame_lanes(F);
    const bf16* Q = (const bf16*)(F.ws + WS_Q); bf16* QL = (bf16*)(F.ws + WS_QLAT);
    for (int idx = (F.vcu * NWAVES + F.wave) * 64 + F.lane; idx < 8192 * 16; idx += F.G * NWAVES * 64) {
        const int row = idx >> 4, ch = idx & 15, b = row >> 8, h = (row >> 4) & 15, qi = row & 15;
        v4u v = (v4u){0u, 0u, 0u, 0u};
        if (ch < 8) v = *(const GAS v4u*)(Q + (size_t)(TP + b * 16 + qi) * 3072 + h * 192 + 128 + ch * 8);
        *(GAS v4u*)(QL + (size_t)row * 640 + 512 + ch * 8) = v;
    }
}

__device__ __forceinline__ void softmax_phase(Frame& F) {
    frame_lanes(F);
    const float* S = (const float*)(F.ws + WS_S); bf16* P = (bf16*)(F.ws + WS_P);
    const int gw = F.vcu * NWAVES + F.wave, NGW = F.G * NWAVES, lane = F.lane;
    constexpr float C = att::SCALE * 1.4426950408889634f;
    for (int row = gw; row < 8192; row += NGW) {
        f32x4 v[9]; float mx = -1e30f;
#pragma unroll
        for (int j = 0; j < 9; ++j) { const int c = lane * 4 + 256 * j; v[j] = *(const GAS f32x4*)(S + (size_t)row * 2304 + c);
            if (c >= 2064) v[j] = (f32x4){-1e30f, -1e30f, -1e30f, -1e30f};
            mx = fmaxf(mx, fmaxf(fmaxf(v[j].x, v[j].y), fmaxf(v[j].z, v[j].w))); }
        mx = wave_max(mx, lane); float sum = 0.f;
#pragma unroll
        for (int j = 0; j < 9; ++j) { const int c = lane * 4 + 256 * j;
            v[j].x = __builtin_amdgcn_exp2f((v[j].x - mx) * C); v[j].y = __builtin_amdgcn_exp2f((v[j].y - mx) * C); v[j].z = __builtin_amdgcn_exp2f((v[j].z - mx) * C); v[j].w = __builtin_amdgcn_exp2f((v[j].w - mx) * C);
            if (c >= 2064) v[j] = (f32x4){0.f, 0.f, 0.f, 0.f};
            sum += (v[j].x + v[j].y) + (v[j].z + v[j].w); }
        const float inv = 1.0f / wave_sum(sum, lane);
#pragma unroll
        for (int j = 0; j < 9; ++j) { const int c = lane * 4 + 256 * j; v2u w; w.x = pk2(v[j].x * inv, v[j].y * inv); w.y = pk2(v[j].z * inv, v[j].w * inv); *(GAS v2u*)(P + (size_t)row * 2304 + c) = w; }
    }
}

__device__ __forceinline__ void pool_d_phase(Frame& F, int j, const float* g0) {
    frame_lanes(F);
    const bf16* X = (const bf16*)(F.ws + WS_XB); bf16* Dd = (bf16*)(F.ws + WS_ACT); const GAS float* RS = (const GAS float*)(F.ws + WS_RS);
    const float* hist = inp(F, 4) + (size_t)j * 32 * 15 * DM;
    const int gw = F.vcu * NWAVES + F.wave, NGW = F.G * NWAVES, lane = F.lane;
    for (int row = gw; row < T; row += NGW) {
        const bool prompt = row < TP; const int s = prompt ? (row & (SEQ - 1)) : ((row - TP) & 15); const int sb = (row - TP) >> 4;
#pragma unroll
        for (int g = 0; g < 4; ++g) {
            const int w = 2 << g, c = g * 512 + lane * 8;
            const f32x4 ga = *(const GAS f32x4*)(g0 + c), gb = *(const GAS f32x4*)(g0 + c + 4);
            const float gg[8] = {ga.x, ga.y, ga.z, ga.w, gb.x, gb.y, gb.z, gb.w};
            float acc[8], self[8];
#pragma unroll
            for (int e = 0; e < 8; ++e) { acc[e] = 0.f; self[e] = 0.f; }
            for (int k = 0; k < w; ++k) {
                const int sk = s - k;
                if (sk >= 0) { const v4u v = *(const GAS v4u*)(X + (size_t)(row - k) * DM + c); const float r = RS[row - k];
                    const float f[8] = {bflo(v.x), bfhi(v.x), bflo(v.y), bfhi(v.y), bflo(v.z), bfhi(v.z), bflo(v.w), bfhi(v.w)};
#pragma unroll
                    for (int e = 0; e < 8; ++e) { const float hv = f[e] * r * gg[e]; acc[e] += hv; if (k == 0) self[e] = hv; } }
                else if (!prompt) { const float* hp = hist + ((size_t)sb * 15 + (15 + sk)) * DM + c; const f32x4 u0 = *(const GAS f32x4*)hp, u1 = *(const GAS f32x4*)(hp + 4);
                    acc[0] += u0.x; acc[1] += u0.y; acc[2] += u0.z; acc[3] += u0.w; acc[4] += u1.x; acc[5] += u1.y; acc[6] += u1.z; acc[7] += u1.w; }
            }
            const float cnt = prompt ? (float)((s + 1) < w ? (s + 1) : w) : (float)w; const float ic = 1.0f / cnt;
            v4u o; o.x = pk2(acc[0] * ic - self[0], acc[1] * ic - self[1]); o.y = pk2(acc[2] * ic - self[2], acc[3] * ic - self[3]);
            o.z = pk2(acc[4] * ic - self[4], acc[5] * ic - self[5]); o.w = pk2(acc[6] * ic - self[6], acc[7] * ic - self[7]);
            *(GAS v4u*)(Dd + (size_t)row * DM + c) = o;
        }
    }
}

__device__ __forceinline__ void fix_phase(Frame& F, int L) {
    frame_lanes(F);
    const bf16* BF = (const bf16*)(F.ws + WS_BND); const bf16* BL = BF + (size_t)512 * 2 * NUP;
    const float* cw = inp(F, 18) + (size_t)L * 3 * NUP; const float* cb = inp(F, 19) + (size_t)L * NUP;
    bf16* act = (bf16*)(F.ws + WS_ACT);
    for (int idx = (F.vcu * NWAVES + F.wave) * 64 + F.lane; idx < 512 * 2 * 704; idx += F.G * NWAVES * 64) {
        const int cc = idx % 704, sj = idx / 704, s = sj >> 1, jr = sj & 1;
        const int jg = cc * 8, np = (jg >> 7) * 256 + (jg & 127);
        const bool seq0 = (s & 63) == 0;
        float u0[2][8], u1[2][8], u2[2][8];
#pragma unroll
        for (int gv = 0; gv < 2; ++gv) {
            const v4u zero = (v4u){0u, 0u, 0u, 0u};
            const v4u cur = *(const GAS v4u*)(BF + (size_t)(s * 2 + jr) * NUP + np + gv * 128);
            const v4u f0 = *(const GAS v4u*)(BF + (size_t)(s * 2) * NUP + np + gv * 128);
            const v4u l0 = seq0 ? zero : *(const GAS v4u*)(BL + (size_t)((s - 1) * 2) * NUP + np + gv * 128);
            const v4u l1 = seq0 ? zero : *(const GAS v4u*)(BL + (size_t)((s - 1) * 2 + 1) * NUP + np + gv * 128);
            const v4u p1 = jr ? f0 : l1, p2 = jr ? l1 : l0;
            const unsigned cu[4] = {cur.x, cur.y, cur.z, cur.w}, a1[4] = {p1.x, p1.y, p1.z, p1.w}, a2[4] = {p2.x, p2.y, p2.z, p2.w};
#pragma unroll
            for (int e = 0; e < 4; ++e) { u0[gv][2 * e] = bflo(cu[e]); u0[gv][2 * e + 1] = bfhi(cu[e]); u1[gv][2 * e] = bflo(a1[e]); u1[gv][2 * e + 1] = bfhi(a1[e]); u2[gv][2 * e] = bflo(a2[e]); u2[gv][2 * e + 1] = bfhi(a2[e]); }
        }
        float r[8];
#pragma unroll
        for (int e = 0; e < 8; ++e) {
            const int cg = jg + e, cv = DFF + jg + e;
            const GAS float* cwg = (const GAS float*)cw; const GAS float* cbg = (const GAS float*)cb;
            const float g = cbg[cg] + cwg[cg] * u2[0][e] + cwg[NUP + cg] * u1[0][e] + cwg[2 * NUP + cg] * u0[0][e];
            const float v = cbg[cv] + cwg[cv] * u2[1][e] + cwg[NUP + cv] * u1[1][e] + cwg[2 * NUP + cv] * u0[1][e];
            r[e] = pg8::silu_mul(g, v);
        }
        v4u o; o.x = pk2(r[0], r[1]); o.y = pk2(r[2], r[3]); o.z = pk2(r[4], r[5]); o.w = pk2(r[6], r[7]);
        *(GAS v4u*)(act + (size_t)(s * 64 + jr) * DFF + jg) = o;
    }
}

__device__ __forceinline__ void kr_copy(Frame& F) {
    frame_lanes(F);
    const bf16* KRB = (const bf16*)(F.ws + WS_KRB); bf16* K2 = (bf16*)(F.ws + WS_K2);
    for (int idx = (F.vcu * NWAVES + F.wave) * 64 + F.lane; idx < TP * 128; idx += F.G * NWAVES * 64) {
        const int tok = idx >> 7, h = (idx >> 3) & 15, ch = idx & 7;
        *(GAS v4u*)(K2 + (size_t)tok * 3072 + h * 192 + 128 + ch * 8) = *(const GAS v4u*)(KRB + (size_t)tok * 64 + ch * 8);
    }
}
__device__ __forceinline__ void attn_phase(Frame& F) {
    frame_lanes(F);
    const bf16* Q = (const bf16*)(F.ws + WS_Q); const bf16* K2 = (const bf16*)(F.ws + WS_K2); const bf16* V2 = (const bf16*)(F.ws + WS_V2); bf16* O = (bf16*)(F.ws + WS_HB);
    for (int pi = F.vcu; pi < 1024; pi += F.G) {
        const int bh = pi >> 3, s = pi & 7, b = bh >> 4, h = bh & 15;
#pragma unroll 1
        for (int half = 0; half < 2; ++half) {
            const int qb = half ? 15 - s : s;
            const size_t row0 = (size_t)b * SEQ;
            att::attn_unit(Q + (row0 + 256 * qb) * 3072 + h * 192, K2 + row0 * 3072 + h * 192, V2 + row0 * 2048 + h * 128,
                           O + (row0 + 256 * qb) * DM + h * 128, 4 * qb + 4, qb, (ATT_LAS char*)(F.lds + RING_OFF));
        }
    }
}

struct Args { const float* in[21]; float* out; unsigned char* ws; int ph_lo, ph_hi; };
constexpr int NPH = 1 + 4 * 16;
#ifndef PG8_ALIGN
#define PG8_ALIGN true
#endif
__global__ void __launch_bounds__(NWAVES * 64, 2) fwd_kernel(Args args) {
    extern __shared__ __attribute__((aligned(16))) unsigned char lds[];
    Frame F;
    F.lds = (LAS unsigned char*)lds;
    F.tid = threadIdx.x; F.lane = F.tid & 63; F.wave = __builtin_amdgcn_readfirstlane(F.tid >> 6);
    F.G = gridDim.x; { const int bx = blockIdx.x; F.vcu = (F.G % 8 == 0) ? (bx % 8) * (F.G / 8) + bx / 8 : bx; }
    F.out = args.out; F.ws = args.ws;
    unsigned* ctl = (unsigned*)(F.ws + WS_CTL);
    for (int u = F.tid; u < (LDS_BYTES - LDSCTL_OFF) / 4; u += NWAVES * 64) ((LAS unsigned*)(F.lds + LDSCTL_OFF))[u] = 0u;
    __syncthreads();
    if (F.tid == 0) {
#pragma unroll
        for (int i = 0; i < 21; ++i) ((LAS unsigned long long*)(F.lds + PTR_OFF))[i] = (unsigned long long)args.in[i];
    }
    __syncthreads();
    const int lo = args.ph_lo, hi = args.ph_hi;
    const bool one_launch = (hi - lo) > 1;
    XcdBarrier bar; bar.bar = ctl + CW_BAR; bar.x = 0; bar.st = nullptr;
    if (one_launch) bar = xcd_barrier_post(ctl + CW_BAR, (volatile LAS unsigned*)(F.lds + MISC_OFF) + 8);
#ifndef PH_MASK
#define PH_MASK 0x1ffffu
#endif
#define IN(k) (lo <= (k) && (k) < hi)
#define EN(p) (((PH_MASK) >> (p)) & 1u)
#ifndef DBL_MASK
#define DBL_MASK 0u
#endif
#define REPS(p) ((int)(((DBL_MASK) >> (p)) & 1u) + 1)
#define SEAM(k) do { if (IN((k) + 1)) { xcd_barrier(bar); if (REPS(17) > 1) xcd_barrier(bar); } } while (0)
    const int bid = (int)blockIdx.x;

    if (EN(16) && IN(0)) { for (int rep_ = 0; rep_ < REPS(16); ++rep_) { if (rep_) xcd_barrier(bar); p0_prologue(F); convert_ffn(F, 0); norm0_phase(F); } SEAM(0); }

    for (int L = 0; L < 4; ++L) {
        const int base = 1 + 16 * L, j = L >> 1;
        const float* ng = inp(F, 6) + (size_t)L * 4 * DM;
        if ((L & 1) == 0) {
            unsigned char* wb = F.ws + WS_W + j * W_MLA;
            if (EN(0) && IN(base + 0)) { for (int rep_ = 0; rep_ < REPS(0); ++rep_) { if (rep_) xcd_barrier(bar); frame_lanes(F); LAS unsigned char* ring = F.lds + RING_OFF;  pg8::SchedPlain S; S.init(130, 5, F.G, bid); S.A = (const char*)(F.ws + WS_XB); S.B = (const char*)(wb + WO_DQKV); S.lda = 2048; S.ldb = 2048; S.K = 2048;
                pg8::EpiF32 E{(float*)(F.ws + WS_MB), 1280}; pg8::gemm_phase<pg8::EpiF32, pg8::SchedPlain, PG8_ALIGN>(ring, S, E);  } SEAM(base + 0); }
            if (EN(1) && IN(base + 1)) { for (int rep_ = 0; rep_ < REPS(1); ++rep_) { if (rep_) xcd_barrier(bar); frame_lanes(F); LAS unsigned char* ring = F.lds + RING_OFF;  s1_phase(F, j);  } SEAM(base + 1); }
            if (EN(2) && IN(base + 2)) { for (int rep_ = 0; rep_ < REPS(2); ++rep_) { if (rep_) xcd_barrier(bar); frame_lanes(F); LAS unsigned char* ring = F.lds + RING_OFF;  pg8::SchedPlain S; S.init(130, 12, F.G, bid); S.A = (const char*)(F.ws + WS_CQ); S.B = (const char*)(wb + WO_UQ); S.lda = 512; S.ldb = 512; S.K = 512;
                pg8::EpiQRope E{(bf16*)(F.ws + WS_Q), (const float*)(F.ws + WS_ROPE), (const float*)(F.ws + WS_ROPE) + 4096 * 32};
                pg8::gemm_phase<pg8::EpiQRope, pg8::SchedPlain, PG8_ALIGN>(ring, S, E);  } SEAM(base + 2); }
            if (EN(3) && IN(base + 3)) { for (int rep_ = 0; rep_ < REPS(3); ++rep_) { if (rep_) xcd_barrier(bar); frame_lanes(F); LAS unsigned char* ring = F.lds + RING_OFF;  qlat_rope_copy(F);
                pg8::SchedQlat S; S.init(32, 2, F.G, bid); S.A = (const char*)(F.ws + WS_Q) + (size_t)TP * 3072 * 2; S.B = (const char*)(wb + WO_UK2); S.lda = 3072; S.ldb = 256; S.K = 256;
                pg8::EpiB<1> E{(bf16*)(F.ws + WS_QLAT), 640, nullptr}; pg8::gemm_phase<pg8::EpiB<1>, pg8::SchedQlat, PG8_ALIGN>(ring, S, E);  } SEAM(base + 3); }
            if (EN(4) && IN(base + 4)) { for (int rep_ = 0; rep_ < REPS(4); ++rep_) { if (rep_) xcd_barrier(bar); frame_lanes(F); LAS unsigned char* ring = F.lds + RING_OFF;  pg8::SchedBatch S; S.init(32, 9, F.G, bid); S.A = (const char*)(F.ws + WS_QLAT); S.B = (const char*)(F.ws + WS_KALL); S.lda = 640; S.ldb = 640; S.K = 640; S.b_pm = (size_t)2304 * 640 * 2;
                pg8::EpiF32 E{(float*)(F.ws + WS_S), 2304}; pg8::gemm_phase<pg8::EpiF32, pg8::SchedBatch, PG8_ALIGN>(ring, S, E);  } SEAM(base + 4); }
            if (EN(5) && IN(base + 5)) { for (int rep_ = 0; rep_ < REPS(5); ++rep_) { if (rep_) xcd_barrier(bar); frame_lanes(F); LAS unsigned char* ring = F.lds + RING_OFF;  softmax_phase(F);  } SEAM(base + 5); }
            if (EN(6) && IN(base + 6)) { for (int rep_ = 0; rep_ < REPS(6); ++rep_) { if (rep_) xcd_barrier(bar); frame_lanes(F); LAS unsigned char* ring = F.lds + RING_OFF;  pg8::SchedBatch S; S.init(32, 2, F.G, bid); S.A = (const char*)(F.ws + WS_P); S.B = (const char*)(F.ws + WS_VT); S.lda = 2304; S.ldb = 2304; S.K = 2304; S.b_pm = (size_t)512 * 2304 * 2;
                pg8::EpiB<2> E{(bf16*)(F.ws + WS_OL), 512, nullptr}; pg8::gemm_phase<pg8::EpiB<2>, pg8::SchedBatch, PG8_ALIGN>(ring, S, E);  } SEAM(base + 6); }
            if (EN(7) && IN(base + 7)) { for (int rep_ = 0; rep_ < REPS(7); ++rep_) { if (rep_) xcd_barrier(bar); frame_lanes(F); LAS unsigned char* ring = F.lds + RING_OFF;  pg8::SchedOV S; S.init(32, 1, F.G, bid); S.A = (const char*)(F.ws + WS_OL); S.B = (const char*)(wb + WO_UKV) + (size_t)2048 * 512 * 2; S.lda = 512; S.ldb = 512; S.K = 512;
                pg8::EpiB<3> E{(bf16*)(F.ws + WS_HB), 2048, nullptr}; pg8::gemm_phase<pg8::EpiB<3>, pg8::SchedOV, PG8_ALIGN>(ring, S, E);  } SEAM(base + 7); }
            if (EN(8) && IN(base + 8)) { for (int rep_ = 0; rep_ < REPS(8); ++rep_) { if (rep_) xcd_barrier(bar); frame_lanes(F); LAS unsigned char* ring = F.lds + RING_OFF;  pg8::SchedPlain S; S.init(128, 16, F.G, bid); S.A = (const char*)(F.ws + WS_CKVB); S.B = (const char*)(wb + WO_UKV); S.lda = 512; S.ldb = 512; S.K = 512;
                kr_copy(F); pg8::EpiKV E{(bf16*)(F.ws + WS_K2), (bf16*)(F.ws + WS_V2)}; pg8::gemm_phase<pg8::EpiKV, pg8::SchedPlain, PG8_ALIGN>(ring, S, E);  } SEAM(base + 8); }
            if (EN(9) && IN(base + 9)) { for (int rep_ = 0; rep_ < REPS(9); ++rep_) { if (rep_) xcd_barrier(bar); frame_lanes(F); LAS unsigned char* ring = F.lds + RING_OFF;  attn_phase(F);  } SEAM(base + 9); }
            if (EN(10) && IN(base + 10)) { for (int rep_ = 0; rep_ < REPS(10); ++rep_) { if (rep_) xcd_barrier(bar); frame_lanes(F); LAS unsigned char* ring = F.lds + RING_OFF;  pg8::SchedPlain S; S.init(128, 8, F.G, bid); S.A = (const char*)(F.ws + WS_HB); S.B = (const char*)(wb + WO_O); S.lda = 2048; S.ldb = 2048; S.K = 2048;
                pg8::EpiB<0> E{(bf16*)(F.ws + WS_MB), 2048, nullptr}; pg8::gemm_phase<pg8::EpiB<0>, pg8::SchedPlain, PG8_ALIGN>(ring, S, E);
                { pg8::SchedSplit S2; S2.init(2 * 4, 8, F.G, bid); S2.A = (const char*)(F.ws + WS_HB) + (size_t)TP * 2048 * 2; S2.B = (const char*)(wb + WO_O); S2.lda = 2048; S2.ldb = 2048; S2.K = 512;
                  pg8::EpiSlab E2{(float*)(F.ws + WS_SLAB)}; pg8::gemm_phase<pg8::EpiSlab, pg8::SchedSplit, PG8_ALIGN>(ring, S2, E2); }  } SEAM(base + 10); }
        } else {
            if (EN(9) && IN(base + 9)) { for (int rep_ = 0; rep_ < REPS(9); ++rep_) { if (rep_) xcd_barrier(bar); frame_lanes(F); LAS unsigned char* ring = F.lds + RING_OFF;  pool_d_phase(F, j, ng);  } SEAM(base + 9); }
            if (EN(10) && IN(base + 10)) { for (int rep_ = 0; rep_ < REPS(10); ++rep_) { if (rep_) xcd_barrier(bar); frame_lanes(F); LAS unsigned char* ring = F.lds + RING_OFF;  pg8::SchedPool S; S.init(130, 8, F.G, bid); S.A = (const char*)(F.ws + WS_ACT); S.B = (const char*)(F.ws + WS_WPOOL + (size_t)j * 2 * MiB); S.lda = 2048; S.ldb = 512; S.K = 512;
                pg8::EpiB<0> E{(bf16*)(F.ws + WS_MB), 2048, inp(F, 16) + (size_t)j * DM}; pg8::gemm_phase<pg8::EpiB<0>, pg8::SchedPool, PG8_ALIGN>(ring, S, E);  } SEAM(base + 10); }
        }
        unsigned char* wf = F.ws + WS_WFFN;
        if (EN(11) && IN(base + 11)) { for (int rep_ = 0; rep_ < REPS(11); ++rep_) { if (rep_) xcd_barrier(bar); frame_lanes(F); LAS unsigned char* ring = F.lds + RING_OFF;  const int nsb = (L & 1) ? 0 : 4; const bool dry = rep_ + 1 < REPS(11); norm_phase<false, false>(F, (const bf16*)(F.ws + WS_MB), (const float*)(F.ws + WS_SLAB), nsb, ng + DM, nullptr, nullptr, nullptr, false, dry);  } SEAM(base + 11); }
        if (EN(12) && IN(base + 12)) { for (int rep_ = 0; rep_ < REPS(12); ++rep_) { if (rep_) xcd_barrier(bar); frame_lanes(F); LAS unsigned char* ring = F.lds + RING_OFF;  pg8::SchedPlain S; S.init(130, 44, F.G, bid); S.A = (const char*)(F.ws + WS_XB); S.B = (const char*)(wf + WO_UP); S.lda = 2048; S.ldb = 2048; S.K = 2048;
            pg8::EpiUp E{(bf16*)(F.ws + WS_ACT), (bf16*)(F.ws + WS_BND), (bf16*)(F.ws + WS_BND) + (size_t)512 * 2 * NUP, inp(F, 18) + (size_t)L * 3 * NUP, inp(F, 19) + (size_t)L * NUP,
                         inp(F, 5) + (size_t)L * 32 * 2 * NUP, F.out + O_CONV_P + (size_t)L * 8 * 2 * NUP, F.out + O_CONV_S + (size_t)L * 32 * 2 * NUP, (const float*)(F.ws + WS_RS)};
            pg8::gemm_phase<pg8::EpiUp, pg8::SchedPlain, PG8_ALIGN>(ring, S, E);  } SEAM(base + 12); }
        if (EN(13) && IN(base + 13)) { for (int rep_ = 0; rep_ < REPS(13); ++rep_) { if (rep_) xcd_barrier(bar); frame_lanes(F); LAS unsigned char* ring = F.lds + RING_OFF;  fix_phase(F, L);  } SEAM(base + 13); }
        if (EN(14) && IN(base + 14)) { for (int rep_ = 0; rep_ < REPS(14); ++rep_) { if (rep_) xcd_barrier(bar); frame_lanes(F); LAS unsigned char* ring = F.lds + RING_OFF;  pg8::SchedPlain S; S.init(128, 8, F.G, bid); S.A = (const char*)(F.ws + WS_ACT); S.B = (const char*)(wf + WO_DOWN); S.lda = DFF; S.ldb = DFF; S.K = DFF;
            pg8::EpiB<0> E{(bf16*)(F.ws + WS_MB), 2048, nullptr}; pg8::gemm_phase<pg8::EpiB<0>, pg8::SchedPlain, PG8_ALIGN>(ring, S, E);
            { pg8::SchedSplit S2; S2.init(2 * 11, 8, F.G, bid); S2.A = (const char*)(F.ws + WS_ACT) + (size_t)TP * DFF * 2; S2.B = (const char*)(wf + WO_DOWN); S2.lda = DFF; S2.ldb = DFF; S2.K = 512;
              pg8::EpiSlab E2{(float*)(F.ws + WS_SLAB)}; pg8::gemm_phase<pg8::EpiSlab, pg8::SchedSplit, PG8_ALIGN>(ring, S2, E2); }  } SEAM(base + 14); }
        if (EN(15) && IN(base + 15)) {
            const bool poison = one_launch && xb_ld(ctl + CW_BAR + XB_TMO) != 0u;
            frame_lanes(F);
            if (L < 3) convert_ffn(F, L + 1);
            const float* slab = (const float*)(F.ws + WS_SLAB);
            if (L == 3) norm_phase<true, false>(F, (const bf16*)(F.ws + WS_MB), slab, 11, ng + 3 * DM, nullptr, nullptr, nullptr, poison);
            else if ((L & 1) == 0) norm_phase<false, true>(F, (const bf16*)(F.ws + WS_MB), slab, 11, ng + 3 * DM, ng + 4 * DM, F.out + O_POOL_P + (size_t)j * 8 * 15 * DM, F.out + O_POOL_S + (size_t)j * 32 * 15 * DM, false);
            else norm_phase<false, false>(F, (const bf16*)(F.ws + WS_MB), slab, 11, ng + 3 * DM, nullptr, nullptr, nullptr, false);
            if (L < 3) SEAM(base + 15);
        }
    }
#undef IN
#undef SEAM
}

#ifndef MK_PER_PHASE
#define MK_PER_PHASE 0
#endif
extern "C" void kernel_launch(void* const* d_in, const int* in_sizes, int n_in, void* d_out, int out_size, void* d_ws, size_t ws_size, hipStream_t stream) {
    static int grid = 0;
    if (grid == 0) {
        if (n_in != 21 || (size_t)out_size != O_END || ws_size < WS_END) { fprintf(stderr, "kernel_launch: unexpected problem shape (n_in %d, out %d, ws %zu < %zu); nothing launched\n", n_in, out_size, ws_size, (size_t)WS_END); grid = -1; return; }
        int dev = 0, cus = 0, per_cu = 0;
        if (hipGetDevice(&dev) != hipSuccess || hipDeviceGetAttribute(&cus, hipDeviceAttributeMultiprocessorCount, dev) != hipSuccess) { grid = -1; return; }
        if (hipFuncSetAttribute((const void*)fwd_kernel, hipFuncAttributeMaxDynamicSharedMemorySize, LDS_BYTES) != hipSuccess) { fprintf(stderr, "kernel_launch: hipFuncSetAttribute failed\n"); grid = -1; return; }
        if (hipOccupancyMaxActiveBlocksPerMultiprocessor(&per_cu, (const void*)fwd_kernel, NWAVES * 64, LDS_BYTES) != hipSuccess || per_cu < 1) { fprintf(stderr, "kernel_launch: occupancy query says %d blocks per CU\n", per_cu); }
        (void)hipGetLastError();
        grid = cus;
    }
    if (grid < 0) return;
    (void)hipMemsetAsync((char*)d_ws + WS_CTL, 0, CTL_ZERO_BYTES, stream);
    Args a{};
    for (int i = 0; i < 21; ++i) a.in[i] = (const float*)d_in[i];
    a.out = (float*)d_out; a.ws = (unsigned char*)d_ws;
#if MK_PER_PHASE
    for (int p = 0; p < NPH; ++p) {
        if (p >= 1) { const int L = (p - 1) >> 4, q = (p - 1) & 15; if ((L & 1) && q < 9) continue; }
        a.ph_lo = p; a.ph_hi = p + 1;
        hipLaunchKernelGGL(fwd_kernel, dim3(grid), dim3(NWAVES * 64), LDS_BYTES, stream, a);
    }
#else
    a.ph_lo = 0; a.ph_hi = NPH;
    hipLaunchKernelGGL(fwd_kernel, dim3(grid), dim3(NWAVES * 64), LDS_BYTES, stream, a);
#endif
}
```

```cpp
#define DBL_MASK 0u
#ifndef MK_PER_PHASE
#define MK_PER_PHASE 0
#endif
#include <hip/hip_runtime.h>
#include <cstdio>
#include <cstdint>
namespace pg8 {
#define PG8_LAS __attribute__((address_space(3)))
#define PG8_GAS __attribute__((address_space(1)))
typedef unsigned short bf16_t;
typedef short bf16x8 __attribute__((ext_vector_type(8)));
typedef float f32x4 __attribute__((ext_vector_type(4)));
typedef unsigned u32x4 __attribute__((ext_vector_type(4)));
typedef unsigned u32x2 __attribute__((ext_vector_type(2)));
constexpr int BM = 256, BK = 64, HALF = 128, HTB = HALF * BK * 2  , STAGE_BYTES = 8 * HTB, NXCD = 8, WGM = 8;

__host__ __device__ __forceinline__ int lds_byte(int r, int c) { const int st = (r >> 4) * 2 + (c >> 5), rr = r & 15, cc = c & 31, ob = rr * 64 + cc * 2; return st * 1024 + (ob ^ (((ob >> 9) & 1) << 5)); }
__host__ __device__ __forceinline__ void stage_rc(int b, int& R, int& C) { const int st = b / 1024, sb = b % 1024, swz = sb ^ (((sb >> 9) & 1) << 5); R = (st >> 1) * 16 + swz / 64; C = (st & 1) * 32 + (swz % 64) / 2; }
__host__ __device__ __forceinline__ int perm32(int rho) { const int n = rho >> 4, i = rho & 15; return 8 * (i >> 2) + 4 * n + (i & 3); }

struct Unit { int pm, pn; };

struct OrderBase {
    int nM, nN, nwg, G, c;
    __device__ __forceinline__ void init(int nM_, int nN_, int G_, int c_) { nM = nM_; nN = nN_; nwg = nM * nN; G = G_; c = c_; }
    __device__ __forceinline__ bool next(int i, Unit& u) const {
        const long L = (long)i * G + c; if (L >= nwg) return false;
        int wgid = (int)L; { const int q = nwg / NXCD, r = nwg % NXCD, xcd = wgid % NXCD, off = wgid / NXCD; wgid = (xcd < r ? xcd * (q + 1) : r * (q + 1) + (xcd - r) * q) + off; }
        const int nig = WGM * nN, gid = wgid / nig, fm = gid * WGM, gsz = (nM - fm) < WGM ? (nM - fm) : WGM;
        u.pm = fm + ((wgid % nig) % gsz); u.pn = (wgid % nig) / gsz; return true;
    }
    __device__ __forceinline__ void a_ready(const Unit&) const {}
    __device__ __forceinline__ void done(const Unit&) const {}
};
struct SchedPlain : OrderBase {
    const char* A; const char* B; int lda, ldb, K;
    __device__ __forceinline__ const char* a_ptr(const Unit& u) const { return A + (size_t)u.pm * 256 * lda * 2; }
    __device__ __forceinline__ const char* b_ptr(const Unit& u) const { return B + (size_t)u.pn * 256 * ldb * 2; }
};
struct SchedBatch : OrderBase {
    const char* A; const char* B; int lda, ldb, K; size_t b_pm;
    __device__ __forceinline__ const char* a_ptr(const Unit& u) const { return A + (size_t)u.pm * 256 * lda * 2; }
    __device__ __forceinline__ const char* b_ptr(const Unit& u) const { return B + (size_t)u.pm * b_pm + (size_t)u.pn * 256 * ldb * 2; }
};
struct SchedQlat : OrderBase {
    const char* A; const char* B; int lda, ldb, K;
    __device__ __forceinline__ const char* a_ptr(const Unit& u) const { return A + ((size_t)(u.pm & 1) * 256 * lda + (size_t)(u.pm >> 1) * 192) * 2; }
    __device__ __forceinline__ const char* b_ptr(const Unit& u) const { return B + ((size_t)(u.pm >> 1) * 512 + (size_t)u.pn * 256) * ldb * 2; }
};
struct SchedOV : OrderBase {
    const char* A; const char* B; int lda, ldb, K;
    __device__ __forceinline__ const char* a_ptr(const Unit& u) const { return A + (size_t)u.pm * 256 * lda * 2; }
    __device__ __forceinline__ const char* b_ptr(const Unit& u) const { return B + (size_t)(u.pm >> 2) * 256 * ldb * 2; }
};
struct SchedPool : OrderBase {
    const char* A; const char* B; int lda, ldb, K;
    __device__ __forceinline__ const char* a_ptr(const Unit& u) const { return A + ((size_t)u.pm * 256 * lda + (size_t)(u.pn >> 1) * 512) * 2; }
    __device__ __forceinline__ const char* b_ptr(const Unit& u) const { return B + (size_t)u.pn * 256 * ldb * 2; }
};

struct SchedSplit : OrderBase {
    const char* A; const char* B; int lda, ldb, K;
    __device__ __forceinline__ const char* a_ptr(const Unit& u) const { return A + ((size_t)(u.pm & 1) * 256 * lda + (size_t)(u.pm >> 1) * K) * 2; }
    __device__ __forceinline__ const char* b_ptr(const Unit& u) const { return B + ((size_t)u.pn * 256 * ldb + (size_t)(u.pm >> 1) * K) * 2; }
};

__device__ __forceinline__ unsigned cvt_pk_bf16(float lo, float hi) { unsigned r; asm volatile("v_cvt_pk_bf16_f32 %0, %1, %2" : "=v"(r) : "v"(lo), "v"(hi)); return r; }

struct EpiF32 {
    static constexpr bool PERM = false, APERM = false, AFTER_DRAIN = false;
    float* C; int ldc;
    __device__ __forceinline__ void operator()(const f32x4 (&acc)[2][2][4][2], const Unit& u, int wr, int wc, int fr, int fq) const {
        const int row0 = u.pm * BM + wr * 64 + fr, col0 = u.pn * BM + wc * 32 + 4 * fq;
#pragma unroll
        for (int ai = 0; ai < 2; ++ai)
#pragma unroll
            for (int m = 0; m < 4; ++m) { float* rowp = C + (size_t)(row0 + ai * HALF + m * 16) * ldc + col0;
#pragma unroll
                for (int bj = 0; bj < 2; ++bj)
#pragma unroll
                    for (int n = 0; n < 2; ++n) *(PG8_GAS f32x4*)(rowp + bj * HALF + n * 16) = acc[ai][bj][m][n]; }
    }
};
struct EpiSlab {
    static constexpr bool PERM = false, APERM = false, AFTER_DRAIN = false;
    float* C;
    __device__ __forceinline__ void operator()(const f32x4 (&acc)[2][2][4][2], const Unit& u, int wr, int wc, int fr, int fq) const {
        float* base = C + ((size_t)(u.pm >> 1) * 512 + (u.pm & 1) * 256 + wr * 64 + fr) * 2048 + u.pn * BM + wc * 32 + 4 * fq;
#pragma unroll
        for (int ai = 0; ai < 2; ++ai)
#pragma unroll
            for (int m = 0; m < 4; ++m) { float* rowp = base + (size_t)(ai * HALF + m * 16) * 2048;
#pragma unroll
                for (int bj = 0; bj < 2; ++bj)
#pragma unroll
                    for (int n = 0; n < 2; ++n) *(PG8_GAS f32x4*)(rowp + bj * HALF + n * 16) = acc[ai][bj][m][n]; }
    }
};
template <int MODE> struct EpiB {
    static constexpr bool PERM = true, APERM = false, AFTER_DRAIN = false;
    bf16_t* O; int ldc; const float* scale;
    __device__ __forceinline__ void operator()(const f32x4 (&acc)[2][2][4][2], const Unit& u, int wr, int wc, int fr, int fq) const {
        f32x4 sv[2][2];
        if (MODE == 0) {
#pragma unroll
            for (int bj = 0; bj < 2; ++bj)
#pragma unroll
                for (int n = 0; n < 2; ++n) sv[bj][n] = scale ? *(const PG8_GAS f32x4*)(scale + u.pn * BM + bj * HALF + wc * 32 + 8 * fq + 4 * n) : (f32x4){1.f, 1.f, 1.f, 1.f};
        }
#pragma unroll
        for (int ai = 0; ai < 2; ++ai)
#pragma unroll
            for (int m = 0; m < 4; ++m) {
                const int r = ai * HALF + wr * 64 + m * 16 + fr;
#pragma unroll
                for (int bj = 0; bj < 2; ++bj) {
                    const int c = bj * HALF + wc * 32 + 8 * fq;
                    bf16_t* p;
                    if (MODE == 0) p = O + (size_t)(u.pm * BM + r) * ldc + u.pn * BM + c;
                    else if (MODE == 1) { const int tok = 256 * (u.pm & 1) + r; p = O + (size_t)((tok >> 4) * 256 + (u.pm >> 1) * 16 + (tok & 15)) * 640 + u.pn * BM + c; }
                    else if (MODE == 2) { p = O + (size_t)((r >> 4) * 512 + 16 * u.pm + (r & 15)) * 512 + u.pn * BM + c; }
                    else { const int tok = 256 * (u.pm & 1) + r; p = O + (size_t)(32768 + tok) * 2048 + (u.pm >> 1) * 128 + (c & 127); }
                    if (MODE == 3 && bj != ((u.pm >> 1) & 1)) continue;
                    f32x4 v0 = acc[ai][bj][m][0], v1 = acc[ai][bj][m][1];
                    if (MODE == 0) { v0 = v0 * sv[bj][0]; v1 = v1 * sv[bj][1]; }
                    u32x4 w; w.x = cvt_pk_bf16(v0[0], v0[1]); w.y = cvt_pk_bf16(v0[2], v0[3]); w.z = cvt_pk_bf16(v1[0], v1[1]); w.w = cvt_pk_bf16(v1[2], v1[3]);
                    *(PG8_GAS u32x4*)p = w;
                }
            }
    }
};
struct EpiQRope {
    static constexpr bool PERM = true, APERM = false, AFTER_DRAIN = false;
    bf16_t* O; const float* ctab; const float* stab;
    __device__ __forceinline__ void operator()(const f32x4 (&acc)[2][2][4][2], const Unit& u, int wr, int wc, int fr, int fq) const {
#pragma unroll
        for (int bj = 0; bj < 2; ++bj) {
            const int c = u.pn * BM + bj * HALF + wc * 32 + 8 * fq;
            const int k32 = (u.pn * 8 + bj * 4 + wc) % 6;
            const bool rope = k32 >= 4;
            const int i0 = ((k32 - 4) * 32 + 8 * fq) >> 1;
#pragma unroll
            for (int ai = 0; ai < 2; ++ai)
#pragma unroll
                for (int m = 0; m < 4; ++m) {
                    const int t = u.pm * BM + ai * HALF + wr * 64 + m * 16 + fr;
                    f32x4 v0 = acc[ai][bj][m][0], v1 = acc[ai][bj][m][1];
                    if (rope) {
                        const int pos = t < 32768 ? (t & 4095) : 2048 + ((t - 32768) & 15);
                        const f32x4 cs = *(const PG8_GAS f32x4*)(ctab + pos * 32 + i0), sn = *(const PG8_GAS f32x4*)(stab + pos * 32 + i0);
                        const float a0 = v0[0], b0 = v0[1], a1 = v0[2], b1 = v0[3], a2 = v1[0], b2 = v1[1], a3 = v1[2], b3 = v1[3];
                        v0[0] = a0 * cs[0] - b0 * sn[0]; v0[1] = a0 * sn[0] + b0 * cs[0];
                        v0[2] = a1 * cs[1] - b1 * sn[1]; v0[3] = a1 * sn[1] + b1 * cs[1];
                        v1[0] = a2 * cs[2] - b2 * sn[2]; v1[1] = a2 * sn[2] + b2 * cs[2];
                        v1[2] = a3 * cs[3] - b3 * sn[3]; v1[3] = a3 * sn[3] + b3 * cs[3];
                    }
                    u32x4 w; w.x = cvt_pk_bf16(v0[0], v0[1]); w.y = cvt_pk_bf16(v0[2], v0[3]); w.z = cvt_pk_bf16(v1[0], v1[1]); w.w = cvt_pk_bf16(v1[2], v1[3]);
                    *(PG8_GAS u32x4*)(O + (size_t)t * 3072 + c) = w;
                }
        }
    }
};
template <int CTRL> __device__ __forceinline__ float dppf(float x) { return __builtin_bit_cast(float, __builtin_amdgcn_update_dpp(0, __builtin_bit_cast(int, x), CTRL, 0xf, 0xf, false)); }
__device__ __forceinline__ f32x4 ror1(f32x4 x) { return (f32x4){dppf<0x121>(x[0]), dppf<0x121>(x[1]), dppf<0x121>(x[2]), dppf<0x121>(x[3])}; }
__device__ __forceinline__ f32x4 ror2(f32x4 x) { return (f32x4){dppf<0x122>(x[0]), dppf<0x122>(x[1]), dppf<0x122>(x[2]), dppf<0x122>(x[3])}; }
__device__ __forceinline__ f32x4 sel4(bool c, f32x4 a, f32x4 b) { return (f32x4){c ? a[0] : b[0], c ? a[1] : b[1], c ? a[2] : b[2], c ? a[3] : b[3]}; }
__device__ __forceinline__ float silu_mul(float g, float v) { const float e = __builtin_amdgcn_exp2f(g * -1.4426950408889634f); return g * __builtin_amdgcn_rcpf(1.0f + e) * v; }
template <int CTRL> __device__ __forceinline__ float dpp_old(float old, float x) { return __builtin_bit_cast(float, __builtin_amdgcn_update_dpp(__builtin_bit_cast(int, old), __builtin_bit_cast(int, x), CTRL, 0xf, 0xf, false)); }
__device__ __forceinline__ f32x4 shr1_old(f32x4 old, f32x4 x) { return (f32x4){dpp_old<0x111>(old[0], x[0]), dpp_old<0x111>(old[1], x[1]), dpp_old<0x111>(old[2], x[2]), dpp_old<0x111>(old[3], x[3])}; }
struct EpiUp {
    static constexpr bool PERM = true, APERM = true, AFTER_DRAIN = false;
    bf16_t* act; bf16_t* bnd_first; bf16_t* bnd_last; const float* cw; const float* cb; const float* hist; float* oconv_p; float* oconv_s; const float* rs;
    __device__ __forceinline__ void operator()(const f32x4 (&acc)[2][2][4][2], const Unit& u, int wr, int wc, int fr, int fq) const {
        const bool sample = u.pm >= 128;
        const int colh = wc * 32 + 8 * fq, jg = u.pn * 128 + colh, np = u.pn * 256 + colh;
        u32x2 stash[2][4];
        const f32x4 zero4 = (f32x4){0.f, 0.f, 0.f, 0.f};
#pragma unroll
        for (int n = 0; n < 2; ++n) {
            const int jc = jg + 4 * n;
            const f32x4 w0g = *(const PG8_GAS f32x4*)(cw + jc), w1g = *(const PG8_GAS f32x4*)(cw + 11264 + jc), w2g = *(const PG8_GAS f32x4*)(cw + 2 * 11264 + jc), bg = *(const PG8_GAS f32x4*)(cb + jc);
            const f32x4 w0v = *(const PG8_GAS f32x4*)(cw + 5632 + jc), w1v = *(const PG8_GAS f32x4*)(cw + 11264 + 5632 + jc), w2v = *(const PG8_GAS f32x4*)(cw + 2 * 11264 + 5632 + jc), bv = *(const PG8_GAS f32x4*)(cb + 5632 + jc);
#pragma unroll
            for (int ai = 0; ai < 2; ++ai) {
                const int strip = u.pm * 4 + ai * 2 + wr;
                const f32x4 r4 = *(const PG8_GAS f32x4*)(rs + u.pm * BM + ai * HALF + wr * 64 + 4 * fr);
                const f32x4 xg0 = acc[ai][0][0][n] * r4[0], xg1 = acc[ai][0][1][n] * r4[1], xg2 = acc[ai][0][2][n] * r4[2], xg3 = acc[ai][0][3][n] * r4[3];
                const f32x4 xv0 = acc[ai][1][0][n] * r4[0], xv1 = acc[ai][1][1][n] * r4[1], xv2 = acc[ai][1][2][n] * r4[2], xv3 = acc[ai][1][3][n] * r4[3];
                f32x4 pg3 = shr1_old(zero4, xg3), pg2 = shr1_old(zero4, xg2), pv3 = shr1_old(zero4, xv3), pv2 = shr1_old(zero4, xv2);
                if (sample) {
                    const int sb = (u.pm - 128) * 16 + ai * 8 + wr * 4 + (fr >> 2);
                    if ((fr & 3) == 0) { const float* hp = hist + (size_t)sb * 2 * 11264 + jc;
                        pg2 = *(const PG8_GAS f32x4*)(hp); pg3 = *(const PG8_GAS f32x4*)(hp + 11264); pv2 = *(const PG8_GAS f32x4*)(hp + 5632); pv3 = *(const PG8_GAS f32x4*)(hp + 11264 + 5632); }
                    if ((fr & 3) == 3) { float* op = oconv_s + (size_t)(sb * 2) * 11264 + jc; *(PG8_GAS f32x4*)op = xg2; *(PG8_GAS f32x4*)(op + 5632) = xv2; *(PG8_GAS f32x4*)(op + 11264) = xg3; *(PG8_GAS f32x4*)(op + 11264 + 5632) = xv3; }
                } else {
                    if (fr == 0) { bf16_t* bp = bnd_first + (size_t)(strip * 2) * 11264 + np + 4 * n;
                        u32x2 a; a.x = cvt_pk_bf16(xg0[0], xg0[1]); a.y = cvt_pk_bf16(xg0[2], xg0[3]); *(PG8_GAS u32x2*)bp = a;
                        u32x2 b; b.x = cvt_pk_bf16(xv0[0], xv0[1]); b.y = cvt_pk_bf16(xv0[2], xv0[3]); *(PG8_GAS u32x2*)(bp + 128) = b;
                        u32x2 c; c.x = cvt_pk_bf16(xg1[0], xg1[1]); c.y = cvt_pk_bf16(xg1[2], xg1[3]); *(PG8_GAS u32x2*)(bp + 11264) = c;
                        u32x2 d; d.x = cvt_pk_bf16(xv1[0], xv1[1]); d.y = cvt_pk_bf16(xv1[2], xv1[3]); *(PG8_GAS u32x2*)(bp + 11264 + 128) = d; }
                    if (fr == 15) { bf16_t* bp = bnd_last + (size_t)(strip * 2) * 11264 + np + 4 * n;
                        u32x2 a; a.x = cvt_pk_bf16(xg2[0], xg2[1]); a.y = cvt_pk_bf16(xg2[2], xg2[3]); *(PG8_GAS u32x2*)bp = a;
                        u32x2 b; b.x = cvt_pk_bf16(xv2[0], xv2[1]); b.y = cvt_pk_bf16(xv2[2], xv2[3]); *(PG8_GAS u32x2*)(bp + 128) = b;
                        u32x2 c; c.x = cvt_pk_bf16(xg3[0], xg3[1]); c.y = cvt_pk_bf16(xg3[2], xg3[3]); *(PG8_GAS u32x2*)(bp + 11264) = c;
                        u32x2 d; d.x = cvt_pk_bf16(xv3[0], xv3[1]); d.y = cvt_pk_bf16(xv3[2], xv3[3]); *(PG8_GAS u32x2*)(bp + 11264 + 128) = d;
                        if ((strip & 63) == 63) { float* op = oconv_p + (size_t)((strip >> 6) * 2) * 11264 + jc; *(PG8_GAS f32x4*)op = xg2; *(PG8_GAS f32x4*)(op + 5632) = xv2; *(PG8_GAS f32x4*)(op + 11264) = xg3; *(PG8_GAS f32x4*)(op + 11264 + 5632) = xv3; } }
                }
                const f32x4 cg0 = bg + w0g * pg2 + w1g * pg3 + w2g * xg0, cv0 = bv + w0v * pv2 + w1v * pv3 + w2v * xv0;
                const f32x4 cg1 = bg + w0g * pg3 + w1g * xg0 + w2g * xg1, cv1 = bv + w0v * pv3 + w1v * xv0 + w2v * xv1;
                const f32x4 cg2 = bg + w0g * xg0 + w1g * xg1 + w2g * xg2, cv2 = bv + w0v * xv0 + w1v * xv1 + w2v * xv2;
                const f32x4 cg3 = bg + w0g * xg1 + w1g * xg2 + w2g * xg3, cv3 = bv + w0v * xv1 + w1v * xv2 + w2v * xv3;
                const f32x4 cgs[4] = {cg0, cg1, cg2, cg3}, cvs[4] = {cv0, cv1, cv2, cv3};
#pragma unroll
                for (int m = 0; m < 4; ++m) {
                    u32x2 pk; pk.x = cvt_pk_bf16(silu_mul(cgs[m][0], cvs[m][0]), silu_mul(cgs[m][1], cvs[m][1])); pk.y = cvt_pk_bf16(silu_mul(cgs[m][2], cvs[m][2]), silu_mul(cgs[m][3], cvs[m][3]));
                    if (n == 0) stash[ai][m] = pk;
                    else if (sample || m >= 2 || fr != 0) { const int t = u.pm * BM + ai * HALF + wr * 64 + 4 * fr + m;
                        u32x4 w; w.x = stash[ai][m].x; w.y = stash[ai][m].y; w.z = pk.x; w.w = pk.y; *(PG8_GAS u32x4*)(act + (size_t)t * 5632 + jg) = w; }
                }
            }
        }
    }
};

template <class Epi, class Sched, bool ALIGN_EPI = true>
__device__ __forceinline__ void gemm_phase(PG8_LAS unsigned char* lds, const Sched& S, const Epi& E) {
    int tid_ = threadIdx.x; asm volatile("" : "+v"(tid_));
    const int tid = tid_, wid = __builtin_amdgcn_readfirstlane(tid >> 6), lane = tid & 63, wr = wid >> 2, wc = wid & 3, fr = lane & 15, fq = lane >> 4;
    const int K = S.K, nt = K / BK, lda = S.lda, ldb = S.ldb;
    unsigned voffA[2], voffB[2];
#pragma unroll
    for (int i = 0; i < 2; ++i) { int R, C; stage_rc(tid * 16 + i * 8192, R, C); const int Rb = Epi::PERM ? ((R & ~31) + perm32(R & 31)) : R;
        const int Ra = Epi::APERM ? ((R & ~63) + 4 * (R & 15) + ((R >> 4) & 3)) : R;
        voffA[i] = (unsigned)(Ra * lda + C) * 2u; voffB[i] = (unsigned)(Rb * ldb + C) * 2u; }
    const size_t kstep = (size_t)(BK * 2);
    const size_t hA = (size_t)HALF * lda * 2, hB = (size_t)HALF * ldb * 2;
    const unsigned ldsw = (unsigned)wid * 1024u;
    const int aoff = lds_byte(wr * 64 + fr, fq * 8), boff = lds_byte(wc * 32 + fr, fq * 8);
#define PG8_SA(b, h) (((b) * 2 + (h)) * HTB)
#define PG8_SB(b, h) ((4 + (b) * 2 + (h)) * HTB)
#define PG8_STAGE(bufoff, gbase, voff) do { _Pragma("unroll") for (int _i = 0; _i < 2; ++_i) \
        __builtin_amdgcn_global_load_lds((const unsigned*)((const char*)(gbase) + (voff)[_i]), (PG8_LAS unsigned*)(lds + (bufoff) + ldsw + _i * 8192), 16, 0, 0); } while (0)
#define PG8_LDA(dst, b, h) do { _Pragma("unroll") for (int m = 0; m < 4; ++m) _Pragma("unroll") for (int k = 0; k < 2; ++k) dst[m][k] = *(const PG8_LAS bf16x8*)(lds + PG8_SA(b, h) + aoff + m * 2048 + k * 1024); } while (0)
#define PG8_LDB(dst, b, h) do { _Pragma("unroll") for (int n = 0; n < 2; ++n) _Pragma("unroll") for (int k = 0; k < 2; ++k) dst[n][k] = *(const PG8_LAS bf16x8*)(lds + PG8_SB(b, h) + boff + n * 2048 + k * 1024); } while (0)
#define PG8_MMA(ai, bj, At, Bt) do { __builtin_amdgcn_s_setprio(1); _Pragma("unroll") for (int m = 0; m < 4; ++m) _Pragma("unroll") for (int n = 0; n < 2; ++n) _Pragma("unroll") for (int k = 0; k < 2; ++k) \
        acc[ai][bj][m][n] = __builtin_amdgcn_mfma_f32_16x16x32_bf16(Bt[n][k], At[m][k], acc[ai][bj][m][n], 0, 0, 0); __builtin_amdgcn_s_setprio(0); } while (0)
#define PG8_WAIT_V(n) asm volatile("s_waitcnt vmcnt(" #n ")" ::: "memory")
#define PG8_WAIT_L(n) asm volatile("s_waitcnt lgkmcnt(" #n ")" ::: "memory")
#define PG8_BAR __builtin_amdgcn_s_barrier()
#define PG8_SCHED __builtin_amdgcn_sched_barrier(0)
    Unit cur, nxt; int ui = 0;
    if (!S.next(0, cur)) return;
    f32x4 acc[2][2][4][2];
#pragma unroll
    for (int a = 0; a < 2; ++a)
#pragma unroll
        for (int b = 0; b < 2; ++b)
#pragma unroll
            for (int m = 0; m < 4; ++m)
#pragma unroll
                for (int n = 0; n < 2; ++n) acc[a][b][m][n] = (f32x4){0.f, 0.f, 0.f, 0.f};
    bf16x8 At[4][2], B0[2][2], B1[2][2];
    const char* cA = S.a_ptr(cur); const char* cB = S.b_ptr(cur);
    S.a_ready(cur);
    PG8_STAGE(PG8_SB(0, 0), cB, voffB); PG8_STAGE(PG8_SB(0, 1), cB + hB, voffB); PG8_STAGE(PG8_SA(0, 0), cA, voffA); PG8_STAGE(PG8_SA(0, 1), cA + hA, voffA);
    if (wr == 1) PG8_BAR;
    PG8_WAIT_V(2); PG8_BAR;
    PG8_STAGE(PG8_SB(1, 0), cB + kstep, voffB); PG8_STAGE(PG8_SA(1, 0), cA + kstep, voffA); PG8_STAGE(PG8_SB(1, 1), cB + hB + kstep, voffB);
    PG8_WAIT_V(6); PG8_BAR;
    for (;;) {
        const bool has_next = S.next(ui + 1, nxt);
        const char* nA = has_next ? S.a_ptr(nxt) : cA; const char* nB = has_next ? S.b_ptr(nxt) : cB;
        for (int t = 0; t < nt; t += 2) {
            const bool last = (t == nt - 2);
            const char* a1 = cA + (size_t)(t + 1) * kstep;
            const char* a2 = last ? nA : cA + (size_t)(t + 2) * kstep; const char* b2 = last ? nB : cB + (size_t)(t + 2) * kstep;
            const char* a3 = a2 + kstep; const char* b3 = b2 + kstep;
            if (last && has_next) S.a_ready(nxt);
            PG8_LDB(B0, 0, 0); PG8_LDB(B1, 0, 1); PG8_SCHED; PG8_LDA(At, 0, 0); PG8_STAGE(PG8_SA(1, 1), a1 + hA, voffA);
            PG8_WAIT_V(8); PG8_WAIT_L(0); PG8_BAR; PG8_MMA(0, 0, At, B0); PG8_MMA(0, 1, At, B1); PG8_BAR; PG8_SCHED;
            PG8_LDA(At, 0, 1); PG8_STAGE(PG8_SB(0, 0), b2, voffB); PG8_STAGE(PG8_SB(0, 1), b2 + hB, voffB); PG8_STAGE(PG8_SA(0, 0), a2, voffA);
            PG8_WAIT_V(8); PG8_WAIT_L(0); PG8_BAR; PG8_MMA(1, 0, At, B0); PG8_MMA(1, 1, At, B1); PG8_BAR; PG8_SCHED;
            PG8_LDB(B0, 1, 0); PG8_LDB(B1, 1, 1); PG8_SCHED; PG8_LDA(At, 1, 0); PG8_STAGE(PG8_SA(0, 1), a2 + hA, voffA);
            PG8_WAIT_V(8); PG8_WAIT_L(0); PG8_BAR; PG8_MMA(0, 0, At, B0); PG8_MMA(0, 1, At, B1); PG8_BAR; PG8_SCHED;
            PG8_LDA(At, 1, 1); PG8_STAGE(PG8_SB(1, 0), b3, voffB); PG8_STAGE(PG8_SB(1, 1), b3 + hB, voffB); PG8_STAGE(PG8_SA(1, 0), a3, voffA);
            PG8_WAIT_V(8); PG8_WAIT_L(0); PG8_BAR; PG8_MMA(1, 0, At, B0); PG8_MMA(1, 1, At, B1); PG8_BAR; PG8_SCHED;
        }
        if constexpr (ALIGN_EPI) { if (wr == 0) PG8_BAR; }
        E(acc, cur, wr, wc, fr, fq); S.done(cur);
        if (!has_next) break;
#pragma unroll
        for (int a = 0; a < 2; ++a)
#pragma unroll
            for (int b = 0; b < 2; ++b)
#pragma unroll
                for (int m = 0; m < 4; ++m)
#pragma unroll
                    for (int n = 0; n < 2; ++n) acc[a][b][m][n] = (f32x4){0.f, 0.f, 0.f, 0.f};
        cur = nxt; cA = nA; cB = nB; ++ui;
        if constexpr (ALIGN_EPI) { if (wr == 1) PG8_BAR; }
    }
    PG8_WAIT_V(0);
    if constexpr (!ALIGN_EPI) { if (wr == 0) PG8_BAR; }
    PG8_BAR;
#undef PG8_SA
#undef PG8_SB
#undef PG8_STAGE
#undef PG8_LDA
#undef PG8_LDB
#undef PG8_MMA
#undef PG8_WAIT_V
#undef PG8_WAIT_L
#undef PG8_BAR
#undef PG8_SCHED
}
}
namespace att {
#define ATT_LAS __attribute__((address_space(3)))
typedef unsigned short bf16;
using bf16x8 = __attribute__((ext_vector_type(8))) short;
using s16x4  = __attribute__((ext_vector_type(4))) short;
using f32x16 = __attribute__((ext_vector_type(16))) float;
using u32x4  = __attribute__((ext_vector_type(4))) unsigned;
constexpr int NW = 8, QBLK = 32, KVBLK = 64;
constexpr float SCALE = 0.07216878364870322f;
constexpr float THR = 8.f;
constexpr int LDQ = 3072, LDKV = 4096, LDKR = 64, LDO = 2048;
constexpr int SHM_V = KVBLK * 128 * 2, SHM_K = KVBLK * 192 * 2, SHM_QR0 = 2 * SHM_V + 2 * SHM_K + NW * 64 * 4, SHM_ATTN = SHM_QR0 + NW * 4 * 64 * 16;
#define KSWZ(row, colB) ((row) * 384 + ((colB) ^ (((row) & 7) << 4)))
#define SBAR() __builtin_amdgcn_sched_barrier(0)
__device__ __forceinline__ int crow(int r, int hi) { return (r & 3) + 8 * (r >> 2) + 4 * hi; }
__device__ __forceinline__ unsigned cvtpk(float lo, float hi) { unsigned r; asm volatile("v_cvt_pk_bf16_f32 %0, %1, %2" : "=v"(r) : "v"(lo), "v"(hi)); return r; }
__device__ __forceinline__ __amdgpu_buffer_rsrc_t mk_rsrc(const void* p) {
  const unsigned long a = (unsigned long)p; const unsigned lo = __builtin_amdgcn_readfirstlane((unsigned)a), hi = __builtin_amdgcn_readfirstlane((unsigned)(a >> 32));
  return __builtin_amdgcn_make_buffer_rsrc((void*)(((unsigned long)hi << 32) | lo), (short)0, 0x7fffffff, 0x00020000);
}
__device__ __forceinline__ bf16x8 ld8(const bf16* p) { return *(const __attribute__((address_space(1))) bf16x8*)p; }

__device__ __forceinline__ void partialSM(f32x16& p0, f32x16& p1, float& m_reg, float& mn, float& alpha, bool dead) {
  constexpr float C = SCALE * 1.4426950408889634f;
  if (dead) {
#pragma unroll
    for (int r = 0; r < 16; ++r) { p0[r] = -__builtin_inff(); p1[r] = -__builtin_inff(); }
  }
  float pmax = p0[0];
#pragma unroll
  for (int r = 1; r < 16; ++r) pmax = fmaxf(pmax, p0[r]);
#pragma unroll
  for (int r = 0; r < 16; ++r) pmax = fmaxf(pmax, p1[r]);
  { auto rr = __builtin_amdgcn_permlane32_swap(__float_as_uint(pmax), __float_as_uint(pmax), false, false);
    pmax = fmaxf(__uint_as_float(rr[0]), __uint_as_float(rr[1])); }
  if (__builtin_expect(__all(pmax - m_reg <= THR / SCALE), 1)) { mn = m_reg; alpha = 1.f; }
  else { mn = fmaxf(m_reg, pmax); alpha = __builtin_amdgcn_exp2f((m_reg - mn) * C); m_reg = mn; }
  float mnC = -mn * C;
#pragma unroll
  for (int r = 0; r < 16; ++r) p0[r] = fmaf(p0[r], C, mnC);
#pragma unroll
  for (int r = 0; r < 16; ++r) p1[r] = fmaf(p1[r], C, mnC);
#pragma unroll
  for (int r = 0; r < 16; ++r) p0[r] = __builtin_amdgcn_exp2f(p0[r]);
}
__device__ __forceinline__ void finishSM(f32x16& p0, f32x16& p1, float alpha, float& l_reg, bf16x8& pa0, bf16x8& pa1, bf16x8& pa2, bf16x8& pa3) {
#pragma unroll
  for (int r = 0; r < 16; ++r) p1[r] = __builtin_amdgcn_exp2f(p1[r]);
  float ps = 0;
#pragma unroll
  for (int r = 0; r < 16; ++r) ps += p0[r];
#pragma unroll
  for (int r = 0; r < 16; ++r) ps += p1[r];
  { auto rr = __builtin_amdgcn_permlane32_swap(__float_as_uint(ps), __float_as_uint(ps), false, false);
    ps = __uint_as_float(rr[0]) + __uint_as_float(rr[1]); }
  l_reg = l_reg * alpha + ps;
#define PK4(P, BASE, OUT) do { unsigned a0 = cvtpk(P[BASE + 0], P[BASE + 1]), a1 = cvtpk(P[BASE + 2], P[BASE + 3]);   \
    unsigned b0 = cvtpk(P[BASE + 4], P[BASE + 5]), b1 = cvtpk(P[BASE + 6], P[BASE + 7]);                              \
    auto r0 = __builtin_amdgcn_permlane32_swap(a0, b0, false, false); auto r1 = __builtin_amdgcn_permlane32_swap(a1, b1, false, false); \
    u32x4 w = {r0[0], r1[0], r0[1], r1[1]}; OUT = *reinterpret_cast<bf16x8*>(&w); } while (0)
  PK4(p0, 0, pa0); PK4(p0, 8, pa1); PK4(p1, 0, pa2); PK4(p1, 8, pa3);
#undef PK4
}
__device__ __forceinline__ void qkt(f32x16& p0, f32x16& p1, const ATT_LAS char* Ks, const bf16x8* qr, const ATT_LAS char* qrl, int r32, int hi) {
  p0 = f32x16{}; p1 = f32x16{};
#pragma unroll
  for (int d0 = 0; d0 < 12; ++d0) { const int cb = (d0 * 16 + hi * 8) * 2;
    bf16x8 b0 = *reinterpret_cast<const ATT_LAS bf16x8*>(Ks + KSWZ(r32, cb));
    bf16x8 b1 = *reinterpret_cast<const ATT_LAS bf16x8*>(Ks + KSWZ(32 + r32, cb));
    const bf16x8 q = d0 < 8 ? qr[d0 < 8 ? d0 : 0] : *reinterpret_cast<const ATT_LAS bf16x8*>(qrl + (d0 - 8) * 1024);
    p0 = __builtin_amdgcn_mfma_f32_32x32x16_bf16(b0, q, p0, 0, 0, 0);
    p1 = __builtin_amdgcn_mfma_f32_32x32x16_bf16(b1, q, p1, 0, 0, 0); }
}
__device__ __forceinline__ int v_st(int k, int c) { const int kk = (k & ~0xC) | ((k & 4) << 1) | ((k & 8) >> 1); return ((kk >> 3) * 4 + (c >> 5)) * 512 + ((kk & 7) * 32 + (c & 31)) * 2; }
__device__ __forceinline__ int v_rd_base(int lane) { return ((lane & 3) << 3) | (((lane >> 2) & 3) << 6) | (((lane >> 4) & 1) << 5) | (((lane >> 5) & 1) << 8); }
constexpr int v_rd_off(int d0, int ks, int half) { return d0 * 512 + ks * 4096 + half * 2048; }
template <int OFF> __device__ __forceinline__ s16x4 tr_read(int vb) {
  s16x4 r; asm volatile("ds_read_b64_tr_b16 %0, %1 offset:%2" : "=&v"(r) : "v"(vb), "i"(OFF) : "memory"); return r;
}
template <int D0> __device__ __forceinline__ void pv_one(f32x16& od, int vb, bf16x8 pa0, bf16x8 pa1, bf16x8 pa2, bf16x8 pa3) {
  const s16x4 l0 = tr_read<v_rd_off(D0, 0, 0)>(vb), h0 = tr_read<v_rd_off(D0, 0, 1)>(vb), l1 = tr_read<v_rd_off(D0, 1, 0)>(vb), h1 = tr_read<v_rd_off(D0, 1, 1)>(vb);
  const s16x4 l2 = tr_read<v_rd_off(D0, 2, 0)>(vb), h2 = tr_read<v_rd_off(D0, 2, 1)>(vb), l3 = tr_read<v_rd_off(D0, 3, 0)>(vb), h3 = tr_read<v_rd_off(D0, 3, 1)>(vb);
  asm volatile("s_waitcnt lgkmcnt(0)" ::: "memory"); SBAR();
#define PK(L, H) (bf16x8){L[0], L[1], L[2], L[3], H[0], H[1], H[2], H[3]}
  od = __builtin_amdgcn_mfma_f32_32x32x16_bf16(pa0, PK(l0, h0), od, 0, 0, 0);
  od = __builtin_amdgcn_mfma_f32_32x32x16_bf16(pa1, PK(l1, h1), od, 0, 0, 0);
  od = __builtin_amdgcn_mfma_f32_32x32x16_bf16(pa2, PK(l2, h2), od, 0, 0, 0);
  od = __builtin_amdgcn_mfma_f32_32x32x16_bf16(pa3, PK(l3, h3), od, 0, 0, 0);
#undef PK
}
__device__ __forceinline__ void pv_d0(f32x16* o, int vb, bf16x8 pa0, bf16x8 pa1, bf16x8 pa2, bf16x8 pa3) {
  pv_one<0>(o[0], vb, pa0, pa1, pa2, pa3); pv_one<1>(o[1], vb, pa0, pa1, pa2, pa3); pv_one<2>(o[2], vb, pa0, pa1, pa2, pa3); pv_one<3>(o[3], vb, pa0, pa1, pa2, pa3);
}

__device__ __forceinline__ void attn_unit(const bf16* __restrict__ Qb, const bf16* __restrict__ Kh, const bf16* __restrict__ Vh, const bf16* __restrict__ KRh,
                                          bf16* __restrict__ Ob, int NT, int qb, ATT_LAS char* lds) {
  int tid_ = threadIdx.x; asm volatile("" : "+v"(tid_));
  const int tid = tid_, wid = __builtin_amdgcn_readfirstlane(tid >> 6), lane = tid & 63, r32 = lane & 31, hi = lane >> 5;
  const int lim = 4 * qb + (wid >> 1);
  ATT_LAS char* V_lds = lds; ATT_LAS char* K_lds = lds + 2 * SHM_V;
  ATT_LAS float* ws = (ATT_LAS float*)(lds + 2 * SHM_V + 2 * SHM_K) + wid * 64; ATT_LAS float* li_l = ws; ATT_LAS float* al_l = ws + 32;
  float m_reg = -1e30f, l_reg = 0; f32x16 o[4] = {}; bf16x8 qr[8];
  ATT_LAS char* qrl = lds + SHM_QR0 + wid * 4096 + lane * 16;
  const bf16* Qw = Qb + (long)(wid * QBLK + r32) * LDQ + hi * 8;
#pragma unroll
  for (int d0 = 0; d0 < 8; ++d0) qr[d0] = ld8(Qw + d0 * 16);
#pragma unroll
  for (int d0 = 8; d0 < 12; ++d0) *reinterpret_cast<ATT_LAS bf16x8*>(qrl + (d0 - 8) * 1024) = ld8(Qw + d0 * 16);
  const int sr = tid >> 4, sc = (tid & 15) * 8, vst0 = v_st(sr, sc), vst1 = v_st(32 + sr, sc);
  const int kr_row = tid >> 3, kr_c = (tid & 7) * 8;
  const int vb0 = (int)(unsigned)(unsigned long)V_lds + v_rd_base(lane);
  const __amdgpu_buffer_rsrc_t rsK = mk_rsrc(Kh), rsV = mk_rsrc(Vh), rsR = mk_rsrc(KRh);
  const unsigned vo0 = (unsigned)(sr * LDKV + sc) * 2u, vo1 = (unsigned)((32 + sr) * LDKV + sc) * 2u, vor = (unsigned)(kr_row * LDKR + kr_c) * 2u;
  struct { bf16x8 vs0, vs1, ks0, ks1, kr; } sr_[1];
#define SLOAD(i, k0) do { const int so_ = (k0) * (LDKV * 2), sr2_ = (k0) * (LDKR * 2); \
    sr_[i].vs0 = __builtin_bit_cast(bf16x8, __builtin_amdgcn_raw_buffer_load_b128(rsV, (int)vo0, so_, 0)); sr_[i].vs1 = __builtin_bit_cast(bf16x8, __builtin_amdgcn_raw_buffer_load_b128(rsV, (int)vo1, so_, 0)); \
    sr_[i].ks0 = __builtin_bit_cast(bf16x8, __builtin_amdgcn_raw_buffer_load_b128(rsK, (int)vo0, so_, 0)); sr_[i].ks1 = __builtin_bit_cast(bf16x8, __builtin_amdgcn_raw_buffer_load_b128(rsK, (int)vo1, so_, 0)); \
    sr_[i].kr = __builtin_bit_cast(bf16x8, __builtin_amdgcn_raw_buffer_load_b128(rsR, (int)vor, sr2_, 0)); } while (0)
#define SWRITE(b, i) do { *(ATT_LAS bf16x8*)(V_lds + (b) * SHM_V + vst0) = sr_[i].vs0;          \
    *(ATT_LAS bf16x8*)(V_lds + (b) * SHM_V + vst1) = sr_[i].vs1; const int kc = sc * 2;               \
    *(ATT_LAS bf16x8*)(K_lds + (b) * SHM_K + KSWZ(sr, kc)) = sr_[i].ks0;                       \
    *(ATT_LAS bf16x8*)(K_lds + (b) * SHM_K + KSWZ(32 + sr, kc)) = sr_[i].ks1;                  \
    *(ATT_LAS bf16x8*)(K_lds + (b) * SHM_K + KSWZ(kr_row, 256 + kr_c * 2)) = sr_[i].kr; } while (0)
#define SWAIT() asm volatile("s_waitcnt vmcnt(0)" ::: "memory")
#define RESC(a) do { if (__any((a) < 1.f)) { if (hi == 0) al_l[r32] = (a); asm volatile("s_waitcnt lgkmcnt(0)" ::: "memory"); \
    _Pragma("unroll") for (int d = 0; d < 4; ++d) _Pragma("unroll") for (int r = 0; r < 16; ++r) o[d][r] *= al_l[crow(r, hi)]; } } while (0)
  f32x16 pA0, pA1, pB0, pB1; float mnA, mnB, alA, alB; bf16x8 pa0, pa1, pa2, pa3;
  constexpr int SE = 0, SO = 0;
  SLOAD(SE, 0); asm volatile("s_waitcnt vmcnt(0)" ::: "memory"); SWRITE(0, SE); __syncthreads();
  qkt(pA0, pA1, K_lds, qr, qrl, r32, hi); partialSM(pA0, pA1, m_reg, mnA, alA, false);
  SLOAD(SO, KVBLK);
  SWAIT(); SWRITE(1, SO); __syncthreads();
  for (int j = 1; j + 1 < NT; j += 2) {
    SBAR(); qkt(pB0, pB1, K_lds + SHM_K, qr, qrl, r32, hi);
    finishSM(pA0, pA1, alA, l_reg, pa0, pa1, pa2, pa3); SBAR();
    SLOAD(SO, (j + 1) * KVBLK); SBAR();
    pv_d0(o, vb0, pa0, pa1, pa2, pa3); partialSM(pB0, pB1, m_reg, mnB, alB, j > lim);
    __syncthreads(); SWAIT(); SWRITE(0, SE);
    RESC(alB); __syncthreads();
    SBAR(); qkt(pA0, pA1, K_lds, qr, qrl, r32, hi);
    finishSM(pB0, pB1, alB, l_reg, pa0, pa1, pa2, pa3); SBAR();
    SLOAD(SE, (j + 2) * KVBLK); SBAR();
    pv_d0(o, vb0 + SHM_V, pa0, pa1, pa2, pa3); partialSM(pA0, pA1, m_reg, mnA, alA, j + 1 > lim);
    __syncthreads(); SWAIT(); SWRITE(1, SO);
    RESC(alA); __syncthreads();
  }
  SBAR(); qkt(pB0, pB1, K_lds + SHM_K, qr, qrl, r32, hi);
  finishSM(pA0, pA1, alA, l_reg, pa0, pa1, pa2, pa3); SBAR();
  pv_d0(o, vb0, pa0, pa1, pa2, pa3); partialSM(pB0, pB1, m_reg, mnB, alB, NT - 1 > lim);
  __syncthreads(); RESC(alB);
  finishSM(pB0, pB1, alB, l_reg, pa0, pa1, pa2, pa3); SBAR();
  pv_d0(o, vb0 + SHM_V, pa0, pa1, pa2, pa3);
  if (hi == 0) li_l[r32] = l_reg; asm volatile("s_waitcnt lgkmcnt(0)" ::: "memory");
  float rli[16];
#pragma unroll
  for (int r = 0; r < 16; ++r) rli[r] = __builtin_amdgcn_rcpf(li_l[crow(r, hi)]);
  bf16* Ow = Ob + (long)(wid * QBLK) * LDO;
#pragma unroll
  for (int r = 0; r < 16; ++r) { const int orow = crow(r, hi);
#pragma unroll
    for (int d0 = 0; d0 < 4; ++d0) { const float v = o[d0][r] * rli[r]; unsigned u = __float_as_uint(v); u = (u + 0x7fffu + ((u >> 16) & 1u)) >> 16; ((__attribute__((address_space(1))) bf16*)Ow)[(long)orow * LDO + d0 * 32 + r32] = (bf16)u; } }
  __syncthreads();
#undef SLOAD
#undef SWRITE
#undef SWAIT
#undef RESC
}
#undef KSWZ
#undef SBAR
}
constexpr int NWAVES = 8;
constexpr int TP = 32768, TS = 512, T = TP + TS, DM = 2048, DFF = 5632, NUP = 2 * DFF, SEQ = 4096;
constexpr float EPS = 1e-6f;
static_assert((2048 + 16 - 1) / 64 == 2048 / 64, "all cache keys and new keys of a sample stream lie in chunks <= the query chunk: the chunk mask is all-true for the sample streams");
constexpr size_t O_Y = 0, O_CKV_P = O_Y + (size_t)T * DM, O_KR_P = O_CKV_P + (size_t)2 * TP * 512, O_POOL_P = O_KR_P + (size_t)2 * TP * 64, O_CONV_P = O_POOL_P + (size_t)2 * 8 * 15 * DM,
                 O_CKV_S = O_CONV_P + (size_t)4 * 8 * 2 * NUP, O_KR_S = O_CKV_S + (size_t)2 * TS * 512, O_POOL_S = O_KR_S + (size_t)2 * TS * 64, O_CONV_S = O_POOL_S + (size_t)2 * 32 * 15 * DM,
                 O_END = O_CONV_S + (size_t)4 * 32 * 2 * NUP;
static_assert(O_END == 112558080, "d_out size");
constexpr size_t MiB = 1u << 20;
constexpr size_t WS_CTL = 0, CTL_ZERO_BYTES = 1 * MiB;
constexpr size_t WS_ROPE = 1 * MiB;
constexpr size_t WS_RS = 2 * MiB;
constexpr size_t WS_W = 3 * MiB;
constexpr size_t W_MLA = 24 * MiB;
constexpr size_t WO_DQKV = 0, WO_UQ = 5 * MiB, WO_UKV = 8 * MiB, WO_UK2 = 12 * MiB, WO_O = 16 * MiB;
constexpr size_t WS_WPOOL = WS_W + 2 * W_MLA;
constexpr size_t WS_WFFN = WS_WPOOL + 4 * MiB, WO_UP = 0, WO_DOWN = 44 * MiB;
constexpr size_t WS_HB = WS_WFFN + 66 * MiB;
constexpr size_t WS_MB = WS_HB + 130 * MiB;
constexpr size_t WS_S = WS_MB, WS_P = WS_MB + 72 * MiB;
constexpr size_t WS_BND = WS_MB + 130 * MiB;
constexpr size_t WS_XB = WS_BND + 44 * MiB;
constexpr size_t WS_SLAB = WS_XB + 130 * MiB;
constexpr size_t WS_BIG = WS_SLAB + 44 * MiB;
constexpr size_t WS_ACT = WS_BIG;
constexpr size_t WS_Q = WS_BIG, WS_CQ = WS_BIG + 196 * MiB, WS_CKVB = WS_BIG + 229 * MiB, WS_KRB = WS_BIG + 261 * MiB, WS_KV = WS_BIG + 265 * MiB;
constexpr size_t WS_KALL = WS_KV, WS_VT = WS_KV + 90 * MiB, WS_QLAT = WS_KV + 162 * MiB, WS_OL = WS_KV + 172 * MiB;
constexpr size_t WS_END = WS_KV + 256 * MiB;
static_assert(WS_HB == 121 * MiB && WS_END == 1120 * MiB, "ws map");
static_assert((size_t)T * 1280 * 4 <= 174 * MiB && (size_t)T * 5632 * 2 <= WS_END - WS_BIG && (size_t)T * 3072 * 2 + 4096 <= 196 * MiB && (size_t)11 * 512 * 2048 * 4 <= 44 * MiB, "ws aliases");
constexpr int CW_BAR = 4096;

#define GAS __attribute__((address_space(1)))
#define LAS __attribute__((address_space(3)))
typedef unsigned short bf16;
typedef unsigned v4u __attribute__((ext_vector_type(4)));
typedef unsigned v2u __attribute__((ext_vector_type(2)));
typedef float f32x4 __attribute__((ext_vector_type(4)));
typedef short bf16x8 __attribute__((ext_vector_type(8)));
#define LDS_WAIT() asm volatile("s_waitcnt lgkmcnt(0)" ::: "memory")
#define VM_WAIT() asm volatile("s_waitcnt vmcnt(0)" ::: "memory")
__device__ __forceinline__ unsigned f2bf(float f) { unsigned u = __builtin_bit_cast(unsigned, f); return (u + 0x7fffu + ((u >> 16) & 1u)) >> 16; }
__device__ __forceinline__ unsigned pk2(float lo, float hi) { return f2bf(lo) | (f2bf(hi) << 16); }
__device__ __forceinline__ float bflo(unsigned w) { return __builtin_bit_cast(float, w << 16); }
__device__ __forceinline__ float bfhi(unsigned w) { return __builtin_bit_cast(float, w & 0xffff0000u); }

#define XB_TMO      128
#define XB_XCNT(j)  (256  + 64 * (j))
#define XB_XSUB(j)  (1280 + 64 * (j))
#define XB_XGEN(j)  (2304 + 64 * (j))
#define XB_TOP      3328
#define XB_TOPGEN   3392
#define XCD_BAR_WORDS 3456
#define XB_SPIN_CAP (1u << 18)
__device__ __forceinline__ unsigned xb_ld(unsigned* p)              { return __hip_atomic_load(p, __ATOMIC_RELAXED, __HIP_MEMORY_SCOPE_AGENT); }
__device__ __forceinline__ unsigned xb_add(unsigned* p, unsigned v) { return __hip_atomic_fetch_add(p, v, __ATOMIC_RELAXED, __HIP_MEMORY_SCOPE_AGENT); }
__device__ __forceinline__ unsigned xb_xcc_id() { return (unsigned)__builtin_amdgcn_s_getreg((3 << 11) | 20) & 0xFu; }
#define XB_SPIN(cond, bar) do { unsigned _sp = 0; while (cond) { __builtin_amdgcn_s_sleep(1); \
    if ((++_sp & 255u) == 0u) { if (xb_ld(&(bar)[XB_TMO])) break; if (_sp > XB_SPIN_CAP) { atomicAdd(&(bar)[XB_TMO], 1u); break; } } } } while (0)
struct XcdBarrier { unsigned* bar; unsigned x; volatile LAS unsigned* st; };
__device__ __forceinline__ XcdBarrier xcd_barrier_post(unsigned* bar, volatile LAS unsigned* st) {
    XcdBarrier b; b.bar = bar; b.x = xb_xcc_id(); b.st = st;
    if (threadIdx.x == 0) (void)xb_add(&bar[XB_XCNT(b.x)], 1u);
    return b;
}
__device__ __forceinline__ void xcd_barrier_complete(unsigned* bar, unsigned x, unsigned& nloc, unsigned& nx) {
    const unsigned G = gridDim.x * gridDim.y * gridDim.z;
    unsigned sum, cnt, mine, sp = 0u;
    for (;;) {
        sum = 0u; cnt = 0u; mine = 0u;
#pragma unroll
        for (unsigned j = 0; j < 16; ++j) { const unsigned c = xb_ld(&bar[XB_XCNT(j)]); sum += c; cnt += (c > 0u) ? 1u : 0u; mine = (j == x) ? c : mine; }
        if (sum == G) break;
        __builtin_amdgcn_s_sleep(1);
        if ((++sp & 255u) == 0u) { if (xb_ld(&bar[XB_TMO])) break; if (sp > XB_SPIN_CAP) { atomicAdd(&bar[XB_TMO], 1u); break; } }
    }
    nloc = mine > 0u ? mine : 1u; nx = cnt > 0u ? cnt : 1u;
}
__device__ __forceinline__ void xcd_barrier(const XcdBarrier& b) {
    asm volatile("s_waitcnt vmcnt(0)" ::: "memory");
    __syncthreads();
    if (threadIdx.x == 0) {
        unsigned* bar = b.bar;
        __builtin_amdgcn_s_waitcnt(0);
        unsigned nloc = b.st[0], nx = b.st[1];
        if (nloc == 0u) { xcd_barrier_complete(bar, b.x, nloc, nx); b.st[0] = nloc; b.st[1] = nx; }
        const unsigned old = xb_add(&bar[XB_XSUB(b.x)], 1u);
        const unsigned gen = old / nloc;
        if (old + 1u == (gen + 1u) * nloc) {
            __builtin_amdgcn_fence(__ATOMIC_RELEASE, "agent");
            asm volatile("s_waitcnt vmcnt(0)" ::: "memory");
            const unsigned og = xb_add(&bar[XB_TOP], 1u);
            const unsigned tg = og / nx;
            if (og + 1u == (tg + 1u) * nx) xb_add(&bar[XB_TOPGEN], 1u);
            else XB_SPIN(xb_ld(&bar[XB_TOPGEN]) == tg, bar);
            __builtin_amdgcn_fence(__ATOMIC_ACQUIRE, "agent");
            xb_add(&bar[XB_XGEN(b.x)], 1u);
            asm volatile("s_waitcnt vmcnt(0)" ::: "memory");
        } else {
            XB_SPIN(xb_ld(&bar[XB_XGEN(b.x)]) == gen, bar);
            __builtin_amdgcn_fence(__ATOMIC_ACQUIRE, "agent");
            asm volatile("s_waitcnt vmcnt(0)" ::: "memory");
        }
    }
    __syncthreads();
}

constexpr int RING_OFF = 0, RING_BYTES = 131072;
constexpr int LDSCTL_OFF = RING_BYTES, MISC_OFF = LDSCTL_OFF + 320;
constexpr int LDS_BYTES = 147456;
static_assert(att::SHM_ATTN <= RING_BYTES, "attention scratch fits the ring");

struct Frame {
    LAS unsigned char* lds;
    int tid, lane, wave;
    int vcu, G;
    float* out; unsigned char* ws;
};
constexpr int PTR_OFF = MISC_OFF + 256;
__device__ __forceinline__ const float* inp(const Frame& F, int i) {
    int off = PTR_OFF + 8 * i; asm volatile("" : "+s"(off));
    const unsigned long long v = *(const LAS unsigned long long*)(F.lds + off);
    const unsigned lo = __builtin_amdgcn_readfirstlane((unsigned)v), hi = __builtin_amdgcn_readfirstlane((unsigned)(v >> 32));
    return (const float*)(((unsigned long long)hi << 32) | lo);
}
__device__ __forceinline__ void frame_lanes(Frame& F) {
    int t = threadIdx.x; asm volatile("" : "+v"(t)); F.tid = t; F.lane = t & 63; F.wave = __builtin_amdgcn_readfirstlane(t >> 6);
    unsigned long long w = (unsigned long long)F.ws, o = (unsigned long long)F.out; unsigned l = (unsigned)(unsigned long long)F.lds; int g = F.G, v = F.vcu;
    asm volatile("" : "+s"(w), "+s"(o), "+s"(l), "+s"(g), "+s"(v));
    F.ws = (unsigned char*)w; F.out = (float*)o; F.lds = (LAS unsigned char*)(unsigned long long)l; F.G = g; F.vcu = v;
}
__device__ __forceinline__ float shx(float v, int o, int lane) { return __builtin_bit_cast(float, __builtin_amdgcn_ds_bpermute((lane ^ o) << 2, __builtin_bit_cast(int, v))); }
__device__ __forceinline__ float wave_sum(float v, int lane) {
#pragma unroll
    for (int o = 1; o < 64; o <<= 1) v += shx(v, o, lane);
    return v;
}
__device__ __forceinline__ float wave_max(float v, int lane) {
#pragma unroll
    for (int o = 1; o < 64; o <<= 1) v = fmaxf(v, shx(v, o, lane));
    return v;
}

__device__ __forceinline__ int dest_row(int map, int row_off, int n) {
    if (map == 1) { return n < DFF ? ((n >> 7) * 256 + (n & 127)) : (((n - DFF) >> 7) * 256 + 128 + ((n - DFF) & 127)); }
    if (map == 2) { const int h = n / 192, d = n - h * 192; if (d < 128) return n; const int i = d - 128; return h * 192 + 128 + (i < 32 ? 2 * i : 2 * (i - 32) + 1); }
    return row_off + n;
}
__device__ __forceinline__ void transpose_item(const float* W, int ldw, bf16* WT, int ldt, int map, int row_off, int kb, int nb, LAS float* scr, int lane, const float* ks = nullptr, bf16* RM = nullptr, int ldr = 0) {
    const int k0 = 64 * kb, n0 = 32 * nb;
#pragma unroll
    for (int i = 0; i < 8; ++i) { const int kk = 8 * i + (lane >> 3), c4 = (lane & 7) * 4; f32x4 v = *(const GAS f32x4*)(W + (size_t)(k0 + kk) * ldw + n0 + c4);
        if (ks) v = v * ((const GAS float*)ks)[k0 + kk];
        LAS float* d = scr + kk * 33 + c4; d[0] = v.x; d[1] = v.y; d[2] = v.z; d[3] = v.w; }
    LDS_WAIT(); asm volatile("" ::: "memory");
    const int c = lane & 7;
#pragma unroll
    for (int j = 0; j < 4; ++j) { const int n = (lane >> 3) + 8 * j; const LAS float* s = scr + (8 * c) * 33 + n;
        v4u o; o.x = pk2(s[0 * 33], s[1 * 33]); o.y = pk2(s[2 * 33], s[3 * 33]); o.z = pk2(s[4 * 33], s[5 * 33]); o.w = pk2(s[6 * 33], s[7 * 33]);
        *(GAS v4u*)(WT + (size_t)dest_row(map, row_off, n0 + n) * ldt + k0 + 8 * c) = o; }
    if (RM) {
        const LAS float* s = scr + lane * 33;
#pragma unroll
        for (int q = 0; q < 4; ++q) { v4u o; o.x = pk2(s[8 * q], s[8 * q + 1]); o.y = pk2(s[8 * q + 2], s[8 * q + 3]); o.z = pk2(s[8 * q + 4], s[8 * q + 5]); o.w = pk2(s[8 * q + 6], s[8 * q + 7]);
            *(GAS v4u*)(RM + (size_t)(k0 + lane) * ldr + n0 + 8 * q) = o; }
    }
    LDS_WAIT(); asm volatile("" ::: "memory");
}

__device__ __forceinline__ void p0_prologue(Frame& F) {
    frame_lanes(F);
    LAS float* scr = (LAS float*)(F.lds + RING_OFF + F.wave * 16384);
    const int gw = F.vcu * NWAVES + F.wave, NGW = F.G * NWAVES;
    {
        float* ct = (float*)(F.ws + WS_ROPE); float* st = ct + 4096 * 32;
        for (int idx = (F.vcu * NWAVES + F.wave) * 64 + F.lane; idx < 4096 * 32; idx += NGW * 64) {
            const int pos = idx >> 5, i = idx & 31;
            double inv = 1.0; for (int k = 0; k < i; ++k) inv *= 0.7498942093324558273;
            double a = (double)pos * inv;
            const double twopi = 6.283185307179586476925287; a -= twopi * __builtin_rint(a / twopi);
            const double x = a * 0.125, x2 = x * x;
            double s = x * (1.0 + x2 * (-1.0 / 6 + x2 * (1.0 / 120 + x2 * (-1.0 / 5040 + x2 * (1.0 / 362880 + x2 * (-1.0 / 39916800))))));
            double c = 1.0 + x2 * (-0.5 + x2 * (1.0 / 24 + x2 * (-1.0 / 720 + x2 * (1.0 / 40320 + x2 * (-1.0 / 3628800 + x2 * (1.0 / 479001600))))));
#pragma unroll
            for (int k = 0; k < 3; ++k) { const double s2 = 2.0 * s * c, c2 = 1.0 - 2.0 * s * s; s = s2; c = c2; }
            ((GAS float*)ct)[idx] = (float)c; ((GAS float*)st)[idx] = (float)s;
        }
    }
    constexpr int I_DQ = 32 * 16, I_DKV = 32 * 18, I_UQ = 8 * 96, I_UK = 8 * 64, I_UV = 8 * 64, I_O = 32 * 64, I_MLA = I_DQ + I_DKV + I_UQ + I_UK + I_UV + I_O;
    constexpr int I_POOL = 4 * 8 * 16;
    constexpr int NITEMS = 2 * I_MLA + 2 * I_POOL;
    for (int it = gw; it < NITEMS; it += NGW) {
        const float* W; const float* ks = nullptr; int ldw, ldt, map = 0, row_off = 0, nnb, r; bf16* WT;
        if (it < 2 * I_MLA) {
            const int j = it / I_MLA; r = it - j * I_MLA; unsigned char* wb = F.ws + WS_W + j * W_MLA;
            if (r < I_DQ) { W = inp(F, 7) + (size_t)j * 2048 * 512; ldw = 512; WT = (bf16*)(wb + WO_DQKV); ldt = 2048; nnb = 16; ks = inp(F, 6) + (size_t)(2 * j) * 4 * DM; }
            else if ((r -= I_DQ) < I_DKV) { W = inp(F, 10) + (size_t)j * 2048 * 576; ldw = 576; WT = (bf16*)(wb + WO_DQKV); ldt = 2048; nnb = 18; row_off = 512; ks = inp(F, 6) + (size_t)(2 * j) * 4 * DM; }
            else if ((r -= I_DKV) < I_UQ) { W = inp(F, 9) + (size_t)j * 512 * 3072; ldw = 3072; WT = (bf16*)(wb + WO_UQ); ldt = 512; nnb = 96; map = 2; }
            else if ((r -= I_UQ) < I_UK) { W = inp(F, 12) + (size_t)j * 512 * 2048; ldw = 2048; WT = (bf16*)(wb + WO_UKV); ldt = 512; nnb = 64; }
            else if ((r -= I_UK) < I_UV) { W = inp(F, 13) + (size_t)j * 512 * 2048; ldw = 2048; WT = (bf16*)(wb + WO_UKV); ldt = 512; nnb = 64; row_off = 2048; }
            else { r -= I_UV; W = inp(F, 14) + (size_t)j * 2048 * 2048; ldw = 2048; WT = (bf16*)(wb + WO_O); ldt = 2048; nnb = 64; }
        } else {
            r = it - 2 * I_MLA; const int jg = r / (8 * 16); r -= jg * (8 * 16);
            W = inp(F, 15) + (size_t)jg * 512 * 512; ldw = 512; WT = (bf16*)(F.ws + WS_WPOOL + (size_t)(jg >> 2) * 2 * MiB); ldt = 512; nnb = 16; row_off = (jg & 3) * 512;
        }
        transpose_item(W, ldw, WT, ldt, map, row_off, r / nnb, r % nnb, scr, F.lane, ks);
    }
    for (int row = gw; row < 2 * 8192; row += NGW) {
        const int j = row >> 13, hc = row & 8191, h = hc >> 9, c = hc & 511;
        const GAS float* src = (const GAS float*)(inp(F, 12) + (size_t)j * 512 * 2048 + (size_t)c * 2048 + h * 128 + 2 * F.lane);
        GAS unsigned* dst = (GAS unsigned*)((unsigned*)(F.ws + WS_W + j * W_MLA + WO_UK2) + (size_t)hc * 128);
        dst[F.lane] = pk2(src[0], src[1]); dst[64 + F.lane] = 0u;
    }
}

__device__ __forceinline__ void convert_ffn(Frame& F, int L) {
    LAS float* scr = (LAS float*)(F.lds + RING_OFF + F.wave * 16384);
    const int gw = F.vcu * NWAVES + F.wave, NGW = F.G * NWAVES;
    constexpr int I_UP = 32 * 352, I_DN = 88 * 64;
    const float* wu = inp(F, 17) + (size_t)L * 2048 * NUP; const float* wd = inp(F, 20) + (size_t)L * DFF * 2048; const float* g2 = inp(F, 6) + (size_t)(L * 4 + 2) * DM;
    for (int it = gw; it < I_UP + I_DN; it += NGW) {
        if (it < I_UP) transpose_item(wu, NUP, (bf16*)(F.ws + WS_WFFN + WO_UP), 2048, 1, 0, it / 352, it % 352, scr, F.lane, g2);
        else { const int r = it - I_UP; transpose_item(wd, 2048, (bf16*)(F.ws + WS_WFFN + WO_DOWN), DFF, 0, 0, r / 64, r % 64, scr, F.lane); }
    }
}
__device__ __forceinline__ void norm0_phase(Frame& F) {
    frame_lanes(F);
    const int gw = F.vcu * NWAVES + F.wave, NGW = F.G * NWAVES;
    const float* xp = inp(F, 0); const float* xs = inp(F, 1);
    bf16* XB = (bf16*)(F.ws + WS_XB); float* RS = (float*)(F.ws + WS_RS);
    for (int row = gw; row < T; row += NGW) {
        const float* xin = row < TP ? xp + (size_t)row * DM : xs + (size_t)(row - TP) * DM;
        f32x4 x[8]; float s2 = 0.f;
#pragma unroll
        for (int j = 0; j < 8; ++j) x[j] = *(const GAS f32x4*)(xin + (F.lane + 64 * j) * 4);
#pragma unroll
        for (int j = 0; j < 8; ++j) s2 += (x[j].x * x[j].x + x[j].y * x[j].y) + (x[j].z * x[j].z + x[j].w * x[j].w);
        const float r2 = 1.0f / sqrtf(wave_sum(s2, F.lane) * (1.0f / DM) + EPS);
#pragma unroll
        for (int j = 0; j < 8; ++j) { v2u w; w.x = pk2(x[j].x, x[j].y); w.y = pk2(x[j].z, x[j].w); *(GAS v2u*)(XB + (size_t)row * DM + (F.lane + 64 * j) * 4) = w; }
        if (F.lane == 0) ((GAS float*)RS)[row] = r2;
    }
}
template <bool LAST, bool POOLST>
__device__ __forceinline__ void norm_phase(Frame& F, const bf16* mres, const float* slab, int ns, const float* g_post, const float* g_pre, float* pool_p, float* pool_s, bool poison, bool dry = false) {
    frame_lanes(F);
    const int gw = F.vcu * NWAVES + F.wave, NGW = F.G * NWAVES;
    bf16* XB = (bf16*)(F.ws + WS_XB); bf16* XBo = dry ? (bf16*)(F.ws + WS_BIG) : XB;
    float* RS = (float*)(F.ws + WS_RS);
    f32x4 gp[8];
#pragma unroll
    for (int j = 0; j < 8; ++j) gp[j] = *(const GAS f32x4*)(g_post + (F.lane + 64 * j) * 4);
    for (int row = gw; row < T; row += NGW) {
        f32x4 x[8], mv[8];
#pragma unroll
        for (int j = 0; j < 8; ++j) { const v2u w = *(const GAS v2u*)(XB + (size_t)row * DM + (F.lane + 64 * j) * 4); x[j] = (f32x4){bflo(w.x), bfhi(w.x), bflo(w.y), bfhi(w.y)}; }
        if (ns > 0 && row >= TP) {
#pragma unroll
            for (int j = 0; j < 8; ++j) mv[j] = (f32x4){0.f, 0.f, 0.f, 0.f};
            for (int k = 0; k < ns; ++k) {
#pragma unroll
                for (int j = 0; j < 8; ++j) mv[j] = mv[j] + *(const GAS f32x4*)(slab + ((size_t)k * TS + (row - TP)) * DM + (F.lane + 64 * j) * 4); }
        } else {
#pragma unroll
            for (int j = 0; j < 8; ++j) { const v2u w = *(const GAS v2u*)(mres + (size_t)row * DM + (F.lane + 64 * j) * 4); mv[j] = (f32x4){bflo(w.x), bfhi(w.x), bflo(w.y), bfhi(w.y)}; } }
        float ss = 0.f;
#pragma unroll
        for (int j = 0; j < 8; ++j) ss += (mv[j].x * mv[j].x + mv[j].y * mv[j].y) + (mv[j].z * mv[j].z + mv[j].w * mv[j].w);
        const float r1 = 1.0f / sqrtf(wave_sum(ss, F.lane) * (1.0f / DM) + EPS);
#pragma unroll
        for (int j = 0; j < 8; ++j) x[j] = x[j] + mv[j] * r1 * gp[j];
        if (LAST) {
            if (poison) {
#pragma unroll
                for (int j = 0; j < 8; ++j) x[j] = x[j] * __builtin_nanf("");
            }
#pragma unroll
            for (int j = 0; j < 8; ++j) *(GAS f32x4*)(F.out + (size_t)row * DM + (F.lane + 64 * j) * 4) = x[j];
        } else {
#pragma unroll
            for (int j = 0; j < 8; ++j) { v2u w; w.x = pk2(x[j].x, x[j].y); w.y = pk2(x[j].z, x[j].w); *(GAS v2u*)(XBo + (size_t)row * DM + (F.lane + 64 * j) * 4) = w; }
            float s2 = 0.f;
#pragma unroll
            for (int j = 0; j < 8; ++j) s2 += (x[j].x * x[j].x + x[j].y * x[j].y) + (x[j].z * x[j].z + x[j].w * x[j].w);
            const float r2 = 1.0f / sqrtf(wave_sum(s2, F.lane) * (1.0f / DM) + EPS);
            if (F.lane == 0) ((GAS float*)RS)[row] = r2;
            if (POOLST) {
                float* ps = nullptr;
                if (row < TP) { const int s = row & (SEQ - 1); if (s >= SEQ - 15) ps = pool_p + ((size_t)(row >> 12) * 15 + (s - (SEQ - 15))) * DM; }
                else { const int qi = (row - TP) & 15; if (qi >= 1) ps = pool_s + ((size_t)((row - TP) >> 4) * 15 + (qi - 1)) * DM; }
                if (ps) {
#pragma unroll
                    for (int j = 0; j < 8; ++j) { const int c = (F.lane + 64 * j) * 4; *(GAS f32x4*)(ps + c) = x[j] * r2 * *(const GAS f32x4*)(g_pre + c); } }
            }
        }
    }
}

__device__ __forceinline__ void s1_phase(Frame& F, int j) {
    frame_lanes(F);
    const int gw = F.vcu * NWAVES + F.wave, NGW = F.G * NWAVES, lane = F.lane;
    const float* raw = (const float*)(F.ws + WS_MB);
    const float* qn = inp(F, 8) + j * 512; const float* kn = inp(F, 11) + j * 512;
    const float* ct = (const float*)(F.ws + WS_ROPE); const float* st = ct + 4096 * 32;
    bf16* CQ = (bf16*)(F.ws + WS_CQ); bf16* CKVB = (bf16*)(F.ws + WS_CKVB); bf16* KRB = (bf16*)(F.ws + WS_KRB);
    bf16* KALL = (bf16*)(F.ws + WS_KALL); bf16* VT = (bf16*)(F.ws + WS_VT);
    f32x4 gqn[2], gkn[2];
#pragma unroll
    for (int i = 0; i < 2; ++i) { gqn[i] = *(const GAS f32x4*)(qn + (lane + 64 * i) * 4); gkn[i] = *(const GAS f32x4*)(kn + (lane + 64 * i) * 4); }
    for (int row = gw; row < T; row += NGW) {
        const float* rr = raw + (size_t)row * 1280;
        f32x4 a[2], b[2]; float ssa = 0.f, ssb = 0.f;
#pragma unroll
        for (int i = 0; i < 2; ++i) { a[i] = *(const GAS f32x4*)(rr + (lane + 64 * i) * 4); b[i] = *(const GAS f32x4*)(rr + 512 + (lane + 64 * i) * 4);
            ssa += (a[i].x * a[i].x + a[i].y * a[i].y) + (a[i].z * a[i].z + a[i].w * a[i].w); ssb += (b[i].x * b[i].x + b[i].y * b[i].y) + (b[i].z * b[i].z + b[i].w * b[i].w); }
        const float rs_row = ((const GAS float*)(F.ws + WS_RS))[row];
#pragma unroll
        for (int i = 0; i < 2; ++i) { a[i] = a[i] * rs_row; b[i] = b[i] * rs_row; }
        ssa *= rs_row * rs_row; ssb *= rs_row * rs_row;
        const float kv = ((const GAS float*)rr)[1024 + lane] * rs_row;
        const float ra = 1.0f / sqrtf(wave_sum(ssa, lane) * (1.0f / 512) + EPS), rb = 1.0f / sqrtf(wave_sum(ssb, lane) * (1.0f / 512) + EPS);
        const bool prompt = row < TP;
        const int sb = (row - TP) >> 4, qi = (row - TP) & 15;
        const int pos = prompt ? (row & (SEQ - 1)) : 2048 + qi;
        float* o_ckv = prompt ? F.out + O_CKV_P + ((size_t)j * TP + row) * 512 : F.out + O_CKV_S + ((size_t)j * TS + (row - TP)) * 512;
        float* o_kr = prompt ? F.out + O_KR_P + ((size_t)j * TP + row) * 64 : F.out + O_KR_S + ((size_t)j * TS + (row - TP)) * 64;
#pragma unroll
        for (int i = 0; i < 2; ++i) {
            const int c = (lane + 64 * i) * 4;
            const f32x4 q = a[i] * ra * gqn[i]; v2u w; w.x = pk2(q.x, q.y); w.y = pk2(q.z, q.w); *(GAS v2u*)(CQ + (size_t)row * 512 + c) = w;
            const f32x4 k = b[i] * rb * gkn[i]; *(GAS f32x4*)(o_ckv + c) = k; v2u wk; wk.x = pk2(k.x, k.y); wk.y = pk2(k.z, k.w);
            if (prompt) *(GAS v2u*)(CKVB + (size_t)row * 512 + c) = wk;
            else { *(GAS v2u*)(KALL + ((size_t)sb * 2304 + 2048 + qi) * 640 + c) = wk;
                GAS bf16* vt = (GAS bf16*)(VT + ((size_t)sb * 512 + c) * 2304 + 2048 + qi); vt[0] = (bf16)(wk.x & 0xffff); vt[2304] = (bf16)(wk.x >> 16); vt[2 * 2304] = (bf16)(wk.y & 0xffff); vt[3 * 2304] = (bf16)(wk.y >> 16); }
        }
        const float other = shx(kv, 32, lane); const int i5 = lane & 31; const float cs = ((const GAS float*)ct)[pos * 32 + i5], sn = ((const GAS float*)st)[pos * 32 + i5];
        const float rot = lane < 32 ? kv * cs - other * sn : other * sn + kv * cs;
        ((GAS float*)o_kr)[lane] = rot;
        const float rot_hi = shx(rot, 32, lane);
        if (lane < 32) { const unsigned w = pk2(rot, rot_hi);
            if (prompt) ((GAS unsigned*)(KRB + (size_t)row * 64))[lane] = w; else ((GAS unsigned*)(KALL + ((size_t)sb * 2304 + 2048 + qi) * 640 + 512))[lane] = w; }
        else if (!prompt) ((GAS unsigned*)(KALL + ((size_t)sb * 2304 + 2048 + qi) * 640 + 576))[lane - 32] = 0u;
    }
    const float* cck = inp(F, 2) + (size_t)j * 32 * 2048 * 512; const float* ckr = inp(F, 3) + (size_t)j * 32 * 2048 * 64;
    for (int r = gw; r < 32 * 2304; r += NGW) {
        const int b = r / 2304, key = r - b * 2304; GAS unsigned* dst = (GAS unsigned*)(KALL + (size_t)r * 640);
        if (key < 2048) {
            const float kr = ((const GAS float*)ckr)[((size_t)b * 2048 + key) * 64 + lane]; const float kh = shx(kr, 32, lane);
            if (lane < 32) dst[256 + lane] = pk2(kr, kh); else dst[288 + lane - 32] = 0u;
        } else if (key >= 2064) {
#pragma unroll
            for (int i = 0; i < 5; ++i) dst[lane + 64 * i] = 0u;
        }
    }
    { LAS float* scr = (LAS float*)(F.lds + RING_OFF + F.wave * 16384);
      for (int it = gw; it < 32 * 512; it += NGW) { const int b = it >> 9, r = it & 511;
          transpose_item(cck + (size_t)b * 2048 * 512, 512, VT + (size_t)b * 512 * 2304, 2304, 0, 0, r >> 4, r & 15, scr, lane, nullptr, KALL + (size_t)b * 2304 * 640, 640); }
      for (int r = gw; r < 32 * 512; r += NGW) { GAS unsigned* dst = (GAS unsigned*)(VT + (size_t)r * 2304 + 2064); dst[lane] = 0u; if (lane < 56) dst[64 + lane] = 0u; }
    }
}

__device__ __forceinline__ void qlat_rope_copy(Frame& F) {
    frame_lanes(F);
    const bf16* Q = (const bf16*)(F.ws + WS_Q); bf16* QL = (bf16*)(F.ws + WS_QLAT);
    for (int idx = (F.vcu * NWAVES + F.wave) * 64 + F.lane; idx < 8192 * 16; idx += F.G * NWAVES * 64) {
        const int row = idx >> 4, ch = idx & 15, b = row >> 8, h = (row >> 4) & 15, qi = row & 15;
        v4u v = (v4u){0u, 0u, 0u, 0u};
        if (ch < 8) v = *(const GAS v4u*)(Q + (size_t)(TP + b * 16 + qi) * 3072 + h * 192 + 128 + ch * 8);
        *(GAS v4u*)(QL + (size_t)row * 640 + 512 + ch * 8) = v;
    }
}

__device__ __forceinline__ void softmax_phase(Frame& F) {
    frame_lanes(F);
    const float* S = (const float*)(F.ws + WS_S); bf16* P = (bf16*)(F.ws + WS_P);
    const int gw = F.vcu * NWAVES + F.wave, NGW = F.G * NWAVES, lane = F.lane;
    constexpr float C = att::SCALE * 1.4426950408889634f;
    for (int row = gw; row < 8192; row += NGW) {
        f32x4 v[9]; float mx = -1e30f;
#pragma unroll
        for (int j = 0; j < 9; ++j) { const int c = lane * 4 + 256 * j; v[j] = *(const GAS f32x4*)(S + (size_t)row * 2304 + c);
            if (c >= 2064) v[j] = (f32x4){-1e30f, -1e30f, -1e30f, -1e30f};
            mx = fmaxf(mx, fmaxf(fmaxf(v[j].x, v[j].y), fmaxf(v[j].z, v[j].w))); }
        mx = wave_max(mx, lane); float sum = 0.f;
#pragma unroll
        for (int j = 0; j < 9; ++j) { const int c = lane * 4 + 256 * j;
            v[j].x = __builtin_amdgcn_exp2f((v[j].x - mx) * C); v[j].y = __builtin_amdgcn_exp2f((v[j].y - mx) * C); v[j].z = __builtin_amdgcn_exp2f((v[j].z - mx) * C); v[j].w = __builtin_amdgcn_exp2f((v[j].w - mx) * C);
            if (c >= 2064) v[j] = (f32x4){0.f, 0.f, 0.f, 0.f};
            sum += (v[j].x + v[j].y) + (v[j].z + v[j].w); }
        const float inv = 1.0f / wave_sum(sum, lane);
#pragma unroll
        for (int j = 0; j < 9; ++j) { const int c = lane * 4 + 256 * j; v2u w; w.x = pk2(v[j].x * inv, v[j].y * inv); w.y = pk2(v[j].z * inv, v[j].w * inv); *(GAS v2u*)(P + (size_t)row * 2304 + c) = w; }
    }
}

__device__ __forceinline__ void pool_d_phase(Frame& F, int j, const float* g0) {
    frame_lanes(F);
    const bf16* X = (const bf16*)(F.ws + WS_XB); bf16* Dd = (bf16*)(F.ws + WS_ACT); const GAS float* RS = (const GAS float*)(F.ws + WS_RS);
    const float* hist = inp(F, 4) + (size_t)j * 32 * 15 * DM;
    const int gw = F.vcu * NWAVES + F.wave, NGW = F.G * NWAVES, lane = F.lane;
    for (int row = gw; row < T; row += NGW) {
        const bool prompt = row < TP; const int s = prompt ? (row & (SEQ - 1)) : ((row - TP) & 15); const int sb = (row - TP) >> 4;
#pragma unroll
        for (int g = 0; g < 4; ++g) {
            const int w = 2 << g, c = g * 512 + lane * 8;
            const f32x4 ga = *(const GAS f32x4*)(g0 + c), gb = *(const GAS f32x4*)(g0 + c + 4);
            const float gg[8] = {ga.x, ga.y, ga.z, ga.w, gb.x, gb.y, gb.z, gb.w};
            float acc[8], self[8];
#pragma unroll
            for (int e = 0; e < 8; ++e) { acc[e] = 0.f; self[e] = 0.f; }
            for (int k = 0; k < w; ++k) {
                const int sk = s - k;
                if (sk >= 0) { const v4u v = *(const GAS v4u*)(X + (size_t)(row - k) * DM + c); const float r = RS[row - k];
                    const float f[8] = {bflo(v.x), bfhi(v.x), bflo(v.y), bfhi(v.y), bflo(v.z), bfhi(v.z), bflo(v.w), bfhi(v.w)};
#pragma unroll
                    for (int e = 0; e < 8; ++e) { const float hv = f[e] * r * gg[e]; acc[e] += hv; if (k == 0) self[e] = hv; } }
                else if (!prompt) { const float* hp = hist + ((size_t)sb * 15 + (15 + sk)) * DM + c; const f32x4 u0 = *(const GAS f32x4*)hp, u1 = *(const GAS f32x4*)(hp + 4);
                    acc[0] += u0.x; acc[1] += u0.y; acc[2] += u0.z; acc[3] += u0.w; acc[4] += u1.x; acc[5] += u1.y; acc[6] += u1.z; acc[7] += u1.w; }
            }
            const float cnt = prompt ? (float)((s + 1) < w ? (s + 1) : w) : (float)w; const float ic = 1.0f / cnt;
            v4u o; o.x = pk2(acc[0] * ic - self[0], acc[1] * ic - self[1]); o.y = pk2(acc[2] * ic - self[2], acc[3] * ic - self[3]);
            o.z = pk2(acc[4] * ic - self[4], acc[5] * ic - self[5]); o.w = pk2(acc[6] * ic - self[6], acc[7] * ic - self[7]);
            *(GAS v4u*)(Dd + (size_t)row * DM + c) = o;
        }
    }
}

__device__ __forceinline__ void fix_phase(Frame& F, int L) {
    frame_lanes(F);
    const bf16* BF = (const bf16*)(F.ws + WS_BND); const bf16* BL = BF + (size_t)512 * 2 * NUP;
    const float* cw = inp(F, 18) + (size_t)L * 3 * NUP; const float* cb = inp(F, 19) + (size_t)L * NUP;
    bf16* act = (bf16*)(F.ws + WS_ACT);
    for (int idx = (F.vcu * NWAVES + F.wave) * 64 + F.lane; idx < 512 * 2 * 704; idx += F.G * NWAVES * 64) {
        const int cc = idx % 704, sj = idx / 704, s = sj >> 1, jr = sj & 1;
        const int jg = cc * 8, np = (jg >> 7) * 256 + (jg & 127);
        const bool seq0 = (s & 63) == 0;
        float u0[2][8], u1[2][8], u2[2][8];
#pragma unroll
        for (int gv = 0; gv < 2; ++gv) {
            const v4u zero = (v4u){0u, 0u, 0u, 0u};
            const v4u cur = *(const GAS v4u*)(BF + (size_t)(s * 2 + jr) * NUP + np + gv * 128);
            const v4u f0 = *(const GAS v4u*)(BF + (size_t)(s * 2) * NUP + np + gv * 128);
            const v4u l0 = seq0 ? zero : *(const GAS v4u*)(BL + (size_t)((s - 1) * 2) * NUP + np + gv * 128);
            const v4u l1 = seq0 ? zero : *(const GAS v4u*)(BL + (size_t)((s - 1) * 2 + 1) * NUP + np + gv * 128);
            const v4u p1 = jr ? f0 : l1, p2 = jr ? l1 : l0;
            const unsigned cu[4] = {cur.x, cur.y, cur.z, cur.w}, a1[4] = {p1.x, p1.y, p1.z, p1.w}, a2[4] = {p2.x, p2.y, p2.z, p2.w};
#pragma unroll
            for (int e = 0; e < 4; ++e) { u0[gv][2 * e] = bflo(cu[e]); u0[gv][2 * e + 1] = bfhi(cu[e]); u1[gv][2 * e] = bflo(a1[e]); u1[gv][2 * e + 1] = bfhi(a1[e]); u2[gv][2 * e] = bflo(a2[e]); u2[gv][2 * e + 1] = bfhi(a2[e]); }
        }
        float r[8];
#pragma unroll
        for (int e = 0; e < 8; ++e) {
            const int cg = jg + e, cv = DFF + jg + e;
            const GAS float* cwg = (const GAS float*)cw; const GAS float* cbg = (const GAS float*)cb;
            const float g = cbg[cg] + cwg[cg] * u2[0][e] + cwg[NUP + cg] * u1[0][e] + cwg[2 * NUP + cg] * u0[0][e];
            const float v = cbg[cv] + cwg[cv] * u2[1][e] + cwg[NUP + cv] * u1[1][e] + cwg[2 * NUP + cv] * u0[1][e];
            r[e] = pg8::silu_mul(g, v);
        }
        v4u o; o.x = pk2(r[0], r[1]); o.y = pk2(r[2], r[3]); o.z = pk2(r[4], r[5]); o.w = pk2(r[6], r[7]);
        *(GAS v4u*)(act + (size_t)(s * 64 + jr) * DFF + jg) = o;
    }
}

__device__ __forceinline__ void attn_phase(Frame& F) {
    frame_lanes(F);
    const bf16* Q = (const bf16*)(F.ws + WS_Q); const bf16* KV = (const bf16*)(F.ws + WS_KV); const bf16* KRB = (const bf16*)(F.ws + WS_KRB); bf16* O = (bf16*)(F.ws + WS_HB);
    for (int pi = F.vcu; pi < 1024; pi += F.G) {
        const int bh = pi >> 3, s = pi & 7, b = bh >> 4, h = bh & 15;
#pragma unroll 1
        for (int half = 0; half < 2; ++half) {
            const int qb = half ? 15 - s : s;
            const size_t row0 = (size_t)b * SEQ;
            att::attn_unit(Q + (row0 + 256 * qb) * 3072 + h * 192, KV + row0 * 4096 + h * 128, KV + row0 * 4096 + 2048 + h * 128, KRB + row0 * 64,
                           O + (row0 + 256 * qb) * DM + h * 128, 4 * qb + 4, qb, (ATT_LAS char*)(F.lds + RING_OFF));
        }
    }
}

struct Args { const float* in[21]; float* out; unsigned char* ws; int ph_lo, ph_hi; };
constexpr int NPH = 1 + 4 * 16;
#ifndef PG8_ALIGN
#define PG8_ALIGN true
#endif
__global__ void __launch_bounds__(NWAVES * 64, 2) fwd_kernel(Args args) {
    extern __shared__ __attribute__((aligned(16))) unsigned char lds[];
    Frame F;
    F.lds = (LAS unsigned char*)lds;
    F.tid = threadIdx.x; F.lane = F.tid & 63; F.wave = __builtin_amdgcn_readfirstlane(F.tid >> 6);
    F.G = gridDim.x; { const int bx = blockIdx.x; F.vcu = (F.G % 8 == 0) ? (bx % 8) * (F.G / 8) + bx / 8 : bx; }
    F.out = args.out; F.ws = args.ws;
    unsigned* ctl = (unsigned*)(F.ws + WS_CTL);
    for (int u = F.tid; u < (LDS_BYTES - LDSCTL_OFF) / 4; u += NWAVES * 64) ((LAS unsigned*)(F.lds + LDSCTL_OFF))[u] = 0u;
    __syncthreads();
    if (F.tid == 0) {
#pragma unroll
        for (int i = 0; i < 21; ++i) ((LAS unsigned long long*)(F.lds + PTR_OFF))[i] = (unsigned long long)args.in[i];
    }
    __syncthreads();
    const int lo = args.ph_lo, hi = args.ph_hi;
    const bool one_launch = (hi - lo) > 1;
    XcdBarrier bar; bar.bar = ctl + CW_BAR; bar.x = 0; bar.st = nullptr;
    if (one_launch) bar = xcd_barrier_post(ctl + CW_BAR, (volatile LAS unsigned*)(F.lds + MISC_OFF) + 8);
#ifndef PH_MASK
#define PH_MASK 0x1ffffu
#endif
#define IN(k) (lo <= (k) && (k) < hi)
#define EN(p) (((PH_MASK) >> (p)) & 1u)
#ifndef DBL_MASK
#define DBL_MASK 0u
#endif
#define REPS(p) ((int)(((DBL_MASK) >> (p)) & 1u) + 1)
#define SEAM(k) do { if (IN((k) + 1)) { xcd_barrier(bar); if (REPS(17) > 1) xcd_barrier(bar); } } while (0)
    const int bid = (int)blockIdx.x;

    if (EN(16) && IN(0)) { for (int rep_ = 0; rep_ < REPS(16); ++rep_) { if (rep_) xcd_barrier(bar); p0_prologue(F); convert_ffn(F, 0); norm0_phase(F); } SEAM(0); }

    for (int L = 0; L < 4; ++L) {
        const int base = 1 + 16 * L, j = L >> 1;
        const float* ng = inp(F, 6) + (size_t)L * 4 * DM;
        if ((L & 1) == 0) {
            unsigned char* wb = F.ws + WS_W + j * W_MLA;
            if (EN(0) && IN(base + 0)) { for (int rep_ = 0; rep_ < REPS(0); ++rep_) { if (rep_) xcd_barrier(bar); frame_lanes(F); LAS unsigned char* ring = F.lds + RING_OFF;  pg8::SchedPlain S; S.init(130, 5, F.G, bid); S.A = (const char*)(F.ws + WS_XB); S.B = (const char*)(wb + WO_DQKV); S.lda = 2048; S.ldb = 2048; S.K = 2048;
                pg8::EpiF32 E{(float*)(F.ws + WS_MB), 1280}; pg8::gemm_phase<pg8::EpiF32, pg8::SchedPlain, PG8_ALIGN>(ring, S, E);  } SEAM(base + 0); }
            if (EN(1) && IN(base + 1)) { for (int rep_ = 0; rep_ < REPS(1); ++rep_) { if (rep_) xcd_barrier(bar); frame_lanes(F); LAS unsigned char* ring = F.lds + RING_OFF;  s1_phase(F, j);  } SEAM(base + 1); }
            if (EN(2) && IN(base + 2)) { for (int rep_ = 0; rep_ < REPS(2); ++rep_) { if (rep_) xcd_barrier(bar); frame_lanes(F); LAS unsigned char* ring = F.lds + RING_OFF;  pg8::SchedPlain S; S.init(130, 12, F.G, bid); S.A = (const char*)(F.ws + WS_CQ); S.B = (const char*)(wb + WO_UQ); S.lda = 512; S.ldb = 512; S.K = 512;
                pg8::EpiQRope E{(bf16*)(F.ws + WS_Q), (const float*)(F.ws + WS_ROPE), (const float*)(F.ws + WS_ROPE) + 4096 * 32};
                pg8::gemm_phase<pg8::EpiQRope, pg8::SchedPlain, PG8_ALIGN>(ring, S, E);  } SEAM(base + 2); }
            if (EN(3) && IN(base + 3)) { for (int rep_ = 0; rep_ < REPS(3); ++rep_) { if (rep_) xcd_barrier(bar); frame_lanes(F); LAS unsigned char* ring = F.lds + RING_OFF;  qlat_rope_copy(F);
                pg8::SchedQlat S; S.init(32, 2, F.G, bid); S.A = (const char*)(F.ws + WS_Q) + (size_t)TP * 3072 * 2; S.B = (const char*)(wb + WO_UK2); S.lda = 3072; S.ldb = 256; S.K = 256;
                pg8::EpiB<1> E{(bf16*)(F.ws + WS_QLAT), 640, nullptr}; pg8::gemm_phase<pg8::EpiB<1>, pg8::SchedQlat, PG8_ALIGN>(ring, S, E);  } SEAM(base + 3); }
            if (EN(4) && IN(base + 4)) { for (int rep_ = 0; rep_ < REPS(4); ++rep_) { if (rep_) xcd_barrier(bar); frame_lanes(F); LAS unsigned char* ring = F.lds + RING_OFF;  pg8::SchedBatch S; S.init(32, 9, F.G, bid); S.A = (const char*)(F.ws + WS_QLAT); S.B = (const char*)(F.ws + WS_KALL); S.lda = 640; S.ldb = 640; S.K = 640; S.b_pm = (size_t)2304 * 640 * 2;
                pg8::EpiF32 E{(float*)(F.ws + WS_S), 2304}; pg8::gemm_phase<pg8::EpiF32, pg8::SchedBatch, PG8_ALIGN>(ring, S, E);  } SEAM(base + 4); }
            if (EN(5) && IN(base + 5)) { for (int rep_ = 0; rep_ < REPS(5); ++rep_) { if (rep_) xcd_barrier(bar); frame_lanes(F); LAS unsigned char* ring = F.lds + RING_OFF;  softmax_phase(F);  } SEAM(base + 5); }
            if (EN(6) && IN(base + 6)) { for (int rep_ = 0; rep_ < REPS(6); ++rep_) { if (rep_) xcd_barrier(bar); frame_lanes(F); LAS unsigned char* ring = F.lds + RING_OFF;  pg8::SchedBatch S; S.init(32, 2, F.G, bid); S.A = (const char*)(F.ws + WS_P); S.B = (const char*)(F.ws + WS_VT); S.lda = 2304; S.ldb = 2304; S.K = 2304; S.b_pm = (size_t)512 * 2304 * 2;
                pg8::EpiB<2> E{(bf16*)(F.ws + WS_OL), 512, nullptr}; pg8::gemm_phase<pg8::EpiB<2>, pg8::SchedBatch, PG8_ALIGN>(ring, S, E);  } SEAM(base + 6); }
            if (EN(7) && IN(base + 7)) { for (int rep_ = 0; rep_ < REPS(7); ++rep_) { if (rep_) xcd_barrier(bar); frame_lanes(F); LAS unsigned char* ring = F.lds + RING_OFF;  pg8::SchedOV S; S.init(32, 1, F.G, bid); S.A = (const char*)(F.ws + WS_OL); S.B = (const char*)(wb + WO_UKV) + (size_t)2048 * 512 * 2; S.lda = 512; S.ldb = 512; S.K = 512;
                pg8::EpiB<3> E{(bf16*)(F.ws + WS_HB), 2048, nullptr}; pg8::gemm_phase<pg8::EpiB<3>, pg8::SchedOV, PG8_ALIGN>(ring, S, E);  } SEAM(base + 7); }
            if (EN(8) && IN(base + 8)) { for (int rep_ = 0; rep_ < REPS(8); ++rep_) { if (rep_) xcd_barrier(bar); frame_lanes(F); LAS unsigned char* ring = F.lds + RING_OFF;  pg8::SchedPlain S; S.init(128, 16, F.G, bid); S.A = (const char*)(F.ws + WS_CKVB); S.B = (const char*)(wb + WO_UKV); S.lda = 512; S.ldb = 512; S.K = 512;
                pg8::EpiB<0> E{(bf16*)(F.ws + WS_KV), 4096, nullptr}; pg8::gemm_phase<pg8::EpiB<0>, pg8::SchedPlain, PG8_ALIGN>(ring, S, E);  } SEAM(base + 8); }
            if (EN(9) && IN(base + 9)) { for (int rep_ = 0; rep_ < REPS(9); ++rep_) { if (rep_) xcd_barrier(bar); frame_lanes(F); LAS unsigned char* ring = F.lds + RING_OFF;  attn_phase(F);  } SEAM(base + 9); }
            if (EN(10) && IN(base + 10)) { for (int rep_ = 0; rep_ < REPS(10); ++rep_) { if (rep_) xcd_barrier(bar); frame_lanes(F); LAS unsigned char* ring = F.lds + RING_OFF;  pg8::SchedPlain S; S.init(128, 8, F.G, bid); S.A = (const char*)(F.ws + WS_HB); S.B = (const char*)(wb + WO_O); S.lda = 2048; S.ldb = 2048; S.K = 2048;
                pg8::EpiB<0> E{(bf16*)(F.ws + WS_MB), 2048, nullptr}; pg8::gemm_phase<pg8::EpiB<0>, pg8::SchedPlain, PG8_ALIGN>(ring, S, E);
                { pg8::SchedSplit S2; S2.init(2 * 4, 8, F.G, bid); S2.A = (const char*)(F.ws + WS_HB) + (size_t)TP * 2048 * 2; S2.B = (const char*)(wb + WO_O); S2.lda = 2048; S2.ldb = 2048; S2.K = 512;
                  pg8::EpiSlab E2{(float*)(F.ws + WS_SLAB)}; pg8::gemm_phase<pg8::EpiSlab, pg8::SchedSplit, PG8_ALIGN>(ring, S2, E2); }  } SEAM(base + 10); }
        } else {
            if (EN(9) && IN(base + 9)) { for (int rep_ = 0; rep_ < REPS(9); ++rep_) { if (rep_) xcd_barrier(bar); frame_lanes(F); LAS unsigned char* ring = F.lds + RING_OFF;  pool_d_phase(F, j, ng);  } SEAM(base + 9); }
            if (EN(10) && IN(base + 10)) { for (int rep_ = 0; rep_ < REPS(10); ++rep_) { if (rep_) xcd_barrier(bar); frame_lanes(F); LAS unsigned char* ring = F.lds + RING_OFF;  pg8::SchedPool S; S.init(130, 8, F.G, bid); S.A = (const char*)(F.ws + WS_ACT); S.B = (const char*)(F.ws + WS_WPOOL + (size_t)j * 2 * MiB); S.lda = 2048; S.ldb = 512; S.K = 512;
                pg8::EpiB<0> E{(bf16*)(F.ws + WS_MB), 2048, inp(F, 16) + (size_t)j * DM}; pg8::gemm_phase<pg8::EpiB<0>, pg8::SchedPool, PG8_ALIGN>(ring, S, E);  } SEAM(base + 10); }
        }
        unsigned char* wf = F.ws + WS_WFFN;
        if (EN(11) && IN(base + 11)) { for (int rep_ = 0; rep_ < REPS(11); ++rep_) { if (rep_) xcd_barrier(bar); frame_lanes(F); LAS unsigned char* ring = F.lds + RING_OFF;  const int nsb = (L & 1) ? 0 : 4; const bool dry = rep_ + 1 < REPS(11); norm_phase<false, false>(F, (const bf16*)(F.ws + WS_MB), (const float*)(F.ws + WS_SLAB), nsb, ng + DM, nullptr, nullptr, nullptr, false, dry);  } SEAM(base + 11); }
        if (EN(12) && IN(base + 12)) { for (int rep_ = 0; rep_ < REPS(12); ++rep_) { if (rep_) xcd_barrier(bar); frame_lanes(F); LAS unsigned char* ring = F.lds + RING_OFF;  pg8::SchedPlain S; S.init(130, 44, F.G, bid); S.A = (const char*)(F.ws + WS_XB); S.B = (const char*)(wf + WO_UP); S.lda = 2048; S.ldb = 2048; S.K = 2048;
            pg8::EpiUp E{(bf16*)(F.ws + WS_ACT), (bf16*)(F.ws + WS_BND), (bf16*)(F.ws + WS_BND) + (size_t)512 * 2 * NUP, inp(F, 18) + (size_t)L * 3 * NUP, inp(F, 19) + (size_t)L * NUP,
                         inp(F, 5) + (size_t)L * 32 * 2 * NUP, F.out + O_CONV_P + (size_t)L * 8 * 2 * NUP, F.out + O_CONV_S + (size_t)L * 32 * 2 * NUP, (const float*)(F.ws + WS_RS)};
            pg8::gemm_phase<pg8::EpiUp, pg8::SchedPlain, PG8_ALIGN>(ring, S, E);  } SEAM(base + 12); }
        if (EN(13) && IN(base + 13)) { for (int rep_ = 0; rep_ < REPS(13); ++rep_) { if (rep_) xcd_barrier(bar); frame_lanes(F); LAS unsigned char* ring = F.lds + RING_OFF;  fix_phase(F, L);  } SEAM(base + 13); }
        if (EN(14) && IN(base + 14)) { for (int rep_ = 0; rep_ < REPS(14); ++rep_) { if (rep_) xcd_barrier(bar); frame_lanes(F); LAS unsigned char* ring = F.lds + RING_OFF;  pg8::SchedPlain S; S.init(128, 8, F.G, bid); S.A = (const char*)(F.ws + WS_ACT); S.B = (const char*)(wf + WO_DOWN); S.lda = DFF; S.ldb = DFF; S.K = DFF;
            pg8::EpiB<0> E{(bf16*)(F.ws + WS_MB), 2048, nullptr}; pg8::gemm_phase<pg8::EpiB<0>, pg8::SchedPlain, PG8_ALIGN>(ring, S, E);
            { pg8::SchedSplit S2; S2.init(2 * 11, 8, F.G, bid); S2.A = (const char*)(F.ws + WS_ACT) + (size_t)TP * DFF * 2; S2.B = (const char*)(wf + WO_DOWN); S2.lda = DFF; S2.ldb = DFF; S2.K = 512;
              pg8::EpiSlab E2{(float*)(F.ws + WS_SLAB)}; pg8::gemm_phase<pg8::EpiSlab, pg8::SchedSplit, PG8_ALIGN>(ring, S2, E2); }  } SEAM(base + 14); }
        if (EN(15) && IN(base + 15)) {
            const bool poison = one_launch && xb_ld(ctl + CW_BAR + XB_TMO) != 0u;
            frame_lanes(F);
            if (L < 3) convert_ffn(F, L + 1);
            const float* slab = (const float*)(F.ws + WS_SLAB);
            if (L == 3) norm_phase<true, false>(F, (const bf16*)(F.ws + WS_MB), slab, 11, ng + 3 * DM, nullptr, nullptr, nullptr, poison);
            else if ((L & 1) == 0) norm_phase<false, true>(F, (const bf16*)(F.ws + WS_MB), slab, 11, ng + 3 * DM, ng + 4 * DM, F.out + O_POOL_P + (size_t)j * 8 * 15 * DM, F.out + O_POOL_S + (size_t)j * 32 * 15 * DM, false);
            else norm_phase<false, false>(F, (const bf16*)(F.ws + WS_MB), slab, 11, ng + 3 * DM, nullptr, nullptr, nullptr, false);
            if (L < 3) SEAM(base + 15);
        }
    }
#undef IN
#undef SEAM
}

#ifndef MK_PER_PHASE
#define MK_PER_PHASE 0
#endif
extern "C" void kernel_launch(void* const* d_in, const int* in_sizes, int n_in, void* d_out, int out_size, void* d_ws, size_t ws_size, hipStream_t stream) {
    static int grid = 0;
    if (grid == 0) {
        if (n_in != 21 || (size_t)out_size != O_END || ws_size < WS_END) { fprintf(stderr, "kernel_launch: unexpected problem shape (n_in %d, out %d, ws %zu < %zu); nothing launched\n", n_in, out_size, ws_size, (size_t)WS_END); grid = -1; return; }
        int dev = 0, cus = 0, per_cu = 0;
        if (hipGetDevice(&dev) != hipSuccess || hipDeviceGetAttribute(&cus, hipDeviceAttributeMultiprocessorCount, dev) != hipSuccess) { grid = -1; return; }
        if (hipFuncSetAttribute((const void*)fwd_kernel, hipFuncAttributeMaxDynamicSharedMemorySize, LDS_BYTES) != hipSuccess) { fprintf(stderr, "kernel_launch: hipFuncSetAttribute failed\n"); grid = -1; return; }
        if (hipOccupancyMaxActiveBlocksPerMultiprocessor(&per_cu, (const void*)fwd_kernel, NWAVES * 64, LDS_BYTES) != hipSuccess || per_cu < 1) { fprintf(stderr, "kernel_launch: occupancy query says %d blocks per CU\n", per_cu); }
        (void)hipGetLastError();
        grid = cus;
    }
    if (grid < 0) return;
    (void)hipMemsetAsync((char*)d_ws + WS_CTL, 0, CTL_ZERO_BYTES, stream);
    Args a{};
    for (int i = 0; i < 21; ++i) a.in[i] = (const float*)d_in[i];
    a.out = (float*)d_out; a.ws = (unsigned char*)d_ws;
#if MK_PER_PHASE
    for (int p = 0; p < NPH; ++p) {
        if (p >= 1) { const int L = (p - 1) >> 4, q = (p - 1) & 15; if ((L & 1) && q < 9) continue; }
        a.ph_lo = p; a.ph_hi = p + 1;
        hipLaunchKernelGGL(fwd_kernel, dim3(grid), dim3(NWAVES * 64), LDS_BYTES, stream, a);
    }
#else
    a.ph_lo = 0; a.ph_hi = NPH;
    hipLaunchKernelGGL(fwd_kernel, dim3(grid), dim3(NWAVES * 64), LDS_BYTES, stream, a);
#endif
}
```

```cpp
#define DBL_MASK 0u
#ifndef MK_PER_PHASE
#define MK_PER_PHASE 0
#endif
#include <hip/hip_runtime.h>
#include <cstdio>
#include <cstdint>
namespace pg8 {
#define PG8_LAS __attribute__((address_space(3)))
#define PG8_GAS __attribute__((address_space(1)))
typedef unsigned short bf16_t;
typedef short bf16x8 __attribute__((ext_vector_type(8)));
typedef float f32x4 __attribute__((ext_vector_type(4)));
typedef unsigned u32x4 __attribute__((ext_vector_type(4)));
typedef unsigned u32x2 __attribute__((ext_vector_type(2)));
constexpr int BM = 256, BK = 64, HALF = 128, HTB = HALF * BK * 2  , STAGE_BYTES = 8 * HTB, NXCD = 8, WGM = 8;

__host__ __device__ __forceinline__ int lds_byte(int r, int c) { const int st = (r >> 4) * 2 + (c >> 5), rr = r & 15, cc = c & 31, ob = rr * 64 + cc * 2; return st * 1024 + (ob ^ (((ob >> 9) & 1) << 5)); }
__host__ __device__ __forceinline__ void stage_rc(int b, int& R, int& C) { const int st = b / 1024, sb = b % 1024, swz = sb ^ (((sb >> 9) & 1) << 5); R = (st >> 1) * 16 + swz / 64; C = (st & 1) * 32 + (swz % 64) / 2; }
__host__ __device__ __forceinline__ int perm32(int rho) { const int n = rho >> 4, i = rho & 15; return 8 * (i >> 2) + 4 * n + (i & 3); }

struct Unit { int pm, pn; };

struct OrderBase {
    int nM, nN, nwg, G, c;
    __device__ __forceinline__ void init(int nM_, int nN_, int G_, int c_) { nM = nM_; nN = nN_; nwg = nM * nN; G = G_; c = c_; }
    __device__ __forceinline__ bool next(int i, Unit& u) const {
        const long L = (long)i * G + c; if (L >= nwg) return false;
        int wgid = (int)L; { const int q = nwg / NXCD, r = nwg % NXCD, xcd = wgid % NXCD, off = wgid / NXCD; wgid = (xcd < r ? xcd * (q + 1) : r * (q + 1) + (xcd - r) * q) + off; }
        const int nig = WGM * nN, gid = wgid / nig, fm = gid * WGM, gsz = (nM - fm) < WGM ? (nM - fm) : WGM;
        u.pm = fm + ((wgid % nig) % gsz); u.pn = (wgid % nig) / gsz; return true;
    }
    __device__ __forceinline__ void a_ready(const Unit&) const {}
    __device__ __forceinline__ void done(const Unit&) const {}
};
struct SchedPlain : OrderBase {
    const char* A; const char* B; int lda, ldb, K;
    __device__ __forceinline__ const char* a_ptr(const Unit& u) const { return A + (size_t)u.pm * 256 * lda * 2; }
    __device__ __forceinline__ const char* b_ptr(const Unit& u) const { return B + (size_t)u.pn * 256 * ldb * 2; }
};
struct SchedBatch : OrderBase {
    const char* A; const char* B; int lda, ldb, K; size_t b_pm;
    __device__ __forceinline__ const char* a_ptr(const Unit& u) const { return A + (size_t)u.pm * 256 * lda * 2; }
    __device__ __forceinline__ const char* b_ptr(const Unit& u) const { return B + (size_t)u.pm * b_pm + (size_t)u.pn * 256 * ldb * 2; }
};
struct SchedQlat : OrderBase {
    const char* A; const char* B; int lda, ldb, K;
    __device__ __forceinline__ const char* a_ptr(const Unit& u) const { return A + ((size_t)(u.pm & 1) * 256 * lda + (size_t)(u.pm >> 1) * 192) * 2; }
    __device__ __forceinline__ const char* b_ptr(const Unit& u) const { return B + ((size_t)(u.pm >> 1) * 512 + (size_t)u.pn * 256) * ldb * 2; }
};
struct SchedOV : OrderBase {
    const char* A; const char* B; int lda, ldb, K;
    __device__ __forceinline__ const char* a_ptr(const Unit& u) const { return A + (size_t)u.pm * 256 * lda * 2; }
    __device__ __forceinline__ const char* b_ptr(const Unit& u) const { return B + (size_t)(u.pm >> 2) * 256 * ldb * 2; }
};
struct SchedPool : OrderBase {
    const char* A; const char* B; int lda, ldb, K;
    __device__ __forceinline__ const char* a_ptr(const Unit& u) const { return A + ((size_t)u.pm * 256 * lda + (size_t)(u.pn >> 1) * 512) * 2; }
    __device__ __forceinline__ const char* b_ptr(const Unit& u) const { return B + (size_t)u.pn * 256 * ldb * 2; }
};

struct SchedSplit : OrderBase {
    const char* A; const char* B; int lda, ldb, K;
    __device__ __forceinline__ const char* a_ptr(const Unit& u) const { return A + ((size_t)(u.pm & 1) * 256 * lda + (size_t)(u.pm >> 1) * K) * 2; }
    __device__ __forceinline__ const char* b_ptr(const Unit& u) const { return B + ((size_t)u.pn * 256 * ldb + (size_t)(u.pm >> 1) * K) * 2; }
};

__device__ __forceinline__ unsigned cvt_pk_bf16(float lo, float hi) { unsigned r; asm volatile("v_cvt_pk_bf16_f32 %0, %1, %2" : "=v"(r) : "v"(lo), "v"(hi)); return r; }

struct EpiF32 {
    static constexpr bool PERM = false, APERM = false, AFTER_DRAIN = false;
    float* C; int ldc;
    __device__ __forceinline__ void operator()(const f32x4 (&acc)[2][2][4][2], const Unit& u, int wr, int wc, int fr, int fq) const {
        const int row0 = u.pm * BM + wr * 64 + fr, col0 = u.pn * BM + wc * 32 + 4 * fq;
#pragma unroll
        for (int ai = 0; ai < 2; ++ai)
#pragma unroll
            for (int m = 0; m < 4; ++m) { float* rowp = C + (size_t)(row0 + ai * HALF + m * 16) * ldc + col0;
#pragma unroll
                for (int bj = 0; bj < 2; ++bj)
#pragma unroll
                    for (int n = 0; n < 2; ++n) *(PG8_GAS f32x4*)(rowp + bj * HALF + n * 16) = acc[ai][bj][m][n]; }
    }
};
struct EpiSlab {
    static constexpr bool PERM = false, APERM = false, AFTER_DRAIN = false;
    float* C;
    __device__ __forceinline__ void operator()(const f32x4 (&acc)[2][2][4][2], const Unit& u, int wr, int wc, int fr, int fq) const {
        float* base = C + ((size_t)(u.pm >> 1) * 512 + (u.pm & 1) * 256 + wr * 64 + fr) * 2048 + u.pn * BM + wc * 32 + 4 * fq;
#pragma unroll
        for (int ai = 0; ai < 2; ++ai)
#pragma unroll
            for (int m = 0; m < 4; ++m) { float* rowp = base + (size_t)(ai * HALF + m * 16) * 2048;
#pragma unroll
                for (int bj = 0; bj < 2; ++bj)
#pragma unroll
                    for (int n = 0; n < 2; ++n) *(PG8_GAS f32x4*)(rowp + bj * HALF + n * 16) = acc[ai][bj][m][n]; }
    }
};
template <int MODE> struct EpiB {
    static constexpr bool PERM = true, APERM = false, AFTER_DRAIN = false;
    bf16_t* O; int ldc; const float* scale;
    __device__ __forceinline__ void operator()(const f32x4 (&acc)[2][2][4][2], const Unit& u, int wr, int wc, int fr, int fq) const {
        f32x4 sv[2][2];
        if (MODE == 0) {
#pragma unroll
            for (int bj = 0; bj < 2; ++bj)
#pragma unroll
                for (int n = 0; n < 2; ++n) sv[bj][n] = scale ? *(const PG8_GAS f32x4*)(scale + u.pn * BM + bj * HALF + wc * 32 + 8 * fq + 4 * n) : (f32x4){1.f, 1.f, 1.f, 1.f};
        }
#pragma unroll
        for (int ai = 0; ai < 2; ++ai)
#pragma unroll
            for (int m = 0; m < 4; ++m) {
                const int r = ai * HALF + wr * 64 + m * 16 + fr;
#pragma unroll
                for (int bj = 0; bj < 2; ++bj) {
                    const int c = bj * HALF + wc * 32 + 8 * fq;
                    bf16_t* p;
                    if (MODE == 0) p = O + (size_t)(u.pm * BM + r) * ldc + u.pn * BM + c;
                    else if (MODE == 1) { const int tok = 256 * (u.pm & 1) + r; p = O + (size_t)((tok >> 4) * 256 + (u.pm >> 1) * 16 + (tok & 15)) * 640 + u.pn * BM + c; }
                    else if (MODE == 2) { p = O + (size_t)((r >> 4) * 512 + 16 * u.pm + (r & 15)) * 512 + u.pn * BM + c; }
                    else { const int tok = 256 * (u.pm & 1) + r; p = O + (size_t)(32768 + tok) * 2048 + (u.pm >> 1) * 128 + (c & 127); }
                    if (MODE == 3 && bj != ((u.pm >> 1) & 1)) continue;
                    f32x4 v0 = acc[ai][bj][m][0], v1 = acc[ai][bj][m][1];
                    if (MODE == 0) { v0 = v0 * sv[bj][0]; v1 = v1 * sv[bj][1]; }
                    u32x4 w; w.x = cvt_pk_bf16(v0[0], v0[1]); w.y = cvt_pk_bf16(v0[2], v0[3]); w.z = cvt_pk_bf16(v1[0], v1[1]); w.w = cvt_pk_bf16(v1[2], v1[3]);
                    *(PG8_GAS u32x4*)p = w;
                }
            }
    }
};
struct EpiQRope {
    static constexpr bool PERM = true, APERM = false, AFTER_DRAIN = false;
    bf16_t* O; const float* ctab; const float* stab;
    __device__ __forceinline__ void operator()(const f32x4 (&acc)[2][2][4][2], const Unit& u, int wr, int wc, int fr, int fq) const {
#pragma unroll
        for (int bj = 0; bj < 2; ++bj) {
            const int c = u.pn * BM + bj * HALF + wc * 32 + 8 * fq;
            const int k32 = (u.pn * 8 + bj * 4 + wc) % 6;
            const bool rope = k32 >= 4;
            const int i0 = ((k32 - 4) * 32 + 8 * fq) >> 1;
#pragma unroll
            for (int ai = 0; ai < 2; ++ai)
#pragma unroll
                for (int m = 0; m < 4; ++m) {
                    const int t = u.pm * BM + ai * HALF + wr * 64 + m * 16 + fr;
                    f32x4 v0 = acc[ai][bj][m][0], v1 = acc[ai][bj][m][1];
                    if (rope) {
                        const int pos = t < 32768 ? (t & 4095) : 2048 + ((t - 32768) & 15);
                        const f32x4 cs = *(const PG8_GAS f32x4*)(ctab + pos * 32 + i0), sn = *(const PG8_GAS f32x4*)(stab + pos * 32 + i0);
                        const float a0 = v0[0], b0 = v0[1], a1 = v0[2], b1 = v0[3], a2 = v1[0], b2 = v1[1], a3 = v1[2], b3 = v1[3];
                        v0[0] = a0 * cs[0] - b0 * sn[0]; v0[1] = a0 * sn[0] + b0 * cs[0];
                        v0[2] = a1 * cs[1] - b1 * sn[1]; v0[3] = a1 * sn[1] + b1 * cs[1];
                        v1[0] = a2 * cs[2] - b2 * sn[2]; v1[1] = a2 * sn[2] + b2 * cs[2];
                        v1[2] = a3 * cs[3] - b3 * sn[3]; v1[3] = a3 * sn[3] + b3 * cs[3];
                    }
                    u32x4 w; w.x = cvt_pk_bf16(v0[0], v0[1]); w.y = cvt_pk_bf16(v0[2], v0[3]); w.z = cvt_pk_bf16(v1[0], v1[1]); w.w = cvt_pk_bf16(v1[2], v1[3]);
                    *(PG8_GAS u32x4*)(O + (size_t)t * 3072 + c) = w;
                }
        }
    }
};
template <int CTRL> __device__ __forceinline__ float dppf(float x) { return __builtin_bit_cast(float, __builtin_amdgcn_update_dpp(0, __builtin_bit_cast(int, x), CTRL, 0xf, 0xf, false)); }
__device__ __forceinline__ f32x4 ror1(f32x4 x) { return (f32x4){dppf<0x121>(x[0]), dppf<0x121>(x[1]), dppf<0x121>(x[2]), dppf<0x121>(x[3])}; }
__device__ __forceinline__ f32x4 ror2(f32x4 x) { return (f32x4){dppf<0x122>(x[0]), dppf<0x122>(x[1]), dppf<0x122>(x[2]), dppf<0x122>(x[3])}; }
__device__ __forceinline__ f32x4 sel4(bool c, f32x4 a, f32x4 b) { return (f32x4){c ? a[0] : b[0], c ? a[1] : b[1], c ? a[2] : b[2], c ? a[3] : b[3]}; }
__device__ __forceinline__ float silu_mul(float g, float v) { const float e = __builtin_amdgcn_exp2f(g * -1.4426950408889634f); return g * __builtin_amdgcn_rcpf(1.0f + e) * v; }
template <int CTRL> __device__ __forceinline__ float dpp_old(float old, float x) { return __builtin_bit_cast(float, __builtin_amdgcn_update_dpp(__builtin_bit_cast(int, old), __builtin_bit_cast(int, x), CTRL, 0xf, 0xf, false)); }
__device__ __forceinline__ f32x4 shr1_old(f32x4 old, f32x4 x) { return (f32x4){dpp_old<0x111>(old[0], x[0]), dpp_old<0x111>(old[1], x[1]), dpp_old<0x111>(old[2], x[2]), dpp_old<0x111>(old[3], x[3])}; }
struct EpiUp {
    static constexpr bool PERM = true, APERM = true, AFTER_DRAIN = false;
    bf16_t* act; bf16_t* bnd_first; bf16_t* bnd_last; const float* cw; const float* cb; const float* hist; float* oconv_p; float* oconv_s; const float* rs;
    __device__ __forceinline__ void operator()(const f32x4 (&acc)[2][2][4][2], const Unit& u, int wr, int wc, int fr, int fq) const {
        const bool sample = u.pm >= 128;
        const int colh = wc * 32 + 8 * fq, jg = u.pn * 128 + colh, np = u.pn * 256 + colh;
        u32x2 stash[2][4];
        const f32x4 zero4 = (f32x4){0.f, 0.f, 0.f, 0.f};
#pragma unroll
        for (int n = 0; n < 2; ++n) {
            const int jc = jg + 4 * n;
            const f32x4 w0g = *(const PG8_GAS f32x4*)(cw + jc), w1g = *(const PG8_GAS f32x4*)(cw + 11264 + jc), w2g = *(const PG8_GAS f32x4*)(cw + 2 * 11264 + jc), bg = *(const PG8_GAS f32x4*)(cb + jc);
            const f32x4 w0v = *(const PG8_GAS f32x4*)(cw + 5632 + jc), w1v = *(const PG8_GAS f32x4*)(cw + 11264 + 5632 + jc), w2v = *(const PG8_GAS f32x4*)(cw + 2 * 11264 + 5632 + jc), bv = *(const PG8_GAS f32x4*)(cb + 5632 + jc);
#pragma unroll
            for (int ai = 0; ai < 2; ++ai) {
                const int strip = u.pm * 4 + ai * 2 + wr;
                const f32x4 r4 = *(const PG8_GAS f32x4*)(rs + u.pm * BM + ai * HALF + wr * 64 + 4 * fr);
                const f32x4 xg0 = acc[ai][0][0][n] * r4[0], xg1 = acc[ai][0][1][n] * r4[1], xg2 = acc[ai][0][2][n] * r4[2], xg3 = acc[ai][0][3][n] * r4[3];
                const f32x4 xv0 = acc[ai][1][0][n] * r4[0], xv1 = acc[ai][1][1][n] * r4[1], xv2 = acc[ai][1][2][n] * r4[2], xv3 = acc[ai][1][3][n] * r4[3];
                f32x4 pg3 = shr1_old(zero4, xg3), pg2 = shr1_old(zero4, xg2), pv3 = shr1_old(zero4, xv3), pv2 = shr1_old(zero4, xv2);
                if (sample) {
                    const int sb = (u.pm - 128) * 16 + ai * 8 + wr * 4 + (fr >> 2);
                    if ((fr & 3) == 0) { const float* hp = hist + (size_t)sb * 2 * 11264 + jc;
                        pg2 = *(const PG8_GAS f32x4*)(hp); pg3 = *(const PG8_GAS f32x4*)(hp + 11264); pv2 = *(const PG8_GAS f32x4*)(hp + 5632); pv3 = *(const PG8_GAS f32x4*)(hp + 11264 + 5632); }
                    if ((fr & 3) == 3) { float* op = oconv_s + (size_t)(sb * 2) * 11264 + jc; *(PG8_GAS f32x4*)op = xg2; *(PG8_GAS f32x4*)(op + 5632) = xv2; *(PG8_GAS f32x4*)(op + 11264) = xg3; *(PG8_GAS f32x4*)(op + 11264 + 5632) = xv3; }
                } else {
                    if (fr == 0) { bf16_t* bp = bnd_first + (size_t)(strip * 2) * 11264 + np + 4 * n;
                        u32x2 a; a.x = cvt_pk_bf16(xg0[0], xg0[1]); a.y = cvt_pk_bf16(xg0[2], xg0[3]); *(PG8_GAS u32x2*)bp = a;
                        u32x2 b; b.x = cvt_pk_bf16(xv0[0], xv0[1]); b.y = cvt_pk_bf16(xv0[2], xv0[3]); *(PG8_GAS u32x2*)(bp + 128) = b;
                        u32x2 c; c.x = cvt_pk_bf16(xg1[0], xg1[1]); c.y = cvt_pk_bf16(xg1[2], xg1[3]); *(PG8_GAS u32x2*)(bp + 11264) = c;
                        u32x2 d; d.x = cvt_pk_bf16(xv1[0], xv1[1]); d.y = cvt_pk_bf16(xv1[2], xv1[3]); *(PG8_GAS u32x2*)(bp + 11264 + 128) = d; }
                    if (fr == 15) { bf16_t* bp = bnd_last + (size_t)(strip * 2) * 11264 + np + 4 * n;
                        u32x2 a; a.x = cvt_pk_bf16(xg2[0], xg2[1]); a.y = cvt_pk_bf16(xg2[2], xg2[3]); *(PG8_GAS u32x2*)bp = a;
                        u32x2 b; b.x = cvt_pk_bf16(xv2[0], xv2[1]); b.y = cvt_pk_bf16(xv2[2], xv2[3]); *(PG8_GAS u32x2*)(bp + 128) = b;
                        u32x2 c; c.x = cvt_pk_bf16(xg3[0], xg3[1]); c.y = cvt_pk_bf16(xg3[2], xg3[3]); *(PG8_GAS u32x2*)(bp + 11264) = c;
                        u32x2 d; d.x = cvt_pk_bf16(xv3[0], xv3[1]); d.y = cvt_pk_bf16(xv3[2], xv3[3]); *(PG8_GAS u32x2*)(bp + 11264 + 128) = d;
                        if ((strip & 63) == 63) { float* op = oconv_p + (size_t)((strip >> 6) * 2) * 11264 + jc; *(PG8_GAS f32x4*)op = xg2; *(PG8_GAS f32x4*)(op + 5632) = xv2; *(PG8_GAS f32x4*)(op + 11264) = xg3; *(PG8_GAS f32x4*)(op + 11264 + 5632) = xv3; } }
                }
                const f32x4 cg0 = bg + w0g * pg2 + w1g * pg3 + w2g * xg0, cv0 = bv + w0v * pv2 + w1v * pv3 + w2v * xv0;
                const f32x4 cg1 = bg + w0g * pg3 + w1g * xg0 + w2g * xg1, cv1 = bv + w0v * pv3 + w1v * xv0 + w2v * xv1;
                const f32x4 cg2 = bg + w0g * xg0 + w1g * xg1 + w2g * xg2, cv2 = bv + w0v * xv0 + w1v * xv1 + w2v * xv2;
                const f32x4 cg3 = bg + w0g * xg1 + w1g * xg2 + w2g * xg3, cv3 = bv + w0v * xv1 + w1v * xv2 + w2v * xv3;
                const f32x4 cgs[4] = {cg0, cg1, cg2, cg3}, cvs[4] = {cv0, cv1, cv2, cv3};
#pragma unroll
                for (int m = 0; m < 4; ++m) {
                    u32x2 pk; pk.x = cvt_pk_bf16(silu_mul(cgs[m][0], cvs[m][0]), silu_mul(cgs[m][1], cvs[m][1])); pk.y = cvt_pk_bf16(silu_mul(cgs[m][2], cvs[m][2]), silu_mul(cgs[m][3], cvs[m][3]));
                    if (n == 0) stash[ai][m] = pk;
                    else if (sample || m >= 2 || fr != 0) { const int t = u.pm * BM + ai * HALF + wr * 64 + 4 * fr + m;
                        u32x4 w; w.x = stash[ai][m].x; w.y = stash[ai][m].y; w.z = pk.x; w.w = pk.y; *(PG8_GAS u32x4*)(act + (size_t)t * 5632 + jg) = w; }
                }
            }
        }
    }
};

template <class Epi, class Sched, bool ALIGN_EPI = true>
__device__ __forceinline__ void gemm_phase(PG8_LAS unsigned char* lds, const Sched& S, const Epi& E) {
    int tid_ = threadIdx.x; asm volatile("" : "+v"(tid_));
    const int tid = tid_, wid = __builtin_amdgcn_readfirstlane(tid >> 6), lane = tid & 63, wr = wid >> 2, wc = wid & 3, fr = lane & 15, fq = lane >> 4;
    const int K = S.K, nt = K / BK, lda = S.lda, ldb = S.ldb;
    unsigned voffA[2], voffB[2];
#pragma unroll
    for (int i = 0; i < 2; ++i) { int R, C; stage_rc(tid * 16 + i * 8192, R, C); const int Rb = Epi::PERM ? ((R & ~31) + perm32(R & 31)) : R;
        const int Ra = Epi::APERM ? ((R & ~63) + 4 * (R & 15) + ((R >> 4) & 3)) : R;
        voffA[i] = (unsigned)(Ra * lda + C) * 2u; voffB[i] = (unsigned)(Rb * ldb + C) * 2u; }
    const size_t kstep = (size_t)(BK * 2);
    const size_t hA = (size_t)HALF * lda * 2, hB = (size_t)HALF * ldb * 2;
    const unsigned ldsw = (unsigned)wid * 1024u;
    const int aoff = lds_byte(wr * 64 + fr, fq * 8), boff = lds_byte(wc * 32 + fr, fq * 8);
#define PG8_SA(b, h) (((b) * 2 + (h)) * HTB)
#define PG8_SB(b, h) ((4 + (b) * 2 + (h)) * HTB)
#define PG8_STAGE(bufoff, gbase, voff) do { _Pragma("unroll") for (int _i = 0; _i < 2; ++_i) \
        __builtin_amdgcn_global_load_lds((const unsigned*)((const char*)(gbase) + (voff)[_i]), (PG8_LAS unsigned*)(lds + (bufoff) + ldsw + _i * 8192), 16, 0, 0); } while (0)
#define PG8_LDA(dst, b, h) do { _Pragma("unroll") for (int m = 0; m < 4; ++m) _Pragma("unroll") for (int k = 0; k < 2; ++k) dst[m][k] = *(const PG8_LAS bf16x8*)(lds + PG8_SA(b, h) + aoff + m * 2048 + k * 1024); } while (0)
#define PG8_LDB(dst, b, h) do { _Pragma("unroll") for (int n = 0; n < 2; ++n) _Pragma("unroll") for (int k = 0; k < 2; ++k) dst[n][k] = *(const PG8_LAS bf16x8*)(lds + PG8_SB(b, h) + boff + n * 2048 + k * 1024); } while (0)
#define PG8_MMA(ai, bj, At, Bt) do { __builtin_amdgcn_s_setprio(1); _Pragma("unroll") for (int m = 0; m < 4; ++m) _Pragma("unroll") for (int n = 0; n < 2; ++n) _Pragma("unroll") for (int k = 0; k < 2; ++k) \
        acc[ai][bj][m][n] = __builtin_amdgcn_mfma_f32_16x16x32_bf16(Bt[n][k], At[m][k], acc[ai][bj][m][n], 0, 0, 0); __builtin_amdgcn_s_setprio(0); } while (0)
#define PG8_WAIT_V(n) asm volatile("s_waitcnt vmcnt(" #n ")" ::: "memory")
#define PG8_WAIT_L(n) asm volatile("s_waitcnt lgkmcnt(" #n ")" ::: "memory")
#define PG8_BAR __builtin_amdgcn_s_barrier()
#define PG8_SCHED __builtin_amdgcn_sched_barrier(0)
    Unit cur, nxt; int ui = 0;
    if (!S.next(0, cur)) return;
    f32x4 acc[2][2][4][2];
#pragma unroll
    for (int a = 0; a < 2; ++a)
#pragma unroll
        for (int b = 0; b < 2; ++b)
#pragma unroll
            for (int m = 0; m < 4; ++m)
#pragma unroll
                for (int n = 0; n < 2; ++n) acc[a][b][m][n] = (f32x4){0.f, 0.f, 0.f, 0.f};
    bf16x8 At[4][2], B0[2][2], B1[2][2];
    const char* cA = S.a_ptr(cur); const char* cB = S.b_ptr(cur);
    S.a_ready(cur);
    PG8_STAGE(PG8_SB(0, 0), cB, voffB); PG8_STAGE(PG8_SB(0, 1), cB + hB, voffB); PG8_STAGE(PG8_SA(0, 0), cA, voffA); PG8_STAGE(PG8_SA(0, 1), cA + hA, voffA);
    if (wr == 1) PG8_BAR;
    PG8_WAIT_V(2); PG8_BAR;
    PG8_STAGE(PG8_SB(1, 0), cB + kstep, voffB); PG8_STAGE(PG8_SA(1, 0), cA + kstep, voffA); PG8_STAGE(PG8_SB(1, 1), cB + hB + kstep, voffB);
    PG8_WAIT_V(6); PG8_BAR;
    for (;;) {
        const bool has_next = S.next(ui + 1, nxt);
        const char* nA = has_next ? S.a_ptr(nxt) : cA; const char* nB = has_next ? S.b_ptr(nxt) : cB;
        for (int t = 0; t < nt; t += 2) {
            const bool last = (t == nt - 2);
            const char* a1 = cA + (size_t)(t + 1) * kstep;
            const char* a2 = last ? nA : cA + (size_t)(t + 2) * kstep; const char* b2 = last ? nB : cB + (size_t)(t + 2) * kstep;
            const char* a3 = a2 + kstep; const char* b3 = b2 + kstep;
            if (last && has_next) S.a_ready(nxt);
            PG8_LDB(B0, 0, 0); PG8_LDB(B1, 0, 1); PG8_SCHED; PG8_LDA(At, 0, 0); PG8_STAGE(PG8_SA(1, 1), a1 + hA, voffA);
            PG8_WAIT_V(8); PG8_WAIT_L(0); PG8_BAR; PG8_MMA(0, 0, At, B0); PG8_MMA(0, 1, At, B1); PG8_BAR; PG8_SCHED;
            PG8_LDA(At, 0, 1); PG8_STAGE(PG8_SB(0, 0), b2, voffB); PG8_STAGE(PG8_SB(0, 1), b2 + hB, voffB); PG8_STAGE(PG8_SA(0, 0), a2, voffA);
            PG8_WAIT_V(8); PG8_WAIT_L(0); PG8_BAR; PG8_MMA(1, 0, At, B0); PG8_MMA(1, 1, At, B1); PG8_BAR; PG8_SCHED;
            PG8_LDB(B0, 1, 0); PG8_LDB(B1, 1, 1); PG8_SCHED; PG8_LDA(At, 1, 0); PG8_STAGE(PG8_SA(0, 1), a2 + hA, voffA);
            PG8_WAIT_V(8); PG8_WAIT_L(0); PG8_BAR; PG8_MMA(0, 0, At, B0); PG8_MMA(0, 1, At, B1); PG8_BAR; PG8_SCHED;
            PG8_LDA(At, 1, 1); PG8_STAGE(PG8_SB(1, 0), b3, voffB); PG8_STAGE(PG8_SB(1, 1), b3 + hB, voffB); PG8_STAGE(PG8_SA(1, 0), a3, voffA);
            PG8_WAIT_V(8); PG8_WAIT_L(0); PG8_BAR; PG8_MMA(1, 0, At, B0); PG8_MMA(1, 1, At, B1); PG8_BAR; PG8_SCHED;
        }
        if constexpr (ALIGN_EPI) { if (wr == 0) PG8_BAR; }
        E(acc, cur, wr, wc, fr, fq); S.done(cur);
        if (!has_next) break;
#pragma unroll
        for (int a = 0; a < 2; ++a)
#pragma unroll
            for (int b = 0; b < 2; ++b)
#pragma unroll
                for (int m = 0; m < 4; ++m)
#pragma unroll
                    for (int n = 0; n < 2; ++n) acc[a][b][m][n] = (f32x4){0.f, 0.f, 0.f, 0.f};
        cur = nxt; cA = nA; cB = nB; ++ui;
        if constexpr (ALIGN_EPI) { if (wr == 1) PG8_BAR; }
    }
    PG8_WAIT_V(0);
    if constexpr (!ALIGN_EPI) { if (wr == 0) PG8_BAR; }
    PG8_BAR;
#undef PG8_SA
#undef PG8_SB
#undef PG8_STAGE
#undef PG8_LDA
#undef PG8_LDB
#undef PG8_MMA
#undef PG8_WAIT_V
#undef PG8_WAIT_L
#undef PG8_BAR
#undef PG8_SCHED
}
}
namespace att {
#define ATT_LAS __attribute__((address_space(3)))
typedef unsigned short bf16;
using bf16x8 = __attribute__((ext_vector_type(8))) short;
using s16x4  = __attribute__((ext_vector_type(4))) short;
using f32x16 = __attribute__((ext_vector_type(16))) float;
using u32x4  = __attribute__((ext_vector_type(4))) unsigned;
constexpr int NW = 8, QBLK = 32, KVBLK = 64;
constexpr float SCALE = 0.07216878364870322f;
constexpr float THR = 8.f;
constexpr int LDQ = 3072, LDKV = 4096, LDKR = 64, LDO = 2048;
constexpr int SHM_V = KVBLK * 128 * 2, SHM_K = KVBLK * 192 * 2, SHM_QR0 = 2 * SHM_V + 2 * SHM_K + NW * 64 * 4, SHM_ATTN = SHM_QR0 + NW * 4 * 64 * 16;
#define KSWZ(row, colB) ((row) * 384 + ((colB) ^ (((row) & 7) << 4)))
#define SBAR() __builtin_amdgcn_sched_barrier(0)
__device__ __forceinline__ int crow(int r, int hi) { return (r & 3) + 8 * (r >> 2) + 4 * hi; }
__device__ __forceinline__ unsigned cvtpk(float lo, float hi) { unsigned r; asm volatile("v_cvt_pk_bf16_f32 %0, %1, %2" : "=v"(r) : "v"(lo), "v"(hi)); return r; }
__device__ __forceinline__ __amdgpu_buffer_rsrc_t mk_rsrc(const void* p) {
  const unsigned long a = (unsigned long)p; const unsigned lo = __builtin_amdgcn_readfirstlane((unsigned)a), hi = __builtin_amdgcn_readfirstlane((unsigned)(a >> 32));
  return __builtin_amdgcn_make_buffer_rsrc((void*)(((unsigned long)hi << 32) | lo), (short)0, 0x7fffffff, 0x00020000);
}
__device__ __forceinline__ bf16x8 ld8(const bf16* p) { return *(const __attribute__((address_space(1))) bf16x8*)p; }

__device__ __forceinline__ void partialSM(f32x16& p0, f32x16& p1, float& m_reg, float& mn, float& alpha, bool dead) {
  constexpr float C = SCALE * 1.4426950408889634f;
  if (dead) {
#pragma unroll
    for (int r = 0; r < 16; ++r) { p0[r] = -__builtin_inff(); p1[r] = -__builtin_inff(); }
  }
  float pmax = p0[0];
#pragma unroll
  for (int r = 1; r < 16; ++r) pmax = fmaxf(pmax, p0[r]);
#pragma unroll
  for (int r = 0; r < 16; ++r) pmax = fmaxf(pmax, p1[r]);
  { auto rr = __builtin_amdgcn_permlane32_swap(__float_as_uint(pmax), __float_as_uint(pmax), false, false);
    pmax = fmaxf(__uint_as_float(rr[0]), __uint_as_float(rr[1])); }
  if (__builtin_expect(__all(pmax - m_reg <= THR / SCALE), 1)) { mn = m_reg; alpha = 1.f; }
  else { mn = fmaxf(m_reg, pmax); alpha = __builtin_amdgcn_exp2f((m_reg - mn) * C); m_reg = mn; }
  float mnC = -mn * C;
#pragma unroll
  for (int r = 0; r < 16; ++r) p0[r] = fmaf(p0[r], C, mnC);
#pragma unroll
  for (int r = 0; r < 16; ++r) p1[r] = fmaf(p1[r], C, mnC);
#pragma unroll
  for (int r = 0; r < 16; ++r) p0[r] = __builtin_amdgcn_exp2f(p0[r]);
}
__device__ __forceinline__ void finishSM(f32x16& p0, f32x16& p1, float alpha, float& l_reg, bf16x8& pa0, bf16x8& pa1, bf16x8& pa2, bf16x8& pa3) {
#pragma unroll
  for (int r = 0; r < 16; ++r) p1[r] = __builtin_amdgcn_exp2f(p1[r]);
  float ps = 0;
#pragma unroll
  for (int r = 0; r < 16; ++r) ps += p0[r];
#pragma unroll
  for (int r = 0; r < 16; ++r) ps += p1[r];
  { auto rr = __builtin_amdgcn_permlane32_swap(__float_as_uint(ps), __float_as_uint(ps), false, false);
    ps = __uint_as_float(rr[0]) + __uint_as_float(rr[1]); }
  l_reg = l_reg * alpha + ps;
#define PK4(P, BASE, OUT) do { unsigned a0 = cvtpk(P[BASE + 0], P[BASE + 1]), a1 = cvtpk(P[BASE + 2], P[BASE + 3]);   \
    unsigned b0 = cvtpk(P[BASE + 4], P[BASE + 5]), b1 = cvtpk(P[BASE + 6], P[BASE + 7]);                              \
    auto r0 = __builtin_amdgcn_permlane32_swap(a0, b0, false, false); auto r1 = __builtin_amdgcn_permlane32_swap(a1, b1, false, false); \
    u32x4 w = {r0[0], r1[0], r0[1], r1[1]}; OUT = *reinterpret_cast<bf16x8*>(&w); } while (0)
  PK4(p0, 0, pa0); PK4(p0, 8, pa1); PK4(p1, 0, pa2); PK4(p1, 8, pa3);
#undef PK4
}
__device__ __forceinline__ void qkt(f32x16& p0, f32x16& p1, const ATT_LAS char* Ks, const bf16x8* qr, const ATT_LAS char* qrl, int r32, int hi) {
  p0 = f32x16{}; p1 = f32x16{};
#pragma unroll
  for (int d0 = 0; d0 < 12; ++d0) { const int cb = (d0 * 16 + hi * 8) * 2;
    bf16x8 b0 = *reinterpret_cast<const ATT_LAS bf16x8*>(Ks + KSWZ(r32, cb));
    bf16x8 b1 = *reinterpret_cast<const ATT_LAS bf16x8*>(Ks + KSWZ(32 + r32, cb));
    const bf16x8 q = d0 < 8 ? qr[d0 < 8 ? d0 : 0] : *reinterpret_cast<const ATT_LAS bf16x8*>(qrl + (d0 - 8) * 1024);
    p0 = __builtin_amdgcn_mfma_f32_32x32x16_bf16(b0, q, p0, 0, 0, 0);
    p1 = __builtin_amdgcn_mfma_f32_32x32x16_bf16(b1, q, p1, 0, 0, 0); }
}
__device__ __forceinline__ int v_st(int k, int c) { const int kk = (k & ~0xC) | ((k & 4) << 1) | ((k & 8) >> 1); return ((kk >> 3) * 4 + (c >> 5)) * 512 + ((kk & 7) * 32 + (c & 31)) * 2; }
__device__ __forceinline__ int v_rd_base(int lane) { return ((lane & 3) << 3) | (((lane >> 2) & 3) << 6) | (((lane >> 4) & 1) << 5) | (((lane >> 5) & 1) << 8); }
constexpr int v_rd_off(int d0, int ks, int half) { return d0 * 512 + ks * 4096 + half * 2048; }
template <int OFF> __device__ __forceinline__ s16x4 tr_read(int vb) {
  s16x4 r; asm volatile("ds_read_b64_tr_b16 %0, %1 offset:%2" : "=&v"(r) : "v"(vb), "i"(OFF) : "memory"); return r;
}
template <int D0> __device__ __forceinline__ void pv_one(f32x16& od, int vb, bf16x8 pa0, bf16x8 pa1, bf16x8 pa2, bf16x8 pa3) {
  const s16x4 l0 = tr_read<v_rd_off(D0, 0, 0)>(vb), h0 = tr_read<v_rd_off(D0, 0, 1)>(vb), l1 = tr_read<v_rd_off(D0, 1, 0)>(vb), h1 = tr_read<v_rd_off(D0, 1, 1)>(vb);
  const s16x4 l2 = tr_read<v_rd_off(D0, 2, 0)>(vb), h2 = tr_read<v_rd_off(D0, 2, 1)>(vb), l3 = tr_read<v_rd_off(D0, 3, 0)>(vb), h3 = tr_read<v_rd_off(D0, 3, 1)>(vb);
  asm volatile("s_waitcnt lgkmcnt(0)" ::: "memory"); SBAR();
#define PK(L, H) (bf16x8){L[0], L[1], L[2], L[3], H[0], H[1], H[2], H[3]}
  od = __builtin_amdgcn_mfma_f32_32x32x16_bf16(pa0, PK(l0, h0), od, 0, 0, 0);
  od = __builtin_amdgcn_mfma_f32_32x32x16_bf16(pa1, PK(l1, h1), od, 0, 0, 0);
  od = __builtin_amdgcn_mfma_f32_32x32x16_bf16(pa2, PK(l2, h2), od, 0, 0, 0);
  od = __builtin_amdgcn_mfma_f32_32x32x16_bf16(pa3, PK(l3, h3), od, 0, 0, 0);
#undef PK
}
__device__ __forceinline__ void pv_d0(f32x16* o, int vb, bf16x8 pa0, bf16x8 pa1, bf16x8 pa2, bf16x8 pa3) {
  pv_one<0>(o[0], vb, pa0, pa1, pa2, pa3); pv_one<1>(o[1], vb, pa0, pa1, pa2, pa3); pv_one<2>(o[2], vb, pa0, pa1, pa2, pa3); pv_one<3>(o[3], vb, pa0, pa1, pa2, pa3);
}

__device__ __forceinline__ void attn_unit(const bf16* __restrict__ Qb, const bf16* __restrict__ Kh, const bf16* __restrict__ Vh, const bf16* __restrict__ KRh,
                                          bf16* __restrict__ Ob, int NT, int qb, ATT_LAS char* lds) {
  int tid_ = threadIdx.x; asm volatile("" : "+v"(tid_));
  const int tid = tid_, wid = __builtin_amdgcn_readfirstlane(tid >> 6), lane = tid & 63, r32 = lane & 31, hi = lane >> 5;
  const int lim = 4 * qb + (wid >> 1);
  ATT_LAS char* V_lds = lds; ATT_LAS char* K_lds = lds + 2 * SHM_V;
  ATT_LAS float* ws = (ATT_LAS float*)(lds + 2 * SHM_V + 2 * SHM_K) + wid * 64; ATT_LAS float* li_l = ws; ATT_LAS float* al_l = ws + 32;
  float m_reg = -1e30f, l_reg = 0; f32x16 o[4] = {}; bf16x8 qr[8];
  ATT_LAS char* qrl = lds + SHM_QR0 + wid * 4096 + lane * 16;
  const bf16* Qw = Qb + (long)(wid * QBLK + r32) * LDQ + hi * 8;
#pragma unroll
  for (int d0 = 0; d0 < 8; ++d0) qr[d0] = ld8(Qw + d0 * 16);
#pragma unroll
  for (int d0 = 8; d0 < 12; ++d0) *reinterpret_cast<ATT_LAS bf16x8*>(qrl + (d0 - 8) * 1024) = ld8(Qw + d0 * 16);
  const int sr = tid >> 4, sc = (tid & 15) * 8, vst0 = v_st(sr, sc), vst1 = v_st(32 + sr, sc);
  const int kr_row = tid >> 3, kr_c = (tid & 7) * 8;
  const int vb0 = (int)(unsigned)(unsigned long)V_lds + v_rd_base(lane);
  const __amdgpu_buffer_rsrc_t rsK = mk_rsrc(Kh), rsV = mk_rsrc(Vh), rsR = mk_rsrc(KRh);
  const unsigned vo0 = (unsigned)(sr * LDKV + sc) * 2u, vo1 = (unsigned)((32 + sr) * LDKV + sc) * 2u, vor = (unsigned)(kr_row * LDKR + kr_c) * 2u;
  struct { bf16x8 vs0, vs1, ks0, ks1, kr; } sr_[1];
#define SLOAD(i, k0) do { const int so_ = (k0) * (LDKV * 2), sr2_ = (k0) * (LDKR * 2); \
    sr_[i].vs0 = __builtin_bit_cast(bf16x8, __builtin_amdgcn_raw_buffer_load_b128(rsV, (int)vo0, so_, 0)); sr_[i].vs1 = __builtin_bit_cast(bf16x8, __builtin_amdgcn_raw_buffer_load_b128(rsV, (int)vo1, so_, 0)); \
    sr_[i].ks0 = __builtin_bit_cast(bf16x8, __builtin_amdgcn_raw_buffer_load_b128(rsK, (int)vo0, so_, 0)); sr_[i].ks1 = __builtin_bit_cast(bf16x8, __builtin_amdgcn_raw_buffer_load_b128(rsK, (int)vo1, so_, 0)); \
    sr_[i].kr = __builtin_bit_cast(bf16x8, __builtin_amdgcn_raw_buffer_load_b128(rsR, (int)vor, sr2_, 0)); } while (0)
#define SWRITE(b, i) do { *(ATT_LAS bf16x8*)(V_lds + (b) * SHM_V + vst0) = sr_[i].vs0;          \
    *(ATT_LAS bf16x8*)(V_lds + (b) * SHM_V + vst1) = sr_[i].vs1; const int kc = sc * 2;               \
    *(ATT_LAS bf16x8*)(K_lds + (b) * SHM_K + KSWZ(sr, kc)) = sr_[i].ks0;                       \
    *(ATT_LAS bf16x8*)(K_lds + (b) * SHM_K + KSWZ(32 + sr, kc)) = sr_[i].ks1;                  \
    *(ATT_LAS bf16x8*)(K_lds + (b) * SHM_K + KSWZ(kr_row, 256 + kr_c * 2)) = sr_[i].kr; } while (0)
#define SWAIT() asm volatile("s_waitcnt vmcnt(0)" ::: "memory")
#define RESC(a) do { if (__any((a) < 1.f)) { if (hi == 0) al_l[r32] = (a); asm volatile("s_waitcnt lgkmcnt(0)" ::: "memory"); \
    _Pragma("unroll") for (int d = 0; d < 4; ++d) _Pragma("unroll") for (int r = 0; r < 16; ++r) o[d][r] *= al_l[crow(r, hi)]; } } while (0)
  f32x16 pA0, pA1, pB0, pB1; float mnA, mnB, alA, alB; bf16x8 pa0, pa1, pa2, pa3;
  constexpr int SE = 0, SO = 0;
  SLOAD(SE, 0); asm volatile("s_waitcnt vmcnt(0)" ::: "memory"); SWRITE(0, SE); __syncthreads();
  qkt(pA0, pA1, K_lds, qr, qrl, r32, hi); partialSM(pA0, pA1, m_reg, mnA, alA, false);
  SLOAD(SO, KVBLK);
  SWAIT(); SWRITE(1, SO); __syncthreads();
  for (int j = 1; j + 1 < NT; j += 2) {
    SBAR(); qkt(pB0, pB1, K_lds + SHM_K, qr, qrl, r32, hi);
    finishSM(pA0, pA1, alA, l_reg, pa0, pa1, pa2, pa3); SBAR();
    SLOAD(SO, (j + 1) * KVBLK); SBAR();
    pv_d0(o, vb0, pa0, pa1, pa2, pa3); partialSM(pB0, pB1, m_reg, mnB, alB, j > lim);
    __syncthreads(); SWAIT(); SWRITE(0, SE);
    RESC(alB); __syncthreads();
    SBAR(); qkt(pA0, pA1, K_lds, qr, qrl, r32, hi);
    finishSM(pB0, pB1, alB, l_reg, pa0, pa1, pa2, pa3); SBAR();
    SLOAD(SE, (j + 2) * KVBLK); SBAR();
    pv_d0(o, vb0 + SHM_V, pa0, pa1, pa2, pa3); partialSM(pA0, pA1, m_reg, mnA, alA, j + 1 > lim);
    __syncthreads(); SWAIT(); SWRITE(1, SO);
    RESC(alA); __syncthreads();
  }
  SBAR(); qkt(pB0, pB1, K_lds + SHM_K, qr, qrl, r32, hi);
  finishSM(pA0, pA1, alA, l_reg, pa0, pa1, pa2, pa3); SBAR();
  pv_d0(o, vb0, pa0, pa1, pa2, pa3); partialSM(pB0, pB1, m_reg, mnB, alB, NT - 1 > lim);
  __syncthreads(); RESC(alB);
  finishSM(pB0, pB1, alB, l_reg, pa0, pa1, pa2, pa3); SBAR();
  pv_d0(o, vb0 + SHM_V, pa0, pa1, pa2, pa3);
  if (hi == 0) li_l[r32] = l_reg; asm volatile("s_waitcnt lgkmcnt(0)" ::: "memory");
  float rli[16];
#pragma unroll
  for (int r = 0; r < 16; ++r) rli[r] = __builtin_amdgcn_rcpf(li_l[crow(r, hi)]);
  bf16* Ow = Ob + (long)(wid * QBLK) * LDO;
#pragma unroll
  for (int r = 0; r < 16; ++r) { const int orow = crow(r, hi);
#pragma unroll
    for (int d0 = 0; d0 < 4; ++d0) { const float v = o[d0][r] * rli[r]; unsigned u = __float_as_uint(v); u = (u + 0x7fffu + ((u >> 16) & 1u)) >> 16; ((__attribute__((address_space(1))) bf16*)Ow)[(long)orow * LDO + d0 * 32 + r32] = (bf16)u; } }
  __syncthreads();
#undef SLOAD
#undef SWRITE
#undef SWAIT
#undef RESC
}
#undef KSWZ
#undef SBAR
}
constexpr int NWAVES = 8;
constexpr int TP = 32768, TS = 512, T = TP + TS, DM = 2048, DFF = 5632, NUP = 2 * DFF, SEQ = 4096;
constexpr float EPS = 1e-6f;
static_assert((2048 + 16 - 1) / 64 == 2048 / 64, "all cache keys and new keys of a sample stream lie in chunks <= the query chunk: the chunk mask is all-true for the sample streams");
constexpr size_t O_Y = 0, O_CKV_P = O_Y + (size_t)T * DM, O_KR_P = O_CKV_P + (size_t)2 * TP * 512, O_POOL_P = O_KR_P + (size_t)2 * TP * 64, O_CONV_P = O_POOL_P + (size_t)2 * 8 * 15 * DM,
                 O_CKV_S = O_CONV_P + (size_t)4 * 8 * 2 * NUP, O_KR_S = O_CKV_S + (size_t)2 * TS * 512, O_POOL_S = O_KR_S + (size_t)2 * TS * 64, O_CONV_S = O_POOL_S + (size_t)2 * 32 * 15 * DM,
                 O_END = O_CONV_S + (size_t)4 * 32 * 2 * NUP;
static_assert(O_END == 112558080, "d_out size");
constexpr size_t MiB = 1u << 20;
constexpr size_t WS_CTL = 0, CTL_ZERO_BYTES = 1 * MiB;
constexpr size_t WS_ROPE = 1 * MiB;
constexpr size_t WS_RS = 2 * MiB;
constexpr size_t WS_W = 3 * MiB;
constexpr size_t W_MLA = 24 * MiB;
constexpr size_t WO_DQKV = 0, WO_UQ = 5 * MiB, WO_UKV = 8 * MiB, WO_UK2 = 12 * MiB, WO_O = 16 * MiB;
constexpr size_t WS_WPOOL = WS_W + 2 * W_MLA;
constexpr size_t WS_WFFN = WS_WPOOL + 4 * MiB, WO_UP = 0, WO_DOWN = 44 * MiB;
constexpr size_t WS_HB = WS_WFFN + 66 * MiB;
constexpr size_t WS_MB = WS_HB + 130 * MiB;
constexpr size_t WS_S = WS_MB, WS_P = WS_MB + 72 * MiB;
constexpr size_t WS_BND = WS_MB + 130 * MiB;
constexpr size_t WS_XB = WS_BND + 44 * MiB;
constexpr size_t WS_SLAB = WS_XB + 130 * MiB;
constexpr size_t WS_BIG = WS_SLAB + 44 * MiB;
constexpr size_t WS_ACT = WS_BIG;
constexpr size_t WS_Q = WS_BIG, WS_CQ = WS_BIG + 196 * MiB, WS_CKVB = WS_BIG + 229 * MiB, WS_KRB = WS_BIG + 261 * MiB, WS_KV = WS_BIG + 265 * MiB;
constexpr size_t WS_KALL = WS_KV, WS_VT = WS_KV + 90 * MiB, WS_QLAT = WS_KV + 162 * MiB, WS_OL = WS_KV + 172 * MiB;
constexpr size_t WS_END = WS_KV + 256 * MiB;
static_assert(WS_HB == 121 * MiB && WS_END == 1120 * MiB, "ws map");
static_assert((size_t)T * 1280 * 4 <= 174 * MiB && (size_t)T * 5632 * 2 <= WS_END - WS_BIG && (size_t)T * 3072 * 2 + 4096 <= 196 * MiB && (size_t)11 * 512 * 2048 * 4 <= 44 * MiB, "ws aliases");
constexpr int CW_BAR = 4096;

#define GAS __attribute__((address_space(1)))
#define LAS __attribute__((address_space(3)))
typedef unsigned short bf16;
typedef unsigned v4u __attribute__((ext_vector_type(4)));
typedef unsigned v2u __attribute__((ext_vector_type(2)));
typedef float f32x4 __attribute__((ext_vector_type(4)));
typedef short bf16x8 __attribute__((ext_vector_type(8)));
#define LDS_WAIT() asm volatile("s_waitcnt lgkmcnt(0)" ::: "memory")
#define VM_WAIT() asm volatile("s_waitcnt vmcnt(0)" ::: "memory")
__device__ __forceinline__ unsigned f2bf(float f) { unsigned u = __builtin_bit_cast(unsigned, f); return (u + 0x7fffu + ((u >> 16) & 1u)) >> 16; }
__device__ __forceinline__ unsigned pk2(float lo, float hi) { return f2bf(lo) | (f2bf(hi) << 16); }
__device__ __forceinline__ float bflo(unsigned w) { return __builtin_bit_cast(float, w << 16); }
__device__ __forceinline__ float bfhi(unsigned w) { return __builtin_bit_cast(float, w & 0xffff0000u); }

#define XB_TMO      128
#define XB_XCNT(j)  (256  + 64 * (j))
#define XB_XSUB(j)  (1280 + 64 * (j))
#define XB_XGEN(j)  (2304 + 64 * (j))
#define XB_TOP      3328
#define XB_TOPGEN   3392
#define XCD_BAR_WORDS 3456
#define XB_SPIN_CAP (1u << 18)
__device__ __forceinline__ unsigned xb_ld(unsigned* p)              { return __hip_atomic_load(p, __ATOMIC_RELAXED, __HIP_MEMORY_SCOPE_AGENT); }
__device__ __forceinline__ unsigned xb_add(unsigned* p, unsigned v) { return __hip_atomic_fetch_add(p, v, __ATOMIC_RELAXED, __HIP_MEMORY_SCOPE_AGENT); }
__device__ __forceinline__ unsigned xb_xcc_id() { return (unsigned)__builtin_amdgcn_s_getreg((3 << 11) | 20) & 0xFu; }
#define XB_SPIN(cond, bar) do { unsigned _sp = 0; while (cond) { __builtin_amdgcn_s_sleep(1); \
    if ((++_sp & 255u) == 0u) { if (xb_ld(&(bar)[XB_TMO])) break; if (_sp > XB_SPIN_CAP) { atomicAdd(&(bar)[XB_TMO], 1u); break; } } } } while (0)
struct XcdBarrier { unsigned* bar; unsigned x; volatile LAS unsigned* st; };
__device__ __forceinline__ XcdBarrier xcd_barrier_post(unsigned* bar, volatile LAS unsigned* st) {
    XcdBarrier b; b.bar = bar; b.x = xb_xcc_id(); b.st = st;
    if (threadIdx.x == 0) (void)xb_add(&bar[XB_XCNT(b.x)], 1u);
    return b;
}
__device__ __forceinline__ void xcd_barrier_complete(unsigned* bar, unsigned x, unsigned& nloc, unsigned& nx) {
    const unsigned G = gridDim.x * gridDim.y * gridDim.z;
    unsigned sum, cnt, mine, sp = 0u;
    for (;;) {
        sum = 0u; cnt = 0u; mine = 0u;
#pragma unroll
        for (unsigned j = 0; j < 16; ++j) { const unsigned c = xb_ld(&bar[XB_XCNT(j)]); sum += c; cnt += (c > 0u) ? 1u : 0u; mine = (j == x) ? c : mine; }
        if (sum == G) break;
        __builtin_amdgcn_s_sleep(1);
        if ((++sp & 255u) == 0u) { if (xb_ld(&bar[XB_TMO])) break; if (sp > XB_SPIN_CAP) { atomicAdd(&bar[XB_TMO], 1u); break; } }
    }
    nloc = mine > 0u ? mine : 1u; nx = cnt > 0u ? cnt : 1u;
}
__device__ __forceinline__ void xcd_barrier(const XcdBarrier& b) {
    asm volatile("s_waitcnt vmcnt(0)" ::: "memory");
    __syncthreads();
    if (threadIdx.x == 0) {
        unsigned* bar = b.bar;
        __builtin_amdgcn_s_waitcnt(0);
        unsigned nloc = b.st[0], nx = b.st[1];
        if (nloc == 0u) { xcd_barrier_complete(bar, b.x, nloc, nx); b.st[0] = nloc; b.st[1] = nx; }
        const unsigned old = xb_add(&bar[XB_XSUB(b.x)], 1u);
        const unsigned gen = old / nloc;
        if (old + 1u == (gen + 1u) * nloc) {
            __builtin_amdgcn_fence(__ATOMIC_RELEASE, "agent");
            asm volatile("s_waitcnt vmcnt(0)" ::: "memory");
            const unsigned og = xb_add(&bar[XB_TOP], 1u);
            const unsigned tg = og / nx;
            if (og + 1u == (tg + 1u) * nx) xb_add(&bar[XB_TOPGEN], 1u);
            else XB_SPIN(xb_ld(&bar[XB_TOPGEN]) == tg, bar);
            __builtin_amdgcn_fence(__ATOMIC_ACQUIRE, "agent");
            xb_add(&bar[XB_XGEN(b.x)], 1u);
            asm volatile("s_waitcnt vmcnt(0)" ::: "memory");
        } else {
            XB_SPIN(xb_ld(&bar[XB_XGEN(b.x)]) == gen, bar);
            __builtin_amdgcn_fence(__ATOMIC_ACQUIRE, "agent");
            asm volatile("s_waitcnt vmcnt(0)" ::: "memory");
        }
    }
    __syncthreads();
}

constexpr int RING_OFF = 0, RING_BYTES = 131072;
constexpr int LDSCTL_OFF = RING_BYTES, MISC_OFF = LDSCTL_OFF + 320;
constexpr int LDS_BYTES = 147456;
static_assert(att::SHM_ATTN <= RING_BYTES, "attention scratch fits the ring");

struct Frame {
    LAS unsigned char* lds;
    int tid, lane, wave;
    int vcu, G;
    float* out; unsigned char* ws;
};
constexpr int PTR_OFF = MISC_OFF + 256;
__device__ __forceinline__ const float* inp(const Frame& F, int i) {
    int off = PTR_OFF + 8 * i; asm volatile("" : "+s"(off));
    const unsigned long long v = *(const LAS unsigned long long*)(F.lds + off);
    const unsigned lo = __builtin_amdgcn_readfirstlane((unsigned)v), hi = __builtin_amdgcn_readfirstlane((unsigned)(v >> 32));
    return (const float*)(((unsigned long long)hi << 32) | lo);
}
__device__ __forceinline__ void frame_lanes(Frame& F) {
    int t = threadIdx.x; asm volatile("" : "+v"(t)); F.tid = t; F.lane = t & 63; F.wave = __builtin_amdgcn_readfirstlane(t >> 6);
    unsigned long long w = (unsigned long long)F.ws, o = (unsigned long long)F.out; unsigned l = (unsigned)(unsigned long long)F.lds; int g = F.G, v = F.vcu;
    asm volatile("" : "+s"(w), "+s"(o), "+s"(l), "+s"(g), "+s"(v));
    F.ws = (unsigned char*)w; F.out = (float*)o; F.lds = (LAS unsigned char*)(unsigned long long)l; F.G = g; F.vcu = v;
}
__device__ __forceinline__ float shx(float v, int o, int lane) { return __builtin_bit_cast(float, __builtin_amdgcn_ds_bpermute((lane ^ o) << 2, __builtin_bit_cast(int, v))); }
__device__ __forceinline__ float wave_sum(float v, int lane) {
#pragma unroll
    for (int o = 1; o < 64; o <<= 1) v += shx(v, o, lane);
    return v;
}
__device__ __forceinline__ float wave_max(float v, int lane) {
#pragma unroll
    for (int o = 1; o < 64; o <<= 1) v = fmaxf(v, shx(v, o, lane));
    return v;
}

__device__ __forceinline__ int dest_row(int map, int row_off, int n) {
    if (map == 1) { return n < DFF ? ((n >> 7) * 256 + (n & 127)) : (((n - DFF) >> 7) * 256 + 128 + ((n - DFF) & 127)); }
    if (map == 2) { const int h = n / 192, d = n - h * 192; if (d < 128) return n; const int i = d - 128; return h * 192 + 128 + (i < 32 ? 2 * i : 2 * (i - 32) + 1); }
    return row_off + n;
}
__device__ __forceinline__ void transpose_item(const float* W, int ldw, bf16* WT, int ldt, int map, int row_off, int kb, int nb, LAS float* scr, int lane, const float* ks = nullptr, bf16* RM = nullptr, int ldr = 0) {
    const int k0 = 64 * kb, n0 = 32 * nb;
#pragma unroll
    for (int i = 0; i < 8; ++i) { const int kk = 8 * i + (lane >> 3), c4 = (lane & 7) * 4; f32x4 v = *(const GAS f32x4*)(W + (size_t)(k0 + kk) * ldw + n0 + c4);
        if (ks) v = v * ((const GAS float*)ks)[k0 + kk];
        LAS float* d = scr + kk * 33 + c4; d[0] = v.x; d[1] = v.y; d[2] = v.z; d[3] = v.w; }
    LDS_WAIT(); asm volatile("" ::: "memory");
    const int c = lane & 7;
#pragma unroll
    for (int j = 0; j < 4; ++j) { const int n = (lane >> 3) + 8 * j; const LAS float* s = scr + (8 * c) * 33 + n;
        v4u o; o.x = pk2(s[0 * 33], s[1 * 33]); o.y = pk2(s[2 * 33], s[3 * 33]); o.z = pk2(s[4 * 33], s[5 * 33]); o.w = pk2(s[6 * 33], s[7 * 33]);
        *(GAS v4u*)(WT + (size_t)dest_row(map, row_off, n0 + n) * ldt + k0 + 8 * c) = o; }
    if (RM) {
        const LAS float* s = scr + lane * 33;
#pragma unroll
        for (int q = 0; q < 4; ++q) { v4u o; o.x = pk2(s[8 * q], s[8 * q + 1]); o.y = pk2(s[8 * q + 2], s[8 * q + 3]); o.z = pk2(s[8 * q + 4], s[8 * q + 5]); o.w = pk2(s[8 * q + 6], s[8 * q + 7]);
            *(GAS v4u*)(RM + (size_t)(k0 + lane) * ldr + n0 + 8 * q) = o; }
    }
    LDS_WAIT(); asm volatile("" ::: "memory");
}

__device__ __forceinline__ void p0_prologue(Frame& F) {
    frame_lanes(F);
    LAS float* scr = (LAS float*)(F.lds + RING_OFF + F.wave * 16384);
    const int gw = F.vcu * NWAVES + F.wave, NGW = F.G * NWAVES;
    {
        float* ct = (float*)(F.ws + WS_ROPE); float* st = ct + 4096 * 32;
        for (int idx = (F.vcu * NWAVES + F.wave) * 64 + F.lane; idx < 4096 * 32; idx += NGW * 64) {
            const int pos = idx >> 5, i = idx & 31;
            double inv = 1.0; for (int k = 0; k < i; ++k) inv *= 0.7498942093324558273;
            double a = (double)pos * inv;
            const double twopi = 6.283185307179586476925287; a -= twopi * __builtin_rint(a / twopi);
            const double x = a * 0.125, x2 = x * x;
            double s = x * (1.0 + x2 * (-1.0 / 6 + x2 * (1.0 / 120 + x2 * (-1.0 / 5040 + x2 * (1.0 / 362880 + x2 * (-1.0 / 39916800))))));
            double c = 1.0 + x2 * (-0.5 + x2 * (1.0 / 24 + x2 * (-1.0 / 720 + x2 * (1.0 / 40320 + x2 * (-1.0 / 3628800 + x2 * (1.0 / 479001600))))));
#pragma unroll
            for (int k = 0; k < 3; ++k) { const double s2 = 2.0 * s * c, c2 = 1.0 - 2.0 * s * s; s = s2; c = c2; }
            ((GAS float*)ct)[idx] = (float)c; ((GAS float*)st)[idx] = (float)s;
        }
    }
    constexpr int I_DQ = 32 * 16, I_DKV = 32 * 18, I_UQ = 8 * 96, I_UK = 8 * 64, I_UV = 8 * 64, I_O = 32 * 64, I_MLA = I_DQ + I_DKV + I_UQ + I_UK + I_UV + I_O;
    constexpr int I_POOL = 4 * 8 * 16;
    constexpr int NITEMS = 2 * I_MLA + 2 * I_POOL;
    for (int it = gw; it < NITEMS; it += NGW) {
        const float* W; const float* ks = nullptr; int ldw, ldt, map = 0, row_off = 0, nnb, r; bf16* WT;
        if (it < 2 * I_MLA) {
            const int j = it / I_MLA; r = it - j * I_MLA; unsigned char* wb = F.ws + WS_W + j * W_MLA;
            if (r < I_DQ) { W = inp(F, 7) + (size_t)j * 2048 * 512; ldw = 512; WT = (bf16*)(wb + WO_DQKV); ldt = 2048; nnb = 16; ks = inp(F, 6) + (size_t)(2 * j) * 4 * DM; }
            else if ((r -= I_DQ) < I_DKV) { W = inp(F, 10) + (size_t)j * 2048 * 576; ldw = 576; WT = (bf16*)(wb + WO_DQKV); ldt = 2048; nnb = 18; row_off = 512; ks = inp(F, 6) + (size_t)(2 * j) * 4 * DM; }
            else if ((r -= I_DKV) < I_UQ) { W = inp(F, 9) + (size_t)j * 512 * 3072; ldw = 3072; WT = (bf16*)(wb + WO_UQ); ldt = 512; nnb = 96; map = 2; }
            else if ((r -= I_UQ) < I_UK) { W = inp(F, 12) + (size_t)j * 512 * 2048; ldw = 2048; WT = (bf16*)(wb + WO_UKV); ldt = 512; nnb = 64; }
            else if ((r -= I_UK) < I_UV) { W = inp(F, 13) + (size_t)j * 512 * 2048; ldw = 2048; WT = (bf16*)(wb + WO_UKV); ldt = 512; nnb = 64; row_off = 2048; }
            else { r -= I_UV; W = inp(F, 14) + (size_t)j * 2048 * 2048; ldw = 2048; WT = (bf16*)(wb + WO_O); ldt = 2048; nnb = 64; }
        } else {
            r = it - 2 * I_MLA; const int jg = r / (8 * 16); r -= jg * (8 * 16);
            W = inp(F, 15) + (size_t)jg * 512 * 512; ldw = 512; WT = (bf16*)(F.ws + WS_WPOOL + (size_t)(jg >> 2) * 2 * MiB); ldt = 512; nnb = 16; row_off = (jg & 3) * 512;
        }
        transpose_item(W, ldw, WT, ldt, map, row_off, r / nnb, r % nnb, scr, F.lane, ks);
    }
    for (int row = gw; row < 2 * 8192; row += NGW) {
        const int j = row >> 13, hc = row & 8191, h = hc >> 9, c = hc & 511;
        const GAS float* src = (const GAS float*)(inp(F, 12) + (size_t)j * 512 * 2048 + (size_t)c * 2048 + h * 128 + 2 * F.lane);
        GAS unsigned* dst = (GAS unsigned*)((unsigned*)(F.ws + WS_W + j * W_MLA + WO_UK2) + (size_t)hc * 128);
        dst[F.lane] = pk2(src[0], src[1]); dst[64 + F.lane] = 0u;
    }
}

__device__ __forceinline__ void convert_ffn(Frame& F, int L) {
    LAS float* scr = (LAS float*)(F.lds + RING_OFF + F.wave * 16384);
    const int gw = F.vcu * NWAVES + F.wave, NGW = F.G * NWAVES;
    constexpr int I_UP = 32 * 352, I_DN = 88 * 64;
    const float* wu = inp(F, 17) + (size_t)L * 2048 * NUP; const float* wd = inp(F, 20) + (size_t)L * DFF * 2048; const float* g2 = inp(F, 6) + (size_t)(L * 4 + 2) * DM;
    for (int it = gw; it < I_UP + I_DN; it += NGW) {
        if (it < I_UP) transpose_item(wu, NUP, (bf16*)(F.ws + WS_WFFN + WO_UP), 2048, 1, 0, it / 352, it % 352, scr, F.lane, g2);
        else { const int r = it - I_UP; transpose_item(wd, 2048, (bf16*)(F.ws + WS_WFFN + WO_DOWN), DFF, 0, 0, r / 64, r % 64, scr, F.lane); }
    }
}
__device__ __forceinline__ void norm0_phase(Frame& F) {
    frame_lanes(F);
    const int gw = F.vcu * NWAVES + F.wave, NGW = F.G * NWAVES;
    const float* xp = inp(F, 0); const float* xs = inp(F, 1);
    bf16* XB = (bf16*)(F.ws + WS_XB); float* RS = (float*)(F.ws + WS_RS);
    for (int row = gw; row < T; row += NGW) {
        const float* xin = row < TP ? xp + (size_t)row * DM : xs + (size_t)(row - TP) * DM;
        f32x4 x[8]; float s2 = 0.f;
#pragma unroll
        for (int j = 0; j < 8; ++j) x[j] = *(const GAS f32x4*)(xin + (F.lane + 64 * j) * 4);
#pragma unroll
        for (int j = 0; j < 8; ++j) s2 += (x[j].x * x[j].x + x[j].y * x[j].y) + (x[j].z * x[j].z + x[j].w * x[j].w);
        const float r2 = 1.0f / sqrtf(wave_sum(s2, F.lane) * (1.0f / DM) + EPS);
#pragma unroll
        for (int j = 0; j < 8; ++j) { v2u w; w.x = pk2(x[j].x, x[j].y); w.y = pk2(x[j].z, x[j].w); *(GAS v2u*)(XB + (size_t)row * DM + (F.lane + 64 * j) * 4) = w; }
        if (F.lane == 0) ((GAS float*)RS)[row] = r2;
    }
}
template <bool LAST, bool POOLST>
__device__ __forceinline__ void norm_phase(Frame& F, const bf16* mres, const float* slab, int ns, const float* g_post, const float* g_pre, float* pool_p, float* pool_s, bool poison, bool dry = false) {
    frame_lanes(F);
    const int gw = F.vcu * NWAVES + F.wave, NGW = F.G * NWAVES;
    bf16* XB = (bf16*)(F.ws + WS_XB); bf16* XBo = dry ? (bf16*)(F.ws + WS_BIG) : XB;
    float* RS = (float*)(F.ws + WS_RS);
    f32x4 gp[8];
#pragma unroll
    for (int j = 0; j < 8; ++j) gp[j] = *(const GAS f32x4*)(g_post + (F.lane + 64 * j) * 4);
    for (int row = gw; row < T; row += NGW) {
        f32x4 x[8], mv[8];
#pragma unroll
        for (int j = 0; j < 8; ++j) { const v2u w = *(const GAS v2u*)(XB + (size_t)row * DM + (F.lane + 64 * j) * 4); x[j] = (f32x4){bflo(w.x), bfhi(w.x), bflo(w.y), bfhi(w.y)}; }
        if (ns > 0 && row >= TP) {
#pragma unroll
            for (int j = 0; j < 8; ++j) mv[j] = (f32x4){0.f, 0.f, 0.f, 0.f};
            for (int k = 0; k < ns; ++k) {
#pragma unroll
                for (int j = 0; j < 8; ++j) mv[j] = mv[j] + *(const GAS f32x4*)(slab + ((size_t)k * TS + (row - TP)) * DM + (F.lane + 64 * j) * 4); }
        } else {
#pragma unroll
            for (int j = 0; j < 8; ++j) { const v2u w = *(const GAS v2u*)(mres + (size_t)row * DM + (F.lane + 64 * j) * 4); mv[j] = (f32x4){bflo(w.x), bfhi(w.x), bflo(w.y), bfhi(w.y)}; } }
        float ss = 0.f;
#pragma unroll
        for (int j = 0; j < 8; ++j) ss += (mv[j].x * mv[j].x + mv[j].y * mv[j].y) + (mv[j].z * mv[j].z + mv[j].w * mv[j].w);
        const float r1 = 1.0f / sqrtf(wave_sum(ss, F.lane) * (1.0f / DM) + EPS);
#pragma unroll
        for (int j = 0; j < 8; ++j) x[j] = x[j] + mv[j] * r1 * gp[j];
        if (LAST) {
            if (poison) {
#pragma unroll
                for (int j = 0; j < 8; ++j) x[j] = x[j] * __builtin_nanf("");
            }
#pragma unroll
            for (int j = 0; j < 8; ++j) *(GAS f32x4*)(F.out + (size_t)row * DM + (F.lane + 64 * j) * 4) = x[j];
        } else {
#pragma unroll
            for (int j = 0; j < 8; ++j) { v2u w; w.x = pk2(x[j].x, x[j].y); w.y = pk2(x[j].z, x[j].w); *(GAS v2u*)(XBo + (size_t)row * DM + (F.lane + 64 * j) * 4) = w; }
            float s2 = 0.f;
#pragma unroll
            for (int j = 0; j < 8; ++j) s2 += (x[j].x * x[j].x + x[j].y * x[j].y) + (x[j].z * x[j].z + x[j].w * x[j].w);
            const float r2 = 1.0f / sqrtf(wave_sum(s2, F.lane) * (1.0f / DM) + EPS);
            if (F.lane == 0) ((GAS float*)RS)[row] = r2;
            if (POOLST) {
                float* ps = nullptr;
                if (row < TP) { const int s = row & (SEQ - 1); if (s >= SEQ - 15) ps = pool_p + ((size_t)(row >> 12) * 15 + (s - (SEQ - 15))) * DM; }
                else { const int qi = (row - TP) & 15; if (qi >= 1) ps = pool_s + ((size_t)((row - TP) >> 4) * 15 + (qi - 1)) * DM; }
                if (ps) {
#pragma unroll
                    for (int j = 0; j < 8; ++j) { const int c = (F.lane + 64 * j) * 4; *(GAS f32x4*)(ps + c) = x[j] * r2 * *(const GAS f32x4*)(g_pre + c); } }
            }
        }
    }
}

__device__ __forceinline__ void s1_phase(Frame& F, int j) {
    frame_lanes(F);
    const int gw = F.vcu * NWAVES + F.wave, NGW = F.G * NWAVES, lane = F.lane;
    const float* raw = (const float*)(F.ws + WS_MB);
    const float* qn = inp(F, 8) + j * 512; const float* kn = inp(F, 11) + j * 512;
    const float* ct = (const float*)(F.ws + WS_ROPE); const float* st = ct + 4096 * 32;
    bf16* CQ = (bf16*)(F.ws + WS_CQ); bf16* CKVB = (bf16*)(F.ws + WS_CKVB); bf16* KRB = (bf16*)(F.ws + WS_KRB);
    bf16* KALL = (bf16*)(F.ws + WS_KALL); bf16* VT = (bf16*)(F.ws + WS_VT);
    f32x4 gqn[2], gkn[2];
#pragma unroll
    for (int i = 0; i < 2; ++i) { gqn[i] = *(const GAS f32x4*)(qn + (lane + 64 * i) * 4); gkn[i] = *(const GAS f32x4*)(kn + (lane + 64 * i) * 4); }
    for (int row = gw; row < T; row += NGW) {
        const float* rr = raw + (size_t)row * 1280;
        f32x4 a[2], b[2]; float ssa = 0.f, ssb = 0.f;
#pragma unroll
        for (int i = 0; i < 2; ++i) { a[i] = *(const GAS f32x4*)(rr + (lane + 64 * i) * 4); b[i] = *(const GAS f32x4*)(rr + 512 + (lane + 64 * i) * 4);
            ssa += (a[i].x * a[i].x + a[i].y * a[i].y) + (a[i].z * a[i].z + a[i].w * a[i].w); ssb += (b[i].x * b[i].x + b[i].y * b[i].y) + (b[i].z * b[i].z + b[i].w * b[i].w); }
        const float rs_row = ((const GAS float*)(F.ws + WS_RS))[row];
#pragma unroll
        for (int i = 0; i < 2; ++i) { a[i] = a[i] * rs_row; b[i] = b[i] * rs_row; }
        ssa *= rs_row * rs_row; ssb *= rs_row * rs_row;
        const float kv = ((const GAS float*)rr)[1024 + lane] * rs_row;
        const float ra = 1.0f / sqrtf(wave_sum(ssa, lane) * (1.0f / 512) + EPS), rb = 1.0f / sqrtf(wave_sum(ssb, lane) * (1.0f / 512) + EPS);
        const bool prompt = row < TP;
        const int sb = (row - TP) >> 4, qi = (row - TP) & 15;
        const int pos = prompt ? (row & (SEQ - 1)) : 2048 + qi;
        float* o_ckv = prompt ? F.out + O_CKV_P + ((size_t)j * TP + row) * 512 : F.out + O_CKV_S + ((size_t)j * TS + (row - TP)) * 512;
        float* o_kr = prompt ? F.out + O_KR_P + ((size_t)j * TP + row) * 64 : F.out + O_KR_S + ((size_t)j * TS + (row - TP)) * 64;
#pragma unroll
        for (int i = 0; i < 2; ++i) {
            const int c = (lane + 64 * i) * 4;
            const f32x4 q = a[i] * ra * gqn[i]; v2u w; w.x = pk2(q.x, q.y); w.y = pk2(q.z, q.w); *(GAS v2u*)(CQ + (size_t)row * 512 + c) = w;
            const f32x4 k = b[i] * rb * gkn[i]; *(GAS f32x4*)(o_ckv + c) = k; v2u wk; wk.x = pk2(k.x, k.y); wk.y = pk2(k.z, k.w);
            if (prompt) *(GAS v2u*)(CKVB + (size_t)row * 512 + c) = wk;
            else { *(GAS v2u*)(KALL + ((size_t)sb * 2304 + 2048 + qi) * 640 + c) = wk;
                GAS bf16* vt = (GAS bf16*)(VT + ((size_t)sb * 512 + c) * 2304 + 2048 + qi); vt[0] = (bf16)(wk.x & 0xffff); vt[2304] = (bf16)(wk.x >> 16); vt[2 * 2304] = (bf16)(wk.y & 0xffff); vt[3 * 2304] = (bf16)(wk.y >> 16); }
        }
        const float other = shx(kv, 32, lane); const int i5 = lane & 31; const float cs = ((const GAS float*)ct)[pos * 32 + i5], sn = ((const GAS float*)st)[pos * 32 + i5];
        const float rot = lane < 32 ? kv * cs - other * sn : other * sn + kv * cs;
        ((GAS float*)o_kr)[lane] = rot;
        const float rot_hi = shx(rot, 32, lane);
        if (lane < 32) { const unsigned w = pk2(rot, rot_hi);
            if (prompt) ((GAS unsigned*)(KRB + (size_t)row * 64))[lane] = w; else ((GAS unsigned*)(KALL + ((size_t)sb * 2304 + 2048 + qi) * 640 + 512))[lane] = w; }
        else if (!prompt) ((GAS unsigned*)(KALL + ((size_t)sb * 2304 + 2048 + qi) * 640 + 576))[lane - 32] = 0u;
    }
    const float* cck = inp(F, 2) + (size_t)j * 32 * 2048 * 512; const float* ckr = inp(F, 3) + (size_t)j * 32 * 2048 * 64;
    for (int r = gw; r < 32 * 2304; r += NGW) {
        const int b = r / 2304, key = r - b * 2304; GAS unsigned* dst = (GAS unsigned*)(KALL + (size_t)r * 640);
        if (key < 2048) {
            const float kr = ((const GAS float*)ckr)[((size_t)b * 2048 + key) * 64 + lane]; const float kh = shx(kr, 32, lane);
            if (lane < 32) dst[256 + lane] = pk2(kr, kh); else dst[288 + lane - 32] = 0u;
        } else if (key >= 2064) {
#pragma unroll
            for (int i = 0; i < 5; ++i) dst[lane + 64 * i] = 0u;
        }
    }
    { LAS float* scr = (LAS float*)(F.lds + RING_OFF + F.wave * 16384);
      for (int it = gw; it < 32 * 512; it += NGW) { const int b = it >> 9, r = it & 511;
          transpose_item(cck + (size_t)b * 2048 * 512, 512, VT + (size_t)b * 512 * 2304, 2304, 0, 0, r >> 4, r & 15, scr, lane, nullptr, KALL + (size_t)b * 2304 * 640, 640); }
      for (int r = gw; r < 32 * 512; r += NGW) { GAS unsigned* dst = (GAS unsigned*)(VT + (size_t)r * 2304 + 2064); dst[lane] = 0u; if (lane < 56) dst[64 + lane] = 0u; }
    }
}

__device__ __forceinline__ void qlat_rope_copy(Frame& F) {
    frame_lanes(F);
    const bf16* Q = (const bf16*)(F.ws + WS_Q); bf16* QL = (bf16*)(F.ws + WS_QLAT);
    for (int idx = (F.vcu * NWAVES + F.wave) * 64 + F.lane; idx < 8192 * 16; idx += F.G * NWAVES * 64) {
        const int row = idx >> 4, ch = idx & 15, b = row >> 8, h = (row >> 4) & 15, qi = row & 15;
        v4u v = (v4u){0u, 0u, 0u, 0u};
        if (ch < 8) v = *(const GAS v4u*)(Q + (size_t)(TP + b * 16 + qi) * 3072 + h * 192 + 128 + ch * 8);
        *(GAS v4u*)(QL + (size_t)row * 640 + 512 + ch * 8) = v;
    }
}

__device__ __forceinline__ void softmax_phase(Frame& F) {
    frame_lanes(F);
    const float* S = (const float*)(F.ws + WS_S); bf16* P = (bf16*)(F.ws + WS_P);
    const int gw = F.vcu * NWAVES + F.wave, NGW = F.G * NWAVES, lane = F.lane;
    constexpr float C = att::SCALE * 1.4426950408889634f;
    for (int row = gw; row < 8192; row += NGW) {
        f32x4 v[9]; float mx = -1e30f;
#pragma unroll
        for (int j = 0; j < 9; ++j) { const int c = lane * 4 + 256 * j; v[j] = *(const GAS f32x4*)(S + (size_t)row * 2304 + c);
            if (c >= 2064) v[j] = (f32x4){-1e30f, -1e30f, -1e30f, -1e30f};
            mx = fmaxf(mx, fmaxf(fmaxf(v[j].x, v[j].y), fmaxf(v[j].z, v[j].w))); }
        mx = wave_max(mx, lane); float sum = 0.f;
#pragma unroll
        for (int j = 0; j < 9; ++j) { const int c = lane * 4 + 256 * j;
            v[j].x = __builtin_amdgcn_exp2f((v[j].x - mx) * C); v[j].y = __builtin_amdgcn_exp2f((v[j].y - mx) * C); v[j].z = __builtin_amdgcn_exp2f((v[j].z - mx) * C); v[j].w = __builtin_amdgcn_exp2f((v[j].w - mx) * C);
            if (c >= 2064) v[j] = (f32x4){0.f, 0.f, 0.f, 0.f};
            sum += (v[j].x + v[j].y) + (v[j].z + v[j].w); }
        const float inv = 1.0f / wave_sum(sum, lane);
#pragma unroll
        for (int j = 0; j < 9; ++j) { const int c = lane * 4 + 256 * j; v2u w; w.x = pk2(v[j].x * inv, v[j].y * inv); w.y = pk2(v[j].z * inv, v[j].w * inv); *(GAS v2u*)(P + (size_t)row * 2304 + c) = w; }
    }
}

template <int G> __device__ __forceinline__ void pool_group_prompt(const bf16* X, const GAS float* RS, bf16* Dd, const float* g0, int t0, int s0, int lane) {
    constexpr int W = 2 << G, H = W - 1;
    const int c = G * 512 + lane * 8;
    const bool hv = s0 > 0;
    const int rrow = t0 - 15 + lane; const float rsv = (lane < 31 && rrow >= 0) ? RS[rrow] : 0.f;
    v4u x[H + 16];
#pragma unroll
    for (int r = 0; r < H + 16; ++r) { x[r] = (v4u){0u, 0u, 0u, 0u}; if (r >= H || hv) x[r] = *(const GAS v4u*)(X + (size_t)(t0 - H + r) * DM + c); }
    const f32x4 ga = *(const GAS f32x4*)(g0 + c), gb = *(const GAS f32x4*)(g0 + c + 4);
    float S[8];
#pragma unroll
    for (int e = 0; e < 8; ++e) S[e] = 0.f;
#define PD_ROWF(v, rs, f) do { f[0] = bflo(v.x) * rs; f[1] = bfhi(v.x) * rs; f[2] = bflo(v.y) * rs; f[3] = bfhi(v.y) * rs; f[4] = bflo(v.z) * rs; f[5] = bfhi(v.z) * rs; f[6] = bflo(v.w) * rs; f[7] = bfhi(v.w) * rs; } while (0)
#pragma unroll
    for (int r = 0; r < H; ++r) { const float rs = __builtin_bit_cast(float, __builtin_amdgcn_readlane(__builtin_bit_cast(int, rsv), 15 - H + r)); float f[8]; PD_ROWF(x[r], rs, f);
#pragma unroll
        for (int e = 0; e < 8; ++e) S[e] += f[e]; }
#pragma unroll
    for (int i = 0; i < 16; ++i) {
        const float rs = __builtin_bit_cast(float, __builtin_amdgcn_readlane(__builtin_bit_cast(int, rsv), 15 + i)); float f[8]; PD_ROWF(x[H + i], rs, f);
#pragma unroll
        for (int e = 0; e < 8; ++e) S[e] += f[e];
        const int s = s0 + i; const float ic = 1.0f / (float)((s + 1) < W ? (s + 1) : W);
        v4u o; o.x = pk2((S[0] * ic - f[0]) * ga.x, (S[1] * ic - f[1]) * ga.y); o.y = pk2((S[2] * ic - f[2]) * ga.z, (S[3] * ic - f[3]) * ga.w);
        o.z = pk2((S[4] * ic - f[4]) * gb.x, (S[5] * ic - f[5]) * gb.y); o.w = pk2((S[6] * ic - f[6]) * gb.z, (S[7] * ic - f[7]) * gb.w);
        *(GAS v4u*)(Dd + (size_t)(t0 + i) * DM + c) = o;
        { const float rl = __builtin_bit_cast(float, __builtin_amdgcn_readlane(__builtin_bit_cast(int, rsv), 15 - H + i)); float fl[8]; PD_ROWF(x[i], rl, fl);
#pragma unroll
          for (int e = 0; e < 8; ++e) S[e] -= fl[e]; }
    }
#undef PD_ROWF
}
__device__ __forceinline__ void pool_d_phase(Frame& F, int j, const float* g0) {
    frame_lanes(F);
    const bf16* X = (const bf16*)(F.ws + WS_XB); bf16* Dd = (bf16*)(F.ws + WS_ACT); const GAS float* RS = (const GAS float*)(F.ws + WS_RS);
    const float* hist = inp(F, 4) + (size_t)j * 32 * 15 * DM;
    const int gw = F.vcu * NWAVES + F.wave, NGW = F.G * NWAVES, lane = F.lane;
    for (int ch = gw; ch < TP / 16; ch += NGW) {
        const int t0 = ch * 16, s0 = t0 & (SEQ - 1);
        pool_group_prompt<0>(X, RS, Dd, g0, t0, s0, lane); pool_group_prompt<1>(X, RS, Dd, g0, t0, s0, lane);
        pool_group_prompt<2>(X, RS, Dd, g0, t0, s0, lane); pool_group_prompt<3>(X, RS, Dd, g0, t0, s0, lane);
    }
    for (int row = TP + gw; row < T; row += NGW) {
        const int s = (row - TP) & 15; const int sb = (row - TP) >> 4;
#pragma unroll
        for (int g = 0; g < 4; ++g) {
            const int w = 2 << g, c = g * 512 + lane * 8;
            const f32x4 ga = *(const GAS f32x4*)(g0 + c), gb = *(const GAS f32x4*)(g0 + c + 4);
            const float gg[8] = {ga.x, ga.y, ga.z, ga.w, gb.x, gb.y, gb.z, gb.w};
            float acc[8], self[8];
#pragma unroll
            for (int e = 0; e < 8; ++e) { acc[e] = 0.f; self[e] = 0.f; }
            for (int k = 0; k < w; ++k) {
                const int sk = s - k;
                if (sk >= 0) { const v4u v = *(const GAS v4u*)(X + (size_t)(row - k) * DM + c); const float r = RS[row - k];
                    const float f[8] = {bflo(v.x), bfhi(v.x), bflo(v.y), bfhi(v.y), bflo(v.z), bfhi(v.z), bflo(v.w), bfhi(v.w)};
#pragma unroll
                    for (int e = 0; e < 8; ++e) { const float hv = f[e] * r * gg[e]; acc[e] += hv; if (k == 0) self[e] = hv; } }
                else { const float* hp = hist + ((size_t)sb * 15 + (15 + sk)) * DM + c; const f32x4 u0 = *(const GAS f32x4*)hp, u1 = *(const GAS f32x4*)(hp + 4);
                    acc[0] += u0.x; acc[1] += u0.y; acc[2] += u0.z; acc[3] += u0.w; acc[4] += u1.x; acc[5] += u1.y; acc[6] += u1.z; acc[7] += u1.w; }
            }
            const float ic = 1.0f / (float)w;
            v4u o; o.x = pk2(acc[0] * ic - self[0], acc[1] * ic - self[1]); o.y = pk2(acc[2] * ic - self[2], acc[3] * ic - self[3]);
            o.z = pk2(acc[4] * ic - self[4], acc[5] * ic - self[5]); o.w = pk2(acc[6] * ic - self[6], acc[7] * ic - self[7]);
            *(GAS v4u*)(Dd + (size_t)row * DM + c) = o;
        }
    }
}

__device__ __forceinline__ void fix_phase(Frame& F, int L) {
    frame_lanes(F);
    const bf16* BF = (const bf16*)(F.ws + WS_BND); const bf16* BL = BF + (size_t)512 * 2 * NUP;
    const float* cw = inp(F, 18) + (size_t)L * 3 * NUP; const float* cb = inp(F, 19) + (size_t)L * NUP;
    bf16* act = (bf16*)(F.ws + WS_ACT);
    for (int idx = (F.vcu * NWAVES + F.wave) * 64 + F.lane; idx < 512 * 2 * 704; idx += F.G * NWAVES * 64) {
        const int cc = idx % 704, sj = idx / 704, s = sj >> 1, jr = sj & 1;
        const int jg = cc * 8, np = (jg >> 7) * 256 + (jg & 127);
        const bool seq0 = (s & 63) == 0;
        float u0[2][8], u1[2][8], u2[2][8];
#pragma unroll
        for (int gv = 0; gv < 2; ++gv) {
            const v4u zero = (v4u){0u, 0u, 0u, 0u};
            const v4u cur = *(const GAS v4u*)(BF + (size_t)(s * 2 + jr) * NUP + np + gv * 128);
            const v4u f0 = *(const GAS v4u*)(BF + (size_t)(s * 2) * NUP + np + gv * 128);
            const v4u l0 = seq0 ? zero : *(const GAS v4u*)(BL + (size_t)((s - 1) * 2) * NUP + np + gv * 128);
            const v4u l1 = seq0 ? zero : *(const GAS v4u*)(BL + (size_t)((s - 1) * 2 + 1) * NUP + np + gv * 128);
            const v4u p1 = jr ? f0 : l1, p2 = jr ? l1 : l0;
            const unsigned cu[4] = {cur.x, cur.y, cur.z, cur.w}, a1[4] = {p1.x, p1.y, p1.z, p1.w}, a2[4] = {p2.x, p2.y, p2.z, p2.w};
#pragma unroll
            for (int e = 0; e < 4; ++e) { u0[gv][2 * e] = bflo(cu[e]); u0[gv][2 * e + 1] = bfhi(cu[e]); u1[gv][2 * e] = bflo(a1[e]); u1[gv][2 * e + 1] = bfhi(a1[e]); u2[gv][2 * e] = bflo(a2[e]); u2[gv][2 * e + 1] = bfhi(a2[e]); }
        }
        float r[8];
#pragma unroll
        for (int e = 0; e < 8; ++e) {
            const int cg = jg + e, cv = DFF + jg + e;
            const GAS float* cwg = (const GAS float*)cw; const GAS float* cbg = (const GAS float*)cb;
            const float g = cbg[cg] + cwg[cg] * u2[0][e] + cwg[NUP + cg] * u1[0][e] + cwg[2 * NUP + cg] * u0[0][e];
            const float v = cbg[cv] + cwg[cv] * u2[1][e] + cwg[NUP + cv] * u1[1][e] + cwg[2 * NUP + cv] * u0[1][e];
            r[e] = pg8::silu_mul(g, v);
        }
        v4u o; o.x = pk2(r[0], r[1]); o.y = pk2(r[2], r[3]); o.z = pk2(r[4], r[5]); o.w = pk2(r[6], r[7]);
        *(GAS v4u*)(act + (size_t)(s * 64 + jr) * DFF + jg) = o;
    }
}

__device__ __forceinline__ void attn_phase(Frame& F) {
    frame_lanes(F);
    const bf16* Q = (const bf16*)(F.ws + WS_Q); const bf16* KV = (const bf16*)(F.ws + WS_KV); const bf16* KRB = (const bf16*)(F.ws + WS_KRB); bf16* O = (bf16*)(F.ws + WS_HB);
    for (int pi = F.vcu; pi < 1024; pi += F.G) {
        const int bh = pi >> 3, s = pi & 7, b = bh >> 4, h = bh & 15;
#pragma unroll 1
        for (int half = 0; half < 2; ++half) {
            const int qb = half ? 15 - s : s;
            const size_t row0 = (size_t)b * SEQ;
            att::attn_unit(Q + (row0 + 256 * qb) * 3072 + h * 192, KV + row0 * 4096 + h * 128, KV + row0 * 4096 + 2048 + h * 128, KRB + row0 * 64,
                           O + (row0 + 256 * qb) * DM + h * 128, 4 * qb + 4, qb, (ATT_LAS char*)(F.lds + RING_OFF));
        }
    }
}

struct Args { const float* in[21]; float* out; unsigned char* ws; int ph_lo, ph_hi; };
constexpr int NPH = 1 + 4 * 16;
#ifndef PG8_ALIGN
#define PG8_ALIGN true
#endif
__global__ void __launch_bounds__(NWAVES * 64, 2) fwd_kernel(Args args) {
    extern __shared__ __attribute__((aligned(16))) unsigned char lds[];
    Frame F;
    F.lds = (LAS unsigned char*)lds;
    F.tid = threadIdx.x; F.lane = F.tid & 63; F.wave = __builtin_amdgcn_readfirstlane(F.tid >> 6);
    F.G = gridDim.x; { const int bx = blockIdx.x; F.vcu = (F.G % 8 == 0) ? (bx % 8) * (F.G / 8) + bx / 8 : bx; }
    F.out = args.out; F.ws = args.ws;
    unsigned* ctl = (unsigned*)(F.ws + WS_CTL);
    for (int u = F.tid; u < (LDS_BYTES - LDSCTL_OFF) / 4; u += NWAVES * 64) ((LAS unsigned*)(F.lds + LDSCTL_OFF))[u] = 0u;
    __syncthreads();
    if (F.tid == 0) {
#pragma unroll
        for (int i = 0; i < 21; ++i) ((LAS unsigned long long*)(F.lds + PTR_OFF))[i] = (unsigned long long)args.in[i];
    }
    __syncthreads();
    const int lo = args.ph_lo, hi = args.ph_hi;
    const bool one_launch = (hi - lo) > 1;
    XcdBarrier bar; bar.bar = ctl + CW_BAR; bar.x = 0; bar.st = nullptr;
    if (one_launch) bar = xcd_barrier_post(ctl + CW_BAR, (volatile LAS unsigned*)(F.lds + MISC_OFF) + 8);
#ifndef PH_MASK
#define PH_MASK 0x1ffffu
#endif
#define IN(k) (lo <= (k) && (k) < hi)
#define EN(p) (((PH_MASK) >> (p)) & 1u)
#ifndef DBL_MASK
#define DBL_MASK 0u
#endif
#define REPS(p) ((int)(((DBL_MASK) >> (p)) & 1u) + 1)
#define SEAM(k) do { if (IN((k) + 1)) { xcd_barrier(bar); if (REPS(17) > 1) xcd_barrier(bar); } } while (0)
    const int bid = (int)blockIdx.x;

    if (EN(16) && IN(0)) { for (int rep_ = 0; rep_ < REPS(16); ++rep_) { if (rep_) xcd_barrier(bar); p0_prologue(F); convert_ffn(F, 0); norm0_phase(F); } SEAM(0); }

    for (int L = 0; L < 4; ++L) {
        const int base = 1 + 16 * L, j = L >> 1;
        const float* ng = inp(F, 6) + (size_t)L * 4 * DM;
        if ((L & 1) == 0) {
            unsigned char* wb = F.ws + WS_W + j * W_MLA;
            if (EN(0) && IN(base + 0)) { for (int rep_ = 0; rep_ < REPS(0); ++rep_) { if (rep_) xcd_barrier(bar); frame_lanes(F); LAS unsigned char* ring = F.lds + RING_OFF;  pg8::SchedPlain S; S.init(130, 5, F.G, bid); S.A = (const char*)(F.ws + WS_XB); S.B = (const char*)(wb + WO_DQKV); S.lda = 2048; S.ldb = 2048; S.K = 2048;
                pg8::EpiF32 E{(float*)(F.ws + WS_MB), 1280}; pg8::gemm_phase<pg8::EpiF32, pg8::SchedPlain, PG8_ALIGN>(ring, S, E);  } SEAM(base + 0); }
            if (EN(1) && IN(base + 1)) { for (int rep_ = 0; rep_ < REPS(1); ++rep_) { if (rep_) xcd_barrier(bar); frame_lanes(F); LAS unsigned char* ring = F.lds + RING_OFF;  s1_phase(F, j);  } SEAM(base + 1); }
            if (EN(2) && IN(base + 2)) { for (int rep_ = 0; rep_ < REPS(2); ++rep_) { if (rep_) xcd_barrier(bar); frame_lanes(F); LAS unsigned char* ring = F.lds + RING_OFF;  pg8::SchedPlain S; S.init(130, 12, F.G, bid); S.A = (const char*)(F.ws + WS_CQ); S.B = (const char*)(wb + WO_UQ); S.lda = 512; S.ldb = 512; S.K = 512;
                pg8::EpiQRope E{(bf16*)(F.ws + WS_Q), (const float*)(F.ws + WS_ROPE), (const float*)(F.ws + WS_ROPE) + 4096 * 32};
                pg8::gemm_phase<pg8::EpiQRope, pg8::SchedPlain, PG8_ALIGN>(ring, S, E);  } SEAM(base + 2); }
            if (EN(3) && IN(base + 3)) { for (int rep_ = 0; rep_ < REPS(3); ++rep_) { if (rep_) xcd_barrier(bar); frame_lanes(F); LAS unsigned char* ring = F.lds + RING_OFF;  qlat_rope_copy(F);
                pg8::SchedQlat S; S.init(32, 2, F.G, bid); S.A = (const char*)(F.ws + WS_Q) + (size_t)TP * 3072 * 2; S.B = (const char*)(wb + WO_UK2); S.lda = 3072; S.ldb = 256; S.K = 256;
                pg8::EpiB<1> E{(bf16*)(F.ws + WS_QLAT), 640, nullptr}; pg8::gemm_phase<pg8::EpiB<1>, pg8::SchedQlat, PG8_ALIGN>(ring, S, E);  } SEAM(base + 3); }
            if (EN(4) && IN(base + 4)) { for (int rep_ = 0; rep_ < REPS(4); ++rep_) { if (rep_) xcd_barrier(bar); frame_lanes(F); LAS unsigned char* ring = F.lds + RING_OFF;  pg8::SchedBatch S; S.init(32, 9, F.G, bid); S.A = (const char*)(F.ws + WS_QLAT); S.B = (const char*)(F.ws + WS_KALL); S.lda = 640; S.ldb = 640; S.K = 640; S.b_pm = (size_t)2304 * 640 * 2;
                pg8::EpiF32 E{(float*)(F.ws + WS_S), 2304}; pg8::gemm_phase<pg8::EpiF32, pg8::SchedBatch, PG8_ALIGN>(ring, S, E);  } SEAM(base + 4); }
            if (EN(5) && IN(base + 5)) { for (int rep_ = 0; rep_ < REPS(5); ++rep_) { if (rep_) xcd_barrier(bar); frame_lanes(F); LAS unsigned char* ring = F.lds + RING_OFF;  softmax_phase(F);  } SEAM(base + 5); }
            if (EN(6) && IN(base + 6)) { for (int rep_ = 0; rep_ < REPS(6); ++rep_) { if (rep_) xcd_barrier(bar); frame_lanes(F); LAS unsigned char* ring = F.lds + RING_OFF;  pg8::SchedBatch S; S.init(32, 2, F.G, bid); S.A = (const char*)(F.ws + WS_P); S.B = (const char*)(F.ws + WS_VT); S.lda = 2304; S.ldb = 2304; S.K = 2304; S.b_pm = (size_t)512 * 2304 * 2;
                pg8::EpiB<2> E{(bf16*)(F.ws + WS_OL), 512, nullptr}; pg8::gemm_phase<pg8::EpiB<2>, pg8::SchedBatch, PG8_ALIGN>(ring, S, E);  } SEAM(base + 6); }
            if (EN(7) && IN(base + 7)) { for (int rep_ = 0; rep_ < REPS(7); ++rep_) { if (rep_) xcd_barrier(bar); frame_lanes(F); LAS unsigned char* ring = F.lds + RING_OFF;  pg8::SchedOV S; S.init(32, 1, F.G, bid); S.A = (const char*)(F.ws + WS_OL); S.B = (const char*)(wb + WO_UKV) + (size_t)2048 * 512 * 2; S.lda = 512; S.ldb = 512; S.K = 512;
                pg8::EpiB<3> E{(bf16*)(F.ws + WS_HB), 2048, nullptr}; pg8::gemm_phase<pg8::EpiB<3>, pg8::SchedOV, PG8_ALIGN>(ring, S, E);  } SEAM(base + 7); }
            if (EN(8) && IN(base + 8)) { for (int rep_ = 0; rep_ < REPS(8); ++rep_) { if (rep_) xcd_barrier(bar); frame_lanes(F); LAS unsigned char* ring = F.lds + RING_OFF;  pg8::SchedPlain S; S.init(128, 16, F.G, bid); S.A = (const char*)(F.ws + WS_CKVB); S.B = (const char*)(wb + WO_UKV); S.lda = 512; S.ldb = 512; S.K = 512;
                pg8::EpiB<0> E{(bf16*)(F.ws + WS_KV), 4096, nullptr}; pg8::gemm_phase<pg8::EpiB<0>, pg8::SchedPlain, PG8_ALIGN>(ring, S, E);  } SEAM(base + 8); }
            if (EN(9) && IN(base + 9)) { for (int rep_ = 0; rep_ < REPS(9); ++rep_) { if (rep_) xcd_barrier(bar); frame_lanes(F); LAS unsigned char* ring = F.lds + RING_OFF;  attn_phase(F);  } SEAM(base + 9); }
            if (EN(10) && IN(base + 10)) { for (int rep_ = 0; rep_ < REPS(10); ++rep_) { if (rep_) xcd_barrier(bar); frame_lanes(F); LAS unsigned char* ring = F.lds + RING_OFF;  pg8::SchedPlain S; S.init(128, 8, F.G, bid); S.A = (const char*)(F.ws + WS_HB); S.B = (const char*)(wb + WO_O); S.lda = 2048; S.ldb = 2048; S.K = 2048;
                pg8::EpiB<0> E{(bf16*)(F.ws + WS_MB), 2048, nullptr}; pg8::gemm_phase<pg8::EpiB<0>, pg8::SchedPlain, PG8_ALIGN>(ring, S, E);
                { pg8::SchedSplit S2; S2.init(2 * 4, 8, F.G, bid); S2.A = (const char*)(F.ws + WS_HB) + (size_t)TP * 2048 * 2; S2.B = (const char*)(wb + WO_O); S2.lda = 2048; S2.ldb = 2048; S2.K = 512;
                  pg8::EpiSlab E2{(float*)(F.ws + WS_SLAB)}; pg8::gemm_phase<pg8::EpiSlab, pg8::SchedSplit, PG8_ALIGN>(ring, S2, E2); }  } SEAM(base + 10); }
        } else {
            if (EN(9) && IN(base + 9)) { for (int rep_ = 0; rep_ < REPS(18); ++rep_) { if (rep_) xcd_barrier(bar); frame_lanes(F); LAS unsigned char* ring = F.lds + RING_OFF;  pool_d_phase(F, j, ng);  } SEAM(base + 9); }
            if (EN(10) && IN(base + 10)) { for (int rep_ = 0; rep_ < REPS(10); ++rep_) { if (rep_) xcd_barrier(bar); frame_lanes(F); LAS unsigned char* ring = F.lds + RING_OFF;  pg8::SchedPool S; S.init(130, 8, F.G, bid); S.A = (const char*)(F.ws + WS_ACT); S.B = (const char*)(F.ws + WS_WPOOL + (size_t)j * 2 * MiB); S.lda = 2048; S.ldb = 512; S.K = 512;
                pg8::EpiB<0> E{(bf16*)(F.ws + WS_MB), 2048, inp(F, 16) + (size_t)j * DM}; pg8::gemm_phase<pg8::EpiB<0>, pg8::SchedPool, PG8_ALIGN>(ring, S, E);  } SEAM(base + 10); }
        }
        unsigned char* wf = F.ws + WS_WFFN;
        if (EN(11) && IN(base + 11)) { for (int rep_ = 0; rep_ < REPS(11); ++rep_) { if (rep_) xcd_barrier(bar); frame_lanes(F); LAS unsigned char* ring = F.lds + RING_OFF;  const int nsb = (L & 1) ? 0 : 4; const bool dry = rep_ + 1 < REPS(11); norm_phase<false, false>(F, (const bf16*)(F.ws + WS_MB), (const float*)(F.ws + WS_SLAB), nsb, ng + DM, nullptr, nullptr, nullptr, false, dry);  } SEAM(base + 11); }
        if (EN(12) && IN(base + 12)) { for (int rep_ = 0; rep_ < REPS(12); ++rep_) { if (rep_) xcd_barrier(bar); frame_lanes(F); LAS unsigned char* ring = F.lds + RING_OFF;  pg8::SchedPlain S; S.init(130, 44, F.G, bid); S.A = (const char*)(F.ws + WS_XB); S.B = (const char*)(wf + WO_UP); S.lda = 2048; S.ldb = 2048; S.K = 2048;
            pg8::EpiUp E{(bf16*)(F.ws + WS_ACT), (bf16*)(F.ws + WS_BND), (bf16*)(F.ws + WS_BND) + (size_t)512 * 2 * NUP, inp(F, 18) + (size_t)L * 3 * NUP, inp(F, 19) + (size_t)L * NUP,
                         inp(F, 5) + (size_t)L * 32 * 2 * NUP, F.out + O_CONV_P + (size_t)L * 8 * 2 * NUP, F.out + O_CONV_S + (size_t)L * 32 * 2 * NUP, (const float*)(F.ws + WS_RS)};
            pg8::gemm_phase<pg8::EpiUp, pg8::SchedPlain, PG8_ALIGN>(ring, S, E);  } SEAM(base + 12); }
        if (EN(13) && IN(base + 13)) { for (int rep_ = 0; rep_ < REPS(13); ++rep_) { if (rep_) xcd_barrier(bar); frame_lanes(F); LAS unsigned char* ring = F.lds + RING_OFF;  fix_phase(F, L);  } SEAM(base + 13); }
        if (EN(14) && IN(base + 14)) { for (int rep_ = 0; rep_ < REPS(14); ++rep_) { if (rep_) xcd_barrier(bar); frame_lanes(F); LAS unsigned char* ring = F.lds + RING_OFF;  pg8::SchedPlain S; S.init(128, 8, F.G, bid); S.A = (const char*)(F.ws + WS_ACT); S.B = (const char*)(wf + WO_DOWN); S.lda = DFF; S.ldb = DFF; S.K = DFF;
            pg8::EpiB<0> E{(bf16*)(F.ws + WS_MB), 2048, nullptr}; pg8::gemm_phase<pg8::EpiB<0>, pg8::SchedPlain, PG8_ALIGN>(ring, S, E);
            { pg8::SchedSplit S2; S2.init(2 * 11, 8, F.G, bid); S2.A = (const char*)(F.ws + WS_ACT) + (size_t)TP * DFF * 2; S2.B = (const char*)(wf + WO_DOWN); S2.lda = DFF; S2.ldb = DFF; S2.K = 512;
              pg8::EpiSlab E2{(float*)(F.ws + WS_SLAB)}; pg8::gemm_phase<pg8::EpiSlab, pg8::SchedSplit, PG8_ALIGN>(ring, S2, E2); }  } SEAM(base + 14); }
        if (EN(15) && IN(base + 15)) {
            const bool poison = one_launch && xb_ld(ctl + CW_BAR + XB_TMO) != 0u;
            frame_lanes(F);
            if (L < 3) convert_ffn(F, L + 1);
            const float* slab = (const float*)(F.ws + WS_SLAB);
            if (L == 3) norm_phase<true, false>(F, (const bf16*)(F.ws + WS_MB), slab, 11, ng + 3 * DM, nullptr, nullptr, nullptr, poison);
            else if ((L & 1) == 0) norm_phase<false, true>(F, (const bf16*)(F.ws + WS_MB), slab, 11, ng + 3 * DM, ng + 4 * DM, F.out + O_POOL_P + (size_t)j * 8 * 15 * DM, F.out + O_POOL_S + (size_t)j * 32 * 15 * DM, false);
            else norm_phase<false, false>(F, (const bf16*)(F.ws + WS_MB), slab, 11, ng + 3 * DM, nullptr, nullptr, nullptr, false);
            if (L < 3) SEAM(base + 15);
        }
    }
#undef IN
#undef SEAM
}

#ifndef MK_PER_PHASE
#define MK_PER_PHASE 0
#endif
extern "C" void kernel_launch(void* const* d_in, const int* in_sizes, int n_in, void* d_out, int out_size, void* d_ws, size_t ws_size, hipStream_t stream) {
    static int grid = 0;
    if (grid == 0) {
        if (n_in != 21 || (size_t)out_size != O_END || ws_size < WS_END) { fprintf(stderr, "kernel_launch: unexpected problem shape (n_in %d, out %d, ws %zu < %zu); nothing launched\n", n_in, out_size, ws_size, (size_t)WS_END); grid = -1; return; }
        int dev = 0, cus = 0, per_cu = 0;
        if (hipGetDevice(&dev) != hipSuccess || hipDeviceGetAttribute(&cus, hipDeviceAttributeMultiprocessorCount, dev) != hipSuccess) { grid = -1; return; }
        if (hipFuncSetAttribute((const void*)fwd_kernel, hipFuncAttributeMaxDynamicSharedMemorySize, LDS_BYTES) != hipSuccess) { fprintf(stderr, "kernel_launch: hipFuncSetAttribute failed\n"); grid = -1; return; }
        if (hipOccupancyMaxActiveBlocksPerMultiprocessor(&per_cu, (const void*)fwd_kernel, NWAVES * 64, LDS_BYTES) != hipSuccess || per_cu < 1) { fprintf(stderr, "kernel_launch: occupancy query says %d blocks per CU\n", per_cu); }
        (void)hipGetLastError();
        grid = cus;
    }
    if (grid < 0) return;
    (void)hipMemsetAsync((char*)d_ws + WS_CTL, 0, CTL_ZERO_BYTES, stream);
    Args a{};
    for (int i = 0; i < 21; ++i) a.in[i] = (const float*)d_in[i];
    a.out = (float*)d_out; a.ws = (unsigned char*)d_ws;
#if MK_PER_PHASE
    for (int p = 0; p < NPH; ++p) {
        if (p >= 1) { const int L = (p - 1) >> 4, q = (p - 1) & 15; if ((L & 1) && q < 9) continue; }
        a.ph_lo = p; a.ph_hi = p + 1;
        hipLaunchKernelGGL(fwd_kernel, dim3(grid), dim3(NWAVES * 64), LDS_BYTES, stream, a);
    }
#else
    a.ph_lo = 0; a.ph_hi = NPH;
    hipLaunchKernelGGL(fwd_kernel, dim3(grid), dim3(NWAVES * 64), LDS_BYTES, stream, a);
#endif
}
```

```cpp
#define DBL_MASK 0u
#ifndef MK_PER_PHASE
#define MK_PER_PHASE 0
#endif
#include <hip/hip_runtime.h>
#include <cstdio>
#include <cstdint>
namespace pg8 {
#define PG8_LAS __attribute__((address_space(3)))
#define PG8_GAS __attribute__((address_space(1)))
typedef unsigned short bf16_t;
typedef short bf16x8 __attribute__((ext_vector_type(8)));
typedef float f32x4 __attribute__((ext_vector_type(4)));
typedef unsigned u32x4 __attribute__((ext_vector_type(4)));
typedef unsigned u32x2 __attribute__((ext_vector_type(2)));
constexpr int BM = 256, BK = 64, HALF = 128, HTB = HALF * BK * 2  , STAGE_BYTES = 8 * HTB, NXCD = 8, WGM = 8;

__host__ __device__ __forceinline__ int lds_byte(int r, int c) { const int st = (r >> 4) * 2 + (c >> 5), rr = r & 15, cc = c & 31, ob = rr * 64 + cc * 2; return st * 1024 + (ob ^ (((ob >> 9) & 1) << 5)); }
__host__ __device__ __forceinline__ void stage_rc(int b, int& R, int& C) { const int st = b / 1024, sb = b % 1024, swz = sb ^ (((sb >> 9) & 1) << 5); R = (st >> 1) * 16 + swz / 64; C = (st & 1) * 32 + (swz % 64) / 2; }
__host__ __device__ __forceinline__ int perm32(int rho) { const int n = rho >> 4, i = rho & 15; return 8 * (i >> 2) + 4 * n + (i & 3); }

struct Unit { int pm, pn; };

struct OrderBase {
    int nM, nN, nwg, G, c;
    __device__ __forceinline__ void init(int nM_, int nN_, int G_, int c_) { nM = nM_; nN = nN_; nwg = nM * nN; G = G_; c = c_; }
    __device__ __forceinline__ bool next(int i, Unit& u) const {
        const long L = (long)i * G + c; if (L >= nwg) return false;
        int wgid = (int)L; { const int q = nwg / NXCD, r = nwg % NXCD, xcd = wgid % NXCD, off = wgid / NXCD; wgid = (xcd < r ? xcd * (q + 1) : r * (q + 1) + (xcd - r) * q) + off; }
        const int nig = WGM * nN, gid = wgid / nig, fm = gid * WGM, gsz = (nM - fm) < WGM ? (nM - fm) : WGM;
        u.pm = fm + ((wgid % nig) % gsz); u.pn = (wgid % nig) / gsz; return true;
    }
    __device__ __forceinline__ void a_ready(const Unit&) const {}
    __device__ __forceinline__ void done(const Unit&) const {}
};
struct SchedPlain : OrderBase {
    const char* A; const char* B; int lda, ldb, K;
    __device__ __forceinline__ const char* a_ptr(const Unit& u) const { return A + (size_t)u.pm * 256 * lda * 2; }
    __device__ __forceinline__ const char* b_ptr(const Unit& u) const { return B + (size_t)u.pn * 256 * ldb * 2; }
};
struct SchedBatch : OrderBase {
    const char* A; const char* B; int lda, ldb, K; size_t b_pm;
    __device__ __forceinline__ const char* a_ptr(const Unit& u) const { return A + (size_t)u.pm * 256 * lda * 2; }
    __device__ __forceinline__ const char* b_ptr(const Unit& u) const { return B + (size_t)u.pm * b_pm + (size_t)u.pn * 256 * ldb * 2; }
};
struct SchedQlat : OrderBase {
    const char* A; const char* B; int lda, ldb, K;
    __device__ __forceinline__ const char* a_ptr(const Unit& u) const { return A + ((size_t)(u.pm & 1) * 256 * lda + (size_t)(u.pm >> 1) * 192) * 2; }
    __device__ __forceinline__ const char* b_ptr(const Unit& u) const { return B + ((size_t)(u.pm >> 1) * 512 + (size_t)u.pn * 256) * ldb * 2; }
};
struct SchedOV : OrderBase {
    const char* A; const char* B; int lda, ldb, K;
    __device__ __forceinline__ const char* a_ptr(const Unit& u) const { return A + (size_t)u.pm * 256 * lda * 2; }
    __device__ __forceinline__ const char* b_ptr(const Unit& u) const { return B + (size_t)(u.pm >> 2) * 256 * ldb * 2; }
};
struct SchedPool : OrderBase {
    const char* A; const char* B; int lda, ldb, K;
    __device__ __forceinline__ const char* a_ptr(const Unit& u) const { return A + ((size_t)u.pm * 256 * lda + (size_t)(u.pn >> 1) * 512) * 2; }
    __device__ __forceinline__ const char* b_ptr(const Unit& u) const { return B + (size_t)u.pn * 256 * ldb * 2; }
};

struct SchedSplit : OrderBase {
    const char* A; const char* B; int lda, ldb, K;
    __device__ __forceinline__ const char* a_ptr(const Unit& u) const { return A + ((size_t)(u.pm & 1) * 256 * lda + (size_t)(u.pm >> 1) * K) * 2; }
    __device__ __forceinline__ const char* b_ptr(const Unit& u) const { return B + ((size_t)u.pn * 256 * ldb + (size_t)(u.pm >> 1) * K) * 2; }
};

__device__ __forceinline__ unsigned cvt_pk_bf16(float lo, float hi) { unsigned r; asm volatile("v_cvt_pk_bf16_f32 %0, %1, %2" : "=v"(r) : "v"(lo), "v"(hi)); return r; }

struct EpiF32 {
    static constexpr bool PERM = false, APERM = false, AFTER_DRAIN = false;
    float* C; int ldc;
    __device__ __forceinline__ void operator()(const f32x4 (&acc)[2][2][4][2], const Unit& u, int wr, int wc, int fr, int fq) const {
        const int row0 = u.pm * BM + wr * 64 + fr, col0 = u.pn * BM + wc * 32 + 4 * fq;
#pragma unroll
        for (int ai = 0; ai < 2; ++ai)
#pragma unroll
            for (int m = 0; m < 4; ++m) { float* rowp = C + (size_t)(row0 + ai * HALF + m * 16) * ldc + col0;
#pragma unroll
                for (int bj = 0; bj < 2; ++bj)
#pragma unroll
                    for (int n = 0; n < 2; ++n) *(PG8_GAS f32x4*)(rowp + bj * HALF + n * 16) = acc[ai][bj][m][n]; }
    }
};
struct EpiSlab {
    static constexpr bool PERM = false, APERM = false, AFTER_DRAIN = false;
    float* C;
    __device__ __forceinline__ void operator()(const f32x4 (&acc)[2][2][4][2], const Unit& u, int wr, int wc, int fr, int fq) const {
        float* base = C + ((size_t)(u.pm >> 1) * 512 + (u.pm & 1) * 256 + wr * 64 + fr) * 2048 + u.pn * BM + wc * 32 + 4 * fq;
#pragma unroll
        for (int ai = 0; ai < 2; ++ai)
#pragma unroll
            for (int m = 0; m < 4; ++m) { float* rowp = base + (size_t)(ai * HALF + m * 16) * 2048;
#pragma unroll
                for (int bj = 0; bj < 2; ++bj)
#pragma unroll
                    for (int n = 0; n < 2; ++n) *(PG8_GAS f32x4*)(rowp + bj * HALF + n * 16) = acc[ai][bj][m][n]; }
    }
};
template <int MODE> struct EpiB {
    static constexpr bool PERM = true, APERM = false, AFTER_DRAIN = false;
    bf16_t* O; int ldc; const float* scale;
    __device__ __forceinline__ void operator()(const f32x4 (&acc)[2][2][4][2], const Unit& u, int wr, int wc, int fr, int fq) const {
        f32x4 sv[2][2];
        if (MODE == 0) {
#pragma unroll
            for (int bj = 0; bj < 2; ++bj)
#pragma unroll
                for (int n = 0; n < 2; ++n) sv[bj][n] = scale ? *(const PG8_GAS f32x4*)(scale + u.pn * BM + bj * HALF + wc * 32 + 8 * fq + 4 * n) : (f32x4){1.f, 1.f, 1.f, 1.f};
        }
#pragma unroll
        for (int ai = 0; ai < 2; ++ai)
#pragma unroll
            for (int m = 0; m < 4; ++m) {
                const int r = ai * HALF + wr * 64 + m * 16 + fr;
#pragma unroll
                for (int bj = 0; bj < 2; ++bj) {
                    const int c = bj * HALF + wc * 32 + 8 * fq;
                    bf16_t* p;
                    if (MODE == 0) p = O + (size_t)(u.pm * BM + r) * ldc + u.pn * BM + c;
                    else if (MODE == 1) { const int tok = 256 * (u.pm & 1) + r; p = O + (size_t)((tok >> 4) * 256 + (u.pm >> 1) * 16 + (tok & 15)) * 640 + u.pn * BM + c; }
                    else if (MODE == 2) { p = O + (size_t)((r >> 4) * 512 + 16 * u.pm + (r & 15)) * 512 + u.pn * BM + c; }
                    else { const int tok = 256 * (u.pm & 1) + r; p = O + (size_t)(32768 + tok) * 2048 + (u.pm >> 1) * 128 + (c & 127); }
                    if (MODE == 3 && bj != ((u.pm >> 1) & 1)) continue;
                    f32x4 v0 = acc[ai][bj][m][0], v1 = acc[ai][bj][m][1];
                    if (MODE == 0) { v0 = v0 * sv[bj][0]; v1 = v1 * sv[bj][1]; }
                    u32x4 w; w.x = cvt_pk_bf16(v0[0], v0[1]); w.y = cvt_pk_bf16(v0[2], v0[3]); w.z = cvt_pk_bf16(v1[0], v1[1]); w.w = cvt_pk_bf16(v1[2], v1[3]);
                    *(PG8_GAS u32x4*)p = w;
                }
            }
    }
};
struct EpiQRope {
    static constexpr bool PERM = true, APERM = false, AFTER_DRAIN = false;
    bf16_t* O; const float* ctab; const float* stab;
    __device__ __forceinline__ void operator()(const f32x4 (&acc)[2][2][4][2], const Unit& u, int wr, int wc, int fr, int fq) const {
#pragma unroll
        for (int bj = 0; bj < 2; ++bj) {
            const int c = u.pn * BM + bj * HALF + wc * 32 + 8 * fq;
            const int k32 = (u.pn * 8 + bj * 4 + wc) % 6;
            const bool rope = k32 >= 4;
            const int i0 = ((k32 - 4) * 32 + 8 * fq) >> 1;
#pragma unroll
            for (int ai = 0; ai < 2; ++ai)
#pragma unroll
                for (int m = 0; m < 4; ++m) {
                    const int t = u.pm * BM + ai * HALF + wr * 64 + m * 16 + fr;
                    f32x4 v0 = acc[ai][bj][m][0], v1 = acc[ai][bj][m][1];
                    if (rope) {
                        const int pos = t < 32768 ? (t & 4095) : 2048 + ((t - 32768) & 15);
                        const f32x4 cs = *(const PG8_GAS f32x4*)(ctab + pos * 32 + i0), sn = *(const PG8_GAS f32x4*)(stab + pos * 32 + i0);
                        const float a0 = v0[0], b0 = v0[1], a1 = v0[2], b1 = v0[3], a2 = v1[0], b2 = v1[1], a3 = v1[2], b3 = v1[3];
                        v0[0] = a0 * cs[0] - b0 * sn[0]; v0[1] = a0 * sn[0] + b0 * cs[0];
                        v0[2] = a1 * cs[1] - b1 * sn[1]; v0[3] = a1 * sn[1] + b1 * cs[1];
                        v1[0] = a2 * cs[2] - b2 * sn[2]; v1[1] = a2 * sn[2] + b2 * cs[2];
                        v1[2] = a3 * cs[3] - b3 * sn[3]; v1[3] = a3 * sn[3] + b3 * cs[3];
                    }
                    u32x4 w; w.x = cvt_pk_bf16(v0[0], v0[1]); w.y = cvt_pk_bf16(v0[2], v0[3]); w.z = cvt_pk_bf16(v1[0], v1[1]); w.w = cvt_pk_bf16(v1[2], v1[3]);
                    *(PG8_GAS u32x4*)(O + (size_t)t * 3072 + c) = w;
                }
        }
    }
};
template <int CTRL> __device__ __forceinline__ float dppf(float x) { return __builtin_bit_cast(float, __builtin_amdgcn_update_dpp(0, __builtin_bit_cast(int, x), CTRL, 0xf, 0xf, false)); }
__device__ __forceinline__ f32x4 ror1(f32x4 x) { return (f32x4){dppf<0x121>(x[0]), dppf<0x121>(x[1]), dppf<0x121>(x[2]), dppf<0x121>(x[3])}; }
__device__ __forceinline__ f32x4 ror2(f32x4 x) { return (f32x4){dppf<0x122>(x[0]), dppf<0x122>(x[1]), dppf<0x122>(x[2]), dppf<0x122>(x[3])}; }
__device__ __forceinline__ f32x4 sel4(bool c, f32x4 a, f32x4 b) { return (f32x4){c ? a[0] : b[0], c ? a[1] : b[1], c ? a[2] : b[2], c ? a[3] : b[3]}; }
__device__ __forceinline__ float silu_mul(float g, float v) { const float e = __builtin_amdgcn_exp2f(g * -1.4426950408889634f); return g * __builtin_amdgcn_rcpf(1.0f + e) * v; }
template <int CTRL> __device__ __forceinline__ float dpp_old(float old, float x) { return __builtin_bit_cast(float, __builtin_amdgcn_update_dpp(__builtin_bit_cast(int, old), __builtin_bit_cast(int, x), CTRL, 0xf, 0xf, false)); }
__device__ __forceinline__ f32x4 shr1_old(f32x4 old, f32x4 x) { return (f32x4){dpp_old<0x111>(old[0], x[0]), dpp_old<0x111>(old[1], x[1]), dpp_old<0x111>(old[2], x[2]), dpp_old<0x111>(old[3], x[3])}; }
struct EpiUp {
    static constexpr bool PERM = true, APERM = true, AFTER_DRAIN = false;
    bf16_t* act; bf16_t* bnd_first; bf16_t* bnd_last; const float* cw; const float* cb; const float* hist; float* oconv_p; float* oconv_s; const float* rs;
    __device__ __forceinline__ void operator()(const f32x4 (&acc)[2][2][4][2], const Unit& u, int wr, int wc, int fr, int fq) const {
        const bool sample = u.pm >= 128;
        const int colh = wc * 32 + 8 * fq, jg = u.pn * 128 + colh, np = u.pn * 256 + colh;
        u32x2 stash[2][4];
        const f32x4 zero4 = (f32x4){0.f, 0.f, 0.f, 0.f};
#pragma unroll
        for (int n = 0; n < 2; ++n) {
            const int jc = jg + 4 * n;
            const f32x4 w0g = *(const PG8_GAS f32x4*)(cw + jc), w1g = *(const PG8_GAS f32x4*)(cw + 11264 + jc), w2g = *(const PG8_GAS f32x4*)(cw + 2 * 11264 + jc), bg = *(const PG8_GAS f32x4*)(cb + jc);
            const f32x4 w0v = *(const PG8_GAS f32x4*)(cw + 5632 + jc), w1v = *(const PG8_GAS f32x4*)(cw + 11264 + 5632 + jc), w2v = *(const PG8_GAS f32x4*)(cw + 2 * 11264 + 5632 + jc), bv = *(const PG8_GAS f32x4*)(cb + 5632 + jc);
#pragma unroll
            for (int ai = 0; ai < 2; ++ai) {
                const int strip = u.pm * 4 + ai * 2 + wr;
                const f32x4 r4 = *(const PG8_GAS f32x4*)(rs + u.pm * BM + ai * HALF + wr * 64 + 4 * fr);
                const f32x4 xg0 = acc[ai][0][0][n] * r4[0], xg1 = acc[ai][0][1][n] * r4[1], xg2 = acc[ai][0][2][n] * r4[2], xg3 = acc[ai][0][3][n] * r4[3];
                const f32x4 xv0 = acc[ai][1][0][n] * r4[0], xv1 = acc[ai][1][1][n] * r4[1], xv2 = acc[ai][1][2][n] * r4[2], xv3 = acc[ai][1][3][n] * r4[3];
                f32x4 pg3 = shr1_old(zero4, xg3), pg2 = shr1_old(zero4, xg2), pv3 = shr1_old(zero4, xv3), pv2 = shr1_old(zero4, xv2);
                if (sample) {
                    const int sb = (u.pm - 128) * 16 + ai * 8 + wr * 4 + (fr >> 2);
                    if ((fr & 3) == 0) { const float* hp = hist + (size_t)sb * 2 * 11264 + jc;
                        pg2 = *(const PG8_GAS f32x4*)(hp); pg3 = *(const PG8_GAS f32x4*)(hp + 11264); pv2 = *(const PG8_GAS f32x4*)(hp + 5632); pv3 = *(const PG8_GAS f32x4*)(hp + 11264 + 5632); }
                    if ((fr & 3) == 3) { float* op = oconv_s + (size_t)(sb * 2) * 11264 + jc; *(PG8_GAS f32x4*)op = xg2; *(PG8_GAS f32x4*)(op + 5632) = xv2; *(PG8_GAS f32x4*)(op + 11264) = xg3; *(PG8_GAS f32x4*)(op + 11264 + 5632) = xv3; }
                } else {
                    if (fr == 0) { bf16_t* bp = bnd_first + (size_t)(strip * 2) * 11264 + np + 4 * n;
                        u32x2 a; a.x = cvt_pk_bf16(xg0[0], xg0[1]); a.y = cvt_pk_bf16(xg0[2], xg0[3]); *(PG8_GAS u32x2*)bp = a;
                        u32x2 b; b.x = cvt_pk_bf16(xv0[0], xv0[1]); b.y = cvt_pk_bf16(xv0[2], xv0[3]); *(PG8_GAS u32x2*)(bp + 128) = b;
                        u32x2 c; c.x = cvt_pk_bf16(xg1[0], xg1[1]); c.y = cvt_pk_bf16(xg1[2], xg1[3]); *(PG8_GAS u32x2*)(bp + 11264) = c;
                        u32x2 d; d.x = cvt_pk_bf16(xv1[0], xv1[1]); d.y = cvt_pk_bf16(xv1[2], xv1[3]); *(PG8_GAS u32x2*)(bp + 11264 + 128) = d; }
                    if (fr == 15) { bf16_t* bp = bnd_last + (size_t)(strip * 2) * 11264 + np + 4 * n;
                        u32x2 a; a.x = cvt_pk_bf16(xg2[0], xg2[1]); a.y = cvt_pk_bf16(xg2[2], xg2[3]); *(PG8_GAS u32x2*)bp = a;
                        u32x2 b; b.x = cvt_pk_bf16(xv2[0], xv2[1]); b.y = cvt_pk_bf16(xv2[2], xv2[3]); *(PG8_GAS u32x2*)(bp + 128) = b;
                        u32x2 c; c.x = cvt_pk_bf16(xg3[0], xg3[1]); c.y = cvt_pk_bf16(xg3[2], xg3[3]); *(PG8_GAS u32x2*)(bp + 11264) = c;
                        u32x2 d; d.x = cvt_pk_bf16(xv3[0], xv3[1]); d.y = cvt_pk_bf16(xv3[2], xv3[3]); *(PG8_GAS u32x2*)(bp + 11264 + 128) = d;
                        if ((strip & 63) == 63) { float* op = oconv_p + (size_t)((strip >> 6) * 2) * 11264 + jc; *(PG8_GAS f32x4*)op = xg2; *(PG8_GAS f32x4*)(op + 5632) = xv2; *(PG8_GAS f32x4*)(op + 11264) = xg3; *(PG8_GAS f32x4*)(op + 11264 + 5632) = xv3; } }
                }
                const f32x4 cg0 = bg + w0g * pg2 + w1g * pg3 + w2g * xg0, cv0 = bv + w0v * pv2 + w1v * pv3 + w2v * xv0;
                const f32x4 cg1 = bg + w0g * pg3 + w1g * xg0 + w2g * xg1, cv1 = bv + w0v * pv3 + w1v * xv0 + w2v * xv1;
                const f32x4 cg2 = bg + w0g * xg0 + w1g * xg1 + w2g * xg2, cv2 = bv + w0v * xv0 + w1v * xv1 + w2v * xv2;
                const f32x4 cg3 = bg + w0g * xg1 + w1g * xg2 + w2g * xg3, cv3 = bv + w0v * xv1 + w1v * xv2 + w2v * xv3;
                const f32x4 cgs[4] = {cg0, cg1, cg2, cg3}, cvs[4] = {cv0, cv1, cv2, cv3};
#pragma unroll
                for (int m = 0; m < 4; ++m) {
                    u32x2 pk; pk.x = cvt_pk_bf16(silu_mul(cgs[m][0], cvs[m][0]), silu_mul(cgs[m][1], cvs[m][1])); pk.y = cvt_pk_bf16(silu_mul(cgs[m][2], cvs[m][2]), silu_mul(cgs[m][3], cvs[m][3]));
                    if (n == 0) stash[ai][m] = pk;
                    else if (sample || m >= 2 || fr != 0) { const int t = u.pm * BM + ai * HALF + wr * 64 + 4 * fr + m;
                        u32x4 w; w.x = stash[ai][m].x; w.y = stash[ai][m].y; w.z = pk.x; w.w = pk.y; *(PG8_GAS u32x4*)(act + (size_t)t * 5632 + jg) = w; }
                }
            }
        }
    }
};

template <class Epi, class Sched, bool ALIGN_EPI = true>
__device__ __forceinline__ void gemm_phase(PG8_LAS unsigned char* lds, const Sched& S, const Epi& E) {
    int tid_ = threadIdx.x; asm volatile("" : "+v"(tid_));
    const int tid = tid_, wid = __builtin_amdgcn_readfirstlane(tid >> 6), lane = tid & 63, wr = wid >> 2, wc = wid & 3, fr = lane & 15, fq = lane >> 4;
    const int K = S.K, nt = K / BK, lda = S.lda, ldb = S.ldb;
    unsigned voffA[2], voffB[2];
#pragma unroll
    for (int i = 0; i < 2; ++i) { int R, C; stage_rc(tid * 16 + i * 8192, R, C); const int Rb = Epi::PERM ? ((R & ~31) + perm32(R & 31)) : R;
        const int Ra = Epi::APERM ? ((R & ~63) + 4 * (R & 15) + ((R >> 4) & 3)) : R;
        voffA[i] = (unsigned)(Ra * lda + C) * 2u; voffB[i] = (unsigned)(Rb * ldb + C) * 2u; }
    const size_t kstep = (size_t)(BK * 2);
    const size_t hA = (size_t)HALF * lda * 2, hB = (size_t)HALF * ldb * 2;
    const unsigned ldsw = (unsigned)wid * 1024u;
    const int aoff = lds_byte(wr * 64 + fr, fq * 8), boff = lds_byte(wc * 32 + fr, fq * 8);
#define PG8_SA(b, h) (((b) * 2 + (h)) * HTB)
#define PG8_SB(b, h) ((4 + (b) * 2 + (h)) * HTB)
#define PG8_STAGE(bufoff, gbase, voff) do { _Pragma("unroll") for (int _i = 0; _i < 2; ++_i) \
        __builtin_amdgcn_global_load_lds((const unsigned*)((const char*)(gbase) + (voff)[_i]), (PG8_LAS unsigned*)(lds + (bufoff) + ldsw + _i * 8192), 16, 0, 0); } while (0)
#define PG8_LDA(dst, b, h) do { _Pragma("unroll") for (int m = 0; m < 4; ++m) _Pragma("unroll") for (int k = 0; k < 2; ++k) dst[m][k] = *(const PG8_LAS bf16x8*)(lds + PG8_SA(b, h) + aoff + m * 2048 + k * 1024); } while (0)
#define PG8_LDB(dst, b, h) do { _Pragma("unroll") for (int n = 0; n < 2; ++n) _Pragma("unroll") for (int k = 0; k < 2; ++k) dst[n][k] = *(const PG8_LAS bf16x8*)(lds + PG8_SB(b, h) + boff + n * 2048 + k * 1024); } while (0)
#define PG8_MMA(ai, bj, At, Bt) do { __builtin_amdgcn_s_setprio(1); _Pragma("unroll") for (int m = 0; m < 4; ++m) _Pragma("unroll") for (int n = 0; n < 2; ++n) _Pragma("unroll") for (int k = 0; k < 2; ++k) \
        acc[ai][bj][m][n] = __builtin_amdgcn_mfma_f32_16x16x32_bf16(Bt[n][k], At[m][k], acc[ai][bj][m][n], 0, 0, 0); __builtin_amdgcn_s_setprio(0); } while (0)
#define PG8_WAIT_V(n) asm volatile("s_waitcnt vmcnt(" #n ")" ::: "memory")
#define PG8_WAIT_L(n) asm volatile("s_waitcnt lgkmcnt(" #n ")" ::: "memory")
#define PG8_BAR __builtin_amdgcn_s_barrier()
#define PG8_SCHED __builtin_amdgcn_sched_barrier(0)
    Unit cur, nxt; int ui = 0;
    if (!S.next(0, cur)) return;
    f32x4 acc[2][2][4][2];
#pragma unroll
    for (int a = 0; a < 2; ++a)
#pragma unroll
        for (int b = 0; b < 2; ++b)
#pragma unroll
            for (int m = 0; m < 4; ++m)
#pragma unroll
                for (int n = 0; n < 2; ++n) acc[a][b][m][n] = (f32x4){0.f, 0.f, 0.f, 0.f};
    bf16x8 At[4][2], B0[2][2], B1[2][2];
    const char* cA = S.a_ptr(cur); const char* cB = S.b_ptr(cur);
    S.a_ready(cur);
    PG8_STAGE(PG8_SB(0, 0), cB, voffB); PG8_STAGE(PG8_SB(0, 1), cB + hB, voffB); PG8_STAGE(PG8_SA(0, 0), cA, voffA); PG8_STAGE(PG8_SA(0, 1), cA + hA, voffA);
    if (wr == 1) PG8_BAR;
    PG8_WAIT_V(2); PG8_BAR;
    PG8_STAGE(PG8_SB(1, 0), cB + kstep, voffB); PG8_STAGE(PG8_SA(1, 0), cA + kstep, voffA); PG8_STAGE(PG8_SB(1, 1), cB + hB + kstep, voffB);
    PG8_WAIT_V(6); PG8_BAR;
    for (;;) {
        const bool has_next = S.next(ui + 1, nxt);
        const char* nA = has_next ? S.a_ptr(nxt) : cA; const char* nB = has_next ? S.b_ptr(nxt) : cB;
        for (int t = 0; t < nt; t += 2) {
            const bool last = (t == nt - 2);
            const char* a1 = cA + (size_t)(t + 1) * kstep;
            const char* a2 = last ? nA : cA + (size_t)(t + 2) * kstep; const char* b2 = last ? nB : cB + (size_t)(t + 2) * kstep;
            const char* a3 = a2 + kstep; const char* b3 = b2 + kstep;
            if (last && has_next) S.a_ready(nxt);
            PG8_LDB(B0, 0, 0); PG8_LDB(B1, 0, 1); PG8_SCHED; PG8_LDA(At, 0, 0); PG8_STAGE(PG8_SA(1, 1), a1 + hA, voffA);
            PG8_WAIT_V(8); PG8_WAIT_L(0); PG8_BAR; PG8_MMA(0, 0, At, B0); PG8_MMA(0, 1, At, B1); PG8_BAR; PG8_SCHED;
            PG8_LDA(At, 0, 1); PG8_STAGE(PG8_SB(0, 0), b2, voffB); PG8_STAGE(PG8_SB(0, 1), b2 + hB, voffB); PG8_STAGE(PG8_SA(0, 0), a2, voffA);
            PG8_WAIT_V(8); PG8_WAIT_L(0); PG8_BAR; PG8_MMA(1, 0, At, B0); PG8_MMA(1, 1, At, B1); PG8_BAR; PG8_SCHED;
            PG8_LDB(B0, 1, 0); PG8_LDB(B1, 1, 1); PG8_SCHED; PG8_LDA(At, 1, 0); PG8_STAGE(PG8_SA(0, 1), a2 + hA, voffA);
            PG8_WAIT_V(8); PG8_WAIT_L(0); PG8_BAR; PG8_MMA(0, 0, At, B0); PG8_MMA(0, 1, At, B1); PG8_BAR; PG8_SCHED;
            PG8_LDA(At, 1, 1); PG8_STAGE(PG8_SB(1, 0), b3, voffB); PG8_STAGE(PG8_SB(1, 1), b3 + hB, voffB); PG8_STAGE(PG8_SA(1, 0), a3, voffA);
            PG8_WAIT_V(8); PG8_WAIT_L(0); PG8_BAR; PG8_MMA(1, 0, At, B0); PG8_MMA(1, 1, At, B1); PG8_BAR; PG8_SCHED;
        }
        if constexpr (ALIGN_EPI) { if (wr == 0) PG8_BAR; }
        E(acc, cur, wr, wc, fr, fq); S.done(cur);
        if (!has_next) break;
#pragma unroll
        for (int a = 0; a < 2; ++a)
#pragma unroll
            for (int b = 0; b < 2; ++b)
#pragma unroll
                for (int m = 0; m < 4; ++m)
#pragma unroll
                    for (int n = 0; n < 2; ++n) acc[a][b][m][n] = (f32x4){0.f, 0.f, 0.f, 0.f};
        cur = nxt; cA = nA; cB = nB; ++ui;
        if constexpr (ALIGN_EPI) { if (wr == 1) PG8_BAR; }
    }
    PG8_WAIT_V(0);
    if constexpr (!ALIGN_EPI) { if (wr == 0) PG8_BAR; }
    PG8_BAR;
#undef PG8_SA
#undef PG8_SB
#undef PG8_STAGE
#undef PG8_LDA
#undef PG8_LDB
#undef PG8_MMA
#undef PG8_WAIT_V
#undef PG8_WAIT_L
#undef PG8_BAR
#undef PG8_SCHED
}
}
namespace att {
#define ATT_LAS __attribute__((address_space(3)))
typedef unsigned short bf16;
using bf16x8 = __attribute__((ext_vector_type(8))) short;
using s16x4  = __attribute__((ext_vector_type(4))) short;
using f32x16 = __attribute__((ext_vector_type(16))) float;
using u32x4  = __attribute__((ext_vector_type(4))) unsigned;
constexpr int NW = 8, QBLK = 32, KVBLK = 64;
constexpr float SCALE = 0.07216878364870322f;
constexpr float THR = 8.f;
constexpr int LDQ = 3072, LDKV = 4096, LDKR = 64, LDO = 2048;
constexpr int SHM_V = KVBLK * 128 * 2, SHM_K = KVBLK * 192 * 2, SHM_QR0 = 2 * SHM_V + 2 * SHM_K + NW * 64 * 4, SHM_ATTN = SHM_QR0 + NW * 4 * 64 * 16;
#define KSWZ(row, colB) ((row) * 384 + ((colB) ^ (((row) & 7) << 4)))
#define SBAR() __builtin_amdgcn_sched_barrier(0)
__device__ __forceinline__ int crow(int r, int hi) { return (r & 3) + 8 * (r >> 2) + 4 * hi; }
__device__ __forceinline__ unsigned cvtpk(float lo, float hi) { unsigned r; asm volatile("v_cvt_pk_bf16_f32 %0, %1, %2" : "=v"(r) : "v"(lo), "v"(hi)); return r; }
__device__ __forceinline__ __amdgpu_buffer_rsrc_t mk_rsrc(const void* p) {
  const unsigned long a = (unsigned long)p; const unsigned lo = __builtin_amdgcn_readfirstlane((unsigned)a), hi = __builtin_amdgcn_readfirstlane((unsigned)(a >> 32));
  return __builtin_amdgcn_make_buffer_rsrc((void*)(((unsigned long)hi << 32) | lo), (short)0, 0x7fffffff, 0x00020000);
}
__device__ __forceinline__ bf16x8 ld8(const bf16* p) { return *(const __attribute__((address_space(1))) bf16x8*)p; }

__device__ __forceinline__ void partialSM(f32x16& p0, f32x16& p1, float& m_reg, float& mn, float& alpha, bool dead) {
  constexpr float C = SCALE * 1.4426950408889634f;
  if (dead) {
#pragma unroll
    for (int r = 0; r < 16; ++r) { p0[r] = -__builtin_inff(); p1[r] = -__builtin_inff(); }
  }
  float pmax = p0[0];
#pragma unroll
  for (int r = 1; r < 16; ++r) pmax = fmaxf(pmax, p0[r]);
#pragma unroll
  for (int r = 0; r < 16; ++r) pmax = fmaxf(pmax, p1[r]);
  { auto rr = __builtin_amdgcn_permlane32_swap(__float_as_uint(pmax), __float_as_uint(pmax), false, false);
    pmax = fmaxf(__uint_as_float(rr[0]), __uint_as_float(rr[1])); }
  if (__builtin_expect(__all(pmax - m_reg <= THR / SCALE), 1)) { mn = m_reg; alpha = 1.f; }
  else { mn = fmaxf(m_reg, pmax); alpha = __builtin_amdgcn_exp2f((m_reg - mn) * C); m_reg = mn; }
  float mnC = -mn * C;
#pragma unroll
  for (int r = 0; r < 16; ++r) p0[r] = fmaf(p0[r], C, mnC);
#pragma unroll
  for (int r = 0; r < 16; ++r) p1[r] = fmaf(p1[r], C, mnC);
#pragma unroll
  for (int r = 0; r < 16; ++r) p0[r] = __builtin_amdgcn_exp2f(p0[r]);
}
__device__ __forceinline__ void finishSM(f32x16& p0, f32x16& p1, float alpha, float& l_reg, bf16x8& pa0, bf16x8& pa1, bf16x8& pa2, bf16x8& pa3) {
#pragma unroll
  for (int r = 0; r < 16; ++r) p1[r] = __builtin_amdgcn_exp2f(p1[r]);
  float ps = 0;
#pragma unroll
  for (int r = 0; r < 16; ++r) ps += p0[r];
#pragma unroll
  for (int r = 0; r < 16; ++r) ps += p1[r];
  { auto rr = __builtin_amdgcn_permlane32_swap(__float_as_uint(ps), __float_as_uint(ps), false, false);
    ps = __uint_as_float(rr[0]) + __uint_as_float(rr[1]); }
  l_reg = l_reg * alpha + ps;
#define PK4(P, BASE, OUT) do { unsigned a0 = cvtpk(P[BASE + 0], P[BASE + 1]), a1 = cvtpk(P[BASE + 2], P[BASE + 3]);   \
    unsigned b0 = cvtpk(P[BASE + 4], P[BASE + 5]), b1 = cvtpk(P[BASE + 6], P[BASE + 7]);                              \
    auto r0 = __builtin_amdgcn_permlane32_swap(a0, b0, false, false); auto r1 = __builtin_amdgcn_permlane32_swap(a1, b1, false, false); \
    u32x4 w = {r0[0], r1[0], r0[1], r1[1]}; OUT = *reinterpret_cast<bf16x8*>(&w); } while (0)
  PK4(p0, 0, pa0); PK4(p0, 8, pa1); PK4(p1, 0, pa2); PK4(p1, 8, pa3);
#undef PK4
}
__device__ __forceinline__ void qkt(f32x16& p0, f32x16& p1, const ATT_LAS char* Ks, const bf16x8* qr, const ATT_LAS char* qrl, int r32, int hi) {
  p0 = f32x16{}; p1 = f32x16{};
#pragma unroll
  for (int d0 = 0; d0 < 12; ++d0) { const int cb = (d0 * 16 + hi * 8) * 2;
    bf16x8 b0 = *reinterpret_cast<const ATT_LAS bf16x8*>(Ks + KSWZ(r32, cb));
    bf16x8 b1 = *reinterpret_cast<const ATT_LAS bf16x8*>(Ks + KSWZ(32 + r32, cb));
    const bf16x8 q = d0 < 8 ? qr[d0 < 8 ? d0 : 0] : *reinterpret_cast<const ATT_LAS bf16x8*>(qrl + (d0 - 8) * 1024);
    p0 = __builtin_amdgcn_mfma_f32_32x32x16_bf16(b0, q, p0, 0, 0, 0);
    p1 = __builtin_amdgcn_mfma_f32_32x32x16_bf16(b1, q, p1, 0, 0, 0); }
}
__device__ __forceinline__ int v_st(int k, int c) { const int kk = (k & ~0xC) | ((k & 4) << 1) | ((k & 8) >> 1); return ((kk >> 3) * 4 + (c >> 5)) * 512 + ((kk & 7) * 32 + (c & 31)) * 2; }
__device__ __forceinline__ int v_rd_base(int lane) { return ((lane & 3) << 3) | (((lane >> 2) & 3) << 6) | (((lane >> 4) & 1) << 5) | (((lane >> 5) & 1) << 8); }
constexpr int v_rd_off(int d0, int ks, int half) { return d0 * 512 + ks * 4096 + half * 2048; }
template <int OFF> __device__ __forceinline__ s16x4 tr_read(int vb) {
  s16x4 r; asm volatile("ds_read_b64_tr_b16 %0, %1 offset:%2" : "=&v"(r) : "v"(vb), "i"(OFF) : "memory"); return r;
}
template <int D0> __device__ __forceinline__ void pv_one(f32x16& od, int vb, bf16x8 pa0, bf16x8 pa1, bf16x8 pa2, bf16x8 pa3) {
  const s16x4 l0 = tr_read<v_rd_off(D0, 0, 0)>(vb), h0 = tr_read<v_rd_off(D0, 0, 1)>(vb), l1 = tr_read<v_rd_off(D0, 1, 0)>(vb), h1 = tr_read<v_rd_off(D0, 1, 1)>(vb);
  const s16x4 l2 = tr_read<v_rd_off(D0, 2, 0)>(vb), h2 = tr_read<v_rd_off(D0, 2, 1)>(vb), l3 = tr_read<v_rd_off(D0, 3, 0)>(vb), h3 = tr_read<v_rd_off(D0, 3, 1)>(vb);
  asm volatile("s_waitcnt lgkmcnt(0)" ::: "memory"); SBAR();
#define PK(L, H) (bf16x8){L[0], L[1], L[2], L[3], H[0], H[1], H[2], H[3]}
  od = __builtin_amdgcn_mfma_f32_32x32x16_bf16(pa0, PK(l0, h0), od, 0, 0, 0);
  od = __builtin_amdgcn_mfma_f32_32x32x16_bf16(pa1, PK(l1, h1), od, 0, 0, 0);
  od = __builtin_amdgcn_mfma_f32_32x32x16_bf16(pa2, PK(l2, h2), od, 0, 0, 0);
  od = __builtin_amdgcn_mfma_f32_32x32x16_bf16(pa3, PK(l3, h3), od, 0, 0, 0);
#undef PK
}
__device__ __forceinline__ void pv_d0(f32x16* o, int vb, bf16x8 pa0, bf16x8 pa1, bf16x8 pa2, bf16x8 pa3) {
  pv_one<0>(o[0], vb, pa0, pa1, pa2, pa3); pv_one<1>(o[1], vb, pa0, pa1, pa2, pa3); pv_one<2>(o[2], vb, pa0, pa1, pa2, pa3); pv_one<3>(o[3], vb, pa0, pa1, pa2, pa3);
}

__device__ __forceinline__ void attn_unit(const bf16* __restrict__ Qb, const bf16* __restrict__ Kh, const bf16* __restrict__ Vh, const bf16* __restrict__ KRh,
                                          bf16* __restrict__ Ob, int NT, int qb, ATT_LAS char* lds) {
  int tid_ = threadIdx.x; asm volatile("" : "+v"(tid_));
  const int tid = tid_, wid = __builtin_amdgcn_readfirstlane(tid >> 6), lane = tid & 63, r32 = lane & 31, hi = lane >> 5;
  const int lim = 4 * qb + (wid >> 1);
  ATT_LAS char* V_lds = lds; ATT_LAS char* K_lds = lds + 2 * SHM_V;
  ATT_LAS float* ws = (ATT_LAS float*)(lds + 2 * SHM_V + 2 * SHM_K) + wid * 64; ATT_LAS float* li_l = ws; ATT_LAS float* al_l = ws + 32;
  float m_reg = -1e30f, l_reg = 0; f32x16 o[4] = {}; bf16x8 qr[8];
  ATT_LAS char* qrl = lds + SHM_QR0 + wid * 4096 + lane * 16;
  const bf16* Qw = Qb + (long)(wid * QBLK + r32) * LDQ + hi * 8;
#pragma unroll
  for (int d0 = 0; d0 < 8; ++d0) qr[d0] = ld8(Qw + d0 * 16);
#pragma unroll
  for (int d0 = 8; d0 < 12; ++d0) *reinterpret_cast<ATT_LAS bf16x8*>(qrl + (d0 - 8) * 1024) = ld8(Qw + d0 * 16);
  const int sr = tid >> 4, sc = (tid & 15) * 8, vst0 = v_st(sr, sc), vst1 = v_st(32 + sr, sc);
  const int kr_row = tid >> 3, kr_c = (tid & 7) * 8;
  const int vb0 = (int)(unsigned)(unsigned long)V_lds + v_rd_base(lane);
  const __amdgpu_buffer_rsrc_t rsK = mk_rsrc(Kh), rsV = mk_rsrc(Vh), rsR = mk_rsrc(KRh);
  const unsigned vo0 = (unsigned)(sr * LDKV + sc) * 2u, vo1 = (unsigned)((32 + sr) * LDKV + sc) * 2u, vor = (unsigned)(kr_row * LDKR + kr_c) * 2u;
  struct { bf16x8 vs0, vs1, ks0, ks1, kr; } sr_[1];
#define SLOAD(i, k0) do { const int so_ = (k0) * (LDKV * 2), sr2_ = (k0) * (LDKR * 2); \
    sr_[i].vs0 = __builtin_bit_cast(bf16x8, __builtin_amdgcn_raw_buffer_load_b128(rsV, (int)vo0, so_, 0)); sr_[i].vs1 = __builtin_bit_cast(bf16x8, __builtin_amdgcn_raw_buffer_load_b128(rsV, (int)vo1, so_, 0)); \
    sr_[i].ks0 = __builtin_bit_cast(bf16x8, __builtin_amdgcn_raw_buffer_load_b128(rsK, (int)vo0, so_, 0)); sr_[i].ks1 = __builtin_bit_cast(bf16x8, __builtin_amdgcn_raw_buffer_load_b128(rsK, (int)vo1, so_, 0)); \
    sr_[i].kr = __builtin_bit_cast(bf16x8, __builtin_amdgcn_raw_buffer_load_b128(rsR, (int)vor, sr2_, 0)); } while (0)
#define SWRITE(b, i) do { *(ATT_LAS bf16x8*)(V_lds + (b) * SHM_V + vst0) = sr_[i].vs0;          \
    *(ATT_LAS bf16x8*)(V_lds + (b) * SHM_V + vst1) = sr_[i].vs1; const int kc = sc * 2;               \
    *(ATT_LAS bf16x8*)(K_lds + (b) * SHM_K + KSWZ(sr, kc)) = sr_[i].ks0;                       \
    *(ATT_LAS bf16x8*)(K_lds + (b) * SHM_K + KSWZ(32 + sr, kc)) = sr_[i].ks1;                  \
    *(ATT_LAS bf16x8*)(K_lds + (b) * SHM_K + KSWZ(kr_row, 256 + kr_c * 2)) = sr_[i].kr; } while (0)
#define SWAIT() asm volatile("s_waitcnt vmcnt(0)" ::: "memory")
#define RESC(a) do { if (__any((a) < 1.f)) { if (hi == 0) al_l[r32] = (a); asm volatile("s_waitcnt lgkmcnt(0)" ::: "memory"); \
    _Pragma("unroll") for (int d = 0; d < 4; ++d) _Pragma("unroll") for (int r = 0; r < 16; ++r) o[d][r] *= al_l[crow(r, hi)]; } } while (0)
  f32x16 pA0, pA1, pB0, pB1; float mnA, mnB, alA, alB; bf16x8 pa0, pa1, pa2, pa3;
  constexpr int SE = 0, SO = 0;
  SLOAD(SE, 0); asm volatile("s_waitcnt vmcnt(0)" ::: "memory"); SWRITE(0, SE); __syncthreads();
  qkt(pA0, pA1, K_lds, qr, qrl, r32, hi); partialSM(pA0, pA1, m_reg, mnA, alA, false);
  SLOAD(SO, KVBLK);
  SWAIT(); SWRITE(1, SO); __syncthreads();
  for (int j = 1; j + 1 < NT; j += 2) {
    SBAR(); qkt(pB0, pB1, K_lds + SHM_K, qr, qrl, r32, hi);
    finishSM(pA0, pA1, alA, l_reg, pa0, pa1, pa2, pa3); SBAR();
    SLOAD(SO, (j + 1) * KVBLK); SBAR();
    pv_d0(o, vb0, pa0, pa1, pa2, pa3); partialSM(pB0, pB1, m_reg, mnB, alB, j > lim);
    __syncthreads(); SWAIT(); SWRITE(0, SE);
    RESC(alB); __syncthreads();
    SBAR(); qkt(pA0, pA1, K_lds, qr, qrl, r32, hi);
    finishSM(pB0, pB1, alB, l_reg, pa0, pa1, pa2, pa3); SBAR();
    SLOAD(SE, (j + 2) * KVBLK); SBAR();
    pv_d0(o, vb0 + SHM_V, pa0, pa1, pa2, pa3); partialSM(pA0, pA1, m_reg, mnA, alA, j + 1 > lim);
    __syncthreads(); SWAIT(); SWRITE(1, SO);
    RESC(alA); __syncthreads();
  }
  SBAR(); qkt(pB0, pB1, K_lds + SHM_K, qr, qrl, r32, hi);
  finishSM(pA0, pA1, alA, l_reg, pa0, pa1, pa2, pa3); SBAR();
  pv_d0(o, vb0, pa0, pa1, pa2, pa3); partialSM(pB0, pB1, m_reg, mnB, alB, NT - 1 > lim);
  __syncthreads(); RESC(alB);
  finishSM(pB0, pB1, alB, l_reg, pa0, pa1, pa2, pa3); SBAR();
  pv_d0(o, vb0 + SHM_V, pa0, pa1, pa2, pa3);
  if (hi == 0) li_l[r32] = l_reg; asm volatile("s_waitcnt lgkmcnt(0)" ::: "memory");
  float rli[16];
#pragma unroll
  for (int r = 0; r < 16; ++r) rli[r] = __builtin_amdgcn_rcpf(li_l[crow(r, hi)]);
  bf16* Ow = Ob + (long)(wid * QBLK) * LDO;
#pragma unroll
  for (int r = 0; r < 16; ++r) { const int orow = crow(r, hi);
#pragma unroll
    for (int d0 = 0; d0 < 4; ++d0) { const float v = o[d0][r] * rli[r]; unsigned u = __float_as_uint(v); u = (u + 0x7fffu + ((u >> 16) & 1u)) >> 16; ((__attribute__((address_space(1))) bf16*)Ow)[(long)orow * LDO + d0 * 32 + r32] = (bf16)u; } }
  __syncthreads();
#undef SLOAD
#undef SWRITE
#undef SWAIT
#undef RESC
}
#undef KSWZ
#undef SBAR
}
constexpr int NWAVES = 8;
constexpr int TP = 32768, TS = 512, T = TP + TS, DM = 2048, DFF = 5632, NUP = 2 * DFF, SEQ = 4096;
constexpr float EPS = 1e-6f;
static_assert((2048 + 16 - 1) / 64 == 2048 / 64, "all cache keys and new keys of a sample stream lie in chunks <= the query chunk: the chunk mask is all-true for the sample streams");
constexpr size_t O_Y = 0, O_CKV_P = O_Y + (size_t)T * DM, O_KR_P = O_CKV_P + (size_t)2 * TP * 512, O_POOL_P = O_KR_P + (size_t)2 * TP * 64, O_CONV_P = O_POOL_P + (size_t)2 * 8 * 15 * DM,
                 O_CKV_S = O_CONV_P + (size_t)4 * 8 * 2 * NUP, O_KR_S = O_CKV_S + (size_t)2 * TS * 512, O_POOL_S = O_KR_S + (size_t)2 * TS * 64, O_CONV_S = O_POOL_S + (size_t)2 * 32 * 15 * DM,
                 O_END = O_CONV_S + (size_t)4 * 32 * 2 * NUP;
static_assert(O_END == 112558080, "d_out size");
constexpr size_t MiB = 1u << 20;
constexpr size_t WS_CTL = 0, CTL_ZERO_BYTES = 1 * MiB;
constexpr size_t WS_ROPE = 1 * MiB;
constexpr size_t WS_RS = 2 * MiB;
constexpr size_t WS_W = 3 * MiB;
constexpr size_t W_MLA = 24 * MiB;
constexpr size_t WO_DQKV = 0, WO_UQ = 5 * MiB, WO_UKV = 8 * MiB, WO_UK2 = 12 * MiB, WO_O = 16 * MiB;
constexpr size_t WS_WPOOL = WS_W + 2 * W_MLA;
constexpr size_t WS_WFFN = WS_WPOOL + 4 * MiB, WO_UP = 0, WO_DOWN = 44 * MiB;
constexpr size_t WS_HB = WS_WFFN + 66 * MiB;
constexpr size_t WS_MB = WS_HB + 130 * MiB;
constexpr size_t WS_S = WS_MB, WS_P = WS_MB + 72 * MiB;
constexpr size_t WS_BND = WS_MB + 130 * MiB;
constexpr size_t WS_XB = WS_BND + 44 * MiB;
constexpr size_t WS_SLAB = WS_XB + 130 * MiB;
constexpr size_t WS_BIG = WS_SLAB + 44 * MiB;
constexpr size_t WS_ACT = WS_BIG;
constexpr size_t WS_Q = WS_BIG, WS_CQ = WS_BIG + 196 * MiB, WS_CKVB = WS_BIG + 229 * MiB, WS_KRB = WS_BIG + 261 * MiB, WS_KV = WS_BIG + 265 * MiB;
constexpr size_t WS_KALL = WS_KV, WS_VT = WS_KV + 90 * MiB, WS_QLAT = WS_KV + 162 * MiB, WS_OL = WS_KV + 172 * MiB;
constexpr size_t WS_END = WS_KV + 256 * MiB;
static_assert(WS_HB == 121 * MiB && WS_END == 1120 * MiB, "ws map");
static_assert((size_t)T * 1280 * 4 <= 174 * MiB && (size_t)T * 5632 * 2 <= WS_END - WS_BIG && (size_t)T * 3072 * 2 + 4096 <= 196 * MiB && (size_t)11 * 512 * 2048 * 4 <= 44 * MiB, "ws aliases");
constexpr int CW_BAR = 4096;

#define GAS __attribute__((address_space(1)))
#define LAS __attribute__((address_space(3)))
typedef unsigned short bf16;
typedef unsigned v4u __attribute__((ext_vector_type(4)));
typedef unsigned v2u __attribute__((ext_vector_type(2)));
typedef float f32x4 __attribute__((ext_vector_type(4)));
typedef short bf16x8 __attribute__((ext_vector_type(8)));
#define LDS_WAIT() asm volatile("s_waitcnt lgkmcnt(0)" ::: "memory")
#define VM_WAIT() asm volatile("s_waitcnt vmcnt(0)" ::: "memory")
__device__ __forceinline__ unsigned f2bf(float f) { unsigned u = __builtin_bit_cast(unsigned, f); return (u + 0x7fffu + ((u >> 16) & 1u)) >> 16; }
__device__ __forceinline__ unsigned pk2(float lo, float hi) { return f2bf(lo) | (f2bf(hi) << 16); }
__device__ __forceinline__ float bflo(unsigned w) { return __builtin_bit_cast(float, w << 16); }
__device__ __forceinline__ float bfhi(unsigned w) { return __builtin_bit_cast(float, w & 0xffff0000u); }

#define XB_TMO      128
#define XB_XCNT(j)  (256  + 64 * (j))
#define XB_XSUB(j)  (1280 + 64 * (j))
#define XB_XGEN(j)  (2304 + 64 * (j))
#define XB_TOP      3328
#define XB_TOPGEN   3392
#define XCD_BAR_WORDS 3456
#define XB_SPIN_CAP (1u << 18)
__device__ __forceinline__ unsigned xb_ld(unsigned* p)              { return __hip_atomic_load(p, __ATOMIC_RELAXED, __HIP_MEMORY_SCOPE_AGENT); }
__device__ __forceinline__ unsigned xb_add(unsigned* p, unsigned v) { return __hip_atomic_fetch_add(p, v, __ATOMIC_RELAXED, __HIP_MEMORY_SCOPE_AGENT); }
__device__ __forceinline__ unsigned xb_xcc_id() { return (unsigned)__builtin_amdgcn_s_getreg((3 << 11) | 20) & 0xFu; }
#define XB_SPIN(cond, bar) do { unsigned _sp = 0; while (cond) { __builtin_amdgcn_s_sleep(1); \
    if ((++_sp & 255u) == 0u) { if (xb_ld(&(bar)[XB_TMO])) break; if (_sp > XB_SPIN_CAP) { atomicAdd(&(bar)[XB_TMO], 1u); break; } } } } while (0)
struct XcdBarrier { unsigned* bar; unsigned x; volatile LAS unsigned* st; };
__device__ __forceinline__ XcdBarrier xcd_barrier_post(unsigned* bar, volatile LAS unsigned* st) {
    XcdBarrier b; b.bar = bar; b.x = xb_xcc_id(); b.st = st;
    if (threadIdx.x == 0) (void)xb_add(&bar[XB_XCNT(b.x)], 1u);
    return b;
}
__device__ __forceinline__ void xcd_barrier_complete(unsigned* bar, unsigned x, unsigned& nloc, unsigned& nx) {
    const unsigned G = gridDim.x * gridDim.y * gridDim.z;
    unsigned sum, cnt, mine, sp = 0u;
    for (;;) {
        sum = 0u; cnt = 0u; mine = 0u;
#pragma unroll
        for (unsigned j = 0; j < 16; ++j) { const unsigned c = xb_ld(&bar[XB_XCNT(j)]); sum += c; cnt += (c > 0u) ? 1u : 0u; mine = (j == x) ? c : mine; }
        if (sum == G) break;
        __builtin_amdgcn_s_sleep(1);
        if ((++sp & 255u) == 0u) { if (xb_ld(&bar[XB_TMO])) break; if (sp > XB_SPIN_CAP) { atomicAdd(&bar[XB_TMO], 1u); break; } }
    }
    nloc = mine > 0u ? mine : 1u; nx = cnt > 0u ? cnt : 1u;
}
__device__ __forceinline__ void xcd_barrier(const XcdBarrier& b) {
    asm volatile("s_waitcnt vmcnt(0)" ::: "memory");
    __syncthreads();
    if (threadIdx.x == 0) {
        unsigned* bar = b.bar;
        __builtin_amdgcn_s_waitcnt(0);
        unsigned nloc = b.st[0], nx = b.st[1];
        if (nloc == 0u) { xcd_barrier_complete(bar, b.x, nloc, nx); b.st[0] = nloc; b.st[1] = nx; }
        const unsigned old = xb_add(&bar[XB_XSUB(b.x)], 1u);
        const unsigned gen = old / nloc;
        if (old + 1u == (gen + 1u) * nloc) {
            __builtin_amdgcn_fence(__ATOMIC_RELEASE, "agent");
            asm volatile("s_waitcnt vmcnt(0)" ::: "memory");
            const unsigned og = xb_add(&bar[XB_TOP], 1u);
            const unsigned tg = og / nx;
            if (og + 1u == (tg + 1u) * nx) xb_add(&bar[XB_TOPGEN], 1u);
            else XB_SPIN(xb_ld(&bar[XB_TOPGEN]) == tg, bar);
            __builtin_amdgcn_fence(__ATOMIC_ACQUIRE, "agent");
            xb_add(&bar[XB_XGEN(b.x)], 1u);
            asm volatile("s_waitcnt vmcnt(0)" ::: "memory");
        } else {
            XB_SPIN(xb_ld(&bar[XB_XGEN(b.x)]) == gen, bar);
            __builtin_amdgcn_fence(__ATOMIC_ACQUIRE, "agent");
            asm volatile("s_waitcnt vmcnt(0)" ::: "memory");
        }
    }
    __syncthreads();
}

constexpr int RING_OFF = 0, RING_BYTES = 131072;
constexpr int LDSCTL_OFF = RING_BYTES, MISC_OFF = LDSCTL_OFF + 320;
constexpr int LDS_BYTES = 147456;
static_assert(att::SHM_ATTN <= RING_BYTES, "attention scratch fits the ring");

struct Frame {
    LAS unsigned char* lds;
    int tid, lane, wave;
    int vcu, G;
    float* out; unsigned char* ws;
};
constexpr int PTR_OFF = MISC_OFF + 256;
__device__ __forceinline__ const float* inp(const Frame& F, int i) {
    int off = PTR_OFF + 8 * i; asm volatile("" : "+s"(off));
    const unsigned long long v = *(const LAS unsigned long long*)(F.lds + off);
    const unsigned lo = __builtin_amdgcn_readfirstlane((unsigned)v), hi = __builtin_amdgcn_readfirstlane((unsigned)(v >> 32));
    return (const float*)(((unsigned long long)hi << 32) | lo);
}
__device__ __forceinline__ void frame_lanes(Frame& F) {
    int t = threadIdx.x; asm volatile("" : "+v"(t)); F.tid = t; F.lane = t & 63; F.wave = __builtin_amdgcn_readfirstlane(t >> 6);
    unsigned long long w = (unsigned long long)F.ws, o = (unsigned long long)F.out; unsigned l = (unsigned)(unsigned long long)F.lds; int g = F.G, v = F.vcu;
    asm volatile("" : "+s"(w), "+s"(o), "+s"(l), "+s"(g), "+s"(v));
    F.ws = (unsigned char*)w; F.out = (float*)o; F.lds = (LAS unsigned char*)(unsigned long long)l; F.G = g; F.vcu = v;
}
__device__ __forceinline__ float shx(float v, int o, int lane) { return __builtin_bit_cast(float, __builtin_amdgcn_ds_bpermute((lane ^ o) << 2, __builtin_bit_cast(int, v))); }
__device__ __forceinline__ float wave_sum(float v, int lane) {
#pragma unroll
    for (int o = 1; o < 64; o <<= 1) v += shx(v, o, lane);
    return v;
}
__device__ __forceinline__ float wave_max(float v, int lane) {
#pragma unroll
    for (int o = 1; o < 64; o <<= 1) v = fmaxf(v, shx(v, o, lane));
    return v;
}

__device__ __forceinline__ int dest_row(int map, int row_off, int n) {
    if (map == 1) { return n < DFF ? ((n >> 7) * 256 + (n & 127)) : (((n - DFF) >> 7) * 256 + 128 + ((n - DFF) & 127)); }
    if (map == 2) { const int h = n / 192, d = n - h * 192; if (d < 128) return n; const int i = d - 128; return h * 192 + 128 + (i < 32 ? 2 * i : 2 * (i - 32) + 1); }
    return row_off + n;
}
struct TrJob { const float* W; int ldw; bf16* WT; int ldt, map, row_off; const float* ks; bf16* RM; int ldr; int k0, n0; };
__device__ __forceinline__ void tr_load(const TrJob& J, int lane, f32x4 (&v)[8]) {
#pragma unroll
    for (int i = 0; i < 8; ++i) { const int kk = 8 * i + (lane >> 3), c4 = (lane & 7) * 4; v[i] = *(const GAS f32x4*)(J.W + (size_t)(J.k0 + kk) * J.ldw + J.n0 + c4);
        if (J.ks) v[i] = v[i] * ((const GAS float*)J.ks)[J.k0 + kk]; }
}
__device__ __forceinline__ void tr_finish(const TrJob& J, const f32x4 (&v)[8], LAS float* scr, int lane) {
#pragma unroll
    for (int i = 0; i < 8; ++i) { const int kk = 8 * i + (lane >> 3), c4 = (lane & 7) * 4; LAS float* d = scr + kk * 33 + c4; d[0] = v[i].x; d[1] = v[i].y; d[2] = v[i].z; d[3] = v[i].w; }
    LDS_WAIT(); asm volatile("" ::: "memory");
    const int c = lane & 7;
#pragma unroll
    for (int j = 0; j < 4; ++j) { const int n = (lane >> 3) + 8 * j; const LAS float* p = scr + (8 * c) * 33 + n;
        v4u o; o.x = pk2(p[0 * 33], p[1 * 33]); o.y = pk2(p[2 * 33], p[3 * 33]); o.z = pk2(p[4 * 33], p[5 * 33]); o.w = pk2(p[6 * 33], p[7 * 33]);
        *(GAS v4u*)(J.WT + (size_t)dest_row(J.map, J.row_off, J.n0 + n) * J.ldt + J.k0 + 8 * c) = o; }
    if (J.RM) {
        const LAS float* p = scr + lane * 33;
#pragma unroll
        for (int q = 0; q < 4; ++q) { v4u o; o.x = pk2(p[8 * q], p[8 * q + 1]); o.y = pk2(p[8 * q + 2], p[8 * q + 3]); o.z = pk2(p[8 * q + 4], p[8 * q + 5]); o.w = pk2(p[8 * q + 6], p[8 * q + 7]);
            *(GAS v4u*)(J.RM + (size_t)(J.k0 + lane) * J.ldr + J.n0 + 8 * q) = o; }
    }
    LDS_WAIT(); asm volatile("" ::: "memory");
}
#define TR_LOOP(NITEMS, JOBEXPR) do { for (int it_ = gw; it_ < (NITEMS); it_ += 2 * NGW) { \
        f32x4 va_[8], vb_[8]; const int itb_ = it_ + NGW; const bool hb_ = itb_ < (NITEMS); \
        int it = it_; const TrJob ja_ = (JOBEXPR); it = hb_ ? itb_ : it_; const TrJob jb_ = (JOBEXPR); \
        tr_load(ja_, lane, va_); if (hb_) tr_load(jb_, lane, vb_); \
        tr_finish(ja_, va_, scr, lane); if (hb_) tr_finish(jb_, vb_, scr, lane); } } while (0)

constexpr int P0_I_DQ = 32 * 16, P0_I_DKV = 32 * 18, P0_I_UQ = 8 * 96, P0_I_UK = 8 * 64, P0_I_UV = 8 * 64, P0_I_O = 32 * 64, P0_I_MLA = P0_I_DQ + P0_I_DKV + P0_I_UQ + P0_I_UK + P0_I_UV + P0_I_O, P0_I_POOL = 4 * 8 * 16;
__device__ __forceinline__ TrJob p0_job(Frame& F, int it) {
    TrJob J; J.ks = nullptr; J.RM = nullptr; J.ldr = 0; J.map = 0; J.row_off = 0; int nnb, r;
    if (it < 2 * P0_I_MLA) {
        const int j = it / P0_I_MLA; r = it - j * P0_I_MLA; unsigned char* wb = F.ws + WS_W + j * W_MLA;
        if (r < P0_I_DQ) { J.W = inp(F, 7) + (size_t)j * 2048 * 512; J.ldw = 512; J.WT = (bf16*)(wb + WO_DQKV); J.ldt = 2048; nnb = 16; J.ks = inp(F, 6) + (size_t)(2 * j) * 4 * DM; }
        else if ((r -= P0_I_DQ) < P0_I_DKV) { J.W = inp(F, 10) + (size_t)j * 2048 * 576; J.ldw = 576; J.WT = (bf16*)(wb + WO_DQKV); J.ldt = 2048; nnb = 18; J.row_off = 512; J.ks = inp(F, 6) + (size_t)(2 * j) * 4 * DM; }
        else if ((r -= P0_I_DKV) < P0_I_UQ) { J.W = inp(F, 9) + (size_t)j * 512 * 3072; J.ldw = 3072; J.WT = (bf16*)(wb + WO_UQ); J.ldt = 512; nnb = 96; J.map = 2; }
        else if ((r -= P0_I_UQ) < P0_I_UK) { J.W = inp(F, 12) + (size_t)j * 512 * 2048; J.ldw = 2048; J.WT = (bf16*)(wb + WO_UKV); J.ldt = 512; nnb = 64; }
        else if ((r -= P0_I_UK) < P0_I_UV) { J.W = inp(F, 13) + (size_t)j * 512 * 2048; J.ldw = 2048; J.WT = (bf16*)(wb + WO_UKV); J.ldt = 512; nnb = 64; J.row_off = 2048; }
        else { r -= P0_I_UV; J.W = inp(F, 14) + (size_t)j * 2048 * 2048; J.ldw = 2048; J.WT = (bf16*)(wb + WO_O); J.ldt = 2048; nnb = 64; }
    } else {
        r = it - 2 * P0_I_MLA; const int jg = r / (8 * 16); r -= jg * (8 * 16);
        J.W = inp(F, 15) + (size_t)jg * 512 * 512; J.ldw = 512; J.WT = (bf16*)(F.ws + WS_WPOOL + (size_t)(jg >> 2) * 2 * MiB); J.ldt = 512; nnb = 16; J.row_off = (jg & 3) * 512;
    }
    J.k0 = 64 * (r / nnb); J.n0 = 32 * (r % nnb); return J;
}
__device__ __forceinline__ void p0_prologue(Frame& F) {
    frame_lanes(F);
    LAS float* scr = (LAS float*)(F.lds + RING_OFF + F.wave * 16384);
    const int gw = F.vcu * NWAVES + F.wave, NGW = F.G * NWAVES;
    {
        float* ct = (float*)(F.ws + WS_ROPE); float* st = ct + 4096 * 32;
        for (int idx = (F.vcu * NWAVES + F.wave) * 64 + F.lane; idx < 4096 * 32; idx += NGW * 64) {
            const int pos = idx >> 5, i = idx & 31;
            double inv = 1.0; for (int k = 0; k < i; ++k) inv *= 0.7498942093324558273;
            double a = (double)pos * inv;
            const double twopi = 6.283185307179586476925287; a -= twopi * __builtin_rint(a / twopi);
            const double x = a * 0.125, x2 = x * x;
            double s = x * (1.0 + x2 * (-1.0 / 6 + x2 * (1.0 / 120 + x2 * (-1.0 / 5040 + x2 * (1.0 / 362880 + x2 * (-1.0 / 39916800))))));
            double c = 1.0 + x2 * (-0.5 + x2 * (1.0 / 24 + x2 * (-1.0 / 720 + x2 * (1.0 / 40320 + x2 * (-1.0 / 3628800 + x2 * (1.0 / 479001600))))));
#pragma unroll
            for (int k = 0; k < 3; ++k) { const double s2 = 2.0 * s * c, c2 = 1.0 - 2.0 * s * s; s = s2; c = c2; }
            ((GAS float*)ct)[idx] = (float)c; ((GAS float*)st)[idx] = (float)s;
        }
    }
    constexpr int NITEMS = 2 * P0_I_MLA + 2 * P0_I_POOL;
    { const int lane = F.lane; TR_LOOP(NITEMS, p0_job(F, it)); }
    for (int row = gw; row < 2 * 8192; row += NGW) {
        const int j = row >> 13, hc = row & 8191, h = hc >> 9, c = hc & 511;
        const GAS float* src = (const GAS float*)(inp(F, 12) + (size_t)j * 512 * 2048 + (size_t)c * 2048 + h * 128 + 2 * F.lane);
        GAS unsigned* dst = (GAS unsigned*)((unsigned*)(F.ws + WS_W + j * W_MLA + WO_UK2) + (size_t)hc * 128);
        dst[F.lane] = pk2(src[0], src[1]); dst[64 + F.lane] = 0u;
    }
}

__device__ __forceinline__ TrJob ffn_job(Frame& F, int it, const float* wu, const float* wd, const float* g2) {
    constexpr int I_UP = 32 * 352; TrJob J; J.RM = nullptr; J.ldr = 0; J.row_off = 0;
    if (it < I_UP) { J.W = wu; J.ldw = NUP; J.WT = (bf16*)(F.ws + WS_WFFN + WO_UP); J.ldt = 2048; J.map = 1; J.ks = g2; J.k0 = 64 * (it / 352); J.n0 = 32 * (it % 352); }
    else { const int r = it - I_UP; J.W = wd; J.ldw = 2048; J.WT = (bf16*)(F.ws + WS_WFFN + WO_DOWN); J.ldt = DFF; J.map = 0; J.ks = nullptr; J.k0 = 64 * (r / 64); J.n0 = 32 * (r % 64); }
    return J;
}
__device__ __forceinline__ void convert_ffn(Frame& F, int L) {
    LAS float* scr = (LAS float*)(F.lds + RING_OFF + F.wave * 16384);
    const int gw = F.vcu * NWAVES + F.wave, NGW = F.G * NWAVES;
    constexpr int I_UP = 32 * 352, I_DN = 88 * 64;
    const float* wu = inp(F, 17) + (size_t)L * 2048 * NUP; const float* wd = inp(F, 20) + (size_t)L * DFF * 2048; const float* g2 = inp(F, 6) + (size_t)(L * 4 + 2) * DM;
    const int lane = F.lane;
    TR_LOOP(I_UP + I_DN, ffn_job(F, it, wu, wd, g2));
}
__device__ __forceinline__ void norm0_phase(Frame& F) {
    frame_lanes(F);
    const int gw = F.vcu * NWAVES + F.wave, NGW = F.G * NWAVES;
    const float* xp = inp(F, 0); const float* xs = inp(F, 1);
    bf16* XB = (bf16*)(F.ws + WS_XB); float* RS = (float*)(F.ws + WS_RS);
    f32x4 nx[8];
#pragma unroll
    for (int j = 0; j < 8; ++j) nx[j] = (f32x4){0.f, 0.f, 0.f, 0.f};
    if (gw < T) { const float* xin = gw < TP ? xp + (size_t)gw * DM : xs + (size_t)(gw - TP) * DM;
#pragma unroll
        for (int j = 0; j < 8; ++j) nx[j] = *(const GAS f32x4*)(xin + (F.lane + 64 * j) * 4); }
    for (int row = gw; row < T; row += NGW) {
        f32x4 x[8]; float s2 = 0.f;
#pragma unroll
        for (int j = 0; j < 8; ++j) x[j] = nx[j];
        { const int nrow = row + NGW;
          if (nrow < T) { const float* xin = nrow < TP ? xp + (size_t)nrow * DM : xs + (size_t)(nrow - TP) * DM;
#pragma unroll
              for (int j = 0; j < 8; ++j) nx[j] = *(const GAS f32x4*)(xin + (F.lane + 64 * j) * 4); } }
#pragma unroll
        for (int j = 0; j < 8; ++j) s2 += (x[j].x * x[j].x + x[j].y * x[j].y) + (x[j].z * x[j].z + x[j].w * x[j].w);
        const float r2 = 1.0f / sqrtf(wave_sum(s2, F.lane) * (1.0f / DM) + EPS);
#pragma unroll
        for (int j = 0; j < 8; ++j) { v2u w; w.x = pk2(x[j].x, x[j].y); w.y = pk2(x[j].z, x[j].w); *(GAS v2u*)(XB + (size_t)row * DM + (F.lane + 64 * j) * 4) = w; }
        if (F.lane == 0) ((GAS float*)RS)[row] = r2;
    }
}
template <bool LAST, bool POOLST>
__device__ __forceinline__ void norm_phase(Frame& F, const bf16* mres, const float* slab, int ns, const float* g_post, const float* g_pre, float* pool_p, float* pool_s, bool poison, bool dry = false) {
    frame_lanes(F);
    const int gw = F.vcu * NWAVES + F.wave, NGW = F.G * NWAVES;
    bf16* XB = (bf16*)(F.ws + WS_XB); bf16* XBo = dry ? (bf16*)(F.ws + WS_BIG) : XB;
    float* RS = (float*)(F.ws + WS_RS);
    f32x4 gp[8];
#pragma unroll
    for (int j = 0; j < 8; ++j) gp[j] = *(const GAS f32x4*)(g_post + (F.lane + 64 * j) * 4);
    v2u nx[8], nm[8];
#pragma unroll
    for (int j = 0; j < 8; ++j) { nx[j] = (v2u){0u, 0u}; nm[j] = (v2u){0u, 0u}; }
    if (gw < T) {
#pragma unroll
        for (int j = 0; j < 8; ++j) { nx[j] = *(const GAS v2u*)(XB + (size_t)gw * DM + (F.lane + 64 * j) * 4); nm[j] = *(const GAS v2u*)(mres + (size_t)gw * DM + (F.lane + 64 * j) * 4); } }
    for (int row = gw; row < T; row += NGW) {
        f32x4 x[8], mv[8]; v2u cm[8];
#pragma unroll
        for (int j = 0; j < 8; ++j) { x[j] = (f32x4){bflo(nx[j].x), bfhi(nx[j].x), bflo(nx[j].y), bfhi(nx[j].y)}; cm[j] = nm[j]; }
        { const int nrow = row + NGW;
          if (nrow < T) {
#pragma unroll
              for (int j = 0; j < 8; ++j) { nx[j] = *(const GAS v2u*)(XB + (size_t)nrow * DM + (F.lane + 64 * j) * 4); nm[j] = *(const GAS v2u*)(mres + (size_t)nrow * DM + (F.lane + 64 * j) * 4); } } }
        if (ns > 0 && row >= TP) {
#pragma unroll
            for (int j = 0; j < 8; ++j) mv[j] = (f32x4){0.f, 0.f, 0.f, 0.f};
            for (int k = 0; k < ns; ++k) {
#pragma unroll
                for (int j = 0; j < 8; ++j) mv[j] = mv[j] + *(const GAS f32x4*)(slab + ((size_t)k * TS + (row - TP)) * DM + (F.lane + 64 * j) * 4); }
        } else {
#pragma unroll
            for (int j = 0; j < 8; ++j) mv[j] = (f32x4){bflo(cm[j].x), bfhi(cm[j].x), bflo(cm[j].y), bfhi(cm[j].y)}; }
        float ss = 0.f;
#pragma unroll
        for (int j = 0; j < 8; ++j) ss += (mv[j].x * mv[j].x + mv[j].y * mv[j].y) + (mv[j].z * mv[j].z + mv[j].w * mv[j].w);
        const float r1 = 1.0f / sqrtf(wave_sum(ss, F.lane) * (1.0f / DM) + EPS);
#pragma unroll
        for (int j = 0; j < 8; ++j) x[j] = x[j] + mv[j] * r1 * gp[j];
        if (LAST) {
            if (poison) {
#pragma unroll
                for (int j = 0; j < 8; ++j) x[j] = x[j] * __builtin_nanf("");
            }
#pragma unroll
            for (int j = 0; j < 8; ++j) *(GAS f32x4*)(F.out + (size_t)row * DM + (F.lane + 64 * j) * 4) = x[j];
        } else {
#pragma unroll
            for (int j = 0; j < 8; ++j) { v2u w; w.x = pk2(x[j].x, x[j].y); w.y = pk2(x[j].z, x[j].w); *(GAS v2u*)(XBo + (size_t)row * DM + (F.lane + 64 * j) * 4) = w; }
            float s2 = 0.f;
#pragma unroll
            for (int j = 0; j < 8; ++j) s2 += (x[j].x * x[j].x + x[j].y * x[j].y) + (x[j].z * x[j].z + x[j].w * x[j].w);
            const float r2 = 1.0f / sqrtf(wave_sum(s2, F.lane) * (1.0f / DM) + EPS);
            if (F.lane == 0) ((GAS float*)RS)[row] = r2;
            if (POOLST) {
                float* ps = nullptr;
                if (row < TP) { const int s = row & (SEQ - 1); if (s >= SEQ - 15) ps = pool_p + ((size_t)(row >> 12) * 15 + (s - (SEQ - 15))) * DM; }
                else { const int qi = (row - TP) & 15; if (qi >= 1) ps = pool_s + ((size_t)((row - TP) >> 4) * 15 + (qi - 1)) * DM; }
                if (ps) {
#pragma unroll
                    for (int j = 0; j < 8; ++j) { const int c = (F.lane + 64 * j) * 4; *(GAS f32x4*)(ps + c) = x[j] * r2 * *(const GAS f32x4*)(g_pre + c); } }
            }
        }
    }
}

__device__ __forceinline__ TrJob vt_job(const float* cck, bf16* VT, bf16* KALL, int it) {
    const int b = it >> 9, r = it & 511; TrJob J; J.W = cck + (size_t)b * 2048 * 512; J.ldw = 512; J.WT = VT + (size_t)b * 512 * 2304; J.ldt = 2304; J.map = 0; J.row_off = 0; J.ks = nullptr;
    J.RM = KALL + (size_t)b * 2304 * 640; J.ldr = 640; J.k0 = 64 * (r >> 4); J.n0 = 32 * (r & 15); return J;
}
__device__ __forceinline__ void s1_phase(Frame& F, int j) {
    frame_lanes(F);
    const int gw = F.vcu * NWAVES + F.wave, NGW = F.G * NWAVES, lane = F.lane;
    const float* raw = (const float*)(F.ws + WS_MB);
    const float* qn = inp(F, 8) + j * 512; const float* kn = inp(F, 11) + j * 512;
    const float* ct = (const float*)(F.ws + WS_ROPE); const float* st = ct + 4096 * 32;
    bf16* CQ = (bf16*)(F.ws + WS_CQ); bf16* CKVB = (bf16*)(F.ws + WS_CKVB); bf16* KRB = (bf16*)(F.ws + WS_KRB);
    bf16* KALL = (bf16*)(F.ws + WS_KALL); bf16* VT = (bf16*)(F.ws + WS_VT);
    f32x4 gqn[2], gkn[2];
#pragma unroll
    for (int i = 0; i < 2; ++i) { gqn[i] = *(const GAS f32x4*)(qn + (lane + 64 * i) * 4); gkn[i] = *(const GAS f32x4*)(kn + (lane + 64 * i) * 4); }
    f32x4 na[2], nb[2]; float nkv = 0.f, nrs = 0.f;
#pragma unroll
    for (int i = 0; i < 2; ++i) { na[i] = (f32x4){0.f, 0.f, 0.f, 0.f}; nb[i] = na[i]; }
    if (gw < T) { const float* rr = raw + (size_t)gw * 1280;
#pragma unroll
        for (int i = 0; i < 2; ++i) { na[i] = *(const GAS f32x4*)(rr + (lane + 64 * i) * 4); nb[i] = *(const GAS f32x4*)(rr + 512 + (lane + 64 * i) * 4); }
        nkv = ((const GAS float*)rr)[1024 + lane]; nrs = ((const GAS float*)(F.ws + WS_RS))[gw]; }
    for (int row = gw; row < T; row += NGW) {
        f32x4 a[2], b[2]; float ssa = 0.f, ssb = 0.f;
        const float rs_row = nrs;
#pragma unroll
        for (int i = 0; i < 2; ++i) { a[i] = na[i] * rs_row; b[i] = nb[i] * rs_row;
            ssa += (a[i].x * a[i].x + a[i].y * a[i].y) + (a[i].z * a[i].z + a[i].w * a[i].w); ssb += (b[i].x * b[i].x + b[i].y * b[i].y) + (b[i].z * b[i].z + b[i].w * b[i].w); }
        const float kv = nkv * rs_row;
        { const int nrow = row + NGW;
          if (nrow < T) { const float* rn = raw + (size_t)nrow * 1280;
#pragma unroll
              for (int i = 0; i < 2; ++i) { na[i] = *(const GAS f32x4*)(rn + (lane + 64 * i) * 4); nb[i] = *(const GAS f32x4*)(rn + 512 + (lane + 64 * i) * 4); }
              nkv = ((const GAS float*)rn)[1024 + lane]; nrs = ((const GAS float*)(F.ws + WS_RS))[nrow]; } }
        const float ra = 1.0f / sqrtf(wave_sum(ssa, lane) * (1.0f / 512) + EPS), rb = 1.0f / sqrtf(wave_sum(ssb, lane) * (1.0f / 512) + EPS);
        const bool prompt = row < TP;
        const int sb = (row - TP) >> 4, qi = (row - TP) & 15;
        const int pos = prompt ? (row & (SEQ - 1)) : 2048 + qi;
        float* o_ckv = prompt ? F.out + O_CKV_P + ((size_t)j * TP + row) * 512 : F.out + O_CKV_S + ((size_t)j * TS + (row - TP)) * 512;
        float* o_kr = prompt ? F.out + O_KR_P + ((size_t)j * TP + row) * 64 : F.out + O_KR_S + ((size_t)j * TS + (row - TP)) * 64;
#pragma unroll
        for (int i = 0; i < 2; ++i) {
            const int c = (lane + 64 * i) * 4;
            const f32x4 q = a[i] * ra * gqn[i]; v2u w; w.x = pk2(q.x, q.y); w.y = pk2(q.z, q.w); *(GAS v2u*)(CQ + (size_t)row * 512 + c) = w;
            const f32x4 k = b[i] * rb * gkn[i]; *(GAS f32x4*)(o_ckv + c) = k; v2u wk; wk.x = pk2(k.x, k.y); wk.y = pk2(k.z, k.w);
            if (prompt) *(GAS v2u*)(CKVB + (size_t)row * 512 + c) = wk;
            else { *(GAS v2u*)(KALL + ((size_t)sb * 2304 + 2048 + qi) * 640 + c) = wk;
                GAS bf16* vt = (GAS bf16*)(VT + ((size_t)sb * 512 + c) * 2304 + 2048 + qi); vt[0] = (bf16)(wk.x & 0xffff); vt[2304] = (bf16)(wk.x >> 16); vt[2 * 2304] = (bf16)(wk.y & 0xffff); vt[3 * 2304] = (bf16)(wk.y >> 16); }
        }
        const float other = shx(kv, 32, lane); const int i5 = lane & 31; const float cs = ((const GAS float*)ct)[pos * 32 + i5], sn = ((const GAS float*)st)[pos * 32 + i5];
        const float rot = lane < 32 ? kv * cs - other * sn : other * sn + kv * cs;
        ((GAS float*)o_kr)[lane] = rot;
        const float rot_hi = shx(rot, 32, lane);
        if (lane < 32) { const unsigned w = pk2(rot, rot_hi);
            if (prompt) ((GAS unsigned*)(KRB + (size_t)row * 64))[lane] = w; else ((GAS unsigned*)(KALL + ((size_t)sb * 2304 + 2048 + qi) * 640 + 512))[lane] = w; }
        else if (!prompt) ((GAS unsigned*)(KALL + ((size_t)sb * 2304 + 2048 + qi) * 640 + 576))[lane - 32] = 0u;
    }
    const float* cck = inp(F, 2) + (size_t)j * 32 * 2048 * 512; const float* ckr = inp(F, 3) + (size_t)j * 32 * 2048 * 64;
    { const int tg = (F.vcu * NWAVES + F.wave) * 64 + lane, NT_ = F.G * NWAVES * 64;
#pragma unroll 4
      for (int idx = tg; idx < 32 * 2048 * 32; idx += NT_) {
          const int rowc = idx >> 5, i = idx & 31, b = rowc >> 11, key = rowc & 2047;
          const GAS float* src = (const GAS float*)ckr + (size_t)rowc * 64;
          GAS unsigned* dst = (GAS unsigned*)(KALL + ((size_t)b * 2304 + key) * 640);
          dst[256 + i] = pk2(src[i], src[i + 32]); dst[288 + i] = 0u; }
      for (int idx = tg; idx < 32 * 240 * 320; idx += NT_) { const int rz = idx / 320, w = idx - rz * 320, b = rz / 240, key = 2064 + (rz - b * 240);
          ((GAS unsigned*)(KALL + ((size_t)b * 2304 + key) * 640))[w] = 0u; }
    }
    { LAS float* scr = (LAS float*)(F.lds + RING_OFF + F.wave * 16384);
      TR_LOOP(32 * 512, vt_job(cck, VT, KALL, it));
      for (int r = gw; r < 32 * 512; r += NGW) { GAS unsigned* dst = (GAS unsigned*)(VT + (size_t)r * 2304 + 2064); dst[lane] = 0u; if (lane < 56) dst[64 + lane] = 0u; }
    }
}

__device__ __forceinline__ void qlat_rope_copy(Frame& F) {
    frame_lanes(F);
    const bf16* Q = (const bf16*)(F.ws + WS_Q); bf16* QL = (bf16*)(F.ws + WS_QLAT);
    for (int idx = (F.vcu * NWAVES + F.wave) * 64 + F.lane; idx < 8192 * 16; idx += F.G * NWAVES * 64) {
        const int row = idx >> 4, ch = idx & 15, b = row >> 8, h = (row >> 4) & 15, qi = row & 15;
        v4u v = (v4u){0u, 0u, 0u, 0u};
        if (ch < 8) v = *(const GAS v4u*)(Q + (size_t)(TP + b * 16 + qi) * 3072 + h * 192 + 128 + ch * 8);
        *(GAS v4u*)(QL + (size_t)row * 640 + 512 + ch * 8) = v;
    }
}

__device__ __forceinline__ void softmax_phase(Frame& F) {
    frame_lanes(F);
    const float* S = (const float*)(F.ws + WS_S); bf16* P = (bf16*)(F.ws + WS_P);
    const int gw = F.vcu * NWAVES + F.wave, NGW = F.G * NWAVES, lane = F.lane;
    constexpr float C = att::SCALE * 1.4426950408889634f;
    for (int row = gw; row < 8192; row += NGW) {
        f32x4 v[9]; float mx = -1e30f;
#pragma unroll
        for (int j = 0; j < 9; ++j) { const int c = lane * 4 + 256 * j; v[j] = *(const GAS f32x4*)(S + (size_t)row * 2304 + c);
            if (c >= 2064) v[j] = (f32x4){-1e30f, -1e30f, -1e30f, -1e30f};
            mx = fmaxf(mx, fmaxf(fmaxf(v[j].x, v[j].y), fmaxf(v[j].z, v[j].w))); }
        mx = wave_max(mx, lane); float sum = 0.f;
#pragma unroll
        for (int j = 0; j < 9; ++j) { const int c = lane * 4 + 256 * j;
            v[j].x = __builtin_amdgcn_exp2f((v[j].x - mx) * C); v[j].y = __builtin_amdgcn_exp2f((v[j].y - mx) * C); v[j].z = __builtin_amdgcn_exp2f((v[j].z - mx) * C); v[j].w = __builtin_amdgcn_exp2f((v[j].w - mx) * C);
            if (c >= 2064) v[j] = (f32x4){0.f, 0.f, 0.f, 0.f};
            sum += (v[j].x + v[j].y) + (v[j].z + v[j].w); }
        const float inv = 1.0f / wave_sum(sum, lane);
#pragma unroll
        for (int j = 0; j < 9; ++j) { const int c = lane * 4 + 256 * j; v2u w; w.x = pk2(v[j].x * inv, v[j].y * inv); w.y = pk2(v[j].z * inv, v[j].w * inv); *(GAS v2u*)(P + (size_t)row * 2304 + c) = w; }
    }
}

template <int G> __device__ __forceinline__ void pool_group_prompt(const bf16* X, const GAS float* RS, bf16* Dd, const float* g0, int t0, int s0, int lane) {
    constexpr int W = 2 << G, H = W - 1;
    const int c = G * 512 + lane * 8;
    const bool hv = s0 > 0;
    const int rrow = t0 - 15 + lane; const float rsv = (lane < 31 && rrow >= 0) ? RS[rrow] : 0.f;
    v4u x[H + 16];
#pragma unroll
    for (int r = 0; r < H + 16; ++r) { x[r] = (v4u){0u, 0u, 0u, 0u}; if (r >= H || hv) x[r] = *(const GAS v4u*)(X + (size_t)(t0 - H + r) * DM + c); }
    const f32x4 ga = *(const GAS f32x4*)(g0 + c), gb = *(const GAS f32x4*)(g0 + c + 4);
    float S[8];
#pragma unroll
    for (int e = 0; e < 8; ++e) S[e] = 0.f;
#define PD_ROWF(v, rs, f) do { f[0] = bflo(v.x) * rs; f[1] = bfhi(v.x) * rs; f[2] = bflo(v.y) * rs; f[3] = bfhi(v.y) * rs; f[4] = bflo(v.z) * rs; f[5] = bfhi(v.z) * rs; f[6] = bflo(v.w) * rs; f[7] = bfhi(v.w) * rs; } while (0)
#pragma unroll
    for (int r = 0; r < H; ++r) { const float rs = __builtin_bit_cast(float, __builtin_amdgcn_readlane(__builtin_bit_cast(int, rsv), 15 - H + r)); float f[8]; PD_ROWF(x[r], rs, f);
#pragma unroll
        for (int e = 0; e < 8; ++e) S[e] += f[e]; }
#pragma unroll
    for (int i = 0; i < 16; ++i) {
        const float rs = __builtin_bit_cast(float, __builtin_amdgcn_readlane(__builtin_bit_cast(int, rsv), 15 + i)); float f[8]; PD_ROWF(x[H + i], rs, f);
#pragma unroll
        for (int e = 0; e < 8; ++e) S[e] += f[e];
        const int s = s0 + i; const float ic = 1.0f / (float)((s + 1) < W ? (s + 1) : W);
        v4u o; o.x = pk2((S[0] * ic - f[0]) * ga.x, (S[1] * ic - f[1]) * ga.y); o.y = pk2((S[2] * ic - f[2]) * ga.z, (S[3] * ic - f[3]) * ga.w);
        o.z = pk2((S[4] * ic - f[4]) * gb.x, (S[5] * ic - f[5]) * gb.y); o.w = pk2((S[6] * ic - f[6]) * gb.z, (S[7] * ic - f[7]) * gb.w);
        *(GAS v4u*)(Dd + (size_t)(t0 + i) * DM + c) = o;
        { const float rl = __builtin_bit_cast(float, __builtin_amdgcn_readlane(__builtin_bit_cast(int, rsv), 15 - H + i)); float fl[8]; PD_ROWF(x[i], rl, fl);
#pragma unroll
          for (int e = 0; e < 8; ++e) S[e] -= fl[e]; }
    }
#undef PD_ROWF
}
__device__ __forceinline__ void pool_d_phase(Frame& F, int j, const float* g0) {
    frame_lanes(F);
    const bf16* X = (const bf16*)(F.ws + WS_XB); bf16* Dd = (bf16*)(F.ws + WS_ACT); const GAS float* RS = (const GAS float*)(F.ws + WS_RS);
    const float* hist = inp(F, 4) + (size_t)j * 32 * 15 * DM;
    const int gw = F.vcu * NWAVES + F.wave, NGW = F.G * NWAVES, lane = F.lane;
    for (int ch = gw; ch < TP / 16; ch += NGW) {
        const int t0 = ch * 16, s0 = t0 & (SEQ - 1);
        pool_group_prompt<0>(X, RS, Dd, g0, t0, s0, lane); pool_group_prompt<1>(X, RS, Dd, g0, t0, s0, lane);
        pool_group_prompt<2>(X, RS, Dd, g0, t0, s0, lane); pool_group_prompt<3>(X, RS, Dd, g0, t0, s0, lane);
    }
    for (int row = TP + gw; row < T; row += NGW) {
        const int s = (row - TP) & 15; const int sb = (row - TP) >> 4;
#pragma unroll
        for (int g = 0; g < 4; ++g) {
            const int w = 2 << g, c = g * 512 + lane * 8;
            const f32x4 ga = *(const GAS f32x4*)(g0 + c), gb = *(const GAS f32x4*)(g0 + c + 4);
            const float gg[8] = {ga.x, ga.y, ga.z, ga.w, gb.x, gb.y, gb.z, gb.w};
            float acc[8], self[8];
#pragma unroll
            for (int e = 0; e < 8; ++e) { acc[e] = 0.f; self[e] = 0.f; }
            for (int k = 0; k < w; ++k) {
                const int sk = s - k;
                if (sk >= 0) { const v4u v = *(const GAS v4u*)(X + (size_t)(row - k) * DM + c); const float r = RS[row - k];
                    const float f[8] = {bflo(v.x), bfhi(v.x), bflo(v.y), bfhi(v.y), bflo(v.z), bfhi(v.z), bflo(v.w), bfhi(v.w)};
#pragma unroll
                    for (int e = 0; e < 8; ++e) { const float hv = f[e] * r * gg[e]; acc[e] += hv; if (k == 0) self[e] = hv; } }
                else { const float* hp = hist + ((size_t)sb * 15 + (15 + sk)) * DM + c; const f32x4 u0 = *(const GAS f32x4*)hp, u1 = *(const GAS f32x4*)(hp + 4);
                    acc[0] += u0.x; acc[1] += u0.y; acc[2] += u0.z; acc[3] += u0.w; acc[4] += u1.x; acc[5] += u1.y; acc[6] += u1.z; acc[7] += u1.w; }
            }
            const float ic = 1.0f / (float)w;
            v4u o; o.x = pk2(acc[0] * ic - self[0], acc[1] * ic - self[1]); o.y = pk2(acc[2] * ic - self[2], acc[3] * ic - self[3]);
            o.z = pk2(acc[4] * ic - self[4], acc[5] * ic - self[5]); o.w = pk2(acc[6] * ic - self[6], acc[7] * ic - self[7]);
            *(GAS v4u*)(Dd + (size_t)row * DM + c) = o;
        }
    }
}

__device__ __forceinline__ void fix_phase(Frame& F, int L) {
    frame_lanes(F);
    const bf16* BF = (const bf16*)(F.ws + WS_BND); const bf16* BL = BF + (size_t)512 * 2 * NUP;
    const float* cw = inp(F, 18) + (size_t)L * 3 * NUP; const float* cb = inp(F, 19) + (size_t)L * NUP;
    bf16* act = (bf16*)(F.ws + WS_ACT);
    for (int idx = (F.vcu * NWAVES + F.wave) * 64 + F.lane; idx < 512 * 2 * 704; idx += F.G * NWAVES * 64) {
        const int cc = idx % 704, sj = idx / 704, s = sj >> 1, jr = sj & 1;
        const int jg = cc * 8, np = (jg >> 7) * 256 + (jg & 127);
        const bool seq0 = (s & 63) == 0;
        float u0[2][8], u1[2][8], u2[2][8];
#pragma unroll
        for (int gv = 0; gv < 2; ++gv) {
            const v4u zero = (v4u){0u, 0u, 0u, 0u};
            const v4u cur = *(const GAS v4u*)(BF + (size_t)(s * 2 + jr) * NUP + np + gv * 128);
            const v4u f0 = *(const GAS v4u*)(BF + (size_t)(s * 2) * NUP + np + gv * 128);
            const v4u l0 = seq0 ? zero : *(const GAS v4u*)(BL + (size_t)((s - 1) * 2) * NUP + np + gv * 128);
            const v4u l1 = seq0 ? zero : *(const GAS v4u*)(BL + (size_t)((s - 1) * 2 + 1) * NUP + np + gv * 128);
            const v4u p1 = jr ? f0 : l1, p2 = jr ? l1 : l0;
            const unsigned cu[4] = {cur.x, cur.y, cur.z, cur.w}, a1[4] = {p1.x, p1.y, p1.z, p1.w}, a2[4] = {p2.x, p2.y, p2.z, p2.w};
#pragma unroll
            for (int e = 0; e < 4; ++e) { u0[gv][2 * e] = bflo(cu[e]); u0[gv][2 * e + 1] = bfhi(cu[e]); u1[gv][2 * e] = bflo(a1[e]); u1[gv][2 * e + 1] = bfhi(a1[e]); u2[gv][2 * e] = bflo(a2[e]); u2[gv][2 * e + 1] = bfhi(a2[e]); }
        }
        float r[8];
#pragma unroll
        for (int e = 0; e < 8; ++e) {
            const int cg = jg + e, cv = DFF + jg + e;
            const GAS float* cwg = (const GAS float*)cw; const GAS float* cbg = (const GAS float*)cb;
            const float g = cbg[cg] + cwg[cg] * u2[0][e] + cwg[NUP + cg] * u1[0][e] + cwg[2 * NUP + cg] * u0[0][e];
            const float v = cbg[cv] + cwg[cv] * u2[1][e] + cwg[NUP + cv] * u1[1][e] + cwg[2 * NUP + cv] * u0[1][e];
            r[e] = pg8::silu_mul(g, v);
        }
        v4u o; o.x = pk2(r[0], r[1]); o.y = pk2(r[2], r[3]); o.z = pk2(r[4], r[5]); o.w = pk2(r[6], r[7]);
        *(GAS v4u*)(act + (size_t)(s * 64 + jr) * DFF + jg) = o;
    }
}

__device__ __forceinline__ void attn_phase(Frame& F) {
    frame_lanes(F);
    const bf16* Q = (const bf16*)(F.ws + WS_Q); const bf16* KV = (const bf16*)(F.ws + WS_KV); const bf16* KRB = (const bf16*)(F.ws + WS_KRB); bf16* O = (bf16*)(F.ws + WS_HB);
    for (int pi = F.vcu; pi < 1024; pi += F.G) {
        const int bh = pi >> 3, s = pi & 7, b = bh >> 4, h = bh & 15;
#pragma unroll 1
        for (int half = 0; half < 2; ++half) {
            const int qb = half ? 15 - s : s;
            const size_t row0 = (size_t)b * SEQ;
            att::attn_unit(Q + (row0 + 256 * qb) * 3072 + h * 192, KV + row0 * 4096 + h * 128, KV + row0 * 4096 + 2048 + h * 128, KRB + row0 * 64,
                           O + (row0 + 256 * qb) * DM + h * 128, 4 * qb + 4, qb, (ATT_LAS char*)(F.lds + RING_OFF));
        }
    }
}

struct Args { const float* in[21]; float* out; unsigned char* ws; int ph_lo, ph_hi; };
constexpr int NPH = 1 + 4 * 16;
#ifndef PG8_ALIGN
#define PG8_ALIGN true
#endif
__global__ void __launch_bounds__(NWAVES * 64, 2) fwd_kernel(Args args) {
    extern __shared__ __attribute__((aligned(16))) unsigned char lds[];
    Frame F;
    F.lds = (LAS unsigned char*)lds;
    F.tid = threadIdx.x; F.lane = F.tid & 63; F.wave = __builtin_amdgcn_readfirstlane(F.tid >> 6);
    F.G = gridDim.x; { const int bx = blockIdx.x; F.vcu = (F.G % 8 == 0) ? (bx % 8) * (F.G / 8) + bx / 8 : bx; }
    F.out = args.out; F.ws = args.ws;
    unsigned* ctl = (unsigned*)(F.ws + WS_CTL);
    for (int u = F.tid; u < (LDS_BYTES - LDSCTL_OFF) / 4; u += NWAVES * 64) ((LAS unsigned*)(F.lds + LDSCTL_OFF))[u] = 0u;
    __syncthreads();
    if (F.tid == 0) {
#pragma unroll
        for (int i = 0; i < 21; ++i) ((LAS unsigned long long*)(F.lds + PTR_OFF))[i] = (unsigned long long)args.in[i];
    }
    __syncthreads();
    const int lo = args.ph_lo, hi = args.ph_hi;
    const bool one_launch = (hi - lo) > 1;
    XcdBarrier bar; bar.bar = ctl + CW_BAR; bar.x = 0; bar.st = nullptr;
    if (one_launch) bar = xcd_barrier_post(ctl + CW_BAR, (volatile LAS unsigned*)(F.lds + MISC_OFF) + 8);
#ifndef PH_MASK
#define PH_MASK 0x1ffffu
#endif
#define IN(k) (lo <= (k) && (k) < hi)
#define EN(p) (((PH_MASK) >> (p)) & 1u)
#ifndef DBL_MASK
#define DBL_MASK 0u
#endif
#define REPS(p) ((int)(((DBL_MASK) >> (p)) & 1u) + 1)
#define SEAM(k) do { if (IN((k) + 1)) { xcd_barrier(bar); if (REPS(17) > 1) xcd_barrier(bar); } } while (0)
    const int bid = (int)blockIdx.x;

    if (EN(16) && IN(0)) { for (int rep_ = 0; rep_ < REPS(16); ++rep_) { if (rep_) xcd_barrier(bar); p0_prologue(F); convert_ffn(F, 0); norm0_phase(F); } SEAM(0); }

    for (int L = 0; L < 4; ++L) {
        const int base = 1 + 16 * L, j = L >> 1;
        const float* ng = inp(F, 6) + (size_t)L * 4 * DM;
        if ((L & 1) == 0) {
            unsigned char* wb = F.ws + WS_W + j * W_MLA;
            if (EN(0) && IN(base + 0)) { for (int rep_ = 0; rep_ < REPS(0); ++rep_) { if (rep_) xcd_barrier(bar); frame_lanes(F); LAS unsigned char* ring = F.lds + RING_OFF;  pg8::SchedPlain S; S.init(130, 5, F.G, bid); S.A = (const char*)(F.ws + WS_XB); S.B = (const char*)(wb + WO_DQKV); S.lda = 2048; S.ldb = 2048; S.K = 2048;
                pg8::EpiF32 E{(float*)(F.ws + WS_MB), 1280}; pg8::gemm_phase<pg8::EpiF32, pg8::SchedPlain, PG8_ALIGN>(ring, S, E);  } SEAM(base + 0); }
            if (EN(1) && IN(base + 1)) { for (int rep_ = 0; rep_ < REPS(1); ++rep_) { if (rep_) xcd_barrier(bar); frame_lanes(F); LAS unsigned char* ring = F.lds + RING_OFF;  s1_phase(F, j);  } SEAM(base + 1); }
            if (EN(2) && IN(base + 2)) { for (int rep_ = 0; rep_ < REPS(2); ++rep_) { if (rep_) xcd_barrier(bar); frame_lanes(F); LAS unsigned char* ring = F.lds + RING_OFF;  pg8::SchedPlain S; S.init(130, 12, F.G, bid); S.A = (const char*)(F.ws + WS_CQ); S.B = (const char*)(wb + WO_UQ); S.lda = 512; S.ldb = 512; S.K = 512;
                pg8::EpiQRope E{(bf16*)(F.ws + WS_Q), (const float*)(F.ws + WS_ROPE), (const float*)(F.ws + WS_ROPE) + 4096 * 32};
                pg8::gemm_phase<pg8::EpiQRope, pg8::SchedPlain, PG8_ALIGN>(ring, S, E);  } SEAM(base + 2); }
            if (EN(3) && IN(base + 3)) { for (int rep_ = 0; rep_ < REPS(3); ++rep_) { if (rep_) xcd_barrier(bar); frame_lanes(F); LAS unsigned char* ring = F.lds + RING_OFF;  qlat_rope_copy(F);
                pg8::SchedQlat S; S.init(32, 2, F.G, bid); S.A = (const char*)(F.ws + WS_Q) + (size_t)TP * 3072 * 2; S.B = (const char*)(wb + WO_UK2); S.lda = 3072; S.ldb = 256; S.K = 256;
                pg8::EpiB<1> E{(bf16*)(F.ws + WS_QLAT), 640, nullptr}; pg8::gemm_phase<pg8::EpiB<1>, pg8::SchedQlat, PG8_ALIGN>(ring, S, E);  } SEAM(base + 3); }
            if (EN(4) && IN(base + 4)) { for (int rep_ = 0; rep_ < REPS(4); ++rep_) { if (rep_) xcd_barrier(bar); frame_lanes(F); LAS unsigned char* ring = F.lds + RING_OFF;  pg8::SchedBatch S; S.init(32, 9, F.G, bid); S.A = (const char*)(F.ws + WS_QLAT); S.B = (const char*)(F.ws + WS_KALL); S.lda = 640; S.ldb = 640; S.K = 640; S.b_pm = (size_t)2304 * 640 * 2;
                pg8::EpiF32 E{(float*)(F.ws + WS_S), 2304}; pg8::gemm_phase<pg8::EpiF32, pg8::SchedBatch, PG8_ALIGN>(ring, S, E);  } SEAM(base + 4); }
            if (EN(5) && IN(base + 5)) { for (int rep_ = 0; rep_ < REPS(5); ++rep_) { if (rep_) xcd_barrier(bar); frame_lanes(F); LAS unsigned char* ring = F.lds + RING_OFF;  softmax_phase(F);  } SEAM(base + 5); }
            if (EN(6) && IN(base + 6)) { for (int rep_ = 0; rep_ < REPS(6); ++rep_) { if (rep_) xcd_barrier(bar); frame_lanes(F); LAS unsigned char* ring = F.lds + RING_OFF;  pg8::SchedBatch S; S.init(32, 2, F.G, bid); S.A = (const char*)(F.ws + WS_P); S.B = (const char*)(F.ws + WS_VT); S.lda = 2304; S.ldb = 2304; S.K = 2304; S.b_pm = (size_t)512 * 2304 * 2;
                pg8::EpiB<2> E{(bf16*)(F.ws + WS_OL), 512, nullptr}; pg8::gemm_phase<pg8::EpiB<2>, pg8::SchedBatch, PG8_ALIGN>(ring, S, E);  } SEAM(base + 6); }
            if (EN(7) && IN(base + 7)) { for (int rep_ = 0; rep_ < REPS(7); ++rep_) { if (rep_) xcd_barrier(bar); frame_lanes(F); LAS unsigned char* ring = F.lds + RING_OFF;  pg8::SchedOV S; S.init(32, 1, F.G, bid); S.A = (const char*)(F.ws + WS_OL); S.B = (const char*)(wb + WO_UKV) + (size_t)2048 * 512 * 2; S.lda = 512; S.ldb = 512; S.K = 512;
                pg8::EpiB<3> E{(bf16*)(F.ws + WS_HB), 2048, nullptr}; pg8::gemm_phase<pg8::EpiB<3>, pg8::SchedOV, PG8_ALIGN>(ring, S, E);  } SEAM(base + 7); }
            if (EN(8) && IN(base + 8)) { for (int rep_ = 0; rep_ < REPS(8); ++rep_) { if (rep_) xcd_barrier(bar); frame_lanes(F); LAS unsigned char* ring = F.lds + RING_OFF;  pg8::SchedPlain S; S.init(128, 16, F.G, bid); S.A = (const char*)(F.ws + WS_CKVB); S.B = (const char*)(wb + WO_UKV); S.lda = 512; S.ldb = 512; S.K = 512;
                pg8::EpiB<0> E{(bf16*)(F.ws + WS_KV), 4096, nullptr}; pg8::gemm_phase<pg8::EpiB<0>, pg8::SchedPlain, PG8_ALIGN>(ring, S, E);  } SEAM(base + 8); }
            if (EN(9) && IN(base + 9)) { for (int rep_ = 0; rep_ < REPS(9); ++rep_) { if (rep_) xcd_barrier(bar); frame_lanes(F); LAS unsigned char* ring = F.lds + RING_OFF;  attn_phase(F);  } SEAM(base + 9); }
            if (EN(10) && IN(base + 10)) { for (int rep_ = 0; rep_ < REPS(10); ++rep_) { if (rep_) xcd_barrier(bar); frame_lanes(F); LAS unsigned char* ring = F.lds + RING_OFF;  pg8::SchedPlain S; S.init(128, 8, F.G, bid); S.A = (const char*)(F.ws + WS_HB); S.B = (const char*)(wb + WO_O); S.lda = 2048; S.ldb = 2048; S.K = 2048;
                pg8::EpiB<0> E{(bf16*)(F.ws + WS_MB), 2048, nullptr}; pg8::gemm_phase<pg8::EpiB<0>, pg8::SchedPlain, PG8_ALIGN>(ring, S, E);
                { pg8::SchedSplit S2; S2.init(2 * 4, 8, F.G, bid); S2.A = (const char*)(F.ws + WS_HB) + (size_t)TP * 2048 * 2; S2.B = (const char*)(wb + WO_O); S2.lda = 2048; S2.ldb = 2048; S2.K = 512;
                  pg8::EpiSlab E2{(float*)(F.ws + WS_SLAB)}; pg8::gemm_phase<pg8::EpiSlab, pg8::SchedSplit, PG8_ALIGN>(ring, S2, E2); }  } SEAM(base + 10); }
        } else {
            if (EN(9) && IN(base + 9)) { for (int rep_ = 0; rep_ < REPS(18); ++rep_) { if (rep_) xcd_barrier(bar); frame_lanes(F); LAS unsigned char* ring = F.lds + RING_OFF;  pool_d_phase(F, j, ng);  } SEAM(base + 9); }
            if (EN(10) && IN(base + 10)) { for (int rep_ = 0; rep_ < REPS(10); ++rep_) { if (rep_) xcd_barrier(bar); frame_lanes(F); LAS unsigned char* ring = F.lds + RING_OFF;  pg8::SchedPool S; S.init(130, 8, F.G, bid); S.A = (const char*)(F.ws + WS_ACT); S.B = (const char*)(F.ws + WS_WPOOL + (size_t)j * 2 * MiB); S.lda = 2048; S.ldb = 512; S.K = 512;
                pg8::EpiB<0> E{(bf16*)(F.ws + WS_MB), 2048, inp(F, 16) + (size_t)j * DM}; pg8::gemm_phase<pg8::EpiB<0>, pg8::SchedPool, PG8_ALIGN>(ring, S, E);  } SEAM(base + 10); }
        }
        unsigned char* wf = F.ws + WS_WFFN;
        if (EN(11) && IN(base + 11)) { for (int rep_ = 0; rep_ < REPS(11); ++rep_) { if (rep_) xcd_barrier(bar); frame_lanes(F); LAS unsigned char* ring = F.lds + RING_OFF;  const int nsb = (L & 1) ? 0 : 4; const bool dry = rep_ + 1 < REPS(11); norm_phase<false, false>(F, (const bf16*)(F.ws + WS_MB), (const float*)(F.ws + WS_SLAB), nsb, ng + DM, nullptr, nullptr, nullptr, false, dry);  } SEAM(base + 11); }
        if (EN(12) && IN(base + 12)) { for (int rep_ = 0; rep_ < REPS(12); ++rep_) { if (rep_) xcd_barrier(bar); frame_lanes(F); LAS unsigned char* ring = F.lds + RING_OFF;  pg8::SchedPlain S; S.init(130, 44, F.G, bid); S.A = (const char*)(F.ws + WS_XB); S.B = (const char*)(wf + WO_UP); S.lda = 2048; S.ldb = 2048; S.K = 2048;
            pg8::EpiUp E{(bf16*)(F.ws + WS_ACT), (bf16*)(F.ws + WS_BND), (bf16*)(F.ws + WS_BND) + (size_t)512 * 2 * NUP, inp(F, 18) + (size_t)L * 3 * NUP, inp(F, 19) + (size_t)L * NUP,
                         inp(F, 5) + (size_t)L * 32 * 2 * NUP, F.out + O_CONV_P + (size_t)L * 8 * 2 * NUP, F.out + O_CONV_S + (size_t)L * 32 * 2 * NUP, (const float*)(F.ws + WS_RS)};
            pg8::gemm_phase<pg8::EpiUp, pg8::SchedPlain, PG8_ALIGN>(ring, S, E);  } SEAM(base + 12); }
        if (EN(13) && IN(base + 13)) { for (int rep_ = 0; rep_ < REPS(13); ++rep_) { if (rep_) xcd_barrier(bar); frame_lanes(F); LAS unsigned char* ring = F.lds + RING_OFF;  fix_phase(F, L);  } SEAM(base + 13); }
        if (EN(14) && IN(base + 14)) { for (int rep_ = 0; rep_ < REPS(14); ++rep_) { if (rep_) xcd_barrier(bar); frame_lanes(F); LAS unsigned char* ring = F.lds + RING_OFF;  pg8::SchedPlain S; S.init(128, 8, F.G, bid); S.A = (const char*)(F.ws + WS_ACT); S.B = (const char*)(wf + WO_DOWN); S.lda = DFF; S.ldb = DFF; S.K = DFF;
            pg8::EpiB<0> E{(bf16*)(F.ws + WS_MB), 2048, nullptr}; pg8::gemm_phase<pg8::EpiB<0>, pg8::SchedPlain, PG8_ALIGN>(ring, S, E);
            { pg8::SchedSplit S2; S2.init(2 * 11, 8, F.G, bid); S2.A = (const char*)(F.ws + WS_ACT) + (size_t)TP * DFF * 2; S2.B = (const char*)(wf + WO_DOWN); S2.lda = DFF; S2.ldb = DFF; S2.K = 512;
              pg8::EpiSlab E2{(float*)(F.ws + WS_SLAB)}; pg8::gemm_phase<pg8::EpiSlab, pg8::SchedSplit, PG8_ALIGN>(ring, S2, E2); }  } SEAM(base + 14); }
        if (EN(15) && IN(base + 15)) {
            const bool poison = one_launch && xb_ld(ctl + CW_BAR + XB_TMO) != 0u;
            frame_lanes(F);
            if (L < 3) convert_ffn(F, L + 1);
            const float* slab = (const float*)(F.ws + WS_SLAB);
            if (L == 3) norm_phase<true, false>(F, (const bf16*)(F.ws + WS_MB), slab, 11, ng + 3 * DM, nullptr, nullptr, nullptr, poison);
            else if ((L & 1) == 0) norm_phase<false, true>(F, (const bf16*)(F.ws + WS_MB), slab, 11, ng + 3 * DM, ng + 4 * DM, F.out + O_POOL_P + (size_t)j * 8 * 15 * DM, F.out + O_POOL_S + (size_t)j * 32 * 15 * DM, false);
            else norm_phase<false, false>(F, (const bf16*)(F.ws + WS_MB), slab, 11, ng + 3 * DM, nullptr, nullptr, nullptr, false);
            if (L < 3) SEAM(base + 15);
        }
    }
#undef IN
#undef SEAM
}

#ifndef MK_PER_PHASE
#define MK_PER_PHASE 0
#endif
extern "C" void kernel_launch(void* const* d_in, const int* in_sizes, int n_in, void* d_out, int out_size, void* d_ws, size_t ws_size, hipStream_t stream) {
    static int grid = 0;
    if (grid == 0) {
        if (n_in != 21 || (size_t)out_size != O_END || ws_size < WS_END) { fprintf(stderr, "kernel_launch: unexpected problem shape (n_in %d, out %d, ws %zu < %zu); nothing launched\n", n_in, out_size, ws_size, (size_t)WS_END); grid = -1; return; }
        int dev = 0, cus = 0, per_cu = 0;
        if (hipGetDevice(&dev) != hipSuccess || hipDeviceGetAttribute(&cus, hipDeviceAttributeMultiprocessorCount, dev) != hipSuccess) { grid = -1; return; }
        if (hipFuncSetAttribute((const void*)fwd_kernel, hipFuncAttributeMaxDynamicSharedMemorySize, LDS_BYTES) != hipSuccess) { fprintf(stderr, "kernel_launch: hipFuncSetAttribute failed\n"); grid = -1; return; }
        if (hipOccupancyMaxActiveBlocksPerMultiprocessor(&per_cu, (const void*)fwd_kernel, NWAVES * 64, LDS_BYTES) != hipSuccess || per_cu < 1) { fprintf(stderr, "kernel_launch: occupancy query says %d blocks per CU\n", per_cu); }
        (void)hipGetLastError();
        grid = cus;
    }
    if (grid < 0) return;
    (void)hipMemsetAsync((char*)d_ws + WS_CTL, 0, CTL_ZERO_BYTES, stream);
    Args a{};
    for (int i = 0; i < 21; ++i) a.in[i] = (const float*)d_in[i];
    a.out = (float*)d_out; a.ws = (unsigned char*)d_ws;
#if MK_PER_PHASE
    for (int p = 0; p < NPH; ++p) {
        if (p >= 1) { const int L = (p - 1) >> 4, q = (p - 1) & 15; if ((L & 1) && q < 9) continue; }
        a.ph_lo = p; a.ph_hi = p + 1;
        hipLaunchKernelGGL(fwd_kernel, dim3(grid), dim3(NWAVES * 64), LDS_BYTES, stream, a);
    }
#else
    a.ph_lo = 0; a.ph_hi = NPH;
    hipLaunchKernelGGL(fwd_kernel, dim3(grid), dim3(NWAVES * 64), LDS_BYTES, stream, a);
#endif
}
```

```cpp
#define DBL_MASK 0u
#ifndef MK_PER_PHASE
#define MK_PER_PHASE 0
#endif
#include <hip/hip_runtime.h>
#include <cstdio>
#include <cstdint>
namespace pg8 {
#define PG8_LAS __attribute__((address_space(3)))
#define PG8_GAS __attribute__((address_space(1)))
typedef unsigned short bf16_t;
typedef short bf16x8 __attribute__((ext_vector_type(8)));
typedef float f32x4 __attribute__((ext_vector_type(4)));
typedef unsigned u32x4 __attribute__((ext_vector_type(4)));
typedef unsigned u32x2 __attribute__((ext_vector_type(2)));
constexpr int BM = 256, BK = 64, HALF = 128, HTB = HALF * BK * 2  , STAGE_BYTES = 8 * HTB, NXCD = 8, WGM = 8;

__host__ __device__ __forceinline__ int lds_byte(int r, int c) { const int st = (r >> 4) * 2 + (c >> 5), rr = r & 15, cc = c & 31, ob = rr * 64 + cc * 2; return st * 1024 + (ob ^ (((ob >> 9) & 1) << 5)); }
__host__ __device__ __forceinline__ void stage_rc(int b, int& R, int& C) { const int st = b / 1024, sb = b % 1024, swz = sb ^ (((sb >> 9) & 1) << 5); R = (st >> 1) * 16 + swz / 64; C = (st & 1) * 32 + (swz % 64) / 2; }
__host__ __device__ __forceinline__ int perm32(int rho) { const int n = rho >> 4, i = rho & 15; return 8 * (i >> 2) + 4 * n + (i & 3); }

struct Unit { int pm, pn; };

struct OrderBase {
    int nM, nN, nwg, G, c;
    __device__ __forceinline__ void init(int nM_, int nN_, int G_, int c_) { nM = nM_; nN = nN_; nwg = nM * nN; G = G_; c = c_; }
    __device__ __forceinline__ bool next(int i, Unit& u) const {
        const long L = (long)i * G + c; if (L >= nwg) return false;
        int wgid = (int)L; { const int q = nwg / NXCD, r = nwg % NXCD, xcd = wgid % NXCD, off = wgid / NXCD; wgid = (xcd < r ? xcd * (q + 1) : r * (q + 1) + (xcd - r) * q) + off; }
        const int nig = WGM * nN, gid = wgid / nig, fm = gid * WGM, gsz = (nM - fm) < WGM ? (nM - fm) : WGM;
        u.pm = fm + ((wgid % nig) % gsz); u.pn = (wgid % nig) / gsz; return true;
    }
    __device__ __forceinline__ void a_ready(const Unit&) const {}
    __device__ __forceinline__ void done(const Unit&) const {}
};
struct SchedPlain : OrderBase {
    const char* A; const char* B; int lda, ldb, K;
    __device__ __forceinline__ const char* a_ptr(const Unit& u) const { return A + (size_t)u.pm * 256 * lda * 2; }
    __device__ __forceinline__ const char* b_ptr(const Unit& u) const { return B + (size_t)u.pn * 256 * ldb * 2; }
};
struct SchedPlainOff : OrderBase {
    const char* A; const char* B; int lda, ldb, K, pm0;
    __device__ __forceinline__ bool next(int i, Unit& u) const { const bool r = OrderBase::next(i, u); u.pm += pm0; return r; }
    __device__ __forceinline__ const char* a_ptr(const Unit& u) const { return A + (size_t)u.pm * 256 * lda * 2; }
    __device__ __forceinline__ const char* b_ptr(const Unit& u) const { return B + (size_t)u.pn * 256 * ldb * 2; }
};
struct SchedBatch : OrderBase {
    const char* A; const char* B; int lda, ldb, K; size_t b_pm;
    __device__ __forceinline__ const char* a_ptr(const Unit& u) const { return A + (size_t)u.pm * 256 * lda * 2; }
    __device__ __forceinline__ const char* b_ptr(const Unit& u) const { return B + (size_t)u.pm * b_pm + (size_t)u.pn * 256 * ldb * 2; }
};
struct SchedQlat : OrderBase {
    const char* A; const char* B; int lda, ldb, K;
    __device__ __forceinline__ const char* a_ptr(const Unit& u) const { return A + ((size_t)(u.pm & 1) * 256 * lda + (size_t)(u.pm >> 1) * 192) * 2; }
    __device__ __forceinline__ const char* b_ptr(const Unit& u) const { return B + ((size_t)(u.pm >> 1) * 512 + (size_t)u.pn * 256) * ldb * 2; }
};
struct SchedOV : OrderBase {
    const char* A; const char* B; int lda, ldb, K;
    __device__ __forceinline__ const char* a_ptr(const Unit& u) const { return A + (size_t)u.pm * 256 * lda * 2; }
    __device__ __forceinline__ const char* b_ptr(const Unit& u) const { return B + (size_t)(u.pm >> 2) * 256 * ldb * 2; }
};
struct SchedPool : OrderBase {
    const char* A; const char* B; int lda, ldb, K;
    __device__ __forceinline__ const char* a_ptr(const Unit& u) const { return A + ((size_t)u.pm * 256 * lda + (size_t)(u.pn >> 1) * 512) * 2; }
    __device__ __forceinline__ const char* b_ptr(const Unit& u) const { return B + (size_t)u.pn * 256 * ldb * 2; }
};

struct SchedSplit : OrderBase {
    const char* A; const char* B; int lda, ldb, K;
    __device__ __forceinline__ const char* a_ptr(const Unit& u) const { return A + ((size_t)(u.pm & 1) * 256 * lda + (size_t)(u.pm >> 1) * K) * 2; }
    __device__ __forceinline__ const char* b_ptr(const Unit& u) const { return B + ((size_t)u.pn * 256 * ldb + (size_t)(u.pm >> 1) * K) * 2; }
};

__device__ __forceinline__ unsigned cvt_pk_bf16(float lo, float hi) { unsigned r; asm volatile("v_cvt_pk_bf16_f32 %0, %1, %2" : "=v"(r) : "v"(lo), "v"(hi)); return r; }

struct EpiF32 {
    static constexpr bool PERM = false, APERM = false, AFTER_DRAIN = false;
    float* C; int ldc;
    __device__ __forceinline__ void operator()(const f32x4 (&acc)[2][2][4][2], const Unit& u, int wr, int wc, int fr, int fq) const {
        const int row0 = u.pm * BM + wr * 64 + fr, col0 = u.pn * BM + wc * 32 + 4 * fq;
#pragma unroll
        for (int ai = 0; ai < 2; ++ai)
#pragma unroll
            for (int m = 0; m < 4; ++m) { float* rowp = C + (size_t)(row0 + ai * HALF + m * 16) * ldc + col0;
#pragma unroll
                for (int bj = 0; bj < 2; ++bj)
#pragma unroll
                    for (int n = 0; n < 2; ++n) *(PG8_GAS f32x4*)(rowp + bj * HALF + n * 16) = acc[ai][bj][m][n]; }
    }
};
struct EpiSlab {
    static constexpr bool PERM = false, APERM = false, AFTER_DRAIN = false;
    float* C;
    __device__ __forceinline__ void operator()(const f32x4 (&acc)[2][2][4][2], const Unit& u, int wr, int wc, int fr, int fq) const {
        float* base = C + ((size_t)(u.pm >> 1) * 512 + (u.pm & 1) * 256 + wr * 64 + fr) * 2048 + u.pn * BM + wc * 32 + 4 * fq;
#pragma unroll
        for (int ai = 0; ai < 2; ++ai)
#pragma unroll
            for (int m = 0; m < 4; ++m) { float* rowp = base + (size_t)(ai * HALF + m * 16) * 2048;
#pragma unroll
                for (int bj = 0; bj < 2; ++bj)
#pragma unroll
                    for (int n = 0; n < 2; ++n) *(PG8_GAS f32x4*)(rowp + bj * HALF + n * 16) = acc[ai][bj][m][n]; }
    }
};
template <int MODE> struct EpiB {
    static constexpr bool PERM = true, APERM = false, AFTER_DRAIN = false;
    bf16_t* O; int ldc; const float* scale;
    __device__ __forceinline__ void operator()(const f32x4 (&acc)[2][2][4][2], const Unit& u, int wr, int wc, int fr, int fq) const {
        f32x4 sv[2][2];
        if (MODE == 0) {
#pragma unroll
            for (int bj = 0; bj < 2; ++bj)
#pragma unroll
                for (int n = 0; n < 2; ++n) sv[bj][n] = scale ? *(const PG8_GAS f32x4*)(scale + u.pn * BM + bj * HALF + wc * 32 + 8 * fq + 4 * n) : (f32x4){1.f, 1.f, 1.f, 1.f};
        }
#pragma unroll
        for (int ai = 0; ai < 2; ++ai)
#pragma unroll
            for (int m = 0; m < 4; ++m) {
                const int r = ai * HALF + wr * 64 + m * 16 + fr;
#pragma unroll
                for (int bj = 0; bj < 2; ++bj) {
                    const int c = bj * HALF + wc * 32 + 8 * fq;
                    bf16_t* p;
                    if (MODE == 0) p = O + (size_t)(u.pm * BM + r) * ldc + u.pn * BM + c;
                    else if (MODE == 1) { const int tok = 256 * (u.pm & 1) + r; p = O + (size_t)((tok >> 4) * 256 + (u.pm >> 1) * 16 + (tok & 15)) * 640 + u.pn * BM + c; }
                    else if (MODE == 2) { p = O + (size_t)((r >> 4) * 512 + 16 * u.pm + (r & 15)) * 512 + u.pn * BM + c; }
                    else { const int tok = 256 * (u.pm & 1) + r; p = O + (size_t)(32768 + tok) * 2048 + (u.pm >> 1) * 128 + (c & 127); }
                    if (MODE == 3 && bj != ((u.pm >> 1) & 1)) continue;
                    f32x4 v0 = acc[ai][bj][m][0], v1 = acc[ai][bj][m][1];
                    if (MODE == 0) { v0 = v0 * sv[bj][0]; v1 = v1 * sv[bj][1]; }
                    u32x4 w; w.x = cvt_pk_bf16(v0[0], v0[1]); w.y = cvt_pk_bf16(v0[2], v0[3]); w.z = cvt_pk_bf16(v1[0], v1[1]); w.w = cvt_pk_bf16(v1[2], v1[3]);
                    *(PG8_GAS u32x4*)p = w;
                }
            }
    }
};
struct EpiQRope {
    static constexpr bool PERM = true, APERM = false, AFTER_DRAIN = false;
    bf16_t* O; const float* ctab; const float* stab;
    __device__ __forceinline__ void operator()(const f32x4 (&acc)[2][2][4][2], const Unit& u, int wr, int wc, int fr, int fq) const {
#pragma unroll
        for (int bj = 0; bj < 2; ++bj) {
            const int c = u.pn * BM + bj * HALF + wc * 32 + 8 * fq;
            const int k32 = (u.pn * 8 + bj * 4 + wc) % 6;
            const bool rope = k32 >= 4;
            const int i0 = ((k32 - 4) * 32 + 8 * fq) >> 1;
#pragma unroll
            for (int ai = 0; ai < 2; ++ai)
#pragma unroll
                for (int m = 0; m < 4; ++m) {
                    const int t = u.pm * BM + ai * HALF + wr * 64 + m * 16 + fr;
                    f32x4 v0 = acc[ai][bj][m][0], v1 = acc[ai][bj][m][1];
                    if (rope) {
                        const int pos = t < 32768 ? (t & 4095) : 2048 + ((t - 32768) & 15);
                        const f32x4 cs = *(const PG8_GAS f32x4*)(ctab + pos * 32 + i0), sn = *(const PG8_GAS f32x4*)(stab + pos * 32 + i0);
                        const float a0 = v0[0], b0 = v0[1], a1 = v0[2], b1 = v0[3], a2 = v1[0], b2 = v1[1], a3 = v1[2], b3 = v1[3];
                        v0[0] = a0 * cs[0] - b0 * sn[0]; v0[1] = a0 * sn[0] + b0 * cs[0];
                        v0[2] = a1 * cs[1] - b1 * sn[1]; v0[3] = a1 * sn[1] + b1 * cs[1];
                        v1[0] = a2 * cs[2] - b2 * sn[2]; v1[1] = a2 * sn[2] + b2 * cs[2];
                        v1[2] = a3 * cs[3] - b3 * sn[3]; v1[3] = a3 * sn[3] + b3 * cs[3];
                    }
                    u32x4 w; w.x = cvt_pk_bf16(v0[0], v0[1]); w.y = cvt_pk_bf16(v0[2], v0[3]); w.z = cvt_pk_bf16(v1[0], v1[1]); w.w = cvt_pk_bf16(v1[2], v1[3]);
                    *(PG8_GAS u32x4*)(O + (size_t)t * 3072 + c) = w;
                }
        }
    }
};
template <int CTRL> __device__ __forceinline__ float dppf(float x) { return __builtin_bit_cast(float, __builtin_amdgcn_update_dpp(0, __builtin_bit_cast(int, x), CTRL, 0xf, 0xf, false)); }
__device__ __forceinline__ f32x4 ror1(f32x4 x) { return (f32x4){dppf<0x121>(x[0]), dppf<0x121>(x[1]), dppf<0x121>(x[2]), dppf<0x121>(x[3])}; }
__device__ __forceinline__ f32x4 ror2(f32x4 x) { return (f32x4){dppf<0x122>(x[0]), dppf<0x122>(x[1]), dppf<0x122>(x[2]), dppf<0x122>(x[3])}; }
__device__ __forceinline__ f32x4 sel4(bool c, f32x4 a, f32x4 b) { return (f32x4){c ? a[0] : b[0], c ? a[1] : b[1], c ? a[2] : b[2], c ? a[3] : b[3]}; }
__device__ __forceinline__ float silu_mul(float g, float v) { const float e = __builtin_amdgcn_exp2f(g * -1.4426950408889634f); return g * __builtin_amdgcn_rcpf(1.0f + e) * v; }
template <int CTRL> __device__ __forceinline__ float dpp_old(float old, float x) { return __builtin_bit_cast(float, __builtin_amdgcn_update_dpp(__builtin_bit_cast(int, old), __builtin_bit_cast(int, x), CTRL, 0xf, 0xf, false)); }
__device__ __forceinline__ f32x4 shr1_old(f32x4 old, f32x4 x) { return (f32x4){dpp_old<0x111>(old[0], x[0]), dpp_old<0x111>(old[1], x[1]), dpp_old<0x111>(old[2], x[2]), dpp_old<0x111>(old[3], x[3])}; }
struct EpiUpP {
    static constexpr bool PERM = true, APERM = true, AFTER_DRAIN = false;
    bf16_t* act; bf16_t* bnd_first; bf16_t* bnd_last; const float* cw; const float* cb; float* oconv_p; const float* rs;
    __device__ __forceinline__ void operator()(const f32x4 (&acc)[2][2][4][2], const Unit& u, int wr, int wc, int fr, int fq) const {
        const int colh = wc * 32 + 8 * fq, jg = u.pn * 128 + colh, np = u.pn * 256 + colh;
        const bool first = fr == 0, edge = fr == 0 || fr == 15;
        u32x2 stash[2][4], bst[2][4];
        const f32x4 zero4 = (f32x4){0.f, 0.f, 0.f, 0.f};
        f32x4 r4a[2];
#pragma unroll
        for (int ai = 0; ai < 2; ++ai) r4a[ai] = *(const PG8_GAS f32x4*)(rs + u.pm * BM + ai * HALF + wr * 64 + 4 * fr);
#pragma unroll
        for (int n = 0; n < 2; ++n) {
            const int jc = jg + 4 * n;
            const f32x4 w0g = *(const PG8_GAS f32x4*)(cw + jc), w1g = *(const PG8_GAS f32x4*)(cw + 11264 + jc), w2g = *(const PG8_GAS f32x4*)(cw + 2 * 11264 + jc), bg = *(const PG8_GAS f32x4*)(cb + jc);
            const f32x4 w0v = *(const PG8_GAS f32x4*)(cw + 5632 + jc), w1v = *(const PG8_GAS f32x4*)(cw + 11264 + 5632 + jc), w2v = *(const PG8_GAS f32x4*)(cw + 2 * 11264 + 5632 + jc), bv = *(const PG8_GAS f32x4*)(cb + 5632 + jc);
#pragma unroll
            for (int ai = 0; ai < 2; ++ai) {
                const int strip = u.pm * 4 + ai * 2 + wr;
                const f32x4 r4 = r4a[ai];
                const f32x4 xg0 = acc[ai][0][0][n] * r4[0], xg1 = acc[ai][0][1][n] * r4[1], xg2 = acc[ai][0][2][n] * r4[2], xg3 = acc[ai][0][3][n] * r4[3];
                const f32x4 xv0 = acc[ai][1][0][n] * r4[0], xv1 = acc[ai][1][1][n] * r4[1], xv2 = acc[ai][1][2][n] * r4[2], xv3 = acc[ai][1][3][n] * r4[3];
                const f32x4 pg3 = shr1_old(zero4, xg3), pg2 = shr1_old(zero4, xg2), pv3 = shr1_old(zero4, xv3), pv2 = shr1_old(zero4, xv2);
                const f32x4 ga = first ? xg0 : xg2, gb = first ? xg1 : xg3, va = first ? xv0 : xv2, vb = first ? xv1 : xv3;
                u32x2 ba, bb, bc, bd; ba.x = cvt_pk_bf16(ga[0], ga[1]); ba.y = cvt_pk_bf16(ga[2], ga[3]); bb.x = cvt_pk_bf16(va[0], va[1]); bb.y = cvt_pk_bf16(va[2], va[3]);
                bc.x = cvt_pk_bf16(gb[0], gb[1]); bc.y = cvt_pk_bf16(gb[2], gb[3]); bd.x = cvt_pk_bf16(vb[0], vb[1]); bd.y = cvt_pk_bf16(vb[2], vb[3]);
                if (fr == 15 && (strip & 63) == 63) { float* op = oconv_p + (size_t)((strip >> 6) * 2) * 11264 + jc;
                    *(PG8_GAS f32x4*)op = xg2; *(PG8_GAS f32x4*)(op + 5632) = xv2; *(PG8_GAS f32x4*)(op + 11264) = xg3; *(PG8_GAS f32x4*)(op + 11264 + 5632) = xv3; }
                const f32x4 cg0 = bg + w0g * pg2 + w1g * pg3 + w2g * xg0, cv0 = bv + w0v * pv2 + w1v * pv3 + w2v * xv0;
                const f32x4 cg1 = bg + w0g * pg3 + w1g * xg0 + w2g * xg1, cv1 = bv + w0v * pv3 + w1v * xv0 + w2v * xv1;
                const f32x4 cg2 = bg + w0g * xg0 + w1g * xg1 + w2g * xg2, cv2 = bv + w0v * xv0 + w1v * xv1 + w2v * xv2;
                const f32x4 cg3 = bg + w0g * xg1 + w1g * xg2 + w2g * xg3, cv3 = bv + w0v * xv1 + w1v * xv2 + w2v * xv3;
                const f32x4 cgs[4] = {cg0, cg1, cg2, cg3}, cvs[4] = {cv0, cv1, cv2, cv3};
                if (n == 0) { bst[ai][0] = ba; bst[ai][1] = bb; bst[ai][2] = bc; bst[ai][3] = bd; }
#pragma unroll
                for (int m = 0; m < 4; ++m) {
                    u32x2 pk; pk.x = cvt_pk_bf16(silu_mul(cgs[m][0], cvs[m][0]), silu_mul(cgs[m][1], cvs[m][1])); pk.y = cvt_pk_bf16(silu_mul(cgs[m][2], cvs[m][2]), silu_mul(cgs[m][3], cvs[m][3]));
                    if (n == 0) stash[ai][m] = pk;
                    else if (m >= 2 || fr != 0) { const int t = u.pm * BM + ai * HALF + wr * 64 + 4 * fr + m;
                        u32x4 w; w.x = stash[ai][m].x; w.y = stash[ai][m].y; w.z = pk.x; w.w = pk.y; *(PG8_GAS u32x4*)(act + (size_t)t * 5632 + jg) = w; }
                }
                if (n == 1 && edge) { bf16_t* bp = (first ? bnd_first : bnd_last) + (size_t)(strip * 2) * 11264 + np;
                    u32x4 w; w.x = bst[ai][0].x; w.y = bst[ai][0].y; w.z = ba.x; w.w = ba.y; *(PG8_GAS u32x4*)bp = w;
                    w.x = bst[ai][1].x; w.y = bst[ai][1].y; w.z = bb.x; w.w = bb.y; *(PG8_GAS u32x4*)(bp + 128) = w;
                    w.x = bst[ai][2].x; w.y = bst[ai][2].y; w.z = bc.x; w.w = bc.y; *(PG8_GAS u32x4*)(bp + 11264) = w;
                    w.x = bst[ai][3].x; w.y = bst[ai][3].y; w.z = bd.x; w.w = bd.y; *(PG8_GAS u32x4*)(bp + 11264 + 128) = w; }
            }
        }
    }
};
struct EpiUpS {
    static constexpr bool PERM = true, APERM = true, AFTER_DRAIN = false;
    bf16_t* act; const float* cw; const float* cb; const float* hist; float* oconv_s; const float* rs;
    __device__ __forceinline__ void operator()(const f32x4 (&acc)[2][2][4][2], const Unit& u, int wr, int wc, int fr, int fq) const {
        const int colh = wc * 32 + 8 * fq, jg = u.pn * 128 + colh;
        u32x2 stash[2][4];
        const f32x4 zero4 = (f32x4){0.f, 0.f, 0.f, 0.f};
#pragma unroll
        for (int n = 0; n < 2; ++n) {
            const int jc = jg + 4 * n;
            const f32x4 w0g = *(const PG8_GAS f32x4*)(cw + jc), w1g = *(const PG8_GAS f32x4*)(cw + 11264 + jc), w2g = *(const PG8_GAS f32x4*)(cw + 2 * 11264 + jc), bg = *(const PG8_GAS f32x4*)(cb + jc);
            const f32x4 w0v = *(const PG8_GAS f32x4*)(cw + 5632 + jc), w1v = *(const PG8_GAS f32x4*)(cw + 11264 + 5632 + jc), w2v = *(const PG8_GAS f32x4*)(cw + 2 * 11264 + 5632 + jc), bv = *(const PG8_GAS f32x4*)(cb + 5632 + jc);
#pragma unroll
            for (int ai = 0; ai < 2; ++ai) {
                const f32x4 r4 = *(const PG8_GAS f32x4*)(rs + u.pm * BM + ai * HALF + wr * 64 + 4 * fr);
                const f32x4 xg0 = acc[ai][0][0][n] * r4[0], xg1 = acc[ai][0][1][n] * r4[1], xg2 = acc[ai][0][2][n] * r4[2], xg3 = acc[ai][0][3][n] * r4[3];
                const f32x4 xv0 = acc[ai][1][0][n] * r4[0], xv1 = acc[ai][1][1][n] * r4[1], xv2 = acc[ai][1][2][n] * r4[2], xv3 = acc[ai][1][3][n] * r4[3];
                f32x4 pg3 = shr1_old(zero4, xg3), pg2 = shr1_old(zero4, xg2), pv3 = shr1_old(zero4, xv3), pv2 = shr1_old(zero4, xv2);
                const int sb = (u.pm - 128) * 16 + ai * 8 + wr * 4 + (fr >> 2);
                if ((fr & 3) == 0) { const float* hp = hist + (size_t)sb * 2 * 11264 + jc;
                    pg2 = *(const PG8_GAS f32x4*)(hp); pg3 = *(const PG8_GAS f32x4*)(hp + 11264); pv2 = *(const PG8_GAS f32x4*)(hp + 5632); pv3 = *(const PG8_GAS f32x4*)(hp + 11264 + 5632); }
                if ((fr & 3) == 3) { float* op = oconv_s + (size_t)(sb * 2) * 11264 + jc; *(PG8_GAS f32x4*)op = xg2; *(PG8_GAS f32x4*)(op + 5632) = xv2; *(PG8_GAS f32x4*)(op + 11264) = xg3; *(PG8_GAS f32x4*)(op + 11264 + 5632) = xv3; }
                const f32x4 cg0 = bg + w0g * pg2 + w1g * pg3 + w2g * xg0, cv0 = bv + w0v * pv2 + w1v * pv3 + w2v * xv0;
                const f32x4 cg1 = bg + w0g * pg3 + w1g * xg0 + w2g * xg1, cv1 = bv + w0v * pv3 + w1v * xv0 + w2v * xv1;
                const f32x4 cg2 = bg + w0g * xg0 + w1g * xg1 + w2g * xg2, cv2 = bv + w0v * xv0 + w1v * xv1 + w2v * xv2;
                const f32x4 cg3 = bg + w0g * xg1 + w1g * xg2 + w2g * xg3, cv3 = bv + w0v * xv1 + w1v * xv2 + w2v * xv3;
                const f32x4 cgs[4] = {cg0, cg1, cg2, cg3}, cvs[4] = {cv0, cv1, cv2, cv3};
#pragma unroll
                for (int m = 0; m < 4; ++m) {
                    u32x2 pk; pk.x = cvt_pk_bf16(silu_mul(cgs[m][0], cvs[m][0]), silu_mul(cgs[m][1], cvs[m][1])); pk.y = cvt_pk_bf16(silu_mul(cgs[m][2], cvs[m][2]), silu_mul(cgs[m][3], cvs[m][3]));
                    if (n == 0) stash[ai][m] = pk;
                    else { const int t = u.pm * BM + ai * HALF + wr * 64 + 4 * fr + m;
                        u32x4 w; w.x = stash[ai][m].x; w.y = stash[ai][m].y; w.z = pk.x; w.w = pk.y; *(PG8_GAS u32x4*)(act + (size_t)t * 5632 + jg) = w; }
                }
            }
        }
    }
};

template <class Epi, class Sched, bool ALIGN_EPI = true>
__device__ __forceinline__ void gemm_phase(PG8_LAS unsigned char* lds, const Sched& S, const Epi& E) {
    int tid_ = threadIdx.x; asm volatile("" : "+v"(tid_));
    const int tid = tid_, wid = __builtin_amdgcn_readfirstlane(tid >> 6), lane = tid & 63, wr = wid >> 2, wc = wid & 3, fr = lane & 15, fq = lane >> 4;
    const int K = S.K, nt = K / BK, lda = S.lda, ldb = S.ldb;
    unsigned voffA[2], voffB[2];
#pragma unroll
    for (int i = 0; i < 2; ++i) { int R, C; stage_rc(tid * 16 + i * 8192, R, C); const int Rb = Epi::PERM ? ((R & ~31) + perm32(R & 31)) : R;
        const int Ra = Epi::APERM ? ((R & ~63) + 4 * (R & 15) + ((R >> 4) & 3)) : R;
        voffA[i] = (unsigned)(Ra * lda + C) * 2u; voffB[i] = (unsigned)(Rb * ldb + C) * 2u; }
    const size_t kstep = (size_t)(BK * 2);
    const size_t hA = (size_t)HALF * lda * 2, hB = (size_t)HALF * ldb * 2;
    const unsigned ldsw = (unsigned)wid * 1024u;
    const int aoff = lds_byte(wr * 64 + fr, fq * 8), boff = lds_byte(wc * 32 + fr, fq * 8);
#define PG8_SA(b, h) (((b) * 2 + (h)) * HTB)
#define PG8_SB(b, h) ((4 + (b) * 2 + (h)) * HTB)
#define PG8_STAGE(bufoff, gbase, voff) do { _Pragma("unroll") for (int _i = 0; _i < 2; ++_i) \
        __builtin_amdgcn_global_load_lds((const unsigned*)((const char*)(gbase) + (voff)[_i]), (PG8_LAS unsigned*)(lds + (bufoff) + ldsw + _i * 8192), 16, 0, 0); } while (0)
#define PG8_LDA(dst, b, h) do { _Pragma("unroll") for (int m = 0; m < 4; ++m) _Pragma("unroll") for (int k = 0; k < 2; ++k) dst[m][k] = *(const PG8_LAS bf16x8*)(lds + PG8_SA(b, h) + aoff + m * 2048 + k * 1024); } while (0)
#define PG8_LDB(dst, b, h) do { _Pragma("unroll") for (int n = 0; n < 2; ++n) _Pragma("unroll") for (int k = 0; k < 2; ++k) dst[n][k] = *(const PG8_LAS bf16x8*)(lds + PG8_SB(b, h) + boff + n * 2048 + k * 1024); } while (0)
#define PG8_MMA(ai, bj, At, Bt) do { __builtin_amdgcn_s_setprio(1); _Pragma("unroll") for (int m = 0; m < 4; ++m) _Pragma("unroll") for (int n = 0; n < 2; ++n) _Pragma("unroll") for (int k = 0; k < 2; ++k) \
        acc[ai][bj][m][n] = __builtin_amdgcn_mfma_f32_16x16x32_bf16(Bt[n][k], At[m][k], acc[ai][bj][m][n], 0, 0, 0); __builtin_amdgcn_s_setprio(0); } while (0)
#define PG8_WAIT_V(n) asm volatile("s_waitcnt vmcnt(" #n ")" ::: "memory")
#define PG8_WAIT_L(n) asm volatile("s_waitcnt lgkmcnt(" #n ")" ::: "memory")
#define PG8_BAR __builtin_amdgcn_s_barrier()
#define PG8_SCHED __builtin_amdgcn_sched_barrier(0)
    Unit cur, nxt; int ui = 0;
    if (!S.next(0, cur)) return;
    f32x4 acc[2][2][4][2];
#pragma unroll
    for (int a = 0; a < 2; ++a)
#pragma unroll
        for (int b = 0; b < 2; ++b)
#pragma unroll
            for (int m = 0; m < 4; ++m)
#pragma unroll
                for (int n = 0; n < 2; ++n) acc[a][b][m][n] = (f32x4){0.f, 0.f, 0.f, 0.f};
    bf16x8 At[4][2], B0[2][2], B1[2][2];
    const char* cA = S.a_ptr(cur); const char* cB = S.b_ptr(cur);
    S.a_ready(cur);
    PG8_STAGE(PG8_SB(0, 0), cB, voffB); PG8_STAGE(PG8_SB(0, 1), cB + hB, voffB); PG8_STAGE(PG8_SA(0, 0), cA, voffA); PG8_STAGE(PG8_SA(0, 1), cA + hA, voffA);
    if (wr == 1) PG8_BAR;
    PG8_WAIT_V(2); PG8_BAR;
    PG8_STAGE(PG8_SB(1, 0), cB + kstep, voffB); PG8_STAGE(PG8_SA(1, 0), cA + kstep, voffA); PG8_STAGE(PG8_SB(1, 1), cB + hB + kstep, voffB);
    PG8_WAIT_V(6); PG8_BAR;
    for (;;) {
        const bool has_next = S.next(ui + 1, nxt);
        const char* nA = has_next ? S.a_ptr(nxt) : cA; const char* nB = has_next ? S.b_ptr(nxt) : cB;
        for (int t = 0; t < nt; t += 2) {
            const bool last = (t == nt - 2);
            const char* a1 = cA + (size_t)(t + 1) * kstep;
            const char* a2 = last ? nA : cA + (size_t)(t + 2) * kstep; const char* b2 = last ? nB : cB + (size_t)(t + 2) * kstep;
            const char* a3 = a2 + kstep; const char* b3 = b2 + kstep;
            if (last && has_next) S.a_ready(nxt);
            PG8_LDB(B0, 0, 0); PG8_LDB(B1, 0, 1); PG8_SCHED; PG8_LDA(At, 0, 0); PG8_STAGE(PG8_SA(1, 1), a1 + hA, voffA);
            PG8_WAIT_V(8); PG8_WAIT_L(0); PG8_BAR; PG8_MMA(0, 0, At, B0); PG8_MMA(0, 1, At, B1); PG8_BAR; PG8_SCHED;
            PG8_LDA(At, 0, 1); PG8_STAGE(PG8_SB(0, 0), b2, voffB); PG8_STAGE(PG8_SB(0, 1), b2 + hB, voffB); PG8_STAGE(PG8_SA(0, 0), a2, voffA);
            PG8_WAIT_V(8); PG8_WAIT_L(0); PG8_BAR; PG8_MMA(1, 0, At, B0); PG8_MMA(1, 1, At, B1); PG8_BAR; PG8_SCHED;
            PG8_LDB(B0, 1, 0); PG8_LDB(B1, 1, 1); PG8_SCHED; PG8_LDA(At, 1, 0); PG8_STAGE(PG8_SA(0, 1), a2 + hA, voffA);
            PG8_WAIT_V(8); PG8_WAIT_L(0); PG8_BAR; PG8_MMA(0, 0, At, B0); PG8_MMA(0, 1, At, B1); PG8_BAR; PG8_SCHED;
            PG8_LDA(At, 1, 1); PG8_STAGE(PG8_SB(1, 0), b3, voffB); PG8_STAGE(PG8_SB(1, 1), b3 + hB, voffB); PG8_STAGE(PG8_SA(1, 0), a3, voffA);
            PG8_WAIT_V(8); PG8_WAIT_L(0); PG8_BAR; PG8_MMA(1, 0, At, B0); PG8_MMA(1, 1, At, B1); PG8_BAR; PG8_SCHED;
        }
        if constexpr (ALIGN_EPI) { if (wr == 0) PG8_BAR; }
        E(acc, cur, wr, wc, fr, fq); S.done(cur);
        if (!has_next) break;
#pragma unroll
        for (int a = 0; a < 2; ++a)
#pragma unroll
            for (int b = 0; b < 2; ++b)
#pragma unroll
                for (int m = 0; m < 4; ++m)
#pragma unroll
                    for (int n = 0; n < 2; ++n) acc[a][b][m][n] = (f32x4){0.f, 0.f, 0.f, 0.f};
        cur = nxt; cA = nA; cB = nB; ++ui;
        if constexpr (ALIGN_EPI) { if (wr == 1) PG8_BAR; }
    }
    PG8_WAIT_V(0);
    if constexpr (!ALIGN_EPI) { if (wr == 0) PG8_BAR; }
    PG8_BAR;
#undef PG8_SA
#undef PG8_SB
#undef PG8_STAGE
#undef PG8_LDA
#undef PG8_LDB
#undef PG8_MMA
#undef PG8_WAIT_V
#undef PG8_WAIT_L
#undef PG8_BAR
#undef PG8_SCHED
}
}
namespace att {
#define ATT_LAS __attribute__((address_space(3)))
typedef unsigned short bf16;
using bf16x8 = __attribute__((ext_vector_type(8))) short;
using s16x4  = __attribute__((ext_vector_type(4))) short;
using f32x16 = __attribute__((ext_vector_type(16))) float;
using u32x4  = __attribute__((ext_vector_type(4))) unsigned;
constexpr int NW = 8, QBLK = 32, KVBLK = 64;
constexpr float SCALE = 0.07216878364870322f;
constexpr float THR = 8.f;
constexpr int LDQ = 3072, LDKV = 4096, LDKR = 64, LDO = 2048;
constexpr int SHM_V = KVBLK * 128 * 2, SHM_K = KVBLK * 192 * 2, SHM_QR0 = 2 * SHM_V + 2 * SHM_K + NW * 64 * 4, SHM_ATTN = SHM_QR0 + NW * 4 * 64 * 16;
#define KSWZ(row, colB) ((row) * 384 + ((colB) ^ (((row) & 7) << 4)))
#define SBAR() __builtin_amdgcn_sched_barrier(0)
__device__ __forceinline__ int crow(int r, int hi) { return (r & 3) + 8 * (r >> 2) + 4 * hi; }
__device__ __forceinline__ unsigned cvtpk(float lo, float hi) { unsigned r; asm volatile("v_cvt_pk_bf16_f32 %0, %1, %2" : "=v"(r) : "v"(lo), "v"(hi)); return r; }
__device__ __forceinline__ __amdgpu_buffer_rsrc_t mk_rsrc(const void* p) {
  const unsigned long a = (unsigned long)p; const unsigned lo = __builtin_amdgcn_readfirstlane((unsigned)a), hi = __builtin_amdgcn_readfirstlane((unsigned)(a >> 32));
  return __builtin_amdgcn_make_buffer_rsrc((void*)(((unsigned long)hi << 32) | lo), (short)0, 0x7fffffff, 0x00020000);
}
__device__ __forceinline__ bf16x8 ld8(const bf16* p) { return *(const __attribute__((address_space(1))) bf16x8*)p; }

__device__ __forceinline__ void partialSM(f32x16& p0, f32x16& p1, float& m_reg, float& mn, float& alpha, bool dead) {
  constexpr float C = SCALE * 1.4426950408889634f;
  if (dead) {
#pragma unroll
    for (int r = 0; r < 16; ++r) { p0[r] = -__builtin_inff(); p1[r] = -__builtin_inff(); }
  }
  float pmax = p0[0];
#pragma unroll
  for (int r = 1; r < 16; ++r) pmax = fmaxf(pmax, p0[r]);
#pragma unroll
  for (int r = 0; r < 16; ++r) pmax = fmaxf(pmax, p1[r]);
  { auto rr = __builtin_amdgcn_permlane32_swap(__float_as_uint(pmax), __float_as_uint(pmax), false, false);
    pmax = fmaxf(__uint_as_float(rr[0]), __uint_as_float(rr[1])); }
  if (__builtin_expect(__all(pmax - m_reg <= THR / SCALE), 1)) { mn = m_reg; alpha = 1.f; }
  else { mn = fmaxf(m_reg, pmax); alpha = __builtin_amdgcn_exp2f((m_reg - mn) * C); m_reg = mn; }
  float mnC = -mn * C;
#pragma unroll
  for (int r = 0; r < 16; ++r) p0[r] = fmaf(p0[r], C, mnC);
#pragma unroll
  for (int r = 0; r < 16; ++r) p1[r] = fmaf(p1[r], C, mnC);
#pragma unroll
  for (int r = 0; r < 16; ++r) p0[r] = __builtin_amdgcn_exp2f(p0[r]);
}
__device__ __forceinline__ void finishSM(f32x16& p0, f32x16& p1, float alpha, float& l_reg, bf16x8& pa0, bf16x8& pa1, bf16x8& pa2, bf16x8& pa3) {
#pragma unroll
  for (int r = 0; r < 16; ++r) p1[r] = __builtin_amdgcn_exp2f(p1[r]);
  float ps = 0;
#pragma unroll
  for (int r = 0; r < 16; ++r) ps += p0[r];
#pragma unroll
  for (int r = 0; r < 16; ++r) ps += p1[r];
  { auto rr = __builtin_amdgcn_permlane32_swap(__float_as_uint(ps), __float_as_uint(ps), false, false);
    ps = __uint_as_float(rr[0]) + __uint_as_float(rr[1]); }
  l_reg = l_reg * alpha + ps;
#define PK4(P, BASE, OUT) do { unsigned a0 = cvtpk(P[BASE + 0], P[BASE + 1]), a1 = cvtpk(P[BASE + 2], P[BASE + 3]);   \
    unsigned b0 = cvtpk(P[BASE + 4], P[BASE + 5]), b1 = cvtpk(P[BASE + 6], P[BASE + 7]);                              \
    auto r0 = __builtin_amdgcn_permlane32_swap(a0, b0, false, false); auto r1 = __builtin_amdgcn_permlane32_swap(a1, b1, false, false); \
    u32x4 w = {r0[0], r1[0], r0[1], r1[1]}; OUT = *reinterpret_cast<bf16x8*>(&w); } while (0)
  PK4(p0, 0, pa0); PK4(p0, 8, pa1); PK4(p1, 0, pa2); PK4(p1, 8, pa3);
#undef PK4
}
__device__ __forceinline__ void qkt(f32x16& p0, f32x16& p1, const ATT_LAS char* Ks, const bf16x8* qr, const ATT_LAS char* qrl, int r32, int hi) {
  p0 = f32x16{}; p1 = f32x16{};
#pragma unroll
  for (int d0 = 0; d0 < 12; ++d0) { const int cb = (d0 * 16 + hi * 8) * 2;
    bf16x8 b0 = *reinterpret_cast<const ATT_LAS bf16x8*>(Ks + KSWZ(r32, cb));
    bf16x8 b1 = *reinterpret_cast<const ATT_LAS bf16x8*>(Ks + KSWZ(32 + r32, cb));
    const bf16x8 q = d0 < 8 ? qr[d0 < 8 ? d0 : 0] : *reinterpret_cast<const ATT_LAS bf16x8*>(qrl + (d0 - 8) * 1024);
    p0 = __builtin_amdgcn_mfma_f32_32x32x16_bf16(b0, q, p0, 0, 0, 0);
    p1 = __builtin_amdgcn_mfma_f32_32x32x16_bf16(b1, q, p1, 0, 0, 0); }
}
__device__ __forceinline__ int v_st(int k, int c) { const int kk = (k & ~0xC) | ((k & 4) << 1) | ((k & 8) >> 1); return ((kk >> 3) * 4 + (c >> 5)) * 512 + ((kk & 7) * 32 + (c & 31)) * 2; }
__device__ __forceinline__ int v_rd_base(int lane) { return ((lane & 3) << 3) | (((lane >> 2) & 3) << 6) | (((lane >> 4) & 1) << 5) | (((lane >> 5) & 1) << 8); }
constexpr int v_rd_off(int d0, int ks, int half) { return d0 * 512 + ks * 4096 + half * 2048; }
template <int OFF> __device__ __forceinline__ s16x4 tr_read(int vb) {
  s16x4 r; asm volatile("ds_read_b64_tr_b16 %0, %1 offset:%2" : "=&v"(r) : "v"(vb), "i"(OFF) : "memory"); return r;
}
template <int D0> __device__ __forceinline__ void pv_one(f32x16& od, int vb, bf16x8 pa0, bf16x8 pa1, bf16x8 pa2, bf16x8 pa3) {
  const s16x4 l0 = tr_read<v_rd_off(D0, 0, 0)>(vb), h0 = tr_read<v_rd_off(D0, 0, 1)>(vb), l1 = tr_read<v_rd_off(D0, 1, 0)>(vb), h1 = tr_read<v_rd_off(D0, 1, 1)>(vb);
  const s16x4 l2 = tr_read<v_rd_off(D0, 2, 0)>(vb), h2 = tr_read<v_rd_off(D0, 2, 1)>(vb), l3 = tr_read<v_rd_off(D0, 3, 0)>(vb), h3 = tr_read<v_rd_off(D0, 3, 1)>(vb);
  asm volatile("s_waitcnt lgkmcnt(0)" ::: "memory"); SBAR();
#define PK(L, H) (bf16x8){L[0], L[1], L[2], L[3], H[0], H[1], H[2], H[3]}
  od = __builtin_amdgcn_mfma_f32_32x32x16_bf16(pa0, PK(l0, h0), od, 0, 0, 0);
  od = __builtin_amdgcn_mfma_f32_32x32x16_bf16(pa1, PK(l1, h1), od, 0, 0, 0);
  od = __builtin_amdgcn_mfma_f32_32x32x16_bf16(pa2, PK(l2, h2), od, 0, 0, 0);
  od = __builtin_amdgcn_mfma_f32_32x32x16_bf16(pa3, PK(l3, h3), od, 0, 0, 0);
#undef PK
}
__device__ __forceinline__ void pv_d0(f32x16* o, int vb, bf16x8 pa0, bf16x8 pa1, bf16x8 pa2, bf16x8 pa3) {
  pv_one<0>(o[0], vb, pa0, pa1, pa2, pa3); pv_one<1>(o[1], vb, pa0, pa1, pa2, pa3); pv_one<2>(o[2], vb, pa0, pa1, pa2, pa3); pv_one<3>(o[3], vb, pa0, pa1, pa2, pa3);
}

__device__ __forceinline__ void attn_unit(const bf16* __restrict__ Qb, const bf16* __restrict__ Kh, const bf16* __restrict__ Vh, const bf16* __restrict__ KRh,
                                          bf16* __restrict__ Ob, int NT, int qb, ATT_LAS char* lds) {
  int tid_ = threadIdx.x; asm volatile("" : "+v"(tid_));
  const int tid = tid_, wid = __builtin_amdgcn_readfirstlane(tid >> 6), lane = tid & 63, r32 = lane & 31, hi = lane >> 5;
  const int lim = 4 * qb + (wid >> 1);
  ATT_LAS char* V_lds = lds; ATT_LAS char* K_lds = lds + 2 * SHM_V;
  ATT_LAS float* ws = (ATT_LAS float*)(lds + 2 * SHM_V + 2 * SHM_K) + wid * 64; ATT_LAS float* li_l = ws; ATT_LAS float* al_l = ws + 32;
  float m_reg = -1e30f, l_reg = 0; f32x16 o[4] = {}; bf16x8 qr[8];
  ATT_LAS char* qrl = lds + SHM_QR0 + wid * 4096 + lane * 16;
  const bf16* Qw = Qb + (long)(wid * QBLK + r32) * LDQ + hi * 8;
#pragma unroll
  for (int d0 = 0; d0 < 8; ++d0) qr[d0] = ld8(Qw + d0 * 16);
#pragma unroll
  for (int d0 = 8; d0 < 12; ++d0) *reinterpret_cast<ATT_LAS bf16x8*>(qrl + (d0 - 8) * 1024) = ld8(Qw + d0 * 16);
  const int sr = tid >> 4, sc = (tid & 15) * 8, vst0 = v_st(sr, sc), vst1 = v_st(32 + sr, sc);
  const int kr_row = tid >> 3, kr_c = (tid & 7) * 8;
  const int vb0 = (int)(unsigned)(unsigned long)V_lds + v_rd_base(lane);
  const __amdgpu_buffer_rsrc_t rsK = mk_rsrc(Kh), rsV = mk_rsrc(Vh), rsR = mk_rsrc(KRh);
  const unsigned vo0 = (unsigned)(sr * LDKV + sc) * 2u, vo1 = (unsigned)((32 + sr) * LDKV + sc) * 2u, vor = (unsigned)(kr_row * LDKR + kr_c) * 2u;
  struct { bf16x8 vs0, vs1, ks0, ks1, kr; } sr_[1];
#define SLOAD(i, k0) do { const int so_ = (k0) * (LDKV * 2), sr2_ = (k0) * (LDKR * 2); \
    sr_[i].vs0 = __builtin_bit_cast(bf16x8, __builtin_amdgcn_raw_buffer_load_b128(rsV, (int)vo0, so_, 0)); sr_[i].vs1 = __builtin_bit_cast(bf16x8, __builtin_amdgcn_raw_buffer_load_b128(rsV, (int)vo1, so_, 0)); \
    sr_[i].ks0 = __builtin_bit_cast(bf16x8, __builtin_amdgcn_raw_buffer_load_b128(rsK, (int)vo0, so_, 0)); sr_[i].ks1 = __builtin_bit_cast(bf16x8, __builtin_amdgcn_raw_buffer_load_b128(rsK, (int)vo1, so_, 0)); \
    sr_[i].kr = __builtin_bit_cast(bf16x8, __builtin_amdgcn_raw_buffer_load_b128(rsR, (int)vor, sr2_, 0)); } while (0)
#define SWRITE(b, i) do { *(ATT_LAS bf16x8*)(V_lds + (b) * SHM_V + vst0) = sr_[i].vs0;          \
    *(ATT_LAS bf16x8*)(V_lds + (b) * SHM_V + vst1) = sr_[i].vs1; const int kc = sc * 2;               \
    *(ATT_LAS bf16x8*)(K_lds + (b) * SHM_K + KSWZ(sr, kc)) = sr_[i].ks0;                       \
    *(ATT_LAS bf16x8*)(K_lds + (b) * SHM_K + KSWZ(32 + sr, kc)) = sr_[i].ks1;                  \
    *(ATT_LAS bf16x8*)(K_lds + (b) * SHM_K + KSWZ(kr_row, 256 + kr_c * 2)) = sr_[i].kr; } while (0)
#define SWAIT() asm volatile("s_waitcnt vmcnt(0)" ::: "memory")
#define RESC(a) do { if (__any((a) < 1.f)) { if (hi == 0) al_l[r32] = (a); asm volatile("s_waitcnt lgkmcnt(0)" ::: "memory"); \
    _Pragma("unroll") for (int d = 0; d < 4; ++d) _Pragma("unroll") for (int r = 0; r < 16; ++r) o[d][r] *= al_l[crow(r, hi)]; } } while (0)
  f32x16 pA0, pA1, pB0, pB1; float mnA, mnB, alA, alB; bf16x8 pa0, pa1, pa2, pa3;
  constexpr int SE = 0, SO = 0;
  SLOAD(SE, 0); asm volatile("s_waitcnt vmcnt(0)" ::: "memory"); SWRITE(0, SE); __syncthreads();
  qkt(pA0, pA1, K_lds, qr, qrl, r32, hi); partialSM(pA0, pA1, m_reg, mnA, alA, false);
  SLOAD(SO, KVBLK);
  SWAIT(); SWRITE(1, SO); __syncthreads();
  for (int j = 1; j + 1 < NT; j += 2) {
    SBAR(); qkt(pB0, pB1, K_lds + SHM_K, qr, qrl, r32, hi);
    finishSM(pA0, pA1, alA, l_reg, pa0, pa1, pa2, pa3); SBAR();
    SLOAD(SO, (j + 1) * KVBLK); SBAR();
    pv_d0(o, vb0, pa0, pa1, pa2, pa3); partialSM(pB0, pB1, m_reg, mnB, alB, j > lim);
    __syncthreads(); SWAIT(); SWRITE(0, SE);
    RESC(alB); __syncthreads();
    SBAR(); qkt(pA0, pA1, K_lds, qr, qrl, r32, hi);
    finishSM(pB0, pB1, alB, l_reg, pa0, pa1, pa2, pa3); SBAR();
    SLOAD(SE, (j + 2) * KVBLK); SBAR();
    pv_d0(o, vb0 + SHM_V, pa0, pa1, pa2, pa3); partialSM(pA0, pA1, m_reg, mnA, alA, j + 1 > lim);
    __syncthreads(); SWAIT(); SWRITE(1, SO);
    RESC(alA); __syncthreads();
  }
  SBAR(); qkt(pB0, pB1, K_lds + SHM_K, qr, qrl, r32, hi);
  finishSM(pA0, pA1, alA, l_reg, pa0, pa1, pa2, pa3); SBAR();
  pv_d0(o, vb0, pa0, pa1, pa2, pa3); partialSM(pB0, pB1, m_reg, mnB, alB, NT - 1 > lim);
  __syncthreads(); RESC(alB);
  finishSM(pB0, pB1, alB, l_reg, pa0, pa1, pa2, pa3); SBAR();
  pv_d0(o, vb0 + SHM_V, pa0, pa1, pa2, pa3);
  if (hi == 0) li_l[r32] = l_reg; asm volatile("s_waitcnt lgkmcnt(0)" ::: "memory");
  float rli[16];
#pragma unroll
  for (int r = 0; r < 16; ++r) rli[r] = __builtin_amdgcn_rcpf(li_l[crow(r, hi)]);
  bf16* Ow = Ob + (long)(wid * QBLK) * LDO;
#pragma unroll
  for (int r = 0; r < 16; ++r) { const int orow = crow(r, hi);
#pragma unroll
    for (int d0 = 0; d0 < 4; ++d0) { const float v = o[d0][r] * rli[r]; unsigned u = __float_as_uint(v); u = (u + 0x7fffu + ((u >> 16) & 1u)) >> 16; ((__attribute__((address_space(1))) bf16*)Ow)[(long)orow * LDO + d0 * 32 + r32] = (bf16)u; } }
  __syncthreads();
#undef SLOAD
#undef SWRITE
#undef SWAIT
#undef RESC
}
#undef KSWZ
#undef SBAR
}
constexpr int NWAVES = 8;
constexpr int TP = 32768, TS = 512, T = TP + TS, DM = 2048, DFF = 5632, NUP = 2 * DFF, SEQ = 4096;
constexpr float EPS = 1e-6f;
static_assert((2048 + 16 - 1) / 64 == 2048 / 64, "all cache keys and new keys of a sample stream lie in chunks <= the query chunk: the chunk mask is all-true for the sample streams");
constexpr size_t O_Y = 0, O_CKV_P = O_Y + (size_t)T * DM, O_KR_P = O_CKV_P + (size_t)2 * TP * 512, O_POOL_P = O_KR_P + (size_t)2 * TP * 64, O_CONV_P = O_POOL_P + (size_t)2 * 8 * 15 * DM,
                 O_CKV_S = O_CONV_P + (size_t)4 * 8 * 2 * NUP, O_KR_S = O_CKV_S + (size_t)2 * TS * 512, O_POOL_S = O_KR_S + (size_t)2 * TS * 64, O_CONV_S = O_POOL_S + (size_t)2 * 32 * 15 * DM,
                 O_END = O_CONV_S + (size_t)4 * 32 * 2 * NUP;
static_assert(O_END == 112558080, "d_out size");
constexpr size_t MiB = 1u << 20;
constexpr size_t WS_CTL = 0, CTL_ZERO_BYTES = 1 * MiB;
constexpr size_t WS_ROPE = 1 * MiB;
constexpr size_t WS_RS = 2 * MiB;
constexpr size_t WS_W = 3 * MiB;
constexpr size_t W_MLA = 24 * MiB;
constexpr size_t WO_DQKV = 0, WO_UQ = 5 * MiB, WO_UKV = 8 * MiB, WO_UK2 = 12 * MiB, WO_O = 16 * MiB;
constexpr size_t WS_WPOOL = WS_W + 2 * W_MLA;
constexpr size_t WS_WFFN = WS_WPOOL + 4 * MiB, WO_UP = 0, WO_DOWN = 44 * MiB;
constexpr size_t WS_HB = WS_WFFN + 66 * MiB;
constexpr size_t WS_MB = WS_HB + 130 * MiB;
constexpr size_t WS_S = WS_MB, WS_P = WS_MB + 72 * MiB;
constexpr size_t WS_BND = WS_MB + 130 * MiB;
constexpr size_t WS_XB = WS_BND + 44 * MiB;
constexpr size_t WS_SLAB = WS_XB + 130 * MiB;
constexpr size_t WS_BIG = WS_SLAB + 44 * MiB;
constexpr size_t WS_ACT = WS_BIG;
constexpr size_t WS_Q = WS_BIG, WS_CQ = WS_BIG + 196 * MiB, WS_CKVB = WS_BIG + 229 * MiB, WS_KRB = WS_BIG + 261 * MiB, WS_KV = WS_BIG + 265 * MiB;
constexpr size_t WS_KALL = WS_KV, WS_VT = WS_KV + 90 * MiB, WS_QLAT = WS_KV + 162 * MiB, WS_OL = WS_KV + 172 * MiB;
constexpr size_t WS_END = WS_KV + 256 * MiB;
static_assert(WS_HB == 121 * MiB && WS_END == 1120 * MiB, "ws map");
static_assert((size_t)T * 1280 * 4 <= 174 * MiB && (size_t)T * 5632 * 2 <= WS_END - WS_BIG && (size_t)T * 3072 * 2 + 4096 <= 196 * MiB && (size_t)11 * 512 * 2048 * 4 <= 44 * MiB, "ws aliases");
constexpr int CW_BAR = 4096;

#define GAS __attribute__((address_space(1)))
#define LAS __attribute__((address_space(3)))
typedef unsigned short bf16;
typedef unsigned v4u __attribute__((ext_vector_type(4)));
typedef unsigned v2u __attribute__((ext_vector_type(2)));
typedef float f32x4 __attribute__((ext_vector_type(4)));
typedef short bf16x8 __attribute__((ext_vector_type(8)));
#define LDS_WAIT() asm volatile("s_waitcnt lgkmcnt(0)" ::: "memory")
#define VM_WAIT() asm volatile("s_waitcnt vmcnt(0)" ::: "memory")
__device__ __forceinline__ unsigned f2bf(float f) { unsigned u = __builtin_bit_cast(unsigned, f); return (u + 0x7fffu + ((u >> 16) & 1u)) >> 16; }
__device__ __forceinline__ unsigned pk2(float lo, float hi) { return f2bf(lo) | (f2bf(hi) << 16); }
__device__ __forceinline__ float bflo(unsigned w) { return __builtin_bit_cast(float, w << 16); }
__device__ __forceinline__ float bfhi(unsigned w) { return __builtin_bit_cast(float, w & 0xffff0000u); }

#define XB_TMO      128
#define XB_XCNT(j)  (256  + 64 * (j))
#define XB_XSUB(j)  (1280 + 64 * (j))
#define XB_XGEN(j)  (2304 + 64 * (j))
#define XB_TOP      3328
#define XB_TOPGEN   3392
#define XCD_BAR_WORDS 3456
#define XB_SPIN_CAP (1u << 18)
__device__ __forceinline__ unsigned xb_ld(unsigned* p)              { return __hip_atomic_load(p, __ATOMIC_RELAXED, __HIP_MEMORY_SCOPE_AGENT); }
__device__ __forceinline__ unsigned xb_add(unsigned* p, unsigned v) { return __hip_atomic_fetch_add(p, v, __ATOMIC_RELAXED, __HIP_MEMORY_SCOPE_AGENT); }
__device__ __forceinline__ unsigned xb_xcc_id() { return (unsigned)__builtin_amdgcn_s_getreg((3 << 11) | 20) & 0xFu; }
#define XB_SPIN(cond, bar) do { unsigned _sp = 0; while (cond) { __builtin_amdgcn_s_sleep(1); \
    if ((++_sp & 255u) == 0u) { if (xb_ld(&(bar)[XB_TMO])) break; if (_sp > XB_SPIN_CAP) { atomicAdd(&(bar)[XB_TMO], 1u); break; } } } } while (0)
struct XcdBarrier { unsigned* bar; unsigned x; volatile LAS unsigned* st; };
__device__ __forceinline__ XcdBarrier xcd_barrier_post(unsigned* bar, volatile LAS unsigned* st) {
    XcdBarrier b; b.bar = bar; b.x = xb_xcc_id(); b.st = st;
    if (threadIdx.x == 0) (void)xb_add(&bar[XB_XCNT(b.x)], 1u);
    return b;
}
__device__ __forceinline__ void xcd_barrier_complete(unsigned* bar, unsigned x, unsigned& nloc, unsigned& nx) {
    const unsigned G = gridDim.x * gridDim.y * gridDim.z;
    unsigned sum, cnt, mine, sp = 0u;
    for (;;) {
        sum = 0u; cnt = 0u; mine = 0u;
#pragma unroll
        for (unsigned j = 0; j < 16; ++j) { const unsigned c = xb_ld(&bar[XB_XCNT(j)]); sum += c; cnt += (c > 0u) ? 1u : 0u; mine = (j == x) ? c : mine; }
        if (sum == G) break;
        __builtin_amdgcn_s_sleep(1);
        if ((++sp & 255u) == 0u) { if (xb_ld(&bar[XB_TMO])) break; if (sp > XB_SPIN_CAP) { atomicAdd(&bar[XB_TMO], 1u); break; } }
    }
    nloc = mine > 0u ? mine : 1u; nx = cnt > 0u ? cnt : 1u;
}
__device__ __forceinline__ void xcd_barrier(const XcdBarrier& b) {
    asm volatile("s_waitcnt vmcnt(0)" ::: "memory");
    __syncthreads();
    if (threadIdx.x == 0) {
        unsigned* bar = b.bar;
        __builtin_amdgcn_s_waitcnt(0);
        unsigned nloc = b.st[0], nx = b.st[1];
        if (nloc == 0u) { xcd_barrier_complete(bar, b.x, nloc, nx); b.st[0] = nloc; b.st[1] = nx; }
        const unsigned old = xb_add(&bar[XB_XSUB(b.x)], 1u);
        const unsigned gen = old / nloc;
        if (old + 1u == (gen + 1u) * nloc) {
            __builtin_amdgcn_fence(__ATOMIC_RELEASE, "agent");
            asm volatile("s_waitcnt vmcnt(0)" ::: "memory");
            const unsigned og = xb_add(&bar[XB_TOP], 1u);
            const unsigned tg = og / nx;
            if (og + 1u == (tg + 1u) * nx) xb_add(&bar[XB_TOPGEN], 1u);
            else XB_SPIN(xb_ld(&bar[XB_TOPGEN]) == tg, bar);
            __builtin_amdgcn_fence(__ATOMIC_ACQUIRE, "agent");
            xb_add(&bar[XB_XGEN(b.x)], 1u);
            asm volatile("s_waitcnt vmcnt(0)" ::: "memory");
        } else {
            XB_SPIN(xb_ld(&bar[XB_XGEN(b.x)]) == gen, bar);
            __builtin_amdgcn_fence(__ATOMIC_ACQUIRE, "agent");
            asm volatile("s_waitcnt vmcnt(0)" ::: "memory");
        }
    }
    __syncthreads();
}

constexpr int RING_OFF = 0, RING_BYTES = 131072;
constexpr int LDSCTL_OFF = RING_BYTES, MISC_OFF = LDSCTL_OFF + 320;
constexpr int LDS_BYTES = 147456;
static_assert(att::SHM_ATTN <= RING_BYTES, "attention scratch fits the ring");

struct Frame {
    LAS unsigned char* lds;
    int tid, lane, wave;
    int vcu, G;
    float* out; unsigned char* ws;
};
constexpr int PTR_OFF = MISC_OFF + 256;
__device__ __forceinline__ const float* inp(const Frame& F, int i) {
    int off = PTR_OFF + 8 * i; asm volatile("" : "+s"(off));
    const unsigned long long v = *(const LAS unsigned long long*)(F.lds + off);
    const unsigned lo = __builtin_amdgcn_readfirstlane((unsigned)v), hi = __builtin_amdgcn_readfirstlane((unsigned)(v >> 32));
    return (const float*)(((unsigned long long)hi << 32) | lo);
}
__device__ __forceinline__ void frame_lanes(Frame& F) {
    int t = threadIdx.x; asm volatile("" : "+v"(t)); F.tid = t; F.lane = t & 63; F.wave = __builtin_amdgcn_readfirstlane(t >> 6);
    unsigned long long w = (unsigned long long)F.ws, o = (unsigned long long)F.out; unsigned l = (unsigned)(unsigned long long)F.lds; int g = F.G, v = F.vcu;
    asm volatile("" : "+s"(w), "+s"(o), "+s"(l), "+s"(g), "+s"(v));
    F.ws = (unsigned char*)w; F.out = (float*)o; F.lds = (LAS unsigned char*)(unsigned long long)l; F.G = g; F.vcu = v;
}
__device__ __forceinline__ float shx(float v, int o, int lane) { return __builtin_bit_cast(float, __builtin_amdgcn_ds_bpermute((lane ^ o) << 2, __builtin_bit_cast(int, v))); }
__device__ __forceinline__ float wave_sum(float v, int lane) {
#pragma unroll
    for (int o = 1; o < 64; o <<= 1) v += shx(v, o, lane);
    return v;
}
__device__ __forceinline__ float wave_max(float v, int lane) {
#pragma unroll
    for (int o = 1; o < 64; o <<= 1) v = fmaxf(v, shx(v, o, lane));
    return v;
}

__device__ __forceinline__ int dest_row(int map, int row_off, int n) {
    if (map == 1) { return n < DFF ? ((n >> 7) * 256 + (n & 127)) : (((n - DFF) >> 7) * 256 + 128 + ((n - DFF) & 127)); }
    if (map == 2) { const int h = n / 192, d = n - h * 192; if (d < 128) return n; const int i = d - 128; return h * 192 + 128 + (i < 32 ? 2 * i : 2 * (i - 32) + 1); }
    return row_off + n;
}
struct TrJob { const float* W; int ldw; bf16* WT; int ldt, map, row_off; const float* ks; bf16* RM; int ldr; int k0, n0; };
__device__ __forceinline__ void tr_load(const TrJob& J, int lane, f32x4 (&v)[8]) {
#pragma unroll
    for (int i = 0; i < 8; ++i) { const int kk = 8 * i + (lane >> 3), c4 = (lane & 7) * 4; v[i] = *(const GAS f32x4*)(J.W + (size_t)(J.k0 + kk) * J.ldw + J.n0 + c4);
        if (J.ks) v[i] = v[i] * ((const GAS float*)J.ks)[J.k0 + kk]; }
}
__device__ __forceinline__ void tr_finish(const TrJob& J, const f32x4 (&v)[8], LAS float* scr, int lane) {
#pragma unroll
    for (int i = 0; i < 8; ++i) { const int kk = 8 * i + (lane >> 3), c4 = (lane & 7) * 4; LAS float* d = scr + kk * 33 + c4; d[0] = v[i].x; d[1] = v[i].y; d[2] = v[i].z; d[3] = v[i].w; }
    LDS_WAIT(); asm volatile("" ::: "memory");
    const int c = lane & 7;
#pragma unroll
    for (int j = 0; j < 4; ++j) { const int n = (lane >> 3) + 8 * j; const LAS float* p = scr + (8 * c) * 33 + n;
        v4u o; o.x = pk2(p[0 * 33], p[1 * 33]); o.y = pk2(p[2 * 33], p[3 * 33]); o.z = pk2(p[4 * 33], p[5 * 33]); o.w = pk2(p[6 * 33], p[7 * 33]);
        *(GAS v4u*)(J.WT + (size_t)dest_row(J.map, J.row_off, J.n0 + n) * J.ldt + J.k0 + 8 * c) = o; }
    if (J.RM) {
        const LAS float* p = scr + lane * 33;
#pragma unroll
        for (int q = 0; q < 4; ++q) { v4u o; o.x = pk2(p[8 * q], p[8 * q + 1]); o.y = pk2(p[8 * q + 2], p[8 * q + 3]); o.z = pk2(p[8 * q + 4], p[8 * q + 5]); o.w = pk2(p[8 * q + 6], p[8 * q + 7]);
            *(GAS v4u*)(J.RM + (size_t)(J.k0 + lane) * J.ldr + J.n0 + 8 * q) = o; }
    }
    LDS_WAIT(); asm volatile("" ::: "memory");
}
#define TR_LOOP(NITEMS, JOBEXPR) do { for (int it_ = gw; it_ < (NITEMS); it_ += 2 * NGW) { \
        f32x4 va_[8], vb_[8]; const int itb_ = it_ + NGW; const bool hb_ = itb_ < (NITEMS); \
        int it = it_; const TrJob ja_ = (JOBEXPR); it = hb_ ? itb_ : it_; const TrJob jb_ = (JOBEXPR); \
        tr_load(ja_, lane, va_); if (hb_) tr_load(jb_, lane, vb_); \
        tr_finish(ja_, va_, scr, lane); if (hb_) tr_finish(jb_, vb_, scr, lane); } } while (0)

constexpr int P0_I_DQ = 32 * 16, P0_I_DKV = 32 * 18, P0_I_UQ = 8 * 96, P0_I_UK = 8 * 64, P0_I_UV = 8 * 64, P0_I_O = 32 * 64, P0_I_MLA = P0_I_DQ + P0_I_DKV + P0_I_UQ + P0_I_UK + P0_I_UV + P0_I_O, P0_I_POOL = 4 * 8 * 16;
__device__ __forceinline__ TrJob p0_job(Frame& F, int it) {
    TrJob J; J.ks = nullptr; J.RM = nullptr; J.ldr = 0; J.map = 0; J.row_off = 0; int nnb, r;
    if (it < 2 * P0_I_MLA) {
        const int j = it / P0_I_MLA; r = it - j * P0_I_MLA; unsigned char* wb = F.ws + WS_W + j * W_MLA;
        if (r < P0_I_DQ) { J.W = inp(F, 7) + (size_t)j * 2048 * 512; J.ldw = 512; J.WT = (bf16*)(wb + WO_DQKV); J.ldt = 2048; nnb = 16; J.ks = inp(F, 6) + (size_t)(2 * j) * 4 * DM; }
        else if ((r -= P0_I_DQ) < P0_I_DKV) { J.W = inp(F, 10) + (size_t)j * 2048 * 576; J.ldw = 576; J.WT = (bf16*)(wb + WO_DQKV); J.ldt = 2048; nnb = 18; J.row_off = 512; J.ks = inp(F, 6) + (size_t)(2 * j) * 4 * DM; }
        else if ((r -= P0_I_DKV) < P0_I_UQ) { J.W = inp(F, 9) + (size_t)j * 512 * 3072; J.ldw = 3072; J.WT = (bf16*)(wb + WO_UQ); J.ldt = 512; nnb = 96; J.map = 2; }
        else if ((r -= P0_I_UQ) < P0_I_UK) { J.W = inp(F, 12) + (size_t)j * 512 * 2048; J.ldw = 2048; J.WT = (bf16*)(wb + WO_UKV); J.ldt = 512; nnb = 64; }
        else if ((r -= P0_I_UK) < P0_I_UV) { J.W = inp(F, 13) + (size_t)j * 512 * 2048; J.ldw = 2048; J.WT = (bf16*)(wb + WO_UKV); J.ldt = 512; nnb = 64; J.row_off = 2048; }
        else { r -= P0_I_UV; J.W = inp(F, 14) + (size_t)j * 2048 * 2048; J.ldw = 2048; J.WT = (bf16*)(wb + WO_O); J.ldt = 2048; nnb = 64; }
    } else {
        r = it - 2 * P0_I_MLA; const int jg = r / (8 * 16); r -= jg * (8 * 16);
        J.W = inp(F, 15) + (size_t)jg * 512 * 512; J.ldw = 512; J.WT = (bf16*)(F.ws + WS_WPOOL + (size_t)(jg >> 2) * 2 * MiB); J.ldt = 512; nnb = 16; J.row_off = (jg & 3) * 512;
    }
    J.k0 = 64 * (r / nnb); J.n0 = 32 * (r % nnb); return J;
}
__device__ __forceinline__ void p0_prologue(Frame& F) {
    frame_lanes(F);
    LAS float* scr = (LAS float*)(F.lds + RING_OFF + F.wave * 16384);
    const int gw = F.vcu * NWAVES + F.wave, NGW = F.G * NWAVES;
    {
        float* ct = (float*)(F.ws + WS_ROPE); float* st = ct + 4096 * 32;
        for (int idx = (F.vcu * NWAVES + F.wave) * 64 + F.lane; idx < 4096 * 32; idx += NGW * 64) {
            const int pos = idx >> 5, i = idx & 31;
            double inv = 1.0; for (int k = 0; k < i; ++k) inv *= 0.7498942093324558273;
            double a = (double)pos * inv;
            const double twopi = 6.283185307179586476925287; a -= twopi * __builtin_rint(a / twopi);
            const double x = a * 0.125, x2 = x * x;
            double s = x * (1.0 + x2 * (-1.0 / 6 + x2 * (1.0 / 120 + x2 * (-1.0 / 5040 + x2 * (1.0 / 362880 + x2 * (-1.0 / 39916800))))));
            double c = 1.0 + x2 * (-0.5 + x2 * (1.0 / 24 + x2 * (-1.0 / 720 + x2 * (1.0 / 40320 + x2 * (-1.0 / 3628800 + x2 * (1.0 / 479001600))))));
#pragma unroll
            for (int k = 0; k < 3; ++k) { const double s2 = 2.0 * s * c, c2 = 1.0 - 2.0 * s * s; s = s2; c = c2; }
            ((GAS float*)ct)[idx] = (float)c; ((GAS float*)st)[idx] = (float)s;
        }
    }
    constexpr int NITEMS = 2 * P0_I_MLA + 2 * P0_I_POOL;
    { const int lane = F.lane; TR_LOOP(NITEMS, p0_job(F, it)); }
    for (int row = gw; row < 2 * 8192; row += NGW) {
        const int j = row >> 13, hc = row & 8191, h = hc >> 9, c = hc & 511;
        const GAS float* src = (const GAS float*)(inp(F, 12) + (size_t)j * 512 * 2048 + (size_t)c * 2048 + h * 128 + 2 * F.lane);
        GAS unsigned* dst = (GAS unsigned*)((unsigned*)(F.ws + WS_W + j * W_MLA + WO_UK2) + (size_t)hc * 128);
        dst[F.lane] = pk2(src[0], src[1]); dst[64 + F.lane] = 0u;
    }
}

__device__ __forceinline__ TrJob ffn_job(Frame& F, int it, const float* wu, const float* wd, const float* g2) {
    constexpr int I_UP = 32 * 352; TrJob J; J.RM = nullptr; J.ldr = 0; J.row_off = 0;
    if (it < I_UP) { J.W = wu; J.ldw = NUP; J.WT = (bf16*)(F.ws + WS_WFFN + WO_UP); J.ldt = 2048; J.map = 1; J.ks = g2; J.k0 = 64 * (it / 352); J.n0 = 32 * (it % 352); }
    else { const int r = it - I_UP; J.W = wd; J.ldw = 2048; J.WT = (bf16*)(F.ws + WS_WFFN + WO_DOWN); J.ldt = DFF; J.map = 0; J.ks = nullptr; J.k0 = 64 * (r / 64); J.n0 = 32 * (r % 64); }
    return J;
}
__device__ __forceinline__ void convert_ffn(Frame& F, int L) {
    LAS float* scr = (LAS float*)(F.lds + RING_OFF + F.wave * 16384);
    const int gw = F.vcu * NWAVES + F.wave, NGW = F.G * NWAVES;
    constexpr int I_UP = 32 * 352, I_DN = 88 * 64;
    const float* wu = inp(F, 17) + (size_t)L * 2048 * NUP; const float* wd = inp(F, 20) + (size_t)L * DFF * 2048; const float* g2 = inp(F, 6) + (size_t)(L * 4 + 2) * DM;
    const int lane = F.lane;
    TR_LOOP(I_UP + I_DN, ffn_job(F, it, wu, wd, g2));
}
__device__ __forceinline__ void norm0_phase(Frame& F) {
    frame_lanes(F);
    const int gw = F.vcu * NWAVES + F.wave, NGW = F.G * NWAVES;
    const float* xp = inp(F, 0); const float* xs = inp(F, 1);
    bf16* XB = (bf16*)(F.ws + WS_XB); float* RS = (float*)(F.ws + WS_RS);
    f32x4 nx[8];
#pragma unroll
    for (int j = 0; j < 8; ++j) nx[j] = (f32x4){0.f, 0.f, 0.f, 0.f};
    if (gw < T) { const float* xin = gw < TP ? xp + (size_t)gw * DM : xs + (size_t)(gw - TP) * DM;
#pragma unroll
        for (int j = 0; j < 8; ++j) nx[j] = *(const GAS f32x4*)(xin + (F.lane + 64 * j) * 4); }
    for (int row = gw; row < T; row += NGW) {
        f32x4 x[8]; float s2 = 0.f;
#pragma unroll
        for (int j = 0; j < 8; ++j) x[j] = nx[j];
        { const int nrow = row + NGW;
          if (nrow < T) { const float* xin = nrow < TP ? xp + (size_t)nrow * DM : xs + (size_t)(nrow - TP) * DM;
#pragma unroll
              for (int j = 0; j < 8; ++j) nx[j] = *(const GAS f32x4*)(xin + (F.lane + 64 * j) * 4); } }
#pragma unroll
        for (int j = 0; j < 8; ++j) s2 += (x[j].x * x[j].x + x[j].y * x[j].y) + (x[j].z * x[j].z + x[j].w * x[j].w);
        const float r2 = 1.0f / sqrtf(wave_sum(s2, F.lane) * (1.0f / DM) + EPS);
#pragma unroll
        for (int j = 0; j < 8; ++j) { v2u w; w.x = pk2(x[j].x, x[j].y); w.y = pk2(x[j].z, x[j].w); *(GAS v2u*)(XB + (size_t)row * DM + (F.lane + 64 * j) * 4) = w; }
        if (F.lane == 0) ((GAS float*)RS)[row] = r2;
    }
}
template <bool LAST, bool POOLST>
__device__ __forceinline__ void norm_phase(Frame& F, const bf16* mres, const float* slab, int ns, const float* g_post, const float* g_pre, float* pool_p, float* pool_s, bool poison, bool dry = false) {
    frame_lanes(F);
    const int gw = F.vcu * NWAVES + F.wave, NGW = F.G * NWAVES;
    bf16* XB = (bf16*)(F.ws + WS_XB); bf16* XBo = dry ? (bf16*)(F.ws + WS_BIG) : XB;
    float* RS = (float*)(F.ws + WS_RS);
    f32x4 gp[8];
#pragma unroll
    for (int j = 0; j < 8; ++j) gp[j] = *(const GAS f32x4*)(g_post + (F.lane + 64 * j) * 4);
    v2u nx[8], nm[8];
#pragma unroll
    for (int j = 0; j < 8; ++j) { nx[j] = (v2u){0u, 0u}; nm[j] = (v2u){0u, 0u}; }
    if (gw < T) {
#pragma unroll
        for (int j = 0; j < 8; ++j) { nx[j] = *(const GAS v2u*)(XB + (size_t)gw * DM + (F.lane + 64 * j) * 4); nm[j] = *(const GAS v2u*)(mres + (size_t)gw * DM + (F.lane + 64 * j) * 4); } }
    for (int row = gw; row < T; row += NGW) {
        f32x4 x[8], mv[8]; v2u cm[8];
#pragma unroll
        for (int j = 0; j < 8; ++j) { x[j] = (f32x4){bflo(nx[j].x), bfhi(nx[j].x), bflo(nx[j].y), bfhi(nx[j].y)}; cm[j] = nm[j]; }
        { const int nrow = row + NGW;
          if (nrow < T) {
#pragma unroll
              for (int j = 0; j < 8; ++j) { nx[j] = *(const GAS v2u*)(XB + (size_t)nrow * DM + (F.lane + 64 * j) * 4); nm[j] = *(const GAS v2u*)(mres + (size_t)nrow * DM + (F.lane + 64 * j) * 4); } } }
        if (ns > 0 && row >= TP) {
#pragma unroll
            for (int j = 0; j < 8; ++j) mv[j] = (f32x4){0.f, 0.f, 0.f, 0.f};
            for (int k = 0; k < ns; ++k) {
#pragma unroll
                for (int j = 0; j < 8; ++j) mv[j] = mv[j] + *(const GAS f32x4*)(slab + ((size_t)k * TS + (row - TP)) * DM + (F.lane + 64 * j) * 4); }
        } else {
#pragma unroll
            for (int j = 0; j < 8; ++j) mv[j] = (f32x4){bflo(cm[j].x), bfhi(cm[j].x), bflo(cm[j].y), bfhi(cm[j].y)}; }
        float ss = 0.f;
#pragma unroll
        for (int j = 0; j < 8; ++j) ss += (mv[j].x * mv[j].x + mv[j].y * mv[j].y) + (mv[j].z * mv[j].z + mv[j].w * mv[j].w);
        const float r1 = 1.0f / sqrtf(wave_sum(ss, F.lane) * (1.0f / DM) + EPS);
#pragma unroll
        for (int j = 0; j < 8; ++j) x[j] = x[j] + mv[j] * r1 * gp[j];
        if (LAST) {
            if (poison) {
#pragma unroll
                for (int j = 0; j < 8; ++j) x[j] = x[j] * __builtin_nanf("");
            }
#pragma unroll
            for (int j = 0; j < 8; ++j) *(GAS f32x4*)(F.out + (size_t)row * DM + (F.lane + 64 * j) * 4) = x[j];
        } else {
#pragma unroll
            for (int j = 0; j < 8; ++j) { v2u w; w.x = pk2(x[j].x, x[j].y); w.y = pk2(x[j].z, x[j].w); *(GAS v2u*)(XBo + (size_t)row * DM + (F.lane + 64 * j) * 4) = w; }
            float s2 = 0.f;
#pragma unroll
            for (int j = 0; j < 8; ++j) s2 += (x[j].x * x[j].x + x[j].y * x[j].y) + (x[j].z * x[j].z + x[j].w * x[j].w);
            const float r2 = 1.0f / sqrtf(wave_sum(s2, F.lane) * (1.0f / DM) + EPS);
            if (F.lane == 0) ((GAS float*)RS)[row] = r2;
            if (POOLST) {
                float* ps = nullptr;
                if (row < TP) { const int s = row & (SEQ - 1); if (s >= SEQ - 15) ps = pool_p + ((size_t)(row >> 12) * 15 + (s - (SEQ - 15))) * DM; }
                else { const int qi = (row - TP) & 15; if (qi >= 1) ps = pool_s + ((size_t)((row - TP) >> 4) * 15 + (qi - 1)) * DM; }
                if (ps) {
#pragma unroll
                    for (int j = 0; j < 8; ++j) { const int c = (F.lane + 64 * j) * 4; *(GAS f32x4*)(ps + c) = x[j] * r2 * *(const GAS f32x4*)(g_pre + c); } }
            }
        }
    }
}

__device__ __forceinline__ TrJob vt_job(const float* cck, bf16* VT, bf16* KALL, int it) {
    const int b = it >> 9, r = it & 511; TrJob J; J.W = cck + (size_t)b * 2048 * 512; J.ldw = 512; J.WT = VT + (size_t)b * 512 * 2304; J.ldt = 2304; J.map = 0; J.row_off = 0; J.ks = nullptr;
    J.RM = KALL + (size_t)b * 2304 * 640; J.ldr = 640; J.k0 = 64 * (r >> 4); J.n0 = 32 * (r & 15); return J;
}
__device__ __forceinline__ void s1_phase(Frame& F, int j) {
    frame_lanes(F);
    const int gw = F.vcu * NWAVES + F.wave, NGW = F.G * NWAVES, lane = F.lane;
    const float* raw = (const float*)(F.ws + WS_MB);
    const float* qn = inp(F, 8) + j * 512; const float* kn = inp(F, 11) + j * 512;
    const float* ct = (const float*)(F.ws + WS_ROPE); const float* st = ct + 4096 * 32;
    bf16* CQ = (bf16*)(F.ws + WS_CQ); bf16* CKVB = (bf16*)(F.ws + WS_CKVB); bf16* KRB = (bf16*)(F.ws + WS_KRB);
    bf16* KALL = (bf16*)(F.ws + WS_KALL); bf16* VT = (bf16*)(F.ws + WS_VT);
    f32x4 gqn[2], gkn[2];
#pragma unroll
    for (int i = 0; i < 2; ++i) { gqn[i] = *(const GAS f32x4*)(qn + (lane + 64 * i) * 4); gkn[i] = *(const GAS f32x4*)(kn + (lane + 64 * i) * 4); }
    f32x4 na[2], nb[2]; float nkv = 0.f, nrs = 0.f;
#pragma unroll
    for (int i = 0; i < 2; ++i) { na[i] = (f32x4){0.f, 0.f, 0.f, 0.f}; nb[i] = na[i]; }
    if (gw < T) { const float* rr = raw + (size_t)gw * 1280;
#pragma unroll
        for (int i = 0; i < 2; ++i) { na[i] = *(const GAS f32x4*)(rr + (lane + 64 * i) * 4); nb[i] = *(const GAS f32x4*)(rr + 512 + (lane + 64 * i) * 4); }
        nkv = ((const GAS float*)rr)[1024 + lane]; nrs = ((const GAS float*)(F.ws + WS_RS))[gw]; }
    for (int row = gw; row < T; row += NGW) {
        f32x4 a[2], b[2]; float ssa = 0.f, ssb = 0.f;
        const float rs_row = nrs;
#pragma unroll
        for (int i = 0; i < 2; ++i) { a[i] = na[i] * rs_row; b[i] = nb[i] * rs_row;
            ssa += (a[i].x * a[i].x + a[i].y * a[i].y) + (a[i].z * a[i].z + a[i].w * a[i].w); ssb += (b[i].x * b[i].x + b[i].y * b[i].y) + (b[i].z * b[i].z + b[i].w * b[i].w); }
        const float kv = nkv * rs_row;
        { const int nrow = row + NGW;
          if (nrow < T) { const float* rn = raw + (size_t)nrow * 1280;
#pragma unroll
              for (int i = 0; i < 2; ++i) { na[i] = *(const GAS f32x4*)(rn + (lane + 64 * i) * 4); nb[i] = *(const GAS f32x4*)(rn + 512 + (lane + 64 * i) * 4); }
              nkv = ((const GAS float*)rn)[1024 + lane]; nrs = ((const GAS float*)(F.ws + WS_RS))[nrow]; } }
        const float ra = 1.0f / sqrtf(wave_sum(ssa, lane) * (1.0f / 512) + EPS), rb = 1.0f / sqrtf(wave_sum(ssb, lane) * (1.0f / 512) + EPS);
        const bool prompt = row < TP;
        const int sb = (row - TP) >> 4, qi = (row - TP) & 15;
        const int pos = prompt ? (row & (SEQ - 1)) : 2048 + qi;
        float* o_ckv = prompt ? F.out + O_CKV_P + ((size_t)j * TP + row) * 512 : F.out + O_CKV_S + ((size_t)j * TS + (row - TP)) * 512;
        float* o_kr = prompt ? F.out + O_KR_P + ((size_t)j * TP + row) * 64 : F.out + O_KR_S + ((size_t)j * TS + (row - TP)) * 64;
#pragma unroll
        for (int i = 0; i < 2; ++i) {
            const int c = (lane + 64 * i) * 4;
            const f32x4 q = a[i] * ra * gqn[i]; v2u w; w.x = pk2(q.x, q.y); w.y = pk2(q.z, q.w); *(GAS v2u*)(CQ + (size_t)row * 512 + c) = w;
            const f32x4 k = b[i] * rb * gkn[i]; *(GAS f32x4*)(o_ckv + c) = k; v2u wk; wk.x = pk2(k.x, k.y); wk.y = pk2(k.z, k.w);
            if (prompt) *(GAS v2u*)(CKVB + (size_t)row * 512 + c) = wk;
            else { *(GAS v2u*)(KALL + ((size_t)sb * 2304 + 2048 + qi) * 640 + c) = wk;
                GAS bf16* vt = (GAS bf16*)(VT + ((size_t)sb * 512 + c) * 2304 + 2048 + qi); vt[0] = (bf16)(wk.x & 0xffff); vt[2304] = (bf16)(wk.x >> 16); vt[2 * 2304] = (bf16)(wk.y & 0xffff); vt[3 * 2304] = (bf16)(wk.y >> 16); }
        }
        const float other = shx(kv, 32, lane); const int i5 = lane & 31; const float cs = ((const GAS float*)ct)[pos * 32 + i5], sn = ((const GAS float*)st)[pos * 32 + i5];
        const float rot = lane < 32 ? kv * cs - other * sn : other * sn + kv * cs;
        ((GAS float*)o_kr)[lane] = rot;
        const float rot_hi = shx(rot, 32, lane);
        if (lane < 32) { const unsigned w = pk2(rot, rot_hi);
            if (prompt) ((GAS unsigned*)(KRB + (size_t)row * 64))[lane] = w; else ((GAS unsigned*)(KALL + ((size_t)sb * 2304 + 2048 + qi) * 640 + 512))[lane] = w; }
        else if (!prompt) ((GAS unsigned*)(KALL + ((size_t)sb * 2304 + 2048 + qi) * 640 + 576))[lane - 32] = 0u;
    }
    const float* cck = inp(F, 2) + (size_t)j * 32 * 2048 * 512; const float* ckr = inp(F, 3) + (size_t)j * 32 * 2048 * 64;
    { const int tg = (F.vcu * NWAVES + F.wave) * 64 + lane, NT_ = F.G * NWAVES * 64;
#pragma unroll 4
      for (int idx = tg; idx < 32 * 2048 * 32; idx += NT_) {
          const int rowc = idx >> 5, i = idx & 31, b = rowc >> 11, key = rowc & 2047;
          const GAS float* src = (const GAS float*)ckr + (size_t)rowc * 64;
          GAS unsigned* dst = (GAS unsigned*)(KALL + ((size_t)b * 2304 + key) * 640);
          dst[256 + i] = pk2(src[i], src[i + 32]); dst[288 + i] = 0u; }
      for (int idx = tg; idx < 32 * 240 * 320; idx += NT_) { const int rz = idx / 320, w = idx - rz * 320, b = rz / 240, key = 2064 + (rz - b * 240);
          ((GAS unsigned*)(KALL + ((size_t)b * 2304 + key) * 640))[w] = 0u; }
    }
    { LAS float* scr = (LAS float*)(F.lds + RING_OFF + F.wave * 16384);
      TR_LOOP(32 * 512, vt_job(cck, VT, KALL, it));
      for (int r = gw; r < 32 * 512; r += NGW) { GAS unsigned* dst = (GAS unsigned*)(VT + (size_t)r * 2304 + 2064); dst[lane] = 0u; if (lane < 56) dst[64 + lane] = 0u; }
    }
}

__device__ __forceinline__ void qlat_rope_copy(Frame& F) {
    frame_lanes(F);
    const bf16* Q = (const bf16*)(F.ws + WS_Q); bf16* QL = (bf16*)(F.ws + WS_QLAT);
    for (int idx = (F.vcu * NWAVES + F.wave) * 64 + F.lane; idx < 8192 * 16; idx += F.G * NWAVES * 64) {
        const int row = idx >> 4, ch = idx & 15, b = row >> 8, h = (row >> 4) & 15, qi = row & 15;
        v4u v = (v4u){0u, 0u, 0u, 0u};
        if (ch < 8) v = *(const GAS v4u*)(Q + (size_t)(TP + b * 16 + qi) * 3072 + h * 192 + 128 + ch * 8);
        *(GAS v4u*)(QL + (size_t)row * 640 + 512 + ch * 8) = v;
    }
}

__device__ __forceinline__ void softmax_phase(Frame& F) {
    frame_lanes(F);
    const float* S = (const float*)(F.ws + WS_S); bf16* P = (bf16*)(F.ws + WS_P);
    const int gw = F.vcu * NWAVES + F.wave, NGW = F.G * NWAVES, lane = F.lane;
    constexpr float C = att::SCALE * 1.4426950408889634f;
    for (int row = gw; row < 8192; row += NGW) {
        f32x4 v[9]; float mx = -1e30f;
#pragma unroll
        for (int j = 0; j < 9; ++j) { const int c = lane * 4 + 256 * j; v[j] = *(const GAS f32x4*)(S + (size_t)row * 2304 + c);
            if (c >= 2064) v[j] = (f32x4){-1e30f, -1e30f, -1e30f, -1e30f};
            mx = fmaxf(mx, fmaxf(fmaxf(v[j].x, v[j].y), fmaxf(v[j].z, v[j].w))); }
        mx = wave_max(mx, lane); float sum = 0.f;
#pragma unroll
        for (int j = 0; j < 9; ++j) { const int c = lane * 4 + 256 * j;
            v[j].x = __builtin_amdgcn_exp2f((v[j].x - mx) * C); v[j].y = __builtin_amdgcn_exp2f((v[j].y - mx) * C); v[j].z = __builtin_amdgcn_exp2f((v[j].z - mx) * C); v[j].w = __builtin_amdgcn_exp2f((v[j].w - mx) * C);
            if (c >= 2064) v[j] = (f32x4){0.f, 0.f, 0.f, 0.f};
            sum += (v[j].x + v[j].y) + (v[j].z + v[j].w); }
        const float inv = 1.0f / wave_sum(sum, lane);
#pragma unroll
        for (int j = 0; j < 9; ++j) { const int c = lane * 4 + 256 * j; v2u w; w.x = pk2(v[j].x * inv, v[j].y * inv); w.y = pk2(v[j].z * inv, v[j].w * inv); *(GAS v2u*)(P + (size_t)row * 2304 + c) = w; }
    }
}

template <int G> __device__ __forceinline__ void pool_group_prompt(const bf16* X, const GAS float* RS, bf16* Dd, const float* g0, int t0, int s0, int lane) {
    constexpr int W = 2 << G, H = W - 1;
    const int c = G * 512 + lane * 8;
    const bool hv = s0 > 0;
    const int rrow = t0 - 15 + lane; const float rsv = (lane < 31 && rrow >= 0) ? RS[rrow] : 0.f;
    v4u x[H + 16];
#pragma unroll
    for (int r = 0; r < H + 16; ++r) { x[r] = (v4u){0u, 0u, 0u, 0u}; if (r >= H || hv) x[r] = *(const GAS v4u*)(X + (size_t)(t0 - H + r) * DM + c); }
    const f32x4 ga = *(const GAS f32x4*)(g0 + c), gb = *(const GAS f32x4*)(g0 + c + 4);
    float S[8];
#pragma unroll
    for (int e = 0; e < 8; ++e) S[e] = 0.f;
#define PD_ROWF(v, rs, f) do { f[0] = bflo(v.x) * rs; f[1] = bfhi(v.x) * rs; f[2] = bflo(v.y) * rs; f[3] = bfhi(v.y) * rs; f[4] = bflo(v.z) * rs; f[5] = bfhi(v.z) * rs; f[6] = bflo(v.w) * rs; f[7] = bfhi(v.w) * rs; } while (0)
#pragma unroll
    for (int r = 0; r < H; ++r) { const float rs = __builtin_bit_cast(float, __builtin_amdgcn_readlane(__builtin_bit_cast(int, rsv), 15 - H + r)); float f[8]; PD_ROWF(x[r], rs, f);
#pragma unroll
        for (int e = 0; e < 8; ++e) S[e] += f[e]; }
#pragma unroll
    for (int i = 0; i < 16; ++i) {
        const float rs = __builtin_bit_cast(float, __builtin_amdgcn_readlane(__builtin_bit_cast(int, rsv), 15 + i)); float f[8]; PD_ROWF(x[H + i], rs, f);
#pragma unroll
        for (int e = 0; e < 8; ++e) S[e] += f[e];
        const int s = s0 + i; const float ic = 1.0f / (float)((s + 1) < W ? (s + 1) : W);
        v4u o; o.x = pk2((S[0] * ic - f[0]) * ga.x, (S[1] * ic - f[1]) * ga.y); o.y = pk2((S[2] * ic - f[2]) * ga.z, (S[3] * ic - f[3]) * ga.w);
        o.z = pk2((S[4] * ic - f[4]) * gb.x, (S[5] * ic - f[5]) * gb.y); o.w = pk2((S[6] * ic - f[6]) * gb.z, (S[7] * ic - f[7]) * gb.w);
        *(GAS v4u*)(Dd + (size_t)(t0 + i) * DM + c) = o;
        { const float rl = __builtin_bit_cast(float, __builtin_amdgcn_readlane(__builtin_bit_cast(int, rsv), 15 - H + i)); float fl[8]; PD_ROWF(x[i], rl, fl);
#pragma unroll
          for (int e = 0; e < 8; ++e) S[e] -= fl[e]; }
    }
#undef PD_ROWF
}
__device__ __forceinline__ void pool_d_phase(Frame& F, int j, const float* g0) {
    frame_lanes(F);
    const bf16* X = (const bf16*)(F.ws + WS_XB); bf16* Dd = (bf16*)(F.ws + WS_ACT); const GAS float* RS = (const GAS float*)(F.ws + WS_RS);
    const float* hist = inp(F, 4) + (size_t)j * 32 * 15 * DM;
    const int gw = F.vcu * NWAVES + F.wave, NGW = F.G * NWAVES, lane = F.lane;
    for (int ch = gw; ch < TP / 16; ch += NGW) {
        const int t0 = ch * 16, s0 = t0 & (SEQ - 1);
        pool_group_prompt<0>(X, RS, Dd, g0, t0, s0, lane); pool_group_prompt<1>(X, RS, Dd, g0, t0, s0, lane);
        pool_group_prompt<2>(X, RS, Dd, g0, t0, s0, lane); pool_group_prompt<3>(X, RS, Dd, g0, t0, s0, lane);
    }
    for (int row = TP + gw; row < T; row += NGW) {
        const int s = (row - TP) & 15; const int sb = (row - TP) >> 4;
#pragma unroll
        for (int g = 0; g < 4; ++g) {
            const int w = 2 << g, c = g * 512 + lane * 8;
            const f32x4 ga = *(const GAS f32x4*)(g0 + c), gb = *(const GAS f32x4*)(g0 + c + 4);
            const float gg[8] = {ga.x, ga.y, ga.z, ga.w, gb.x, gb.y, gb.z, gb.w};
            float acc[8], self[8];
#pragma unroll
            for (int e = 0; e < 8; ++e) { acc[e] = 0.f; self[e] = 0.f; }
            for (int k = 0; k < w; ++k) {
                const int sk = s - k;
                if (sk >= 0) { const v4u v = *(const GAS v4u*)(X + (size_t)(row - k) * DM + c); const float r = RS[row - k];
                    const float f[8] = {bflo(v.x), bfhi(v.x), bflo(v.y), bfhi(v.y), bflo(v.z), bfhi(v.z), bflo(v.w), bfhi(v.w)};
#pragma unroll
                    for (int e = 0; e < 8; ++e) { const float hv = f[e] * r * gg[e]; acc[e] += hv; if (k == 0) self[e] = hv; } }
                else { const float* hp = hist + ((size_t)sb * 15 + (15 + sk)) * DM + c; const f32x4 u0 = *(const GAS f32x4*)hp, u1 = *(const GAS f32x4*)(hp + 4);
                    acc[0] += u0.x; acc[1] += u0.y; acc[2] += u0.z; acc[3] += u0.w; acc[4] += u1.x; acc[5] += u1.y; acc[6] += u1.z; acc[7] += u1.w; }
            }
            const float ic = 1.0f / (float)w;
            v4u o; o.x = pk2(acc[0] * ic - self[0], acc[1] * ic - self[1]); o.y = pk2(acc[2] * ic - self[2], acc[3] * ic - self[3]);
            o.z = pk2(acc[4] * ic - self[4], acc[5] * ic - self[5]); o.w = pk2(acc[6] * ic - self[6], acc[7] * ic - self[7]);
            *(GAS v4u*)(Dd + (size_t)row * DM + c) = o;
        }
    }
}

__device__ __forceinline__ void fix_phase(Frame& F, int L) {
    frame_lanes(F);
    const bf16* BF = (const bf16*)(F.ws + WS_BND); const bf16* BL = BF + (size_t)512 * 2 * NUP;
    const float* cw = inp(F, 18) + (size_t)L * 3 * NUP; const float* cb = inp(F, 19) + (size_t)L * NUP;
    bf16* act = (bf16*)(F.ws + WS_ACT);
    for (int idx = (F.vcu * NWAVES + F.wave) * 64 + F.lane; idx < 512 * 2 * 704; idx += F.G * NWAVES * 64) {
        const int cc = idx % 704, sj = idx / 704, s = sj >> 1, jr = sj & 1;
        const int jg = cc * 8, np = (jg >> 7) * 256 + (jg & 127);
        const bool seq0 = (s & 63) == 0;
        float u0[2][8], u1[2][8], u2[2][8];
#pragma unroll
        for (int gv = 0; gv < 2; ++gv) {
            const v4u zero = (v4u){0u, 0u, 0u, 0u};
            const v4u cur = *(const GAS v4u*)(BF + (size_t)(s * 2 + jr) * NUP + np + gv * 128);
            const v4u f0 = *(const GAS v4u*)(BF + (size_t)(s * 2) * NUP + np + gv * 128);
            const v4u l0 = seq0 ? zero : *(const GAS v4u*)(BL + (size_t)((s - 1) * 2) * NUP + np + gv * 128);
            const v4u l1 = seq0 ? zero : *(const GAS v4u*)(BL + (size_t)((s - 1) * 2 + 1) * NUP + np + gv * 128);
            const v4u p1 = jr ? f0 : l1, p2 = jr ? l1 : l0;
            const unsigned cu[4] = {cur.x, cur.y, cur.z, cur.w}, a1[4] = {p1.x, p1.y, p1.z, p1.w}, a2[4] = {p2.x, p2.y, p2.z, p2.w};
#pragma unroll
            for (int e = 0; e < 4; ++e) { u0[gv][2 * e] = bflo(cu[e]); u0[gv][2 * e + 1] = bfhi(cu[e]); u1[gv][2 * e] = bflo(a1[e]); u1[gv][2 * e + 1] = bfhi(a1[e]); u2[gv][2 * e] = bflo(a2[e]); u2[gv][2 * e + 1] = bfhi(a2[e]); }
        }
        float r[8];
#pragma unroll
        for (int e = 0; e < 8; ++e) {
            const int cg = jg + e, cv = DFF + jg + e;
            const GAS float* cwg = (const GAS float*)cw; const GAS float* cbg = (const GAS float*)cb;
            const float g = cbg[cg] + cwg[cg] * u2[0][e] + cwg[NUP + cg] * u1[0][e] + cwg[2 * NUP + cg] * u0[0][e];
            const float v = cbg[cv] + cwg[cv] * u2[1][e] + cwg[NUP + cv] * u1[1][e] + cwg[2 * NUP + cv] * u0[1][e];
            r[e] = pg8::silu_mul(g, v);
        }
        v4u o; o.x = pk2(r[0], r[1]); o.y = pk2(r[2], r[3]); o.z = pk2(r[4], r[5]); o.w = pk2(r[6], r[7]);
        *(GAS v4u*)(act + (size_t)(s * 64 + jr) * DFF + jg) = o;
    }
}

__device__ __forceinline__ void attn_phase(Frame& F) {
    frame_lanes(F);
    const bf16* Q = (const bf16*)(F.ws + WS_Q); const bf16* KV = (const bf16*)(F.ws + WS_KV); const bf16* KRB = (const bf16*)(F.ws + WS_KRB); bf16* O = (bf16*)(F.ws + WS_HB);
    for (int pi = F.vcu; pi < 1024; pi += F.G) {
        const int bh = pi >> 3, s = pi & 7, b = bh >> 4, h = bh & 15;
#pragma unroll 1
        for (int half = 0; half < 2; ++half) {
            const int qb = half ? 15 - s : s;
            const size_t row0 = (size_t)b * SEQ;
            att::attn_unit(Q + (row0 + 256 * qb) * 3072 + h * 192, KV + row0 * 4096 + h * 128, KV + row0 * 4096 + 2048 + h * 128, KRB + row0 * 64,
                           O + (row0 + 256 * qb) * DM + h * 128, 4 * qb + 4, qb, (ATT_LAS char*)(F.lds + RING_OFF));
        }
    }
}

struct Args { const float* in[21]; float* out; unsigned char* ws; int ph_lo, ph_hi; };
constexpr int NPH = 1 + 4 * 16;
#ifndef PG8_ALIGN
#define PG8_ALIGN true
#endif
__global__ void __launch_bounds__(NWAVES * 64, 2) fwd_kernel(Args args) {
    extern __shared__ __attribute__((aligned(16))) unsigned char lds[];
    Frame F;
    F.lds = (LAS unsigned char*)lds;
    F.tid = threadIdx.x; F.lane = F.tid & 63; F.wave = __builtin_amdgcn_readfirstlane(F.tid >> 6);
    F.G = gridDim.x; { const int bx = blockIdx.x; F.vcu = (F.G % 8 == 0) ? (bx % 8) * (F.G / 8) + bx / 8 : bx; }
    F.out = args.out; F.ws = args.ws;
    unsigned* ctl = (unsigned*)(F.ws + WS_CTL);
    for (int u = F.tid; u < (LDS_BYTES - LDSCTL_OFF) / 4; u += NWAVES * 64) ((LAS unsigned*)(F.lds + LDSCTL_OFF))[u] = 0u;
    __syncthreads();
    if (F.tid == 0) {
#pragma unroll
        for (int i = 0; i < 21; ++i) ((LAS unsigned long long*)(F.lds + PTR_OFF))[i] = (unsigned long long)args.in[i];
    }
    __syncthreads();
    const int lo = args.ph_lo, hi = args.ph_hi;
    const bool one_launch = (hi - lo) > 1;
    XcdBarrier bar; bar.bar = ctl + CW_BAR; bar.x = 0; bar.st = nullptr;
    if (one_launch) bar = xcd_barrier_post(ctl + CW_BAR, (volatile LAS unsigned*)(F.lds + MISC_OFF) + 8);
#ifndef PH_MASK
#define PH_MASK 0x1ffffu
#endif
#define IN(k) (lo <= (k) && (k) < hi)
#define EN(p) (((PH_MASK) >> (p)) & 1u)
#ifndef DBL_MASK
#define DBL_MASK 0u
#endif
#define REPS(p) ((int)(((DBL_MASK) >> (p)) & 1u) + 1)
#define SEAM(k) do { if (IN((k) + 1)) { xcd_barrier(bar); if (REPS(17) > 1) xcd_barrier(bar); } } while (0)
    const int bid = (int)blockIdx.x;

    if (EN(16) && IN(0)) { for (int rep_ = 0; rep_ < REPS(16); ++rep_) { if (rep_) xcd_barrier(bar); p0_prologue(F); convert_ffn(F, 0); norm0_phase(F); } SEAM(0); }

    for (int L = 0; L < 4; ++L) {
        const int base = 1 + 16 * L, j = L >> 1;
        const float* ng = inp(F, 6) + (size_t)L * 4 * DM;
        if ((L & 1) == 0) {
            unsigned char* wb = F.ws + WS_W + j * W_MLA;
            if (EN(0) && IN(base + 0)) { for (int rep_ = 0; rep_ < REPS(0); ++rep_) { if (rep_) xcd_barrier(bar); frame_lanes(F); LAS unsigned char* ring = F.lds + RING_OFF;  pg8::SchedPlain S; S.init(130, 5, F.G, bid); S.A = (const char*)(F.ws + WS_XB); S.B = (const char*)(wb + WO_DQKV); S.lda = 2048; S.ldb = 2048; S.K = 2048;
                pg8::EpiF32 E{(float*)(F.ws + WS_MB), 1280}; pg8::gemm_phase<pg8::EpiF32, pg8::SchedPlain, PG8_ALIGN>(ring, S, E);  } SEAM(base + 0); }
            if (EN(1) && IN(base + 1)) { for (int rep_ = 0; rep_ < REPS(1); ++rep_) { if (rep_) xcd_barrier(bar); frame_lanes(F); LAS unsigned char* ring = F.lds + RING_OFF;  s1_phase(F, j);  } SEAM(base + 1); }
            if (EN(2) && IN(base + 2)) { for (int rep_ = 0; rep_ < REPS(2); ++rep_) { if (rep_) xcd_barrier(bar); frame_lanes(F); LAS unsigned char* ring = F.lds + RING_OFF;  pg8::SchedPlain S; S.init(130, 12, F.G, bid); S.A = (const char*)(F.ws + WS_CQ); S.B = (const char*)(wb + WO_UQ); S.lda = 512; S.ldb = 512; S.K = 512;
                pg8::EpiQRope E{(bf16*)(F.ws + WS_Q), (const float*)(F.ws + WS_ROPE), (const float*)(F.ws + WS_ROPE) + 4096 * 32};
                pg8::gemm_phase<pg8::EpiQRope, pg8::SchedPlain, PG8_ALIGN>(ring, S, E);  } SEAM(base + 2); }
            if (EN(3) && IN(base + 3)) { for (int rep_ = 0; rep_ < REPS(3); ++rep_) { if (rep_) xcd_barrier(bar); frame_lanes(F); LAS unsigned char* ring = F.lds + RING_OFF;  qlat_rope_copy(F);
                pg8::SchedQlat S; S.init(32, 2, F.G, bid); S.A = (const char*)(F.ws + WS_Q) + (size_t)TP * 3072 * 2; S.B = (const char*)(wb + WO_UK2); S.lda = 3072; S.ldb = 256; S.K = 256;
                pg8::EpiB<1> E{(bf16*)(F.ws + WS_QLAT), 640, nullptr}; pg8::gemm_phase<pg8::EpiB<1>, pg8::SchedQlat, PG8_ALIGN>(ring, S, E);  } SEAM(base + 3); }
            if (EN(4) && IN(base + 4)) { for (int rep_ = 0; rep_ < REPS(4); ++rep_) { if (rep_) xcd_barrier(bar); frame_lanes(F); LAS unsigned char* ring = F.lds + RING_OFF;  pg8::SchedBatch S; S.init(32, 9, F.G, bid); S.A = (const char*)(F.ws + WS_QLAT); S.B = (const char*)(F.ws + WS_KALL); S.lda = 640; S.ldb = 640; S.K = 640; S.b_pm = (size_t)2304 * 640 * 2;
                pg8::EpiF32 E{(float*)(F.ws + WS_S), 2304}; pg8::gemm_phase<pg8::EpiF32, pg8::SchedBatch, PG8_ALIGN>(ring, S, E);  } SEAM(base + 4); }
            if (EN(5) && IN(base + 5)) { for (int rep_ = 0; rep_ < REPS(5); ++rep_) { if (rep_) xcd_barrier(bar); frame_lanes(F); LAS unsigned char* ring = F.lds + RING_OFF;  softmax_phase(F);  } SEAM(base + 5); }
            if (EN(6) && IN(base + 6)) { for (int rep_ = 0; rep_ < REPS(6); ++rep_) { if (rep_) xcd_barrier(bar); frame_lanes(F); LAS unsigned char* ring = F.lds + RING_OFF;  pg8::SchedBatch S; S.init(32, 2, F.G, bid); S.A = (const char*)(F.ws + WS_P); S.B = (const char*)(F.ws + WS_VT); S.lda = 2304; S.ldb = 2304; S.K = 2304; S.b_pm = (size_t)512 * 2304 * 2;
                pg8::EpiB<2> E{(bf16*)(F.ws + WS_OL), 512, nullptr}; pg8::gemm_phase<pg8::EpiB<2>, pg8::SchedBatch, PG8_ALIGN>(ring, S, E);  } SEAM(base + 6); }
            if (EN(7) && IN(base + 7)) { for (int rep_ = 0; rep_ < REPS(7); ++rep_) { if (rep_) xcd_barrier(bar); frame_lanes(F); LAS unsigned char* ring = F.lds + RING_OFF;  pg8::SchedOV S; S.init(32, 1, F.G, bid); S.A = (const char*)(F.ws + WS_OL); S.B = (const char*)(wb + WO_UKV) + (size_t)2048 * 512 * 2; S.lda = 512; S.ldb = 512; S.K = 512;
                pg8::EpiB<3> E{(bf16*)(F.ws + WS_HB), 2048, nullptr}; pg8::gemm_phase<pg8::EpiB<3>, pg8::SchedOV, PG8_ALIGN>(ring, S, E);  } SEAM(base + 7); }
            if (EN(8) && IN(base + 8)) { for (int rep_ = 0; rep_ < REPS(8); ++rep_) { if (rep_) xcd_barrier(bar); frame_lanes(F); LAS unsigned char* ring = F.lds + RING_OFF;  pg8::SchedPlain S; S.init(128, 16, F.G, bid); S.A = (const char*)(F.ws + WS_CKVB); S.B = (const char*)(wb + WO_UKV); S.lda = 512; S.ldb = 512; S.K = 512;
                pg8::EpiB<0> E{(bf16*)(F.ws + WS_KV), 4096, nullptr}; pg8::gemm_phase<pg8::EpiB<0>, pg8::SchedPlain, PG8_ALIGN>(ring, S, E);  } SEAM(base + 8); }
            if (EN(9) && IN(base + 9)) { for (int rep_ = 0; rep_ < REPS(9); ++rep_) { if (rep_) xcd_barrier(bar); frame_lanes(F); LAS unsigned char* ring = F.lds + RING_OFF;  attn_phase(F);  } SEAM(base + 9); }
            if (EN(10) && IN(base + 10)) { for (int rep_ = 0; rep_ < REPS(10); ++rep_) { if (rep_) xcd_barrier(bar); frame_lanes(F); LAS unsigned char* ring = F.lds + RING_OFF;  pg8::SchedPlain S; S.init(128, 8, F.G, bid); S.A = (const char*)(F.ws + WS_HB); S.B = (const char*)(wb + WO_O); S.lda = 2048; S.ldb = 2048; S.K = 2048;
                pg8::EpiB<0> E{(bf16*)(F.ws + WS_MB), 2048, nullptr}; pg8::gemm_phase<pg8::EpiB<0>, pg8::SchedPlain, PG8_ALIGN>(ring, S, E);
                { pg8::SchedSplit S2; S2.init(2 * 4, 8, F.G, bid); S2.A = (const char*)(F.ws + WS_HB) + (size_t)TP * 2048 * 2; S2.B = (const char*)(wb + WO_O); S2.lda = 2048; S2.ldb = 2048; S2.K = 512;
                  pg8::EpiSlab E2{(float*)(F.ws + WS_SLAB)}; pg8::gemm_phase<pg8::EpiSlab, pg8::SchedSplit, PG8_ALIGN>(ring, S2, E2); }  } SEAM(base + 10); }
        } else {
            if (EN(9) && IN(base + 9)) { for (int rep_ = 0; rep_ < REPS(18); ++rep_) { if (rep_) xcd_barrier(bar); frame_lanes(F); LAS unsigned char* ring = F.lds + RING_OFF;  pool_d_phase(F, j, ng);  } SEAM(base + 9); }
            if (EN(10) && IN(base + 10)) { for (int rep_ = 0; rep_ < REPS(10); ++rep_) { if (rep_) xcd_barrier(bar); frame_lanes(F); LAS unsigned char* ring = F.lds + RING_OFF;  pg8::SchedPool S; S.init(130, 8, F.G, bid); S.A = (const char*)(F.ws + WS_ACT); S.B = (const char*)(F.ws + WS_WPOOL + (size_t)j * 2 * MiB); S.lda = 2048; S.ldb = 512; S.K = 512;
                pg8::EpiB<0> E{(bf16*)(F.ws + WS_MB), 2048, inp(F, 16) + (size_t)j * DM}; pg8::gemm_phase<pg8::EpiB<0>, pg8::SchedPool, PG8_ALIGN>(ring, S, E);  } SEAM(base + 10); }
        }
        unsigned char* wf = F.ws + WS_WFFN;
        if (EN(11) && IN(base + 11)) { for (int rep_ = 0; rep_ < REPS(11); ++rep_) { if (rep_) xcd_barrier(bar); frame_lanes(F); LAS unsigned char* ring = F.lds + RING_OFF;  const int nsb = (L & 1) ? 0 : 4; const bool dry = rep_ + 1 < REPS(11); norm_phase<false, false>(F, (const bf16*)(F.ws + WS_MB), (const float*)(F.ws + WS_SLAB), nsb, ng + DM, nullptr, nullptr, nullptr, false, dry);  } SEAM(base + 11); }
        if (EN(12) && IN(base + 12)) { for (int rep_ = 0; rep_ < REPS(12); ++rep_) { if (rep_) xcd_barrier(bar); frame_lanes(F); LAS unsigned char* ring = F.lds + RING_OFF;
            { pg8::SchedPlain S; S.init(128, 44, F.G, bid); S.A = (const char*)(F.ws + WS_XB); S.B = (const char*)(wf + WO_UP); S.lda = 2048; S.ldb = 2048; S.K = 2048;
              pg8::EpiUpP E{(bf16*)(F.ws + WS_ACT), (bf16*)(F.ws + WS_BND), (bf16*)(F.ws + WS_BND) + (size_t)512 * 2 * NUP, inp(F, 18) + (size_t)L * 3 * NUP, inp(F, 19) + (size_t)L * NUP,
                             F.out + O_CONV_P + (size_t)L * 8 * 2 * NUP, (const float*)(F.ws + WS_RS)};
              pg8::gemm_phase<pg8::EpiUpP, pg8::SchedPlain, PG8_ALIGN>(ring, S, E); }
            { pg8::SchedPlainOff S; S.init(2, 44, F.G, bid); S.pm0 = 128; S.A = (const char*)(F.ws + WS_XB); S.B = (const char*)(wf + WO_UP); S.lda = 2048; S.ldb = 2048; S.K = 2048;
              pg8::EpiUpS E{(bf16*)(F.ws + WS_ACT), inp(F, 18) + (size_t)L * 3 * NUP, inp(F, 19) + (size_t)L * NUP, inp(F, 5) + (size_t)L * 32 * 2 * NUP, F.out + O_CONV_S + (size_t)L * 32 * 2 * NUP, (const float*)(F.ws + WS_RS)};
              pg8::gemm_phase<pg8::EpiUpS, pg8::SchedPlainOff, PG8_ALIGN>(ring, S, E); }
            } SEAM(base + 12); }
        if (EN(13) && IN(base + 13)) { for (int rep_ = 0; rep_ < REPS(13); ++rep_) { if (rep_) xcd_barrier(bar); frame_lanes(F); LAS unsigned char* ring = F.lds + RING_OFF;  fix_phase(F, L);  } SEAM(base + 13); }
        if (EN(14) && IN(base + 14)) { for (int rep_ = 0; rep_ < REPS(14); ++rep_) { if (rep_) xcd_barrier(bar); frame_lanes(F); LAS unsigned char* ring = F.lds + RING_OFF;  pg8::SchedPlain S; S.init(128, 8, F.G, bid); S.A = (const char*)(F.ws + WS_ACT); S.B = (const char*)(wf + WO_DOWN); S.lda = DFF; S.ldb = DFF; S.K = DFF;
            pg8::EpiB<0> E{(bf16*)(F.ws + WS_MB), 2048, nullptr}; pg8::gemm_phase<pg8::EpiB<0>, pg8::SchedPlain, PG8_ALIGN>(ring, S, E);
            { pg8::SchedSplit S2; S2.init(2 * 11, 8, F.G, bid); S2.A = (const char*)(F.ws + WS_ACT) + (size_t)TP * DFF * 2; S2.B = (const char*)(wf + WO_DOWN); S2.lda = DFF; S2.ldb = DFF; S2.K = 512;
              pg8::EpiSlab E2{(float*)(F.ws + WS_SLAB)}; pg8::gemm_phase<pg8::EpiSlab, pg8::SchedSplit, PG8_ALIGN>(ring, S2, E2); }  } SEAM(base + 14); }
        if (EN(15) && IN(base + 15)) {
            const bool poison = one_launch && xb_ld(ctl + CW_BAR + XB_TMO) != 0u;
            frame_lanes(F);
            if (L < 3) convert_ffn(F, L + 1);
            const float* slab = (const float*)(F.ws + WS_SLAB);
            if (L == 3) norm_phase<true, false>(F, (const bf16*)(F.ws + WS_MB), slab, 11, ng + 3 * DM, nullptr, nullptr, nullptr, poison);
            else if ((L & 1) == 0) norm_phase<false, true>(F, (const bf16*)(F.ws + WS_MB), slab, 11, ng + 3 * DM, ng + 4 * DM, F.out + O_POOL_P + (size_t)j * 8 * 15 * DM, F.out + O_POOL_S + (size_t)j * 32 * 15 * DM, false);
            else norm_phase<false, false>(F, (const bf16*)(F.ws + WS_MB), slab, 11, ng + 3 * DM, nullptr, nullptr, nullptr, false);
            if (L < 3) SEAM(base + 15);
        }
    }
#undef IN
#undef SEAM
}

#ifndef MK_PER_PHASE
#define MK_PER_PHASE 0
#endif
extern "C" void kernel_launch(void* const* d_in, const int* in_sizes, int n_in, void* d_out, int out_size, void* d_ws, size_t ws_size, hipStream_t stream) {
    static int grid = 0;
    if (grid == 0) {
        if (n_in != 21 || (size_t)out_size != O_END || ws_size < WS_END) { fprintf(stderr, "kernel_launch: unexpected problem shape (n_in %d, out %d, ws %zu < %zu); nothing launched\n", n_in, out_size, ws_size, (size_t)WS_END); grid = -1; return; }
        int dev = 0, cus = 0, per_cu = 0;
        if (hipGetDevice(&dev) != hipSuccess || hipDeviceGetAttribute(&cus, hipDeviceAttributeMultiprocessorCount, dev) != hipSuccess) { grid = -1; return; }
        if (hipFuncSetAttribute((const void*)fwd_kernel, hipFuncAttributeMaxDynamicSharedMemorySize, LDS_BYTES) != hipSuccess) { fprintf(stderr, "kernel_launch: hipFuncSetAttribute failed\n"); grid = -1; return; }
        if (hipOccupancyMaxActiveBlocksPerMultiprocessor(&per_cu, (const void*)fwd_kernel, NWAVES * 64, LDS_BYTES) != hipSuccess || per_cu < 1) { fprintf(stderr, "kernel_launch: occupancy query says %d blocks per CU\n", per_cu); }
        (void)hipGetLastError();
        grid = cus;
    }
    if (grid < 0) return;
    (void)hipMemsetAsync((char*)d_ws + WS_CTL, 0, CTL_ZERO_BYTES, stream);
    Args a{};
    for (int i = 0; i < 21; ++i) a.in[i] = (const float*)d_in[i];
    a.out = (float*)d_out; a.ws = (unsigned char*)d_ws;
#if MK_PER_PHASE
    for (int p = 0; p < NPH; ++p) {
        if (p >= 1) { const int L = (p - 1) >> 4, q = (p - 1) & 15; if ((L & 1) && q < 9) continue; }
        a.ph_lo = p; a.ph_hi = p + 1;
        hipLaunchKernelGGL(fwd_kernel, dim3(grid), dim3(NWAVES * 64), LDS_BYTES, stream, a);
    }
#else
    a.ph_lo = 0; a.ph_hi = NPH;
    hipLaunchKernelGGL(fwd_kernel, dim3(grid), dim3(NWAVES * 64), LDS_BYTES, stream, a);
#endif
}
```

```cpp
#define DBL_MASK 0u
#ifndef MK_PER_PHASE
#define MK_PER_PHASE 0
#endif
#include <hip/hip_runtime.h>
#include <cstdio>
#include <cstdint>
namespace pg8 {
#define PG8_LAS __attribute__((address_space(3)))
#define PG8_GAS __attribute__((address_space(1)))
typedef unsigned short bf16_t;
typedef short bf16x8 __attribute__((ext_vector_type(8)));
typedef float f32x4 __attribute__((ext_vector_type(4)));
typedef unsigned u32x4 __attribute__((ext_vector_type(4)));
typedef unsigned u32x2 __attribute__((ext_vector_type(2)));
constexpr int BM = 256, BK = 64, HALF = 128, HTB = HALF * BK * 2  , STAGE_BYTES = 8 * HTB, NXCD = 8, WGM = 8;

__host__ __device__ __forceinline__ int lds_byte(int r, int c) { const int st = (r >> 4) * 2 + (c >> 5), rr = r & 15, cc = c & 31, ob = rr * 64 + cc * 2; return st * 1024 + (ob ^ (((ob >> 9) & 1) << 5)); }
__host__ __device__ __forceinline__ void stage_rc(int b, int& R, int& C) { const int st = b / 1024, sb = b % 1024, swz = sb ^ (((sb >> 9) & 1) << 5); R = (st >> 1) * 16 + swz / 64; C = (st & 1) * 32 + (swz % 64) / 2; }
__host__ __device__ __forceinline__ int perm32(int rho) { const int n = rho >> 4, i = rho & 15; return 8 * (i >> 2) + 4 * n + (i & 3); }

struct Unit { int pm, pn; };

struct OrderBase {
    int nM, nN, nwg, G, c;
    __device__ __forceinline__ void init(int nM_, int nN_, int G_, int c_) { nM = nM_; nN = nN_; nwg = nM * nN; G = G_; c = c_; }
    __device__ __forceinline__ bool next(int i, Unit& u) const {
        const long L = (long)i * G + c; if (L >= nwg) return false;
        int wgid = (int)L; { const int q = nwg / NXCD, r = nwg % NXCD, xcd = wgid % NXCD, off = wgid / NXCD; wgid = (xcd < r ? xcd * (q + 1) : r * (q + 1) + (xcd - r) * q) + off; }
        const int nig = WGM * nN, gid = wgid / nig, fm = gid * WGM, gsz = (nM - fm) < WGM ? (nM - fm) : WGM;
        u.pm = fm + ((wgid % nig) % gsz); u.pn = (wgid % nig) / gsz; return true;
    }
    __device__ __forceinline__ void a_ready(const Unit&) const {}
    __device__ __forceinline__ void done(const Unit&) const {}
};
struct SchedPlain : OrderBase {
    const char* A; const char* B; int lda, ldb, K;
    __device__ __forceinline__ const char* a_ptr(const Unit& u) const { return A + (size_t)u.pm * 256 * lda * 2; }
    __device__ __forceinline__ const char* b_ptr(const Unit& u) const { return B + (size_t)u.pn * 256 * ldb * 2; }
};
struct SchedPlainOff : OrderBase {
    const char* A; const char* B; int lda, ldb, K, pm0;
    __device__ __forceinline__ bool next(int i, Unit& u) const { const bool r = OrderBase::next(i, u); u.pm += pm0; return r; }
    __device__ __forceinline__ const char* a_ptr(const Unit& u) const { return A + (size_t)u.pm * 256 * lda * 2; }
    __device__ __forceinline__ const char* b_ptr(const Unit& u) const { return B + (size_t)u.pn * 256 * ldb * 2; }
};
struct SchedBatch : OrderBase {
    const char* A; const char* B; int lda, ldb, K; size_t b_pm;
    __device__ __forceinline__ const char* a_ptr(const Unit& u) const { return A + (size_t)u.pm * 256 * lda * 2; }
    __device__ __forceinline__ const char* b_ptr(const Unit& u) const { return B + (size_t)u.pm * b_pm + (size_t)u.pn * 256 * ldb * 2; }
};
struct SchedQlat : OrderBase {
    const char* A; const char* B; int lda, ldb, K;
    __device__ __forceinline__ const char* a_ptr(const Unit& u) const { return A + ((size_t)(u.pm & 1) * 256 * lda + (size_t)(u.pm >> 1) * 192) * 2; }
    __device__ __forceinline__ const char* b_ptr(const Unit& u) const { return B + ((size_t)(u.pm >> 1) * 512 + (size_t)u.pn * 256) * ldb * 2; }
};
struct SchedOV : OrderBase {
    const char* A; const char* B; int lda, ldb, K;
    __device__ __forceinline__ const char* a_ptr(const Unit& u) const { return A + (size_t)u.pm * 256 * lda * 2; }
    __device__ __forceinline__ const char* b_ptr(const Unit& u) const { return B + (size_t)(u.pm >> 2) * 256 * ldb * 2; }
};
struct SchedPool : OrderBase {
    const char* A; const char* B; int lda, ldb, K;
    __device__ __forceinline__ const char* a_ptr(const Unit& u) const { return A + ((size_t)u.pm * 256 * lda + (size_t)(u.pn >> 1) * 512) * 2; }
    __device__ __forceinline__ const char* b_ptr(const Unit& u) const { return B + (size_t)u.pn * 256 * ldb * 2; }
};

struct SchedSplit : OrderBase {
    const char* A; const char* B; int lda, ldb, K;
    __device__ __forceinline__ const char* a_ptr(const Unit& u) const { return A + ((size_t)(u.pm & 1) * 256 * lda + (size_t)(u.pm >> 1) * K) * 2; }
    __device__ __forceinline__ const char* b_ptr(const Unit& u) const { return B + ((size_t)u.pn * 256 * ldb + (size_t)(u.pm >> 1) * K) * 2; }
};

__device__ __forceinline__ unsigned cvt_pk_bf16(float lo, float hi) { unsigned r; asm volatile("v_cvt_pk_bf16_f32 %0, %1, %2" : "=v"(r) : "v"(lo), "v"(hi)); return r; }

struct EpiF32 {
    static constexpr bool PERM = false, APERM = false, AFTER_DRAIN = false; static constexpr int NST = 32;
    float* C; int ldc;
    __device__ __forceinline__ void operator()(const f32x4 (&acc)[2][2][4][2], const Unit& u, int wr, int wc, int fr, int fq) const {
        const int row0 = u.pm * BM + wr * 64 + fr, col0 = u.pn * BM + wc * 32 + 4 * fq;
#pragma unroll
        for (int ai = 0; ai < 2; ++ai)
#pragma unroll
            for (int m = 0; m < 4; ++m) { float* rowp = C + (size_t)(row0 + ai * HALF + m * 16) * ldc + col0;
#pragma unroll
                for (int bj = 0; bj < 2; ++bj)
#pragma unroll
                    for (int n = 0; n < 2; ++n) *(PG8_GAS f32x4*)(rowp + bj * HALF + n * 16) = acc[ai][bj][m][n]; }
    }
};
struct EpiSlab {
    static constexpr bool PERM = true, APERM = false, AFTER_DRAIN = false; static constexpr int NST = 16;
    bf16_t* C;
    __device__ __forceinline__ void operator()(const f32x4 (&acc)[2][2][4][2], const Unit& u, int wr, int wc, int fr, int fq) const {
        bf16_t* base = C + ((size_t)(u.pm >> 1) * 512 + (u.pm & 1) * 256 + wr * 64 + fr) * 2048 + u.pn * BM + wc * 32 + 8 * fq;
#pragma unroll
        for (int ai = 0; ai < 2; ++ai)
#pragma unroll
            for (int m = 0; m < 4; ++m) { bf16_t* rowp = base + (size_t)(ai * HALF + m * 16) * 2048;
#pragma unroll
                for (int bj = 0; bj < 2; ++bj) { const f32x4 v0 = acc[ai][bj][m][0], v1 = acc[ai][bj][m][1];
                    u32x4 w; w.x = cvt_pk_bf16(v0[0], v0[1]); w.y = cvt_pk_bf16(v0[2], v0[3]); w.z = cvt_pk_bf16(v1[0], v1[1]); w.w = cvt_pk_bf16(v1[2], v1[3]);
                    *(PG8_GAS u32x4*)(rowp + bj * HALF) = w; } }
    }
};
template <int MODE> struct EpiB {
    static constexpr bool PERM = true, APERM = false, AFTER_DRAIN = false; static constexpr int NST = MODE == 3 ? 8 : 16;
    bf16_t* O; int ldc; const float* scale; const float* rsc;
    __device__ __forceinline__ void operator()(const f32x4 (&acc)[2][2][4][2], const Unit& u, int wr, int wc, int fr, int fq) const {
        f32x4 sv[2][2]; float rrow[2][4];
        if (MODE == 4) {
#pragma unroll
            for (int ai = 0; ai < 2; ++ai)
#pragma unroll
                for (int m = 0; m < 4; ++m) rrow[ai][m] = ((const PG8_GAS float*)rsc)[u.pm * BM + ai * HALF + wr * 64 + m * 16 + fr];
        }
        if (MODE == 0 || MODE == 4) {
#pragma unroll
            for (int bj = 0; bj < 2; ++bj)
#pragma unroll
                for (int n = 0; n < 2; ++n) sv[bj][n] = scale ? *(const PG8_GAS f32x4*)(scale + u.pn * BM + bj * HALF + wc * 32 + 8 * fq + 4 * n) : (f32x4){1.f, 1.f, 1.f, 1.f};
        }
#pragma unroll
        for (int ai = 0; ai < 2; ++ai)
#pragma unroll
            for (int m = 0; m < 4; ++m) {
                const int r = ai * HALF + wr * 64 + m * 16 + fr;
#pragma unroll
                for (int bj = 0; bj < 2; ++bj) {
                    const int c = bj * HALF + wc * 32 + 8 * fq;
                    bf16_t* p;
                    if (MODE == 0 || MODE == 4) p = O + (size_t)(u.pm * BM + r) * ldc + u.pn * BM + c;
                    else if (MODE == 1) { const int tok = 256 * (u.pm & 1) + r; p = O + (size_t)((tok >> 4) * 256 + (u.pm >> 1) * 16 + (tok & 15)) * 640 + u.pn * BM + c; }
                    else if (MODE == 2) { p = O + (size_t)((r >> 4) * 512 + 16 * u.pm + (r & 15)) * 512 + u.pn * BM + c; }
                    else { const int tok = 256 * (u.pm & 1) + r; p = O + (size_t)(32768 + tok) * 2048 + (u.pm >> 1) * 128 + (c & 127); }
                    if (MODE == 3 && bj != ((u.pm >> 1) & 1)) continue;
                    f32x4 v0 = acc[ai][bj][m][0], v1 = acc[ai][bj][m][1];
                    if (MODE == 0) { v0 = v0 * sv[bj][0]; v1 = v1 * sv[bj][1]; }
                    if (MODE == 4) { v0 = v0 * sv[bj][0] * rrow[ai][m]; v1 = v1 * sv[bj][1] * rrow[ai][m]; }
                    u32x4 w; w.x = cvt_pk_bf16(v0[0], v0[1]); w.y = cvt_pk_bf16(v0[2], v0[3]); w.z = cvt_pk_bf16(v1[0], v1[1]); w.w = cvt_pk_bf16(v1[2], v1[3]);
                    *(PG8_GAS u32x4*)p = w;
                }
            }
    }
};
struct EpiQRope {
    static constexpr bool PERM = true, APERM = false, AFTER_DRAIN = false; static constexpr int NST = 16;
    bf16_t* O; const float* ctab; const float* stab;
    __device__ __forceinline__ void operator()(const f32x4 (&acc)[2][2][4][2], const Unit& u, int wr, int wc, int fr, int fq) const {
        const int k0 = (u.pn * 8 + wc) % 6, k1 = (u.pn * 8 + 4 + wc) % 6;
        const int rbj = k0 >= 4 ? 0 : (k1 >= 4 ? 1 : -1);
        const int i0 = (((rbj == 0 ? k0 : k1) - 4) * 32 + 8 * fq) >> 1;
        f32x4 cs[2][4], sn[2][4];
        if (rbj >= 0) {
#pragma unroll
            for (int ai = 0; ai < 2; ++ai)
#pragma unroll
                for (int m = 0; m < 4; ++m) { const int t = u.pm * BM + ai * HALF + wr * 64 + m * 16 + fr; const int pos = t < 32768 ? (t & 4095) : 2048 + ((t - 32768) & 15);
                    cs[ai][m] = *(const PG8_GAS f32x4*)(ctab + pos * 32 + i0); sn[ai][m] = *(const PG8_GAS f32x4*)(stab + pos * 32 + i0); }
        }
#pragma unroll
        for (int bj = 0; bj < 2; ++bj) {
            const int c = u.pn * BM + bj * HALF + wc * 32 + 8 * fq;
            const bool rope = rbj == bj;
#pragma unroll
            for (int ai = 0; ai < 2; ++ai)
#pragma unroll
                for (int m = 0; m < 4; ++m) {
                    const int t = u.pm * BM + ai * HALF + wr * 64 + m * 16 + fr;
                    f32x4 v0 = acc[ai][bj][m][0], v1 = acc[ai][bj][m][1];
                    if (rope) {
                        const f32x4 c4 = cs[ai][m], s4 = sn[ai][m];
                        const float a0 = v0[0], b0 = v0[1], a1 = v0[2], b1 = v0[3], a2 = v1[0], b2 = v1[1], a3 = v1[2], b3 = v1[3];
                        v0[0] = a0 * c4[0] - b0 * s4[0]; v0[1] = a0 * s4[0] + b0 * c4[0];
                        v0[2] = a1 * c4[1] - b1 * s4[1]; v0[3] = a1 * s4[1] + b1 * c4[1];
                        v1[0] = a2 * c4[2] - b2 * s4[2]; v1[1] = a2 * s4[2] + b2 * c4[2];
                        v1[2] = a3 * c4[3] - b3 * s4[3]; v1[3] = a3 * s4[3] + b3 * c4[3];
                    }
                    u32x4 w; w.x = cvt_pk_bf16(v0[0], v0[1]); w.y = cvt_pk_bf16(v0[2], v0[3]); w.z = cvt_pk_bf16(v1[0], v1[1]); w.w = cvt_pk_bf16(v1[2], v1[3]);
                    *(PG8_GAS u32x4*)(O + (size_t)t * 3072 + c) = w;
                }
        }
    }
};
template <int CTRL> __device__ __forceinline__ float dppf(float x) { return __builtin_bit_cast(float, __builtin_amdgcn_update_dpp(0, __builtin_bit_cast(int, x), CTRL, 0xf, 0xf, false)); }
__device__ __forceinline__ f32x4 ror1(f32x4 x) { return (f32x4){dppf<0x121>(x[0]), dppf<0x121>(x[1]), dppf<0x121>(x[2]), dppf<0x121>(x[3])}; }
__device__ __forceinline__ f32x4 ror2(f32x4 x) { return (f32x4){dppf<0x122>(x[0]), dppf<0x122>(x[1]), dppf<0x122>(x[2]), dppf<0x122>(x[3])}; }
__device__ __forceinline__ f32x4 sel4(bool c, f32x4 a, f32x4 b) { return (f32x4){c ? a[0] : b[0], c ? a[1] : b[1], c ? a[2] : b[2], c ? a[3] : b[3]}; }
__device__ __forceinline__ float silu_mul(float g, float v) { const float e = __builtin_amdgcn_exp2f(g * -1.4426950408889634f); return g * __builtin_amdgcn_rcpf(1.0f + e) * v; }
__device__ __forceinline__ f32x4 silu_mul4s(f32x4 gs, f32x4 vs) {
    f32x4 e; e[0] = __builtin_amdgcn_exp2f(gs[0]); e[1] = __builtin_amdgcn_exp2f(gs[1]); e[2] = __builtin_amdgcn_exp2f(gs[2]); e[3] = __builtin_amdgcn_exp2f(gs[3]);
    const f32x4 d = e + 1.0f; const f32x4 p = gs * vs;
    f32x4 r; r[0] = __builtin_amdgcn_rcpf(d[0]); r[1] = __builtin_amdgcn_rcpf(d[1]); r[2] = __builtin_amdgcn_rcpf(d[2]); r[3] = __builtin_amdgcn_rcpf(d[3]);
    return p * r;
}
template <int CTRL> __device__ __forceinline__ float dpp_old(float old, float x) { return __builtin_bit_cast(float, __builtin_amdgcn_update_dpp(__builtin_bit_cast(int, old), __builtin_bit_cast(int, x), CTRL, 0xf, 0xf, false)); }
template <int CTRL> __device__ __forceinline__ float dpp_z(float x) { return __builtin_bit_cast(float, __builtin_amdgcn_update_dpp(0, __builtin_bit_cast(int, x), CTRL, 0xf, 0xf, true)); }
__device__ __forceinline__ f32x4 shr1_z(f32x4 x) { return (f32x4){dpp_z<0x111>(x[0]), dpp_z<0x111>(x[1]), dpp_z<0x111>(x[2]), dpp_z<0x111>(x[3])}; }
__device__ __forceinline__ f32x4 shr1_old(f32x4 old, f32x4 x) { return (f32x4){dpp_old<0x111>(old[0], x[0]), dpp_old<0x111>(old[1], x[1]), dpp_old<0x111>(old[2], x[2]), dpp_old<0x111>(old[3], x[3])}; }
struct EpiUpP {
    static constexpr bool PERM = true, APERM = true, AFTER_DRAIN = false; static constexpr int NST = 24;
    bf16_t* act; bf16_t* bnd_first; bf16_t* bnd_last; const float* cw; const float* cb; float* oconv_p; const float* rs;
    __device__ __forceinline__ void operator()(const f32x4 (&acc)[2][2][4][2], const Unit& u, int wr, int wc, int fr, int fq) const {
        const int colh = wc * 32 + 8 * fq, jg = u.pn * 128 + colh, np = u.pn * 256 + colh;
        const bool first = fr == 0, edge = fr == 0 || fr == 15;
        u32x2 stash[2][4], bst[2][4];
        const f32x4 zero4 = (f32x4){0.f, 0.f, 0.f, 0.f};
        f32x4 r4a[2];
#pragma unroll
        for (int ai = 0; ai < 2; ++ai) r4a[ai] = *(const PG8_GAS f32x4*)(rs + u.pm * BM + ai * HALF + wr * 64 + 4 * fr);
#pragma unroll
        for (int n = 0; n < 2; ++n) {
            const int jc = jg + 4 * n;
            constexpr float KG = -1.4426950408889634f, KV = -0.6931471805599453f;
            const f32x4 w0g = *(const PG8_GAS f32x4*)(cw + jc) * KG, w1g = *(const PG8_GAS f32x4*)(cw + 11264 + jc) * KG, w2g = *(const PG8_GAS f32x4*)(cw + 2 * 11264 + jc) * KG, bg = *(const PG8_GAS f32x4*)(cb + jc) * KG;
            const f32x4 w0v = *(const PG8_GAS f32x4*)(cw + 5632 + jc) * KV, w1v = *(const PG8_GAS f32x4*)(cw + 11264 + 5632 + jc) * KV, w2v = *(const PG8_GAS f32x4*)(cw + 2 * 11264 + 5632 + jc) * KV, bv = *(const PG8_GAS f32x4*)(cb + 5632 + jc) * KV;
#pragma unroll
            for (int ai = 0; ai < 2; ++ai) {
                const int strip = u.pm * 4 + ai * 2 + wr;
                const f32x4 r4 = r4a[ai];
                const f32x4 xg0 = acc[ai][0][0][n] * r4[0], xg1 = acc[ai][0][1][n] * r4[1], xg2 = acc[ai][0][2][n] * r4[2], xg3 = acc[ai][0][3][n] * r4[3];
                const f32x4 xv0 = acc[ai][1][0][n] * r4[0], xv1 = acc[ai][1][1][n] * r4[1], xv2 = acc[ai][1][2][n] * r4[2], xv3 = acc[ai][1][3][n] * r4[3];
                const f32x4 pg3 = shr1_z(xg3), pg2 = shr1_z(xg2), pv3 = shr1_z(xv3), pv2 = shr1_z(xv2);
                const f32x4 ga = first ? xg0 : xg2, gb = first ? xg1 : xg3, va = first ? xv0 : xv2, vb = first ? xv1 : xv3;
                u32x2 ba, bb, bc, bd; ba.x = cvt_pk_bf16(ga[0], ga[1]); ba.y = cvt_pk_bf16(ga[2], ga[3]); bb.x = cvt_pk_bf16(va[0], va[1]); bb.y = cvt_pk_bf16(va[2], va[3]);
                bc.x = cvt_pk_bf16(gb[0], gb[1]); bc.y = cvt_pk_bf16(gb[2], gb[3]); bd.x = cvt_pk_bf16(vb[0], vb[1]); bd.y = cvt_pk_bf16(vb[2], vb[3]);
                if (fr == 15 && (strip & 63) == 63) { float* op = oconv_p + (size_t)((strip >> 6) * 2) * 11264 + jc;
                    *(PG8_GAS f32x4*)op = xg2; *(PG8_GAS f32x4*)(op + 5632) = xv2; *(PG8_GAS f32x4*)(op + 11264) = xg3; *(PG8_GAS f32x4*)(op + 11264 + 5632) = xv3; }
                const f32x4 cg0 = bg + w0g * pg2 + w1g * pg3 + w2g * xg0, cv0 = bv + w0v * pv2 + w1v * pv3 + w2v * xv0;
                const f32x4 cg1 = bg + w0g * pg3 + w1g * xg0 + w2g * xg1, cv1 = bv + w0v * pv3 + w1v * xv0 + w2v * xv1;
                const f32x4 cg2 = bg + w0g * xg0 + w1g * xg1 + w2g * xg2, cv2 = bv + w0v * xv0 + w1v * xv1 + w2v * xv2;
                const f32x4 cg3 = bg + w0g * xg1 + w1g * xg2 + w2g * xg3, cv3 = bv + w0v * xv1 + w1v * xv2 + w2v * xv3;
                const f32x4 cgs[4] = {cg0, cg1, cg2, cg3}, cvs[4] = {cv0, cv1, cv2, cv3};
                if (n == 0) { bst[ai][0] = ba; bst[ai][1] = bb; bst[ai][2] = bc; bst[ai][3] = bd; }
#pragma unroll
                for (int m = 0; m < 4; ++m) {
                    const f32x4 sm = silu_mul4s(cgs[m], cvs[m]); u32x2 pk; pk.x = cvt_pk_bf16(sm[0], sm[1]); pk.y = cvt_pk_bf16(sm[2], sm[3]);
                    if (n == 0) stash[ai][m] = pk;
                    else if (m >= 2 || fr != 0) { const int t = u.pm * BM + ai * HALF + wr * 64 + 4 * fr + m;
                        u32x4 w; w.x = stash[ai][m].x; w.y = stash[ai][m].y; w.z = pk.x; w.w = pk.y; *(PG8_GAS u32x4*)(act + (size_t)t * 5632 + jg) = w; }
                }
                if (n == 1 && edge) { bf16_t* bp = (first ? bnd_first : bnd_last) + (size_t)(strip * 2) * 11264 + np;
                    u32x4 w; w.x = bst[ai][0].x; w.y = bst[ai][0].y; w.z = ba.x; w.w = ba.y; *(PG8_GAS u32x4*)bp = w;
                    w.x = bst[ai][1].x; w.y = bst[ai][1].y; w.z = bb.x; w.w = bb.y; *(PG8_GAS u32x4*)(bp + 128) = w;
                    w.x = bst[ai][2].x; w.y = bst[ai][2].y; w.z = bc.x; w.w = bc.y; *(PG8_GAS u32x4*)(bp + 11264) = w;
                    w.x = bst[ai][3].x; w.y = bst[ai][3].y; w.z = bd.x; w.w = bd.y; *(PG8_GAS u32x4*)(bp + 11264 + 128) = w; }
            }
        }
    }
};
struct EpiUpS {
    static constexpr bool PERM = true, APERM = true, AFTER_DRAIN = false; static constexpr int NST = 24;
    bf16_t* act; const float* cw; const float* cb; const float* hist; float* oconv_s; const float* rs;
    __device__ __forceinline__ void operator()(const f32x4 (&acc)[2][2][4][2], const Unit& u, int wr, int wc, int fr, int fq) const {
        const int colh = wc * 32 + 8 * fq, jg = u.pn * 128 + colh;
        u32x2 stash[2][4];
        const f32x4 zero4 = (f32x4){0.f, 0.f, 0.f, 0.f};
#pragma unroll
        for (int n = 0; n < 2; ++n) {
            const int jc = jg + 4 * n;
            const f32x4 w0g = *(const PG8_GAS f32x4*)(cw + jc), w1g = *(const PG8_GAS f32x4*)(cw + 11264 + jc), w2g = *(const PG8_GAS f32x4*)(cw + 2 * 11264 + jc), bg = *(const PG8_GAS f32x4*)(cb + jc);
            const f32x4 w0v = *(const PG8_GAS f32x4*)(cw + 5632 + jc), w1v = *(const PG8_GAS f32x4*)(cw + 11264 + 5632 + jc), w2v = *(const PG8_GAS f32x4*)(cw + 2 * 11264 + 5632 + jc), bv = *(const PG8_GAS f32x4*)(cb + 5632 + jc);
#pragma unroll
            for (int ai = 0; ai < 2; ++ai) {
                const f32x4 r4 = *(const PG8_GAS f32x4*)(rs + u.pm * BM + ai * HALF + wr * 64 + 4 * fr);
                const f32x4 xg0 = acc[ai][0][0][n] * r4[0], xg1 = acc[ai][0][1][n] * r4[1], xg2 = acc[ai][0][2][n] * r4[2], xg3 = acc[ai][0][3][n] * r4[3];
                const f32x4 xv0 = acc[ai][1][0][n] * r4[0], xv1 = acc[ai][1][1][n] * r4[1], xv2 = acc[ai][1][2][n] * r4[2], xv3 = acc[ai][1][3][n] * r4[3];
                f32x4 pg3 = shr1_old(zero4, xg3), pg2 = shr1_old(zero4, xg2), pv3 = shr1_old(zero4, xv3), pv2 = shr1_old(zero4, xv2);
                const int sb = (u.pm - 128) * 16 + ai * 8 + wr * 4 + (fr >> 2);
                if ((fr & 3) == 0) { const float* hp = hist + (size_t)sb * 2 * 11264 + jc;
                    pg2 = *(const PG8_GAS f32x4*)(hp); pg3 = *(const PG8_GAS f32x4*)(hp + 11264); pv2 = *(const PG8_GAS f32x4*)(hp + 5632); pv3 = *(const PG8_GAS f32x4*)(hp + 11264 + 5632); }
                if ((fr & 3) == 3) { float* op = oconv_s + (size_t)(sb * 2) * 11264 + jc; *(PG8_GAS f32x4*)op = xg2; *(PG8_GAS f32x4*)(op + 5632) = xv2; *(PG8_GAS f32x4*)(op + 11264) = xg3; *(PG8_GAS f32x4*)(op + 11264 + 5632) = xv3; }
                const f32x4 cg0 = bg + w0g * pg2 + w1g * pg3 + w2g * xg0, cv0 = bv + w0v * pv2 + w1v * pv3 + w2v * xv0;
                const f32x4 cg1 = bg + w0g * pg3 + w1g * xg0 + w2g * xg1, cv1 = bv + w0v * pv3 + w1v * xv0 + w2v * xv1;
                const f32x4 cg2 = bg + w0g * xg0 + w1g * xg1 + w2g * xg2, cv2 = bv + w0v * xv0 + w1v * xv1 + w2v * xv2;
                const f32x4 cg3 = bg + w0g * xg1 + w1g * xg2 + w2g * xg3, cv3 = bv + w0v * xv1 + w1v * xv2 + w2v * xv3;
                const f32x4 cgs[4] = {cg0, cg1, cg2, cg3}, cvs[4] = {cv0, cv1, cv2, cv3};
#pragma unroll
                for (int m = 0; m < 4; ++m) {
                    u32x2 pk; pk.x = cvt_pk_bf16(silu_mul(cgs[m][0], cvs[m][0]), silu_mul(cgs[m][1], cvs[m][1])); pk.y = cvt_pk_bf16(silu_mul(cgs[m][2], cvs[m][2]), silu_mul(cgs[m][3], cvs[m][3]));
                    if (n == 0) stash[ai][m] = pk;
                    else { const int t = u.pm * BM + ai * HALF + wr * 64 + 4 * fr + m;
                        u32x4 w; w.x = stash[ai][m].x; w.y = stash[ai][m].y; w.z = pk.x; w.w = pk.y; *(PG8_GAS u32x4*)(act + (size_t)t * 5632 + jg) = w; }
                }
            }
        }
    }
};

template <class Epi, class Sched, bool ALIGN_EPI = true>
__device__ __forceinline__ void gemm_phase(PG8_LAS unsigned char* lds, const Sched& S, const Epi& E) {
    int tid_ = threadIdx.x; asm volatile("" : "+v"(tid_));
    const int tid = tid_, wid = __builtin_amdgcn_readfirstlane(tid >> 6), lane = tid & 63, wr = wid >> 2, wc = wid & 3, fr = lane & 15, fq = lane >> 4;
    const int K = S.K, nt = K / BK, lda = S.lda, ldb = S.ldb;
    unsigned voffA[2], voffB[2];
#pragma unroll
    for (int i = 0; i < 2; ++i) { int R, C; stage_rc(tid * 16 + i * 8192, R, C); const int Rb = Epi::PERM ? ((R & ~31) + perm32(R & 31)) : R;
        const int Ra = Epi::APERM ? ((R & ~63) + 4 * (R & 15) + ((R >> 4) & 3)) : R;
        voffA[i] = (unsigned)(Ra * lda + C) * 2u; voffB[i] = (unsigned)(Rb * ldb + C) * 2u; }
    const size_t kstep = (size_t)(BK * 2);
    const size_t hA = (size_t)HALF * lda * 2, hB = (size_t)HALF * ldb * 2;
    const unsigned ldsw = (unsigned)wid * 1024u;
    const int aoff = lds_byte(wr * 64 + fr, fq * 8), boff = lds_byte(wc * 32 + fr, fq * 8);
#define PG8_SA(b, h) (((b) * 2 + (h)) * HTB)
#define PG8_SB(b, h) ((4 + (b) * 2 + (h)) * HTB)
#define PG8_STAGE(bufoff, gbase, voff) do { _Pragma("unroll") for (int _i = 0; _i < 2; ++_i) \
        __builtin_amdgcn_global_load_lds((const unsigned*)((const char*)(gbase) + (voff)[_i]), (PG8_LAS unsigned*)(lds + (bufoff) + ldsw + _i * 8192), 16, 0, 0); } while (0)
#define PG8_LDA(dst, b, h) do { _Pragma("unroll") for (int m = 0; m < 4; ++m) _Pragma("unroll") for (int k = 0; k < 2; ++k) dst[m][k] = *(const PG8_LAS bf16x8*)(lds + PG8_SA(b, h) + aoff + m * 2048 + k * 1024); } while (0)
#define PG8_LDB(dst, b, h) do { _Pragma("unroll") for (int n = 0; n < 2; ++n) _Pragma("unroll") for (int k = 0; k < 2; ++k) dst[n][k] = *(const PG8_LAS bf16x8*)(lds + PG8_SB(b, h) + boff + n * 2048 + k * 1024); } while (0)
#define PG8_MMA(ai, bj, At, Bt) do { __builtin_amdgcn_s_setprio(1); _Pragma("unroll") for (int m = 0; m < 4; ++m) _Pragma("unroll") for (int n = 0; n < 2; ++n) _Pragma("unroll") for (int k = 0; k < 2; ++k) \
        acc[ai][bj][m][n] = __builtin_amdgcn_mfma_f32_16x16x32_bf16(Bt[n][k], At[m][k], acc[ai][bj][m][n], 0, 0, 0); __builtin_amdgcn_s_setprio(0); } while (0)
#define PG8_WAIT_V(n) asm volatile("s_waitcnt vmcnt(" #n ")" ::: "memory")
#define PG8_WAIT_L(n) asm volatile("s_waitcnt lgkmcnt(" #n ")" ::: "memory")
#define PG8_WAIT_V8R(rlx) asm volatile("s_cmp_eq_u32 %0, 0\n\ts_cbranch_scc1 .Lw8a%=\n\ts_waitcnt vmcnt(%1)\n\ts_branch .Lw8b%=\n.Lw8a%=:\n\ts_waitcnt vmcnt(8)\n.Lw8b%=:" :: "s"(rlx), "n"(8 + Epi::NST) : "memory", "scc")
#define PG8_BAR __builtin_amdgcn_s_barrier()
#define PG8_SCHED __builtin_amdgcn_sched_barrier(0)
    Unit cur, nxt; int ui = 0;
    if (!S.next(0, cur)) return;
    f32x4 acc[2][2][4][2];
#pragma unroll
    for (int a = 0; a < 2; ++a)
#pragma unroll
        for (int b = 0; b < 2; ++b)
#pragma unroll
            for (int m = 0; m < 4; ++m)
#pragma unroll
                for (int n = 0; n < 2; ++n) acc[a][b][m][n] = (f32x4){0.f, 0.f, 0.f, 0.f};
    bf16x8 At[4][2], B0[2][2], B1[2][2];
    const char* cA = S.a_ptr(cur); const char* cB = S.b_ptr(cur);
    S.a_ready(cur);
    PG8_STAGE(PG8_SB(0, 0), cB, voffB); PG8_STAGE(PG8_SB(0, 1), cB + hB, voffB); PG8_STAGE(PG8_SA(0, 0), cA, voffA); PG8_STAGE(PG8_SA(0, 1), cA + hA, voffA);
    if (wr == 1) PG8_BAR;
    PG8_WAIT_V(2); PG8_BAR;
    PG8_STAGE(PG8_SB(1, 0), cB + kstep, voffB); PG8_STAGE(PG8_SA(1, 0), cA + kstep, voffA); PG8_STAGE(PG8_SB(1, 1), cB + hB + kstep, voffB);
    PG8_WAIT_V(6); PG8_BAR;
    for (;;) {
        const bool has_next = S.next(ui + 1, nxt);
        const char* nA = has_next ? S.a_ptr(nxt) : cA; const char* nB = has_next ? S.b_ptr(nxt) : cB;
        for (int t = 0; t < nt; t += 2) {
            const bool last = (t == nt - 2);
            const char* a1 = cA + (size_t)(t + 1) * kstep;
            const char* a2 = last ? nA : cA + (size_t)(t + 2) * kstep; const char* b2 = last ? nB : cB + (size_t)(t + 2) * kstep;
            const char* a3 = a2 + kstep; const char* b3 = b2 + kstep;
            if (last && has_next) S.a_ready(nxt);
            const int relax = __builtin_amdgcn_readfirstlane((t == 0 && ui > 0) ? 1 : 0);
            PG8_LDB(B0, 0, 0); PG8_LDB(B1, 0, 1); PG8_SCHED; PG8_LDA(At, 0, 0); PG8_STAGE(PG8_SA(1, 1), a1 + hA, voffA);
            PG8_WAIT_V8R(relax); PG8_WAIT_L(0); PG8_BAR; PG8_MMA(0, 0, At, B0); PG8_MMA(0, 1, At, B1); PG8_BAR; PG8_SCHED;
            PG8_LDA(At, 0, 1); PG8_STAGE(PG8_SB(0, 0), b2, voffB); PG8_STAGE(PG8_SB(0, 1), b2 + hB, voffB); PG8_STAGE(PG8_SA(0, 0), a2, voffA);
            PG8_WAIT_V8R(relax); PG8_WAIT_L(0); PG8_BAR; PG8_MMA(1, 0, At, B0); PG8_MMA(1, 1, At, B1); PG8_BAR; PG8_SCHED;
            PG8_LDB(B0, 1, 0); PG8_LDB(B1, 1, 1); PG8_SCHED; PG8_LDA(At, 1, 0); PG8_STAGE(PG8_SA(0, 1), a2 + hA, voffA);
            PG8_WAIT_V(8); PG8_WAIT_L(0); PG8_BAR; PG8_MMA(0, 0, At, B0); PG8_MMA(0, 1, At, B1); PG8_BAR; PG8_SCHED;
            PG8_LDA(At, 1, 1); PG8_STAGE(PG8_SB(1, 0), b3, voffB); PG8_STAGE(PG8_SB(1, 1), b3 + hB, voffB); PG8_STAGE(PG8_SA(1, 0), a3, voffA);
            PG8_WAIT_V(8); PG8_WAIT_L(0); PG8_BAR; PG8_MMA(1, 0, At, B0); PG8_MMA(1, 1, At, B1); PG8_BAR; PG8_SCHED;
        }
        if constexpr (ALIGN_EPI) { if (wr == 0) PG8_BAR; }
        E(acc, cur, wr, wc, fr, fq); S.done(cur);
        if (!has_next) break;
#pragma unroll
        for (int a = 0; a < 2; ++a)
#pragma unroll
            for (int b = 0; b < 2; ++b)
#pragma unroll
                for (int m = 0; m < 4; ++m)
#pragma unroll
                    for (int n = 0; n < 2; ++n) acc[a][b][m][n] = (f32x4){0.f, 0.f, 0.f, 0.f};
        cur = nxt; cA = nA; cB = nB; ++ui;
        if constexpr (ALIGN_EPI) { if (wr == 1) PG8_BAR; }
    }
    PG8_WAIT_V(0);
    if constexpr (!ALIGN_EPI) { if (wr == 0) PG8_BAR; }
    PG8_BAR;
#undef PG8_SA
#undef PG8_SB
#undef PG8_STAGE
#undef PG8_LDA
#undef PG8_LDB
#undef PG8_MMA
#undef PG8_WAIT_V
#undef PG8_WAIT_L
#undef PG8_WAIT_V8R
#undef PG8_BAR
#undef PG8_SCHED
}
}
namespace att {
#define ATT_LAS __attribute__((address_space(3)))
typedef unsigned short bf16;
using bf16x8 = __attribute__((ext_vector_type(8))) short;
using s16x4  = __attribute__((ext_vector_type(4))) short;
using f32x16 = __attribute__((ext_vector_type(16))) float;
using u32x4  = __attribute__((ext_vector_type(4))) unsigned;
constexpr int NW = 8, QBLK = 32, KVBLK = 64;
constexpr float SCALE = 0.07216878364870322f;
constexpr float THR = 8.f;
constexpr int LDQ = 3072, LDKV = 4096, LDKR = 64, LDO = 2048;
constexpr int SHM_V = KVBLK * 128 * 2, SHM_K = KVBLK * 192 * 2, SHM_QR0 = 2 * SHM_V + 2 * SHM_K + NW * 64 * 4, SHM_ATTN = SHM_QR0 + NW * 4 * 64 * 16;
#define KSWZ(row, colB) ((row) * 384 + ((colB) ^ (((row) & 7) << 4)))
#define SBAR() __builtin_amdgcn_sched_barrier(0)
__device__ __forceinline__ int crow(int r, int hi) { return (r & 3) + 8 * (r >> 2) + 4 * hi; }
__device__ __forceinline__ unsigned cvtpk(float lo, float hi) { unsigned r; asm volatile("v_cvt_pk_bf16_f32 %0, %1, %2" : "=v"(r) : "v"(lo), "v"(hi)); return r; }
__device__ __forceinline__ __amdgpu_buffer_rsrc_t mk_rsrc(const void* p) {
  const unsigned long a = (unsigned long)p; const unsigned lo = __builtin_amdgcn_readfirstlane((unsigned)a), hi = __builtin_amdgcn_readfirstlane((unsigned)(a >> 32));
  return __builtin_amdgcn_make_buffer_rsrc((void*)(((unsigned long)hi << 32) | lo), (short)0, 0x7fffffff, 0x00020000);
}
__device__ __forceinline__ bf16x8 ld8(const bf16* p) { return *(const __attribute__((address_space(1))) bf16x8*)p; }

__device__ __forceinline__ void partialSM(f32x16& p0, f32x16& p1, float& m_reg, float& mn, float& alpha, bool dead) {
  constexpr float C = SCALE * 1.4426950408889634f;
  if (dead) {
#pragma unroll
    for (int r = 0; r < 16; ++r) { p0[r] = -__builtin_inff(); p1[r] = -__builtin_inff(); }
  }
  float pmax = p0[0];
#pragma unroll
  for (int r = 1; r < 16; ++r) pmax = fmaxf(pmax, p0[r]);
#pragma unroll
  for (int r = 0; r < 16; ++r) pmax = fmaxf(pmax, p1[r]);
  { auto rr = __builtin_amdgcn_permlane32_swap(__float_as_uint(pmax), __float_as_uint(pmax), false, false);
    pmax = fmaxf(__uint_as_float(rr[0]), __uint_as_float(rr[1])); }
  if (__builtin_expect(__all(pmax - m_reg <= THR / SCALE), 1)) { mn = m_reg; alpha = 1.f; }
  else { mn = fmaxf(m_reg, pmax); alpha = __builtin_amdgcn_exp2f((m_reg - mn) * C); m_reg = mn; }
  float mnC = -mn * C;
#pragma unroll
  for (int r = 0; r < 16; ++r) p0[r] = fmaf(p0[r], C, mnC);
#pragma unroll
  for (int r = 0; r < 16; ++r) p1[r] = fmaf(p1[r], C, mnC);
#pragma unroll
  for (int r = 0; r < 16; ++r) p0[r] = __builtin_amdgcn_exp2f(p0[r]);
}
__device__ __forceinline__ void finishSM(f32x16& p0, f32x16& p1, float alpha, float& l_reg, bf16x8& pa0, bf16x8& pa1, bf16x8& pa2, bf16x8& pa3) {
#pragma unroll
  for (int r = 0; r < 16; ++r) p1[r] = __builtin_amdgcn_exp2f(p1[r]);
  float ps = 0;
#pragma unroll
  for (int r = 0; r < 16; ++r) ps += p0[r];
#pragma unroll
  for (int r = 0; r < 16; ++r) ps += p1[r];
  { auto rr = __builtin_amdgcn_permlane32_swap(__float_as_uint(ps), __float_as_uint(ps), false, false);
    ps = __uint_as_float(rr[0]) + __uint_as_float(rr[1]); }
  l_reg = l_reg * alpha + ps;
#define PK4(P, BASE, OUT) do { unsigned a0 = cvtpk(P[BASE + 0], P[BASE + 1]), a1 = cvtpk(P[BASE + 2], P[BASE + 3]);   \
    unsigned b0 = cvtpk(P[BASE + 4], P[BASE + 5]), b1 = cvtpk(P[BASE + 6], P[BASE + 7]);                              \
    auto r0 = __builtin_amdgcn_permlane32_swap(a0, b0, false, false); auto r1 = __builtin_amdgcn_permlane32_swap(a1, b1, false, false); \
    u32x4 w = {r0[0], r1[0], r0[1], r1[1]}; OUT = *reinterpret_cast<bf16x8*>(&w); } while (0)
  PK4(p0, 0, pa0); PK4(p0, 8, pa1); PK4(p1, 0, pa2); PK4(p1, 8, pa3);
#undef PK4
}
__device__ __forceinline__ void qkt(f32x16& p0, f32x16& p1, const ATT_LAS char* Ks, const bf16x8* qr, const ATT_LAS char* qrl, int r32, int hi) {
  p0 = f32x16{}; p1 = f32x16{};
#pragma unroll
  for (int d0 = 0; d0 < 12; ++d0) { const int cb = (d0 * 16 + hi * 8) * 2;
    bf16x8 b0 = *reinterpret_cast<const ATT_LAS bf16x8*>(Ks + KSWZ(r32, cb));
    bf16x8 b1 = *reinterpret_cast<const ATT_LAS bf16x8*>(Ks + KSWZ(32 + r32, cb));
    const bf16x8 q = d0 < 8 ? qr[d0 < 8 ? d0 : 0] : *reinterpret_cast<const ATT_LAS bf16x8*>(qrl + (d0 - 8) * 1024);
    p0 = __builtin_amdgcn_mfma_f32_32x32x16_bf16(b0, q, p0, 0, 0, 0);
    p1 = __builtin_amdgcn_mfma_f32_32x32x16_bf16(b1, q, p1, 0, 0, 0); }
}
__device__ __forceinline__ int v_st(int k, int c) { const int kk = (k & ~0xC) | ((k & 4) << 1) | ((k & 8) >> 1); return ((kk >> 3) * 4 + (c >> 5)) * 512 + ((kk & 7) * 32 + (c & 31)) * 2; }
__device__ __forceinline__ int v_rd_base(int lane) { return ((lane & 3) << 3) | (((lane >> 2) & 3) << 6) | (((lane >> 4) & 1) << 5) | (((lane >> 5) & 1) << 8); }
constexpr int v_rd_off(int d0, int ks, int half) { return d0 * 512 + ks * 4096 + half * 2048; }
template <int OFF> __device__ __forceinline__ s16x4 tr_read(int vb) {
  s16x4 r; asm volatile("ds_read_b64_tr_b16 %0, %1 offset:%2" : "=&v"(r) : "v"(vb), "i"(OFF) : "memory"); return r;
}
template <int D0> __device__ __forceinline__ void pv_one(f32x16& od, int vb, bf16x8 pa0, bf16x8 pa1, bf16x8 pa2, bf16x8 pa3) {
  s16x4 l0 = tr_read<v_rd_off(D0, 0, 0)>(vb), h0 = tr_read<v_rd_off(D0, 0, 1)>(vb), l1 = tr_read<v_rd_off(D0, 1, 0)>(vb), h1 = tr_read<v_rd_off(D0, 1, 1)>(vb);
  s16x4 l2 = tr_read<v_rd_off(D0, 2, 0)>(vb), h2 = tr_read<v_rd_off(D0, 2, 1)>(vb), l3 = tr_read<v_rd_off(D0, 3, 0)>(vb), h3 = tr_read<v_rd_off(D0, 3, 1)>(vb);
  asm volatile("s_waitcnt lgkmcnt(0)" : "+v"(l0), "+v"(h0), "+v"(l1), "+v"(h1), "+v"(l2), "+v"(h2), "+v"(l3), "+v"(h3) :: "memory");
#define PK(L, H) (bf16x8){L[0], L[1], L[2], L[3], H[0], H[1], H[2], H[3]}
  od = __builtin_amdgcn_mfma_f32_32x32x16_bf16(pa0, PK(l0, h0), od, 0, 0, 0);
  od = __builtin_amdgcn_mfma_f32_32x32x16_bf16(pa1, PK(l1, h1), od, 0, 0, 0);
  od = __builtin_amdgcn_mfma_f32_32x32x16_bf16(pa2, PK(l2, h2), od, 0, 0, 0);
  od = __builtin_amdgcn_mfma_f32_32x32x16_bf16(pa3, PK(l3, h3), od, 0, 0, 0);
#undef PK
}
__device__ __forceinline__ void pv_d0(f32x16* o, int vb, bf16x8 pa0, bf16x8 pa1, bf16x8 pa2, bf16x8 pa3) {
  pv_one<0>(o[0], vb, pa0, pa1, pa2, pa3); pv_one<1>(o[1], vb, pa0, pa1, pa2, pa3); pv_one<2>(o[2], vb, pa0, pa1, pa2, pa3); pv_one<3>(o[3], vb, pa0, pa1, pa2, pa3);
}

__device__ __forceinline__ void attn_unit(const bf16* __restrict__ Qb, const bf16* __restrict__ Kh, const bf16* __restrict__ Vh, const bf16* __restrict__ KRh,
                                          bf16* __restrict__ Ob, int NT, int qb, ATT_LAS char* lds, unsigned* qctr, volatile ATT_LAS int* qslot) {
  int tid_ = threadIdx.x; asm volatile("" : "+v"(tid_));
  const int tid = tid_, wid = __builtin_amdgcn_readfirstlane(tid >> 6), lane = tid & 63, r32 = lane & 31, hi = lane >> 5;
  unsigned qnext = 0u; if (tid == 0) qnext = __hip_atomic_fetch_add((__attribute__((address_space(1))) unsigned*)qctr, 1u, __ATOMIC_RELAXED, __HIP_MEMORY_SCOPE_AGENT);
  const int lim = 4 * qb + (wid >> 1);
  ATT_LAS char* V_lds = lds; ATT_LAS char* K_lds = lds + 2 * SHM_V;
  ATT_LAS float* ws = (ATT_LAS float*)(lds + 2 * SHM_V + 2 * SHM_K) + wid * 64; ATT_LAS float* li_l = ws; ATT_LAS float* al_l = ws + 32;
  float m_reg = -1e30f, l_reg = 0; f32x16 o[4] = {}; bf16x8 qr[8];
  ATT_LAS char* qrl = lds + SHM_QR0 + wid * 4096 + lane * 16;
  const bf16* Qw = Qb + (long)(wid * QBLK + r32) * LDQ + hi * 8;
#pragma unroll
  for (int d0 = 0; d0 < 8; ++d0) qr[d0] = ld8(Qw + d0 * 16);
#pragma unroll
  for (int d0 = 8; d0 < 12; ++d0) *reinterpret_cast<ATT_LAS bf16x8*>(qrl + (d0 - 8) * 1024) = ld8(Qw + d0 * 16);
  const int sr = tid >> 4, sc = (tid & 15) * 8, vst0 = v_st(sr, sc), vst1 = v_st(32 + sr, sc);
  const int kr_row = tid >> 3, kr_c = (tid & 7) * 8;
  const int vb0 = (int)(unsigned)(unsigned long)V_lds + v_rd_base(lane);
  const __amdgpu_buffer_rsrc_t rsK = mk_rsrc(Kh), rsV = mk_rsrc(Vh), rsR = mk_rsrc(KRh);
  const unsigned vo0 = (unsigned)(sr * LDKV + sc) * 2u, vo1 = (unsigned)((32 + sr) * LDKV + sc) * 2u, vor = (unsigned)(kr_row * LDKR + kr_c) * 2u;
  struct { bf16x8 vs0, vs1, ks0, ks1, kr; } sr_[1];
#define SLOAD(i, k0) do { const int so_ = (k0) * (LDKV * 2), sr2_ = (k0) * (LDKR * 2); \
    sr_[i].vs0 = __builtin_bit_cast(bf16x8, __builtin_amdgcn_raw_buffer_load_b128(rsV, (int)vo0, so_, 0)); sr_[i].vs1 = __builtin_bit_cast(bf16x8, __builtin_amdgcn_raw_buffer_load_b128(rsV, (int)vo1, so_, 0)); \
    sr_[i].ks0 = __builtin_bit_cast(bf16x8, __builtin_amdgcn_raw_buffer_load_b128(rsK, (int)vo0, so_, 0)); sr_[i].ks1 = __builtin_bit_cast(bf16x8, __builtin_amdgcn_raw_buffer_load_b128(rsK, (int)vo1, so_, 0)); \
    sr_[i].kr = __builtin_bit_cast(bf16x8, __builtin_amdgcn_raw_buffer_load_b128(rsR, (int)vor, sr2_, 0)); } while (0)
#define SWRITE(b, i) do { *(ATT_LAS bf16x8*)(V_lds + (b) * SHM_V + vst0) = sr_[i].vs0;          \
    *(ATT_LAS bf16x8*)(V_lds + (b) * SHM_V + vst1) = sr_[i].vs1; const int kc = sc * 2;               \
    *(ATT_LAS bf16x8*)(K_lds + (b) * SHM_K + KSWZ(sr, kc)) = sr_[i].ks0;                       \
    *(ATT_LAS bf16x8*)(K_lds + (b) * SHM_K + KSWZ(32 + sr, kc)) = sr_[i].ks1;                  \
    *(ATT_LAS bf16x8*)(K_lds + (b) * SHM_K + KSWZ(kr_row, 256 + kr_c * 2)) = sr_[i].kr; } while (0)
#define SWAIT() asm volatile("s_waitcnt vmcnt(0)" ::: "memory")
#define RESC(a) do { if (__any((a) < 1.f)) { if (hi == 0) al_l[r32] = (a); asm volatile("s_waitcnt lgkmcnt(0)" ::: "memory"); \
    _Pragma("unroll") for (int d = 0; d < 4; ++d) _Pragma("unroll") for (int r = 0; r < 16; ++r) o[d][r] *= al_l[crow(r, hi)]; } } while (0)
  f32x16 pA0, pA1, pB0, pB1; float mnA, mnB, alA, alB; bf16x8 pa0, pa1, pa2, pa3;
  constexpr int SE = 0, SO = 0;
  SLOAD(SE, 0); asm volatile("s_waitcnt vmcnt(0)" ::: "memory"); if (tid == 0) *qslot = (int)qnext; SWRITE(0, SE); __syncthreads();
  qkt(pA0, pA1, K_lds, qr, qrl, r32, hi); partialSM(pA0, pA1, m_reg, mnA, alA, false);
  SLOAD(SO, KVBLK);
  SWAIT(); SWRITE(1, SO); __syncthreads();
  for (int j = 1; j + 1 < NT; j += 2) {
    SBAR(); qkt(pB0, pB1, K_lds + SHM_K, qr, qrl, r32, hi);
    finishSM(pA0, pA1, alA, l_reg, pa0, pa1, pa2, pa3); SBAR();
    SLOAD(SO, (j + 1) * KVBLK); SBAR();
    pv_d0(o, vb0, pa0, pa1, pa2, pa3); partialSM(pB0, pB1, m_reg, mnB, alB, j > lim);
    __syncthreads(); SWAIT(); SWRITE(0, SE);
    RESC(alB); __syncthreads();
    SBAR(); qkt(pA0, pA1, K_lds, qr, qrl, r32, hi);
    finishSM(pB0, pB1, alB, l_reg, pa0, pa1, pa2, pa3); SBAR();
    SLOAD(SE, (j + 2) * KVBLK); SBAR();
    pv_d0(o, vb0 + SHM_V, pa0, pa1, pa2, pa3); partialSM(pA0, pA1, m_reg, mnA, alA, j + 1 > lim);
    __syncthreads(); SWAIT(); SWRITE(1, SO);
    RESC(alA); __syncthreads();
  }
  SBAR(); qkt(pB0, pB1, K_lds + SHM_K, qr, qrl, r32, hi);
  finishSM(pA0, pA1, alA, l_reg, pa0, pa1, pa2, pa3); SBAR();
  pv_d0(o, vb0, pa0, pa1, pa2, pa3); partialSM(pB0, pB1, m_reg, mnB, alB, NT - 1 > lim);
  __syncthreads(); RESC(alB);
  finishSM(pB0, pB1, alB, l_reg, pa0, pa1, pa2, pa3); SBAR();
  pv_d0(o, vb0 + SHM_V, pa0, pa1, pa2, pa3);
  if (hi == 0) li_l[r32] = l_reg; asm volatile("s_waitcnt lgkmcnt(0)" ::: "memory");
  float rli[16];
#pragma unroll
  for (int r = 0; r < 16; ++r) rli[r] = __builtin_amdgcn_rcpf(li_l[crow(r, hi)]);
  bf16* Ow = Ob + (long)(wid * QBLK) * LDO;
  ATT_LAS char* ot = lds + SHM_QR0 + wid * 4096;
#pragma unroll
  for (int half = 0; half < 2; ++half) {
#pragma unroll
    for (int dl = 0; dl < 2; ++dl)
#pragma unroll
      for (int r = 0; r < 16; ++r) { const float v = o[half * 2 + dl][r] * rli[r]; const unsigned u = cvtpk(v, v);
        *(ATT_LAS unsigned short*)(ot + crow(r, hi) * 128 + (dl * 32 + r32) * 2) = (unsigned short)u; }
    asm volatile("s_waitcnt lgkmcnt(0)" ::: "memory");
    bf16x8 rowv[4];
#pragma unroll
    for (int q = 0; q < 4; ++q) rowv[q] = *(const ATT_LAS bf16x8*)(ot + (q * 8 + (lane >> 3)) * 128 + (lane & 7) * 16);
    asm volatile("s_waitcnt lgkmcnt(0)" ::: "memory");
#pragma unroll
    for (int q = 0; q < 4; ++q) *(__attribute__((address_space(1))) bf16x8*)(Ow + (long)(q * 8 + (lane >> 3)) * LDO + half * 64 + (lane & 7) * 8) = rowv[q];
  }
  __syncthreads();
#undef SLOAD
#undef SWRITE
#undef SWAIT
#undef RESC
}
#undef KSWZ
#undef SBAR
}
constexpr int NWAVES = 8;
constexpr int TP = 32768, TS = 512, T = TP + TS, DM = 2048, DFF = 5632, NUP = 2 * DFF, SEQ = 4096;
constexpr float EPS = 1e-6f;
static_assert((2048 + 16 - 1) / 64 == 2048 / 64, "all cache keys and new keys of a sample stream lie in chunks <= the query chunk: the chunk mask is all-true for the sample streams");
constexpr size_t O_Y = 0, O_CKV_P = O_Y + (size_t)T * DM, O_KR_P = O_CKV_P + (size_t)2 * TP * 512, O_POOL_P = O_KR_P + (size_t)2 * TP * 64, O_CONV_P = O_POOL_P + (size_t)2 * 8 * 15 * DM,
                 O_CKV_S = O_CONV_P + (size_t)4 * 8 * 2 * NUP, O_KR_S = O_CKV_S + (size_t)2 * TS * 512, O_POOL_S = O_KR_S + (size_t)2 * TS * 64, O_CONV_S = O_POOL_S + (size_t)2 * 32 * 15 * DM,
                 O_END = O_CONV_S + (size_t)4 * 32 * 2 * NUP;
static_assert(O_END == 112558080, "d_out size");
constexpr size_t MiB = 1u << 20;
constexpr size_t WS_CTL = 0, CTL_ZERO_BYTES = 1 * MiB;
constexpr size_t WS_ROPE = 1 * MiB;
constexpr size_t WS_RS = 2 * MiB;
constexpr size_t WS_W = 3 * MiB;
constexpr size_t W_MLA = 24 * MiB;
constexpr size_t WO_DQKV = 0, WO_UQ = 5 * MiB, WO_UKV = 8 * MiB, WO_UK2 = 12 * MiB, WO_O = 16 * MiB;
constexpr size_t WS_WPOOL = WS_W + 2 * W_MLA;
constexpr size_t WS_WFFN = WS_WPOOL + 4 * MiB, WO_UP = 0, WO_DOWN = 44 * MiB;
constexpr size_t WS_HB = WS_WFFN + 66 * MiB;
constexpr size_t WS_MB = WS_HB + 130 * MiB;
constexpr size_t WS_S = WS_MB, WS_P = WS_MB + 72 * MiB;
constexpr size_t WS_BND = WS_MB + 130 * MiB;
constexpr size_t WS_XB = WS_BND + 44 * MiB;
constexpr size_t WS_SLAB = WS_XB + 130 * MiB;
constexpr size_t WS_BIG = WS_SLAB + 44 * MiB;
constexpr size_t WS_ACT = WS_BIG;
constexpr size_t WS_Q = WS_BIG, WS_CQ = WS_BIG + 196 * MiB, WS_CKVB = WS_BIG + 229 * MiB, WS_KRB = WS_BIG + 261 * MiB, WS_KV = WS_BIG + 265 * MiB;
constexpr size_t WS_KALL = WS_KV + 256 * MiB, WS_VT = WS_KALL + 90 * MiB, WS_QLAT = WS_VT + 72 * MiB, WS_OL = WS_QLAT + 10 * MiB;
constexpr size_t WS_WPOOLH = WS_OL + 8 * MiB;
constexpr size_t WS_HS = WS_WPOOLH + 4 * MiB;
constexpr size_t WS_ZH = WS_HS + 4 * MiB;
constexpr size_t WS_END = WS_ZH + 2 * MiB;
static_assert(WS_HB == 121 * MiB && WS_END == 1310 * MiB, "ws map");
static_assert((size_t)T * 1280 * 4 <= 174 * MiB && (size_t)T * 5632 * 2 <= WS_END - WS_BIG && (size_t)T * 3072 * 2 + 4096 <= 196 * MiB && (size_t)11 * 512 * 2048 * 4 <= 44 * MiB, "ws aliases");
constexpr int CW_BAR = 4096, CW_SUB = 8192  , CW_Q = 8192 + 1024  ;

#define GAS __attribute__((address_space(1)))
#define LAS __attribute__((address_space(3)))
typedef unsigned short bf16;
typedef unsigned v4u __attribute__((ext_vector_type(4)));
typedef unsigned v2u __attribute__((ext_vector_type(2)));
typedef float f32x4 __attribute__((ext_vector_type(4)));
typedef short bf16x8 __attribute__((ext_vector_type(8)));
#define LDS_WAIT() asm volatile("s_waitcnt lgkmcnt(0)" ::: "memory")
#define VM_WAIT() asm volatile("s_waitcnt vmcnt(0)" ::: "memory")
__device__ __forceinline__ unsigned f2bf(float f) { unsigned u = __builtin_bit_cast(unsigned, f); return (u + 0x7fffu + ((u >> 16) & 1u)) >> 16; }
__device__ __forceinline__ unsigned pk2(float lo, float hi) { return f2bf(lo) | (f2bf(hi) << 16); }
__device__ __forceinline__ float bflo(unsigned w) { return __builtin_bit_cast(float, w << 16); }
__device__ __forceinline__ float bfhi(unsigned w) { return __builtin_bit_cast(float, w & 0xffff0000u); }

#define XB_TMO      128
#define XB_XCNT(j)  (256  + 64 * (j))
#define XB_XSUB(j)  (1280 + 64 * (j))
#define XB_XGEN(j)  (2304 + 64 * (j))
#define XB_TOP      3328
#define XB_TOPGEN   3392
#define XCD_BAR_WORDS 3456
#define XB_SPIN_CAP (1u << 18)
__device__ __forceinline__ unsigned xb_ld(unsigned* p)              { return __hip_atomic_load(p, __ATOMIC_RELAXED, __HIP_MEMORY_SCOPE_AGENT); }
__device__ __forceinline__ unsigned xb_add(unsigned* p, unsigned v) { return __hip_atomic_fetch_add(p, v, __ATOMIC_RELAXED, __HIP_MEMORY_SCOPE_AGENT); }
__device__ __forceinline__ unsigned xb_xcc_id() { return (unsigned)__builtin_amdgcn_s_getreg((3 << 11) | 20) & 0xFu; }
#define XB_SPIN(cond, bar) do { unsigned _sp = 0; while (cond) { __builtin_amdgcn_s_sleep(1); \
    if ((++_sp & 255u) == 0u) { if (xb_ld(&(bar)[XB_TMO])) break; if (_sp > XB_SPIN_CAP) { atomicAdd(&(bar)[XB_TMO], 1u); break; } } } } while (0)
struct XcdBarrier { unsigned* bar; unsigned x; volatile LAS unsigned* st; };
__device__ __forceinline__ XcdBarrier xcd_barrier_post(unsigned* bar, volatile LAS unsigned* st) {
    XcdBarrier b; b.bar = bar; b.x = xb_xcc_id(); b.st = st;
    if (threadIdx.x == 0) (void)xb_add(&bar[XB_XCNT(b.x)], 1u);
    return b;
}
__device__ __forceinline__ void xcd_barrier_complete(unsigned* bar, unsigned x, unsigned& nloc, unsigned& nx) {
    const unsigned G = gridDim.x * gridDim.y * gridDim.z;
    unsigned sum, cnt, mine, sp = 0u;
    for (;;) {
        sum = 0u; cnt = 0u; mine = 0u;
#pragma unroll
        for (unsigned j = 0; j < 16; ++j) { const unsigned c = xb_ld(&bar[XB_XCNT(j)]); sum += c; cnt += (c > 0u) ? 1u : 0u; mine = (j == x) ? c : mine; }
        if (sum == G) break;
        __builtin_amdgcn_s_sleep(1);
        if ((++sp & 255u) == 0u) { if (xb_ld(&bar[XB_TMO])) break; if (sp > XB_SPIN_CAP) { atomicAdd(&bar[XB_TMO], 1u); break; } }
    }
    nloc = mine > 0u ? mine : 1u; nx = cnt > 0u ? cnt : 1u;
}
__device__ __forceinline__ void xcd_barrier(const XcdBarrier& b) {
    asm volatile("s_waitcnt vmcnt(0)" ::: "memory");
    __syncthreads();
    if (threadIdx.x == 0) {
        unsigned* bar = b.bar;
        __builtin_amdgcn_s_waitcnt(0);
        unsigned nloc = b.st[0], nx = b.st[1];
        if (nloc == 0u) { xcd_barrier_complete(bar, b.x, nloc, nx); b.st[0] = nloc; b.st[1] = nx; }
        const unsigned old = xb_add(&bar[XB_XSUB(b.x)], 1u);
        const unsigned gen = old / nloc;
        if (old + 1u == (gen + 1u) * nloc) {
            __builtin_amdgcn_fence(__ATOMIC_RELEASE, "agent");
            asm volatile("s_waitcnt vmcnt(0)" ::: "memory");
            const unsigned og = xb_add(&bar[XB_TOP], 1u);
            const unsigned tg = og / nx;
            if (og + 1u == (tg + 1u) * nx) xb_add(&bar[XB_TOPGEN], 1u);
            else XB_SPIN(xb_ld(&bar[XB_TOPGEN]) == tg, bar);
            __builtin_amdgcn_fence(__ATOMIC_ACQUIRE, "agent");
            xb_add(&bar[XB_XGEN(b.x)], 1u);
            asm volatile("s_waitcnt vmcnt(0)" ::: "memory");
        } else {
            XB_SPIN(xb_ld(&bar[XB_XGEN(b.x)]) == gen, bar);
            __builtin_amdgcn_fence(__ATOMIC_ACQUIRE, "agent");
            asm volatile("s_waitcnt vmcnt(0)" ::: "memory");
        }
    }
    __syncthreads();
}

__device__ __forceinline__ void sub_barrier(unsigned* cnt, unsigned n, unsigned* bar) {
    asm volatile("s_waitcnt vmcnt(0)" ::: "memory");
    __syncthreads();
    if (threadIdx.x == 0) {
        __builtin_amdgcn_fence(__ATOMIC_RELEASE, "agent");
        asm volatile("s_waitcnt vmcnt(0)" ::: "memory");
        (void)xb_add(cnt, 1u);
        XB_SPIN(xb_ld(cnt) < n, bar);
        __builtin_amdgcn_fence(__ATOMIC_ACQUIRE, "agent");
        asm volatile("s_waitcnt vmcnt(0)" ::: "memory");
    }
    __syncthreads();
}

constexpr int RING_OFF = 0, RING_BYTES = 131072;
constexpr int LDSCTL_OFF = RING_BYTES, MISC_OFF = LDSCTL_OFF + 320;
constexpr int LDS_BYTES = 147456;
static_assert(att::SHM_ATTN <= RING_BYTES, "attention scratch fits the ring");

struct Frame {
    LAS unsigned char* lds;
    int tid, lane, wave;
    int vcu, G;
    float* out; unsigned char* ws;
};
constexpr int PTR_OFF = MISC_OFF + 256;
__device__ __forceinline__ const float* inp(const Frame& F, int i) {
    int off = PTR_OFF + 8 * i; asm volatile("" : "+s"(off));
    const unsigned long long v = *(const LAS unsigned long long*)(F.lds + off);
    const unsigned lo = __builtin_amdgcn_readfirstlane((unsigned)v), hi = __builtin_amdgcn_readfirstlane((unsigned)(v >> 32));
    return (const float*)(((unsigned long long)hi << 32) | lo);
}
__device__ __forceinline__ void frame_lanes(Frame& F) {
    int t = threadIdx.x; asm volatile("" : "+v"(t)); F.tid = t; F.lane = t & 63; F.wave = __builtin_amdgcn_readfirstlane(t >> 6);
    unsigned long long w = (unsigned long long)F.ws, o = (unsigned long long)F.out; unsigned l = (unsigned)(unsigned long long)F.lds; int g = F.G, v = F.vcu;
    asm volatile("" : "+s"(w), "+s"(o), "+s"(l), "+s"(g), "+s"(v));
    F.ws = (unsigned char*)w; F.out = (float*)o; F.lds = (LAS unsigned char*)(unsigned long long)l; F.G = g; F.vcu = v;
}
__device__ __forceinline__ float shx(float v, int o, int lane) { return __builtin_bit_cast(float, __builtin_amdgcn_ds_bpermute((lane ^ o) << 2, __builtin_bit_cast(int, v))); }
__device__ __forceinline__ float wave_sum(float v, int lane) {
#pragma unroll
    for (int o = 1; o < 64; o <<= 1) v += shx(v, o, lane);
    return v;
}
__device__ __forceinline__ float wave_max(float v, int lane) {
#pragma unroll
    for (int o = 1; o < 64; o <<= 1) v = fmaxf(v, shx(v, o, lane));
    return v;
}

__device__ __forceinline__ int dest_row(int map, int row_off, int n) {
    if (map == 1) { return n < DFF ? ((n >> 7) * 256 + (n & 127)) : (((n - DFF) >> 7) * 256 + 128 + ((n - DFF) & 127)); }
    if (map == 2) { const int h = n / 192, d = n - h * 192; if (d < 128) return n; const int i = d - 128; return h * 192 + 128 + (i < 32 ? 2 * i : 2 * (i - 32) + 1); }
    return row_off + n;
}
struct TrJob { const float* W; int ldw; bf16* WT; int ldt, map, row_off; const float* ks; bf16* RM; int ldr; int k0, n0; };
__device__ __forceinline__ void tr_load(const TrJob& J, int lane, f32x4 (&v)[8]) {
#pragma unroll
    for (int i = 0; i < 8; ++i) { const int kk = 8 * i + (lane >> 3), c4 = (lane & 7) * 4; v[i] = *(const GAS f32x4*)(J.W + (size_t)(J.k0 + kk) * J.ldw + J.n0 + c4);
        if (J.ks) v[i] = v[i] * ((const GAS float*)J.ks)[J.k0 + kk]; }
}
__device__ __forceinline__ void tr_finish(const TrJob& J, const f32x4 (&v)[8], LAS float* scr, int lane) {
#pragma unroll
    for (int i = 0; i < 8; ++i) { const int kk = 8 * i + (lane >> 3), c4 = (lane & 7) * 4; LAS float* d = scr + kk * 33 + c4; d[0] = v[i].x; d[1] = v[i].y; d[2] = v[i].z; d[3] = v[i].w; }
    LDS_WAIT(); asm volatile("" ::: "memory");
    const int c = lane & 7;
#pragma unroll
    for (int j = 0; j < 4; ++j) { const int n = (lane >> 3) + 8 * j; const LAS float* p = scr + (8 * c) * 33 + n;
        v4u o; o.x = pk2(p[0 * 33], p[1 * 33]); o.y = pk2(p[2 * 33], p[3 * 33]); o.z = pk2(p[4 * 33], p[5 * 33]); o.w = pk2(p[6 * 33], p[7 * 33]);
        *(GAS v4u*)(J.WT + (size_t)dest_row(J.map, J.row_off, J.n0 + n) * J.ldt + J.k0 + 8 * c) = o; }
    if (J.RM) {
        const LAS float* p = scr + lane * 33;
#pragma unroll
        for (int q = 0; q < 4; ++q) { v4u o; o.x = pk2(p[8 * q], p[8 * q + 1]); o.y = pk2(p[8 * q + 2], p[8 * q + 3]); o.z = pk2(p[8 * q + 4], p[8 * q + 5]); o.w = pk2(p[8 * q + 6], p[8 * q + 7]);
            *(GAS v4u*)(J.RM + (size_t)(J.k0 + lane) * J.ldr + J.n0 + 8 * q) = o; }
    }
    LDS_WAIT(); asm volatile("" ::: "memory");
}
#define TR_LOOP(NITEMS, JOBEXPR) do { \
        f32x4 va_[8], vb_[8], na_[8], nb_[8]; TrJob ja_, jb_, nja_, njb_; bool hb_ = false, nhb_ = false; \
        int it_ = gw; \
        if (it_ < (NITEMS)) { int it = it_; ja_ = (JOBEXPR); hb_ = it_ + NGW < (NITEMS); it = hb_ ? it_ + NGW : it_; jb_ = (JOBEXPR); tr_load(ja_, lane, va_); if (hb_) tr_load(jb_, lane, vb_); } \
        while (it_ < (NITEMS)) { \
            const int nit_ = it_ + 2 * NGW; const bool hn_ = nit_ < (NITEMS); \
            if (hn_) { int it = nit_; nja_ = (JOBEXPR); nhb_ = nit_ + NGW < (NITEMS); it = nhb_ ? nit_ + NGW : nit_; njb_ = (JOBEXPR); tr_load(nja_, lane, na_); if (nhb_) tr_load(njb_, lane, nb_); } \
            tr_finish(ja_, va_, scr, lane); if (hb_) tr_finish(jb_, vb_, scr, lane); \
            if (hn_) { ja_ = nja_; jb_ = njb_; hb_ = nhb_; _Pragma("unroll") for (int q_ = 0; q_ < 8; ++q_) { va_[q_] = na_[q_]; vb_[q_] = nb_[q_]; } } \
            it_ = nit_; } } while (0)

constexpr int P0_I_DQ = 32 * 16, P0_I_DKV = 32 * 18, P0_I_UQ = 8 * 96, P0_I_UK = 8 * 64, P0_I_UV = 8 * 64, P0_I_O = 32 * 64, P0_I_MLA = P0_I_DQ + P0_I_DKV + P0_I_UQ + P0_I_UK + P0_I_UV + P0_I_O, P0_I_POOL = 4 * 8 * 16;
__device__ __forceinline__ TrJob p0_job(Frame& F, int it) {
    TrJob J; J.ks = nullptr; J.RM = nullptr; J.ldr = 0; J.map = 0; J.row_off = 0; int nnb, r;
    if (it < 2 * P0_I_MLA) {
        const int j = it / P0_I_MLA; r = it - j * P0_I_MLA; unsigned char* wb = F.ws + WS_W + j * W_MLA;
        if (r < P0_I_DQ) { J.W = inp(F, 7) + (size_t)j * 2048 * 512; J.ldw = 512; J.WT = (bf16*)(wb + WO_DQKV); J.ldt = 2048; nnb = 16; J.ks = inp(F, 6) + (size_t)(2 * j) * 4 * DM; }
        else if ((r -= P0_I_DQ) < P0_I_DKV) { J.W = inp(F, 10) + (size_t)j * 2048 * 576; J.ldw = 576; J.WT = (bf16*)(wb + WO_DQKV); J.ldt = 2048; nnb = 18; J.row_off = 512; J.ks = inp(F, 6) + (size_t)(2 * j) * 4 * DM; }
        else if ((r -= P0_I_DKV) < P0_I_UQ) { J.W = inp(F, 9) + (size_t)j * 512 * 3072; J.ldw = 3072; J.WT = (bf16*)(wb + WO_UQ); J.ldt = 512; nnb = 96; J.map = 2; }
        else if ((r -= P0_I_UQ) < P0_I_UK) { J.W = inp(F, 12) + (size_t)j * 512 * 2048; J.ldw = 2048; J.WT = (bf16*)(wb + WO_UKV); J.ldt = 512; nnb = 64; }
        else if ((r -= P0_I_UK) < P0_I_UV) { J.W = inp(F, 13) + (size_t)j * 512 * 2048; J.ldw = 2048; J.WT = (bf16*)(wb + WO_UKV); J.ldt = 512; nnb = 64; J.row_off = 2048; }
        else { r -= P0_I_UV; J.W = inp(F, 14) + (size_t)j * 2048 * 2048; J.ldw = 2048; J.WT = (bf16*)(wb + WO_O); J.ldt = 2048; nnb = 64; }
    } else {
        r = it - 2 * P0_I_MLA; const int jg2 = r / (8 * 16); r -= jg2 * (8 * 16); const int jg = jg2 & 7, unf = jg2 >> 3;
        J.W = inp(F, 15) + (size_t)jg * 512 * 512; J.ldw = 512; J.WT = (bf16*)(F.ws + (unf ? WS_WPOOLH : WS_WPOOL) + (size_t)(jg >> 2) * 2 * MiB); J.ldt = 512; nnb = 16; J.row_off = (jg & 3) * 512;
        if (!unf) J.ks = inp(F, 6) + (size_t)(2 * (jg >> 2) + 1) * 4 * DM + (jg & 3) * 512;
    }
    J.k0 = 64 * (r / nnb); J.n0 = 32 * (r % nnb); return J;
}
__device__ __forceinline__ void p0_prologue(Frame& F) {
    frame_lanes(F);
    LAS float* scr = (LAS float*)(F.lds + RING_OFF + F.wave * 16384);
    const int gw = F.vcu * NWAVES + F.wave, NGW = F.G * NWAVES;
    {
        float* ct = (float*)(F.ws + WS_ROPE); float* st = ct + 4096 * 32;
        for (int idx = (F.vcu * NWAVES + F.wave) * 64 + F.lane; idx < 4096 * 32; idx += NGW * 64) {
            const int pos = idx >> 5, i = idx & 31;
            double inv = 1.0; for (int k = 0; k < i; ++k) inv *= 0.7498942093324558273;
            double a = (double)pos * inv;
            const double twopi = 6.283185307179586476925287; a -= twopi * __builtin_rint(a / twopi);
            const double x = a * 0.125, x2 = x * x;
            double s = x * (1.0 + x2 * (-1.0 / 6 + x2 * (1.0 / 120 + x2 * (-1.0 / 5040 + x2 * (1.0 / 362880 + x2 * (-1.0 / 39916800))))));
            double c = 1.0 + x2 * (-0.5 + x2 * (1.0 / 24 + x2 * (-1.0 / 720 + x2 * (1.0 / 40320 + x2 * (-1.0 / 3628800 + x2 * (1.0 / 479001600))))));
#pragma unroll
            for (int k = 0; k < 3; ++k) { const double s2 = 2.0 * s * c, c2 = 1.0 - 2.0 * s * s; s = s2; c = c2; }
            ((GAS float*)ct)[idx] = (float)c; ((GAS float*)st)[idx] = (float)s;
        }
    }
    constexpr int NITEMS = 2 * P0_I_MLA + 4 * P0_I_POOL;
    { const int lane = F.lane; TR_LOOP(NITEMS, p0_job(F, it)); }
    for (int row = gw; row < 2 * 8192; row += NGW) {
        const int j = row >> 13, hc = row & 8191, h = hc >> 9, c = hc & 511;
        const GAS float* src = (const GAS float*)(inp(F, 12) + (size_t)j * 512 * 2048 + (size_t)c * 2048 + h * 128 + 2 * F.lane);
        GAS unsigned* dst = (GAS unsigned*)((unsigned*)(F.ws + WS_W + j * W_MLA + WO_UK2) + (size_t)hc * 128);
        dst[F.lane] = pk2(src[0], src[1]); dst[64 + F.lane] = 0u;
    }
    for (int row = gw; row < 2 * 512; row += NGW) {
        const int j = row >> 9, r = row & 511, sb = r >> 4, slot = r & 15;
        const float* src = inp(F, 4) + ((size_t)(j * 32 + sb) * 15 + (slot < 15 ? slot : 0)) * DM;
        bf16* dst = (bf16*)(F.ws + WS_HS) + (size_t)row * DM;
#pragma unroll
        for (int q = 0; q < 8; ++q) { const int c = (F.lane + 64 * q) * 4; f32x4 v = *(const GAS f32x4*)(src + c); if (slot == 15) v = (f32x4){0.f, 0.f, 0.f, 0.f};
            v2u w; w.x = pk2(v.x, v.y); w.y = pk2(v.z, v.w); *(GAS v2u*)(dst + c) = w; }
    }
}

__device__ __forceinline__ TrJob ffn_job(Frame& F, int it, const float* wu, const float* wd, const float* g2) {
    constexpr int I_UP = 32 * 352; TrJob J; J.RM = nullptr; J.ldr = 0; J.row_off = 0;
    if (it < I_UP) { J.W = wu; J.ldw = NUP; J.WT = (bf16*)(F.ws + WS_WFFN + WO_UP); J.ldt = 2048; J.map = 1; J.ks = g2; J.k0 = 64 * (it / 352); J.n0 = 32 * (it % 352); }
    else { const int r = it - I_UP; J.W = wd; J.ldw = 2048; J.WT = (bf16*)(F.ws + WS_WFFN + WO_DOWN); J.ldt = DFF; J.map = 0; J.ks = nullptr; J.k0 = 64 * (r / 64); J.n0 = 32 * (r % 64); }
    return J;
}
__device__ __forceinline__ void convert_ffn(Frame& F, int L) {
    LAS float* scr = (LAS float*)(F.lds + RING_OFF + F.wave * 16384);
    const int gw = F.vcu * NWAVES + F.wave, NGW = F.G * NWAVES;
    constexpr int I_UP = 32 * 352, I_DN = 88 * 64;
    const float* wu = inp(F, 17) + (size_t)L * 2048 * NUP; const float* wd = inp(F, 20) + (size_t)L * DFF * 2048; const float* g2 = inp(F, 6) + (size_t)(L * 4 + 2) * DM;
    const int lane = F.lane;
    TR_LOOP(I_UP + I_DN, ffn_job(F, it, wu, wd, g2));
}
__device__ __forceinline__ void norm0_phase(Frame& F) {
    frame_lanes(F);
    const int gw = F.vcu * NWAVES + F.wave, NGW = F.G * NWAVES;
    const float* xp = inp(F, 0); const float* xs = inp(F, 1);
    bf16* XB = (bf16*)(F.ws + WS_XB); float* RS = (float*)(F.ws + WS_RS);
    f32x4 nx[8];
#pragma unroll
    for (int j = 0; j < 8; ++j) nx[j] = (f32x4){0.f, 0.f, 0.f, 0.f};
    if (gw < T) { const float* xin = gw < TP ? xp + (size_t)gw * DM : xs + (size_t)(gw - TP) * DM;
#pragma unroll
        for (int j = 0; j < 8; ++j) nx[j] = *(const GAS f32x4*)(xin + (F.lane + 64 * j) * 4); }
    for (int row = gw; row < T; row += NGW) {
        f32x4 x[8]; float s2 = 0.f;
#pragma unroll
        for (int j = 0; j < 8; ++j) x[j] = nx[j];
        { const int nrow = row + NGW;
          if (nrow < T) { const float* xin = nrow < TP ? xp + (size_t)nrow * DM : xs + (size_t)(nrow - TP) * DM;
#pragma unroll
              for (int j = 0; j < 8; ++j) nx[j] = *(const GAS f32x4*)(xin + (F.lane + 64 * j) * 4); } }
#pragma unroll
        for (int j = 0; j < 8; ++j) s2 += (x[j].x * x[j].x + x[j].y * x[j].y) + (x[j].z * x[j].z + x[j].w * x[j].w);
        const float r2 = 1.0f / sqrtf(wave_sum(s2, F.lane) * (1.0f / DM) + EPS);
#pragma unroll
        for (int j = 0; j < 8; ++j) { v2u w; w.x = pk2(x[j].x, x[j].y); w.y = pk2(x[j].z, x[j].w); *(GAS v2u*)(XB + (size_t)row * DM + (F.lane + 64 * j) * 4) = w; }
        if (F.lane == 0) ((GAS float*)RS)[row] = r2;
    }
}
struct NormRows { int cnt, first, start, stride; };
__device__ __forceinline__ NormRows norm_rows(int gw, int NGW, int ns) {
    NormRows R;
    if (NGW == 2048 && ns > 0) { const int hp = 13, lp = 17;
        if (gw < 512) { R.cnt = 1 + hp; R.first = TP + gw; R.start = gw - 512; R.stride = 512; }
        else { R.cnt = lp; R.start = 512 * hp + (gw - 512); R.first = R.start; R.stride = 1536; } }
    else { R.cnt = gw < T ? (T - gw + NGW - 1) / NGW : 0; R.first = gw; R.start = gw; R.stride = NGW; }
    return R;
}
template <bool LAST, bool POOLST>
__device__ __forceinline__ void norm_phase(Frame& F, const bf16* mres, const bf16* slab, int ns, const float* g_post, const float* g_pre, float* pool_p, float* pool_s, bool poison, bool dry = false) {
    frame_lanes(F);
    const int gw = F.vcu * NWAVES + F.wave, NGW = F.G * NWAVES;
    const NormRows NR = norm_rows(gw, NGW, ns);
    bf16* XB = (bf16*)(F.ws + WS_XB); bf16* XBo = dry ? (bf16*)(F.ws + WS_BIG) : XB;
    float* RS = (float*)(F.ws + WS_RS);
    f32x4 gp[8];
#pragma unroll
    for (int j = 0; j < 8; ++j) gp[j] = *(const GAS f32x4*)(g_post + (F.lane + 64 * j) * 4);
    v2u nx[8], nm[8];
#pragma unroll
    for (int j = 0; j < 8; ++j) { nx[j] = (v2u){0u, 0u}; nm[j] = (v2u){0u, 0u}; }
    if (NR.cnt > 0) {
#pragma unroll
        for (int j = 0; j < 8; ++j) { nx[j] = *(const GAS v2u*)(XB + (size_t)NR.first * DM + (F.lane + 64 * j) * 4); nm[j] = *(const GAS v2u*)(mres + (size_t)NR.first * DM + (F.lane + 64 * j) * 4); } }
    for (int ri = 0; ri < NR.cnt; ++ri) {
        const int row = ri == 0 ? NR.first : NR.start + NR.stride * ri;
        f32x4 x[8], mv[8]; v2u cm[8];
#pragma unroll
        for (int j = 0; j < 8; ++j) { x[j] = (f32x4){bflo(nx[j].x), bfhi(nx[j].x), bflo(nx[j].y), bfhi(nx[j].y)}; cm[j] = nm[j]; }
        { const int nrow = NR.start + NR.stride * (ri + 1);
          if (ri + 1 < NR.cnt) {
#pragma unroll
              for (int j = 0; j < 8; ++j) { nx[j] = *(const GAS v2u*)(XB + (size_t)nrow * DM + (F.lane + 64 * j) * 4); nm[j] = *(const GAS v2u*)(mres + (size_t)nrow * DM + (F.lane + 64 * j) * 4); } } }
        if (ns > 0 && row >= TP) {
#pragma unroll
            for (int j = 0; j < 8; ++j) mv[j] = (f32x4){0.f, 0.f, 0.f, 0.f};
#pragma unroll 2
            for (int k = 0; k < ns; ++k) {
#pragma unroll
                for (int j = 0; j < 8; ++j) { const v2u w = *(const GAS v2u*)(slab + ((size_t)k * TS + (row - TP)) * DM + (F.lane + 64 * j) * 4); mv[j] = mv[j] + (f32x4){bflo(w.x), bfhi(w.x), bflo(w.y), bfhi(w.y)}; } }
        } else {
#pragma unroll
            for (int j = 0; j < 8; ++j) mv[j] = (f32x4){bflo(cm[j].x), bfhi(cm[j].x), bflo(cm[j].y), bfhi(cm[j].y)}; }
        float ss = 0.f;
#pragma unroll
        for (int j = 0; j < 8; ++j) ss += (mv[j].x * mv[j].x + mv[j].y * mv[j].y) + (mv[j].z * mv[j].z + mv[j].w * mv[j].w);
        const float r1 = 1.0f / sqrtf(wave_sum(ss, F.lane) * (1.0f / DM) + EPS);
#pragma unroll
        for (int j = 0; j < 8; ++j) x[j] = x[j] + mv[j] * r1 * gp[j];
        if (LAST) {
            if (poison) {
#pragma unroll
                for (int j = 0; j < 8; ++j) x[j] = x[j] * __builtin_nanf("");
            }
#pragma unroll
            for (int j = 0; j < 8; ++j) *(GAS f32x4*)(F.out + (size_t)row * DM + (F.lane + 64 * j) * 4) = x[j];
        } else {
#pragma unroll
            for (int j = 0; j < 8; ++j) { v2u w; w.x = pk2(x[j].x, x[j].y); w.y = pk2(x[j].z, x[j].w); *(GAS v2u*)(XBo + (size_t)row * DM + (F.lane + 64 * j) * 4) = w; }
            float s2 = 0.f;
#pragma unroll
            for (int j = 0; j < 8; ++j) s2 += (x[j].x * x[j].x + x[j].y * x[j].y) + (x[j].z * x[j].z + x[j].w * x[j].w);
            const float r2 = 1.0f / sqrtf(wave_sum(s2, F.lane) * (1.0f / DM) + EPS);
            if (F.lane == 0) ((GAS float*)RS)[row] = r2;
            if (POOLST) {
                float* ps = nullptr;
                if (row < TP) { const int s = row & (SEQ - 1); if (s >= SEQ - 15) ps = pool_p + ((size_t)(row >> 12) * 15 + (s - (SEQ - 15))) * DM; }
                else { const int qi = (row - TP) & 15; if (qi >= 1) ps = pool_s + ((size_t)((row - TP) >> 4) * 15 + (qi - 1)) * DM; }
                if (ps) {
#pragma unroll
                    for (int j = 0; j < 8; ++j) { const int c = (F.lane + 64 * j) * 4; *(GAS f32x4*)(ps + c) = x[j] * r2 * *(const GAS f32x4*)(g_pre + c); } }
            }
        }
    }
}

__device__ __forceinline__ TrJob vt_job(const float* cck, bf16* VT, bf16* KALL, int it) {
    const int b = it >> 9, r = it & 511; TrJob J; J.W = cck + (size_t)b * 2048 * 512; J.ldw = 512; J.WT = VT + (size_t)b * 512 * 2304; J.ldt = 2304; J.map = 0; J.row_off = 0; J.ks = nullptr;
    J.RM = KALL + (size_t)b * 2304 * 640; J.ldr = 640; J.k0 = 64 * (r >> 4); J.n0 = 32 * (r & 15); return J;
}
__device__ __forceinline__ void s1_phase(Frame& F, int j) {
    frame_lanes(F);
    const int gw = F.vcu * NWAVES + F.wave, NGW = F.G * NWAVES, lane = F.lane;
    const bf16* raw = (const bf16*)(F.ws + WS_MB);
    const float* qn = inp(F, 8) + j * 512; const float* kn = inp(F, 11) + j * 512;
    const float* ct = (const float*)(F.ws + WS_ROPE); const float* st = ct + 4096 * 32;
    bf16* CQ = (bf16*)(F.ws + WS_CQ); bf16* CKVB = (bf16*)(F.ws + WS_CKVB); bf16* KRB = (bf16*)(F.ws + WS_KRB);
    bf16* KALL = (bf16*)(F.ws + WS_KALL); bf16* VT = (bf16*)(F.ws + WS_VT);
    f32x4 gqn[2], gkn[2];
#pragma unroll
    for (int i = 0; i < 2; ++i) { gqn[i] = *(const GAS f32x4*)(qn + (lane + 64 * i) * 4); gkn[i] = *(const GAS f32x4*)(kn + (lane + 64 * i) * 4); }
    f32x4 na[2], nb[2]; float nkv = 0.f, nrs = 0.f, ncs = 0.f, nsn = 0.f;
#pragma unroll
    for (int i = 0; i < 2; ++i) { na[i] = (f32x4){0.f, 0.f, 0.f, 0.f}; nb[i] = na[i]; }
#define S1_LD4(p) ({ const v2u w_ = *(const GAS v2u*)(p); (f32x4){bflo(w_.x), bfhi(w_.x), bflo(w_.y), bfhi(w_.y)}; })
    if (gw < T) { const bf16* rr = raw + (size_t)gw * 1280;
#pragma unroll
        for (int i = 0; i < 2; ++i) { na[i] = S1_LD4(rr + (lane + 64 * i) * 4); nb[i] = S1_LD4(rr + 512 + (lane + 64 * i) * 4); }
        nkv = __builtin_bit_cast(float, (unsigned)((const GAS bf16*)rr)[1024 + lane] << 16); nrs = ((const GAS float*)(F.ws + WS_RS))[gw];
        { const int p0 = gw < TP ? (gw & (SEQ - 1)) : 2048 + ((gw - TP) & 15); ncs = ((const GAS float*)ct)[p0 * 32 + (lane & 31)]; nsn = ((const GAS float*)st)[p0 * 32 + (lane & 31)]; } }
    for (int row = gw; row < T; row += NGW) {
        f32x4 a[2], b[2]; float ssa = 0.f, ssb = 0.f;
        const float rs_row = nrs;
#pragma unroll
        for (int i = 0; i < 2; ++i) { a[i] = na[i] * rs_row; b[i] = nb[i] * rs_row;
            ssa += (a[i].x * a[i].x + a[i].y * a[i].y) + (a[i].z * a[i].z + a[i].w * a[i].w); ssb += (b[i].x * b[i].x + b[i].y * b[i].y) + (b[i].z * b[i].z + b[i].w * b[i].w); }
        const float kv = nkv * rs_row; const float cs = ncs, sn = nsn;
        { const int nrow = row + NGW;
          if (nrow < T) { const bf16* rn = raw + (size_t)nrow * 1280;
#pragma unroll
              for (int i = 0; i < 2; ++i) { na[i] = S1_LD4(rn + (lane + 64 * i) * 4); nb[i] = S1_LD4(rn + 512 + (lane + 64 * i) * 4); }
              nkv = __builtin_bit_cast(float, (unsigned)((const GAS bf16*)rn)[1024 + lane] << 16); nrs = ((const GAS float*)(F.ws + WS_RS))[nrow];
              const int p1 = nrow < TP ? (nrow & (SEQ - 1)) : 2048 + ((nrow - TP) & 15); ncs = ((const GAS float*)ct)[p1 * 32 + (lane & 31)]; nsn = ((const GAS float*)st)[p1 * 32 + (lane & 31)]; } }
        const float ra = 1.0f / sqrtf(wave_sum(ssa, lane) * (1.0f / 512) + EPS), rb = 1.0f / sqrtf(wave_sum(ssb, lane) * (1.0f / 512) + EPS);
        const bool prompt = row < TP;
        const int sb = (row - TP) >> 4, qi = (row - TP) & 15;
        float* o_ckv = prompt ? F.out + O_CKV_P + ((size_t)j * TP + row) * 512 : F.out + O_CKV_S + ((size_t)j * TS + (row - TP)) * 512;
        float* o_kr = prompt ? F.out + O_KR_P + ((size_t)j * TP + row) * 64 : F.out + O_KR_S + ((size_t)j * TS + (row - TP)) * 64;
#pragma unroll
        for (int i = 0; i < 2; ++i) {
            const int c = (lane + 64 * i) * 4;
            const f32x4 q = a[i] * ra * gqn[i]; v2u w; w.x = pk2(q.x, q.y); w.y = pk2(q.z, q.w); *(GAS v2u*)(CQ + (size_t)row * 512 + c) = w;
            const f32x4 k = b[i] * rb * gkn[i]; *(GAS f32x4*)(o_ckv + c) = k; v2u wk; wk.x = pk2(k.x, k.y); wk.y = pk2(k.z, k.w);
            if (prompt) *(GAS v2u*)(CKVB + (size_t)row * 512 + c) = wk;
            else { *(GAS v2u*)(KALL + ((size_t)sb * 2304 + 2048 + qi) * 640 + c) = wk;
                GAS bf16* vt = (GAS bf16*)(VT + ((size_t)sb * 512 + c) * 2304 + 2048 + qi); vt[0] = (bf16)(wk.x & 0xffff); vt[2304] = (bf16)(wk.x >> 16); vt[2 * 2304] = (bf16)(wk.y & 0xffff); vt[3 * 2304] = (bf16)(wk.y >> 16); }
        }
        const float other = shx(kv, 32, lane);
        const float rot = lane < 32 ? kv * cs - other * sn : other * sn + kv * cs;
        ((GAS float*)o_kr)[lane] = rot;
        const float rot_hi = shx(rot, 32, lane);
        if (lane < 32) { const unsigned w = pk2(rot, rot_hi);
            if (prompt) ((GAS unsigned*)(KRB + (size_t)row * 64))[lane] = w; else ((GAS unsigned*)(KALL + ((size_t)sb * 2304 + 2048 + qi) * 640 + 512))[lane] = w; }
        else if (!prompt) ((GAS unsigned*)(KALL + ((size_t)sb * 2304 + 2048 + qi) * 640 + 576))[lane - 32] = 0u;
    }
}
__device__ __forceinline__ void s1_cache_phase(Frame& F, int j) {
    frame_lanes(F);
    const int gw = F.vcu * NWAVES + F.wave, NGW = F.G * NWAVES, lane = F.lane;
    bf16* KALL = (bf16*)(F.ws + WS_KALL); bf16* VT = (bf16*)(F.ws + WS_VT);
    const float* cck = inp(F, 2) + (size_t)j * 32 * 2048 * 512; const float* ckr = inp(F, 3) + (size_t)j * 32 * 2048 * 64;
    { const int tg = (F.vcu * NWAVES + F.wave) * 64 + lane, NT_ = F.G * NWAVES * 64;
#pragma unroll 4
      for (int idx = tg; idx < 32 * 2048 * 32; idx += NT_) {
          const int rowc = idx >> 5, i = idx & 31, b = rowc >> 11, key = rowc & 2047;
          const GAS float* src = (const GAS float*)ckr + (size_t)rowc * 64;
          GAS unsigned* dst = (GAS unsigned*)(KALL + ((size_t)b * 2304 + key) * 640);
          dst[256 + i] = pk2(src[i], src[i + 32]); dst[288 + i] = 0u; }
      for (int idx = tg; idx < 32 * 240 * 320; idx += NT_) { const int rz = idx / 320, w = idx - rz * 320, b = rz / 240, key = 2064 + (rz - b * 240);
          ((GAS unsigned*)(KALL + ((size_t)b * 2304 + key) * 640))[w] = 0u; }
    }
    { LAS float* scr = (LAS float*)(F.lds + RING_OFF + F.wave * 16384);
      TR_LOOP(32 * 512, vt_job(cck, VT, KALL, it));
      for (int r = gw; r < 32 * 512; r += NGW) { GAS unsigned* dst = (GAS unsigned*)(VT + (size_t)r * 2304 + 2064); dst[lane] = 0u; if (lane < 56) dst[64 + lane] = 0u; }
    }
}

__device__ __forceinline__ void qlat_rope_copy(Frame& F) {
    frame_lanes(F);
    const bf16* Q = (const bf16*)(F.ws + WS_Q); bf16* QL = (bf16*)(F.ws + WS_QLAT);
    for (int idx = (F.vcu * NWAVES + F.wave) * 64 + F.lane; idx < 8192 * 16; idx += F.G * NWAVES * 64) {
        const int row = idx >> 4, ch = idx & 15, b = row >> 8, h = (row >> 4) & 15, qi = row & 15;
        v4u v = (v4u){0u, 0u, 0u, 0u};
        if (ch < 8) v = *(const GAS v4u*)(Q + (size_t)(TP + b * 16 + qi) * 3072 + h * 192 + 128 + ch * 8);
        *(GAS v4u*)(QL + (size_t)row * 640 + 512 + ch * 8) = v;
    }
}

__device__ __forceinline__ void softmax_phase(Frame& F) {
    frame_lanes(F);
    const float* S = (const float*)(F.ws + WS_S); bf16* P = (bf16*)(F.ws + WS_P);
    const int gw = F.vcu * NWAVES + F.wave, NGW = F.G * NWAVES, lane = F.lane;
    constexpr float C = att::SCALE * 1.4426950408889634f;
    for (int row = gw; row < 8192; row += NGW) {
        f32x4 v[9]; float mx = -1e30f;
#pragma unroll
        for (int j = 0; j < 9; ++j) { const int c = lane * 4 + 256 * j; v[j] = *(const GAS f32x4*)(S + (size_t)row * 2304 + c);
            if (c >= 2064) v[j] = (f32x4){-1e30f, -1e30f, -1e30f, -1e30f};
            mx = fmaxf(mx, fmaxf(fmaxf(v[j].x, v[j].y), fmaxf(v[j].z, v[j].w))); }
        mx = wave_max(mx, lane); float sum = 0.f;
#pragma unroll
        for (int j = 0; j < 9; ++j) { const int c = lane * 4 + 256 * j;
            v[j].x = __builtin_amdgcn_exp2f((v[j].x - mx) * C); v[j].y = __builtin_amdgcn_exp2f((v[j].y - mx) * C); v[j].z = __builtin_amdgcn_exp2f((v[j].z - mx) * C); v[j].w = __builtin_amdgcn_exp2f((v[j].w - mx) * C);
            if (c >= 2064) v[j] = (f32x4){0.f, 0.f, 0.f, 0.f};
            sum += (v[j].x + v[j].y) + (v[j].z + v[j].w); }
        const float inv = 1.0f / wave_sum(sum, lane);
#pragma unroll
        for (int j = 0; j < 9; ++j) { const int c = lane * 4 + 256 * j; v2u w; w.x = pk2(v[j].x * inv, v[j].y * inv); w.y = pk2(v[j].z * inv, v[j].w * inv); *(GAS v2u*)(P + (size_t)row * 2304 + c) = w; }
    }
}

template <int G> __device__ __forceinline__ void pool_group_prompt(const bf16* X, const GAS float* RS, bf16* Dd, const float* g0, int t0, int s0, int lane) {
    constexpr int W = 2 << G, H = W - 1;
    const int c = G * 512 + lane * 8;
    const bool hv = s0 > 0;
    const int rrow = t0 - 15 + lane; const float rsv = (lane < 31 && rrow >= 0) ? RS[rrow] : 0.f;
    v4u x[H + 16];
#pragma unroll
    for (int r = 0; r < H + 16; ++r) { x[r] = (v4u){0u, 0u, 0u, 0u}; if (r >= H || hv) x[r] = *(const GAS v4u*)(X + (size_t)(t0 - H + r) * DM + c); }
    const f32x4 ga = *(const GAS f32x4*)(g0 + c), gb = *(const GAS f32x4*)(g0 + c + 4);
    float S[8];
#pragma unroll
    for (int e = 0; e < 8; ++e) S[e] = 0.f;
#define PD_ROWF(v, rs, f) do { f[0] = bflo(v.x) * rs; f[1] = bfhi(v.x) * rs; f[2] = bflo(v.y) * rs; f[3] = bfhi(v.y) * rs; f[4] = bflo(v.z) * rs; f[5] = bfhi(v.z) * rs; f[6] = bflo(v.w) * rs; f[7] = bfhi(v.w) * rs; } while (0)
#pragma unroll
    for (int r = 0; r < H; ++r) { const float rs = __builtin_bit_cast(float, __builtin_amdgcn_readlane(__builtin_bit_cast(int, rsv), 15 - H + r)); float f[8]; PD_ROWF(x[r], rs, f);
#pragma unroll
        for (int e = 0; e < 8; ++e) S[e] += f[e]; }
#pragma unroll
    for (int i = 0; i < 16; ++i) {
        const float rs = __builtin_bit_cast(float, __builtin_amdgcn_readlane(__builtin_bit_cast(int, rsv), 15 + i)); float f[8]; PD_ROWF(x[H + i], rs, f);
#pragma unroll
        for (int e = 0; e < 8; ++e) S[e] += f[e];
        const int s = s0 + i; const float ic = 1.0f / (float)((s + 1) < W ? (s + 1) : W);
        v4u o; o.x = pk2((S[0] * ic - f[0]) * ga.x, (S[1] * ic - f[1]) * ga.y); o.y = pk2((S[2] * ic - f[2]) * ga.z, (S[3] * ic - f[3]) * ga.w);
        o.z = pk2((S[4] * ic - f[4]) * gb.x, (S[5] * ic - f[5]) * gb.y); o.w = pk2((S[6] * ic - f[6]) * gb.z, (S[7] * ic - f[7]) * gb.w);
        *(GAS v4u*)(Dd + (size_t)(t0 + i) * DM + c) = o;
        { const float rl = __builtin_bit_cast(float, __builtin_amdgcn_readlane(__builtin_bit_cast(int, rsv), 15 - H + i)); float fl[8]; PD_ROWF(x[i], rl, fl);
#pragma unroll
          for (int e = 0; e < 8; ++e) S[e] -= fl[e]; }
    }
#undef PD_ROWF
}
__device__ __forceinline__ void pool_d_phase(Frame& F, int j, const float* g0) {
    frame_lanes(F);
    const bf16* X = (const bf16*)(F.ws + WS_XB); bf16* Dd = (bf16*)(F.ws + WS_ACT); const GAS float* RS = (const GAS float*)(F.ws + WS_RS);
    const float* hist = inp(F, 4) + (size_t)j * 32 * 15 * DM;
    const int gw = F.vcu * NWAVES + F.wave, NGW = F.G * NWAVES, lane = F.lane;
    for (int ch = gw; ch < TP / 16; ch += NGW) {
        const int t0 = ch * 16, s0 = t0 & (SEQ - 1);
        pool_group_prompt<0>(X, RS, Dd, g0, t0, s0, lane); pool_group_prompt<1>(X, RS, Dd, g0, t0, s0, lane);
        pool_group_prompt<2>(X, RS, Dd, g0, t0, s0, lane); pool_group_prompt<3>(X, RS, Dd, g0, t0, s0, lane);
    }
    for (int row = TP + gw; row < T; row += NGW) {
        const int s = (row - TP) & 15; const int sb = (row - TP) >> 4;
#pragma unroll
        for (int g = 0; g < 4; ++g) {
            const int w = 2 << g, c = g * 512 + lane * 8;
            const f32x4 ga = *(const GAS f32x4*)(g0 + c), gb = *(const GAS f32x4*)(g0 + c + 4);
            const float gg[8] = {ga.x, ga.y, ga.z, ga.w, gb.x, gb.y, gb.z, gb.w};
            float acc[8], self[8];
#pragma unroll
            for (int e = 0; e < 8; ++e) { acc[e] = 0.f; self[e] = 0.f; }
            for (int k = 0; k < w; ++k) {
                const int sk = s - k;
                if (sk >= 0) { const v4u v = *(const GAS v4u*)(X + (size_t)(row - k) * DM + c); const float r = RS[row - k];
                    const float f[8] = {bflo(v.x), bfhi(v.x), bflo(v.y), bfhi(v.y), bflo(v.z), bfhi(v.z), bflo(v.w), bfhi(v.w)};
#pragma unroll
                    for (int e = 0; e < 8; ++e) { const float hv = f[e] * r * gg[e]; acc[e] += hv; if (k == 0) self[e] = hv; } }
                else { const float* hp = hist + ((size_t)sb * 15 + (15 + sk)) * DM + c; const f32x4 u0 = *(const GAS f32x4*)hp, u1 = *(const GAS f32x4*)(hp + 4);
                    acc[0] += u0.x; acc[1] += u0.y; acc[2] += u0.z; acc[3] += u0.w; acc[4] += u1.x; acc[5] += u1.y; acc[6] += u1.z; acc[7] += u1.w; }
            }
            const float ic = 1.0f / (float)w;
            v4u o; o.x = pk2(acc[0] * ic - self[0], acc[1] * ic - self[1]); o.y = pk2(acc[2] * ic - self[2], acc[3] * ic - self[3]);
            o.z = pk2(acc[4] * ic - self[4], acc[5] * ic - self[5]); o.w = pk2(acc[6] * ic - self[6], acc[7] * ic - self[7]);
            *(GAS v4u*)(Dd + (size_t)row * DM + c) = o;
        }
    }
}

constexpr int PNR = 4;
template <int G> __device__ __forceinline__ void pool_mix_group(const bf16* Z, const bf16* ZH, bool sample, int rowbase, int hbase, int p0, int lane, unsigned (&mp)[PNR][4], float (&ss)[PNR]) {
    constexpr int W = 2 << G, H = W - 1;
    const int c = G * 512 + lane * 8;
#define PM_LOAD(r) ({ const int p_ = p0 - H + (r); v4u v_ = (v4u){0u, 0u, 0u, 0u}; \
        if (p_ >= 0) v_ = *(const GAS v4u*)(Z + (size_t)(rowbase + p_) * DM + c); else if (sample) v_ = *(const GAS v4u*)(ZH + (size_t)(hbase + 15 + p_) * DM + c); v_; })
#define PM_ROWF(v, f) do { f[0] = bflo(v.x); f[1] = bfhi(v.x); f[2] = bflo(v.y); f[3] = bfhi(v.y); f[4] = bflo(v.z); f[5] = bfhi(v.z); f[6] = bflo(v.w); f[7] = bfhi(v.w); } while (0)
    float S[8];
#pragma unroll
    for (int e = 0; e < 8; ++e) S[e] = 0.f;
    v4u zk[PNR];
#pragma unroll
    for (int r = 0; r < PNR; ++r) zk[r] = (v4u){0u, 0u, 0u, 0u};
#pragma unroll
    for (int b = 0; b < H; b += 16) {
        v4u zb[16];
#pragma unroll
        for (int r = 0; r < 16; ++r) if (b + r < H) zb[r] = PM_LOAD(b + r);
#pragma unroll
        for (int r = 0; r < 16; ++r) if (b + r < H) { float f[8]; PM_ROWF(zb[r], f);
#pragma unroll
            for (int e = 0; e < 8; ++e) S[e] += f[e];
            if (b + r < PNR) zk[b + r < PNR ? b + r : 0] = zb[r]; }
    }
    v4u zc[PNR];
#pragma unroll
    for (int i = 0; i < PNR; ++i) zc[i] = PM_LOAD(H + i);
#pragma unroll
    for (int i = 0; i < PNR; ++i) {
        float f[8]; PM_ROWF(zc[i], f);
#pragma unroll
        for (int e = 0; e < 8; ++e) S[e] += f[e];
        const int pos = p0 + i; const float ic = 1.0f / (float)(sample ? W : ((pos + 1) < W ? (pos + 1) : W));
        float m[8];
#pragma unroll
        for (int e = 0; e < 8; ++e) { m[e] = S[e] * ic - f[e]; ss[i] += m[e] * m[e]; }
        mp[i][0] = pg8::cvt_pk_bf16(m[0], m[1]); mp[i][1] = pg8::cvt_pk_bf16(m[2], m[3]); mp[i][2] = pg8::cvt_pk_bf16(m[4], m[5]); mp[i][3] = pg8::cvt_pk_bf16(m[6], m[7]);
        { float fl[8]; const v4u lv = (i < H) ? zk[i < H ? i : 0] : zc[i >= H ? i - H : 0]; PM_ROWF(lv, fl);
#pragma unroll
          for (int e = 0; e < 8; ++e) S[e] -= fl[e]; }
    }
#undef PM_ROWF
#undef PM_LOAD
}
__device__ __forceinline__ void pool_norm_item(Frame& F, const float* g_post, bool sample, int rowbase, int hbase, int p0, int lane) {
    const bf16* Z = (const bf16*)(F.ws + WS_MB); const bf16* ZH = (const bf16*)(F.ws + WS_ZH);
    bf16* XB = (bf16*)(F.ws + WS_XB); float* RS = (float*)(F.ws + WS_RS);
    unsigned mp[4][PNR][4]; float ss[PNR];
#pragma unroll
    for (int i = 0; i < PNR; ++i) ss[i] = 0.f;
#define PM_FENCE() asm volatile("" ::: "memory")
    pool_mix_group<3>(Z, ZH, sample, rowbase, hbase, p0, lane, mp[3], ss); PM_FENCE(); pool_mix_group<2>(Z, ZH, sample, rowbase, hbase, p0, lane, mp[2], ss);
    pool_mix_group<1>(Z, ZH, sample, rowbase, hbase, p0, lane, mp[1], ss); pool_mix_group<0>(Z, ZH, sample, rowbase, hbase, p0, lane, mp[0], ss); PM_FENCE();
    float r1[PNR], s2[PNR];
#pragma unroll
    for (int i = 0; i < PNR; ++i) { r1[i] = 1.0f / sqrtf(wave_sum(ss[i], lane) * (1.0f / DM) + EPS); s2[i] = 0.f; }
#pragma unroll
    for (int g = 0; g < 4; ++g) {
        const int c = g * 512 + lane * 8;
        const f32x4 ga = *(const GAS f32x4*)(g_post + c), gb = *(const GAS f32x4*)(g_post + c + 4);
        const float gg[8] = {ga.x, ga.y, ga.z, ga.w, gb.x, gb.y, gb.z, gb.w};
        v4u xv[PNR];
#pragma unroll
        for (int i = 0; i < PNR; ++i) xv[i] = *(const GAS v4u*)(XB + (size_t)(rowbase + p0 + i) * DM + c);
#pragma unroll
        for (int i = 0; i < PNR; ++i) {
            const unsigned xw[4] = {xv[i].x, xv[i].y, xv[i].z, xv[i].w};
            float xn[8];
#pragma unroll
            for (int q = 0; q < 4; ++q) { xn[2 * q] = bflo(xw[q]) + bflo(mp[g][i][q]) * r1[i] * gg[2 * q]; xn[2 * q + 1] = bfhi(xw[q]) + bfhi(mp[g][i][q]) * r1[i] * gg[2 * q + 1]; }
#pragma unroll
            for (int e = 0; e < 8; ++e) s2[i] += xn[e] * xn[e];
            v4u o; o.x = pg8::cvt_pk_bf16(xn[0], xn[1]); o.y = pg8::cvt_pk_bf16(xn[2], xn[3]); o.z = pg8::cvt_pk_bf16(xn[4], xn[5]); o.w = pg8::cvt_pk_bf16(xn[6], xn[7]);
            *(GAS v4u*)(XB + (size_t)(rowbase + p0 + i) * DM + c) = o;
        }
        if (g & 1) PM_FENCE();
    }
#undef PM_FENCE
#pragma unroll
    for (int i = 0; i < PNR; ++i) { const float r2 = 1.0f / sqrtf(wave_sum(s2[i], lane) * (1.0f / DM) + EPS); if (lane == 0) ((GAS float*)RS)[rowbase + p0 + i] = r2; }
}
__device__ __forceinline__ void norm_pool_phase(Frame& F, const float* g_post) {
    frame_lanes(F);
    const int gw = F.vcu * NWAVES + F.wave, NGW = F.G * NWAVES, lane = F.lane;
    for (int ch = gw; ch < TP / 16; ch += NGW) {
        const int t0 = ch * 16, rowbase = t0 & ~(SEQ - 1), s0 = t0 & (SEQ - 1);
#pragma unroll 1
        for (int q = 0; q < 16 / PNR; ++q) pool_norm_item(F, g_post, false, rowbase, 0, s0 + PNR * q, lane);
    }
    for (int si = gw; si < 32 * (16 / PNR); si += NGW) { const int sb = si / (16 / PNR), q = si % (16 / PNR); pool_norm_item(F, g_post, true, TP + 16 * sb, 16 * sb, PNR * q, lane); }
}

__device__ __forceinline__ void fix_phase(Frame& F, int L, int b0) {
    frame_lanes(F);
    const int nb = F.G - b0, vb = (int)blockIdx.x - b0; if (vb < 0) return;
    const bf16* BF = (const bf16*)(F.ws + WS_BND); const bf16* BL = BF + (size_t)512 * 2 * NUP;
    const float* cw = inp(F, 18) + (size_t)L * 3 * NUP; const float* cb = inp(F, 19) + (size_t)L * NUP;
    bf16* act = (bf16*)(F.ws + WS_ACT);
    for (int idx = (vb * NWAVES + F.wave) * 64 + F.lane; idx < 512 * 2 * 704; idx += nb * NWAVES * 64) {
        const int cc = idx % 704, sj = idx / 704, s = sj >> 1, jr = sj & 1;
        const int jg = cc * 8, np = (jg >> 7) * 256 + (jg & 127);
        const bool seq0 = (s & 63) == 0;
        float u0[2][8], u1[2][8], u2[2][8];
#pragma unroll
        for (int gv = 0; gv < 2; ++gv) {
            const v4u zero = (v4u){0u, 0u, 0u, 0u};
            const v4u cur = *(const GAS v4u*)(BF + (size_t)(s * 2 + jr) * NUP + np + gv * 128);
            const v4u f0 = *(const GAS v4u*)(BF + (size_t)(s * 2) * NUP + np + gv * 128);
            const v4u l0 = seq0 ? zero : *(const GAS v4u*)(BL + (size_t)((s - 1) * 2) * NUP + np + gv * 128);
            const v4u l1 = seq0 ? zero : *(const GAS v4u*)(BL + (size_t)((s - 1) * 2 + 1) * NUP + np + gv * 128);
            const v4u p1 = jr ? f0 : l1, p2 = jr ? l1 : l0;
            const unsigned cu[4] = {cur.x, cur.y, cur.z, cur.w}, a1[4] = {p1.x, p1.y, p1.z, p1.w}, a2[4] = {p2.x, p2.y, p2.z, p2.w};
#pragma unroll
            for (int e = 0; e < 4; ++e) { u0[gv][2 * e] = bflo(cu[e]); u0[gv][2 * e + 1] = bfhi(cu[e]); u1[gv][2 * e] = bflo(a1[e]); u1[gv][2 * e + 1] = bfhi(a1[e]); u2[gv][2 * e] = bflo(a2[e]); u2[gv][2 * e + 1] = bfhi(a2[e]); }
        }
        float r[8];
#pragma unroll
        for (int e = 0; e < 8; ++e) {
            const int cg = jg + e, cv = DFF + jg + e;
            const GAS float* cwg = (const GAS float*)cw; const GAS float* cbg = (const GAS float*)cb;
            const float g = cbg[cg] + cwg[cg] * u2[0][e] + cwg[NUP + cg] * u1[0][e] + cwg[2 * NUP + cg] * u0[0][e];
            const float v = cbg[cv] + cwg[cv] * u2[1][e] + cwg[NUP + cv] * u1[1][e] + cwg[2 * NUP + cv] * u0[1][e];
            r[e] = pg8::silu_mul(g, v);
        }
        v4u o; o.x = pk2(r[0], r[1]); o.y = pk2(r[2], r[3]); o.z = pk2(r[4], r[5]); o.w = pk2(r[6], r[7]);
        *(GAS v4u*)(act + (size_t)(s * 64 + jr) * DFF + jg) = o;
    }
}

__device__ __forceinline__ int attn_fetch_any(unsigned* qc, int g0) {
    for (int tries = 0; tries < 8; ++tries) {
        unsigned c[8];
#pragma unroll
        for (int g = 0; g < 8; ++g) c[g] = xb_ld(qc + 64 * g);
        int best = 8, bg = 0;
#pragma unroll
        for (int g = 0; g < 8; ++g) { const int d = (g - g0) & 7; if (c[g] < 256u && d < best) { best = d; bg = g; } }
        if (best == 8) return -1;
        const unsigned u = xb_add(qc + 64 * bg, 1u);
        if (u < 256u) return (bg << 16) | (int)u;
    }
    return -1;
}
__device__ __forceinline__ void attn_phase(Frame& F, unsigned* qc) {
    frame_lanes(F);
    const bf16* Q = (const bf16*)(F.ws + WS_Q); const bf16* KV = (const bf16*)(F.ws + WS_KV); const bf16* KRB = (const bf16*)(F.ws + WS_KRB); bf16* O = (bf16*)(F.ws + WS_HB);
    volatile LAS int* slot = (volatile LAS int*)(F.lds + MISC_OFF + 64);
    const int g0 = (F.G % 8 == 0) ? (F.vcu / (F.G / 8)) & 7 : (F.vcu & 7);
    int par = 0;
    for (;;) {
        if (F.tid == 0) slot[par] = attn_fetch_any(qc, g0);
        __syncthreads();
        const int gu = __builtin_amdgcn_readfirstlane(slot[par]); par ^= 1;
        if (gu < 0) break;
        const int g = gu >> 16; int u = gu & 0xffff;
        unsigned* ctr = qc + 64 * g;
        while (u < 256) {
            const int k = u >> 6, r = u & 63, qb = 15 - (r >> 2), bh = 4 * g + (r & 3) + 32 * k, b = bh >> 4, h = bh & 15;
            const size_t row0 = (size_t)b * SEQ;
            att::attn_unit(Q + (row0 + 256 * qb) * 3072 + h * 192, KV + row0 * 4096 + h * 128, KV + row0 * 4096 + 2048 + h * 128, KRB + row0 * 64,
                           O + (row0 + 256 * qb) * DM + h * 128, 4 * qb + 4, qb, (ATT_LAS char*)(F.lds + RING_OFF), ctr, (volatile ATT_LAS int*)(slot + par));
            u = __builtin_amdgcn_readfirstlane(slot[par]); par ^= 1;
        }
    }
}

struct Args { const float* in[21]; float* out; unsigned char* ws; int ph_lo, ph_hi; };
constexpr int NPH = 1 + 4 * 16;
#ifndef PG8_ALIGN
#define PG8_ALIGN true
#endif
__global__ void __launch_bounds__(NWAVES * 64, 2) fwd_kernel(Args args) {
    extern __shared__ __attribute__((aligned(16))) unsigned char lds[];
    Frame F;
    F.lds = (LAS unsigned char*)lds;
    F.tid = threadIdx.x; F.lane = F.tid & 63; F.wave = __builtin_amdgcn_readfirstlane(F.tid >> 6);
    F.G = gridDim.x; { const int bx = blockIdx.x; F.vcu = (F.G % 8 == 0) ? (bx % 8) * (F.G / 8) + bx / 8 : bx; }
    F.out = args.out; F.ws = args.ws;
    unsigned* ctl = (unsigned*)(F.ws + WS_CTL);
    for (int u = F.tid; u < (LDS_BYTES - LDSCTL_OFF) / 4; u += NWAVES * 64) ((LAS unsigned*)(F.lds + LDSCTL_OFF))[u] = 0u;
    __syncthreads();
    if (F.tid == 0) {
#pragma unroll
        for (int i = 0; i < 21; ++i) ((LAS unsigned long long*)(F.lds + PTR_OFF))[i] = (unsigned long long)args.in[i];
    }
    __syncthreads();
    const int lo = args.ph_lo, hi = args.ph_hi;
    const bool one_launch = (hi - lo) > 1;
    XcdBarrier bar; bar.bar = ctl + CW_BAR; bar.x = 0; bar.st = nullptr;
    if (one_launch) bar = xcd_barrier_post(ctl + CW_BAR, (volatile LAS unsigned*)(F.lds + MISC_OFF) + 8);
#ifndef PH_MASK
#define PH_MASK 0x1ffffu
#endif
#define IN(k) (lo <= (k) && (k) < hi)
#define EN(p) (((PH_MASK) >> (p)) & 1u)
#ifndef DBL_MASK
#define DBL_MASK 0u
#endif
#define REPS(p) ((int)(((DBL_MASK) >> (p)) & 1u) + 1)
#define SEAM(k) do { if (IN((k) + 1)) { xcd_barrier(bar); if (REPS(17) > 1) xcd_barrier(bar); } } while (0)
    const int bid = (int)blockIdx.x;

    if (EN(16) && IN(0)) { for (int rep_ = 0; rep_ < REPS(16); ++rep_) { if (rep_) xcd_barrier(bar); p0_prologue(F); convert_ffn(F, 0); norm0_phase(F); } SEAM(0); }

    for (int L = 0; L < 4; ++L) {
        const int base = 1 + 16 * L, j = L >> 1;
        const float* ng = inp(F, 6) + (size_t)L * 4 * DM;
        if ((L & 1) == 0) {
            unsigned char* wb = F.ws + WS_W + j * W_MLA;
            if (EN(0) && IN(base + 0)) { for (int rep_ = 0; rep_ < REPS(0); ++rep_) { if (rep_) xcd_barrier(bar); frame_lanes(F); LAS unsigned char* ring = F.lds + RING_OFF;  pg8::SchedPlain S; S.init(130, 5, F.G, bid); S.A = (const char*)(F.ws + WS_XB); S.B = (const char*)(wb + WO_DQKV); S.lda = 2048; S.ldb = 2048; S.K = 2048;
                pg8::EpiB<0> E{(bf16*)(F.ws + WS_MB), 1280, nullptr}; pg8::gemm_phase<pg8::EpiB<0>, pg8::SchedPlain, PG8_ALIGN>(ring, S, E);  } SEAM(base + 0); }
            if (EN(1) && IN(base + 1)) { for (int rep_ = 0; rep_ < REPS(1); ++rep_) { if (rep_) xcd_barrier(bar); frame_lanes(F); LAS unsigned char* ring = F.lds + RING_OFF;  s1_phase(F, j); s1_cache_phase(F, j);  } SEAM(base + 1); }
            if (EN(2) && IN(base + 2)) { for (int rep_ = 0; rep_ < REPS(2); ++rep_) { if (rep_) xcd_barrier(bar); frame_lanes(F); LAS unsigned char* ring = F.lds + RING_OFF;  pg8::SchedPlain S; S.init(128, 12, F.G, bid); S.A = (const char*)(F.ws + WS_CQ); S.B = (const char*)(wb + WO_UQ); S.lda = 512; S.ldb = 512; S.K = 512;
                pg8::EpiQRope E{(bf16*)(F.ws + WS_Q), (const float*)(F.ws + WS_ROPE), (const float*)(F.ws + WS_ROPE) + 4096 * 32};
                pg8::gemm_phase<pg8::EpiQRope, pg8::SchedPlain, PG8_ALIGN>(ring, S, E);  } SEAM(base + 2); }
            if (EN(8) && IN(base + 3)) { for (int rep_ = 0; rep_ < REPS(8); ++rep_) { if (rep_) xcd_barrier(bar); frame_lanes(F); LAS unsigned char* ring = F.lds + RING_OFF;  pg8::SchedPlain S; S.init(128, 16, F.G, bid); S.A = (const char*)(F.ws + WS_CKVB); S.B = (const char*)(wb + WO_UKV); S.lda = 512; S.ldb = 512; S.K = 512;
                pg8::EpiB<0> E{(bf16*)(F.ws + WS_KV), 4096, nullptr}; pg8::gemm_phase<pg8::EpiB<0>, pg8::SchedPlain, PG8_ALIGN>(ring, S, E);  } SEAM(base + 3); }
            if (EN(9) && IN(base + 4)) {
                frame_lanes(F); LAS unsigned char* ring = F.lds + RING_OFF;
                if ((F.vcu & 7) == 0) {
                    Frame Fs = F; Fs.vcu = F.vcu >> 3; Fs.G = (F.G + 7) >> 3;
                    const int NS = Fs.G, sb = Fs.vcu;
                    unsigned* sc = ctl + CW_SUB + 512 * j;
                    { pg8::SchedPlainOff S; S.init(2, 12, NS, sb); S.pm0 = 128; S.A = (const char*)(F.ws + WS_CQ); S.B = (const char*)(wb + WO_UQ); S.lda = 512; S.ldb = 512; S.K = 512;
                      pg8::EpiQRope E{(bf16*)(F.ws + WS_Q), (const float*)(F.ws + WS_ROPE), (const float*)(F.ws + WS_ROPE) + 4096 * 32};
                      pg8::gemm_phase<pg8::EpiQRope, pg8::SchedPlainOff, PG8_ALIGN>(ring, S, E); }
                    sub_barrier(sc + 256, NS, ctl + CW_BAR);
                    qlat_rope_copy(Fs);
                    { pg8::SchedQlat S; S.init(32, 2, NS, sb); S.A = (const char*)(F.ws + WS_Q) + (size_t)TP * 3072 * 2; S.B = (const char*)(wb + WO_UK2); S.lda = 3072; S.ldb = 256; S.K = 256;
                      pg8::EpiB<1> E{(bf16*)(F.ws + WS_QLAT), 640, nullptr}; pg8::gemm_phase<pg8::EpiB<1>, pg8::SchedQlat, PG8_ALIGN>(ring, S, E); }
                    sub_barrier(sc, NS, ctl + CW_BAR);
                    { pg8::SchedBatch S; S.init(32, 9, NS, sb); S.A = (const char*)(F.ws + WS_QLAT); S.B = (const char*)(F.ws + WS_KALL); S.lda = 640; S.ldb = 640; S.K = 640; S.b_pm = (size_t)2304 * 640 * 2;
                      pg8::EpiF32 E{(float*)(F.ws + WS_S), 2304}; pg8::gemm_phase<pg8::EpiF32, pg8::SchedBatch, PG8_ALIGN>(ring, S, E); }
                    sub_barrier(sc + 64, NS, ctl + CW_BAR);
                    softmax_phase(Fs);
                    sub_barrier(sc + 128, NS, ctl + CW_BAR);
                    { pg8::SchedBatch S; S.init(32, 2, NS, sb); S.A = (const char*)(F.ws + WS_P); S.B = (const char*)(F.ws + WS_VT); S.lda = 2304; S.ldb = 2304; S.K = 2304; S.b_pm = (size_t)512 * 2304 * 2;
                      pg8::EpiB<2> E{(bf16*)(F.ws + WS_OL), 512, nullptr}; pg8::gemm_phase<pg8::EpiB<2>, pg8::SchedBatch, PG8_ALIGN>(ring, S, E); }
                    sub_barrier(sc + 192, NS, ctl + CW_BAR);
                    { pg8::SchedOV S; S.init(32, 1, NS, sb); S.A = (const char*)(F.ws + WS_OL); S.B = (const char*)(wb + WO_UKV) + (size_t)2048 * 512 * 2; S.lda = 512; S.ldb = 512; S.K = 512;
                      pg8::EpiB<3> E{(bf16*)(F.ws + WS_HB), 2048, nullptr}; pg8::gemm_phase<pg8::EpiB<3>, pg8::SchedOV, PG8_ALIGN>(ring, S, E); }
                    sub_barrier(sc + 320, NS, ctl + CW_BAR);
                    { pg8::SchedSplit S2; S2.init(2 * 4, 8, NS, sb); S2.A = (const char*)(F.ws + WS_HB) + (size_t)TP * 2048 * 2; S2.B = (const char*)(wb + WO_O); S2.lda = 2048; S2.ldb = 2048; S2.K = 512;
                      pg8::EpiSlab E2{(bf16*)(F.ws + WS_SLAB)}; pg8::gemm_phase<pg8::EpiSlab, pg8::SchedSplit, PG8_ALIGN>(ring, S2, E2); }
                    __syncthreads();
                }
                attn_phase(F, ctl + CW_Q + 512 * j);
                SEAM(base + 4);
            }
            if (EN(10) && IN(base + 10)) { for (int rep_ = 0; rep_ < REPS(10); ++rep_) { if (rep_) xcd_barrier(bar); frame_lanes(F); LAS unsigned char* ring = F.lds + RING_OFF;  pg8::SchedPlain S; S.init(128, 8, F.G, bid); S.A = (const char*)(F.ws + WS_HB); S.B = (const char*)(wb + WO_O); S.lda = 2048; S.ldb = 2048; S.K = 2048;
                pg8::EpiB<0> E{(bf16*)(F.ws + WS_MB), 2048, nullptr}; pg8::gemm_phase<pg8::EpiB<0>, pg8::SchedPlain, PG8_ALIGN>(ring, S, E);
  } SEAM(base + 10); }
        } else {
            if (EN(10) && IN(base + 10)) { for (int rep_ = 0; rep_ < REPS(10); ++rep_) { if (rep_) xcd_barrier(bar); frame_lanes(F); LAS unsigned char* ring = F.lds + RING_OFF;
                { pg8::SchedPool S; S.init(130, 8, F.G, bid); S.A = (const char*)(F.ws + WS_XB); S.B = (const char*)(F.ws + WS_WPOOL + (size_t)j * 2 * MiB); S.lda = 2048; S.ldb = 512; S.K = 512;
                  pg8::EpiB<4> E{(bf16*)(F.ws + WS_MB), 2048, inp(F, 16) + (size_t)j * DM, (const float*)(F.ws + WS_RS)}; pg8::gemm_phase<pg8::EpiB<4>, pg8::SchedPool, PG8_ALIGN>(ring, S, E); }
                { pg8::SchedPool S; S.init(2, 8, F.G, (bid + F.G - (F.G > 16 ? 16 : 0)) % F.G); S.A = (const char*)(F.ws + WS_HS + (size_t)j * 2 * MiB); S.B = (const char*)(F.ws + WS_WPOOLH + (size_t)j * 2 * MiB); S.lda = 2048; S.ldb = 512; S.K = 512;
                  pg8::EpiB<0> E{(bf16*)(F.ws + WS_ZH), 2048, inp(F, 16) + (size_t)j * DM, nullptr}; pg8::gemm_phase<pg8::EpiB<0>, pg8::SchedPool, PG8_ALIGN>(ring, S, E); }
                } SEAM(base + 10); }
        }
        unsigned char* wf = F.ws + WS_WFFN;
        if (EN(11) && IN(base + 11)) { for (int rep_ = 0; rep_ < REPS(11); ++rep_) { if (rep_) xcd_barrier(bar); frame_lanes(F); LAS unsigned char* ring = F.lds + RING_OFF;  const bool dry = rep_ + 1 < REPS(11); if (L & 1) norm_pool_phase(F, ng + DM); else norm_phase<false, false>(F, (const bf16*)(F.ws + WS_MB), (const bf16*)(F.ws + WS_SLAB), 4, ng + DM, nullptr, nullptr, nullptr, false, dry);  } SEAM(base + 11); }
        if (EN(12) && IN(base + 12)) { for (int rep_ = 0; rep_ < REPS(12); ++rep_) { if (rep_) xcd_barrier(bar); frame_lanes(F); LAS unsigned char* ring = F.lds + RING_OFF;
            { pg8::SchedPlain S; S.init(128, 44, F.G, bid); S.A = (const char*)(F.ws + WS_XB); S.B = (const char*)(wf + WO_UP); S.lda = 2048; S.ldb = 2048; S.K = 2048;
              pg8::EpiUpP E{(bf16*)(F.ws + WS_ACT), (bf16*)(F.ws + WS_BND), (bf16*)(F.ws + WS_BND) + (size_t)512 * 2 * NUP, inp(F, 18) + (size_t)L * 3 * NUP, inp(F, 19) + (size_t)L * NUP,
                             F.out + O_CONV_P + (size_t)L * 8 * 2 * NUP, (const float*)(F.ws + WS_RS)};
              pg8::gemm_phase<pg8::EpiUpP, pg8::SchedPlain, PG8_ALIGN>(ring, S, E); }
            } SEAM(base + 12); }
        if (EN(13) && IN(base + 13)) { for (int rep_ = 0; rep_ < REPS(13); ++rep_) { if (rep_) xcd_barrier(bar); frame_lanes(F); LAS unsigned char* ring = F.lds + RING_OFF;  { { pg8::SchedPlainOff S; S.init(2, 44, F.G, bid); S.pm0 = 128; S.A = (const char*)(F.ws + WS_XB); S.B = (const char*)(wf + WO_UP); S.lda = 2048; S.ldb = 2048; S.K = 2048;
              pg8::EpiUpS E{(bf16*)(F.ws + WS_ACT), inp(F, 18) + (size_t)L * 3 * NUP, inp(F, 19) + (size_t)L * NUP, inp(F, 5) + (size_t)L * 32 * 2 * NUP, F.out + O_CONV_S + (size_t)L * 32 * 2 * NUP, (const float*)(F.ws + WS_RS)};
              pg8::gemm_phase<pg8::EpiUpS, pg8::SchedPlainOff, PG8_ALIGN>(ring, S, E); } }
            fix_phase(F, L, F.G > 88 ? 88 : 0);  } SEAM(base + 13); }
        if (EN(14) && IN(base + 14)) { for (int rep_ = 0; rep_ < REPS(14); ++rep_) { if (rep_) xcd_barrier(bar); frame_lanes(F); LAS unsigned char* ring = F.lds + RING_OFF;  pg8::SchedPlain S; S.init(128, 8, F.G, bid); S.A = (const char*)(F.ws + WS_ACT); S.B = (const char*)(wf + WO_DOWN); S.lda = DFF; S.ldb = DFF; S.K = DFF;
            pg8::EpiB<0> E{(bf16*)(F.ws + WS_MB), 2048, nullptr}; pg8::gemm_phase<pg8::EpiB<0>, pg8::SchedPlain, PG8_ALIGN>(ring, S, E);
            { pg8::SchedSplit S2; S2.init(2 * 11, 8, F.G, bid); S2.A = (const char*)(F.ws + WS_ACT) + (size_t)TP * DFF * 2; S2.B = (const char*)(wf + WO_DOWN); S2.lda = DFF; S2.ldb = DFF; S2.K = 512;
              pg8::EpiSlab E2{(bf16*)(F.ws + WS_SLAB)}; pg8::gemm_phase<pg8::EpiSlab, pg8::SchedSplit, PG8_ALIGN>(ring, S2, E2); }  } SEAM(base + 14); }
        if (EN(15) && IN(base + 15)) {
            const bool poison = one_launch && xb_ld(ctl + CW_BAR + XB_TMO) != 0u;
            frame_lanes(F);
            if (L < 3) convert_ffn(F, L + 1);
            const bf16* slab = (const bf16*)(F.ws + WS_SLAB);
            if (L == 3) norm_phase<true, false>(F, (const bf16*)(F.ws + WS_MB), slab, 11, ng + 3 * DM, nullptr, nullptr, nullptr, poison);
            else if ((L & 1) == 0) norm_phase<false, true>(F, (const bf16*)(F.ws + WS_MB), slab, 11, ng + 3 * DM, ng + 4 * DM, F.out + O_POOL_P + (size_t)j * 8 * 15 * DM, F.out + O_POOL_S + (size_t)j * 32 * 15 * DM, false);
            else norm_phase<false, false>(F, (const bf16*)(F.ws + WS_MB), slab, 11, ng + 3 * DM, nullptr, nullptr, nullptr, false);
            if (L < 3) SEAM(base + 15);
        }
    }
#undef IN
#undef SEAM
}

#ifndef MK_PER_PHASE
#define MK_PER_PHASE 0
#endif
extern "C" void kernel_launch(void* const* d_in, const int* in_sizes, int n_in, void* d_out, int out_size, void* d_ws, size_t ws_size, hipStream_t stream) {
    static int grid = 0;
    if (grid == 0) {
        if (n_in != 21 || (size_t)out_size != O_END || ws_size < WS_END) { fprintf(stderr, "kernel_launch: unexpected problem shape (n_in %d, out %d, ws %zu < %zu); nothing launched\n", n_in, out_size, ws_size, (size_t)WS_END); grid = -1; return; }
        int dev = 0, cus = 0, per_cu = 0;
        if (hipGetDevice(&dev) != hipSuccess || hipDeviceGetAttribute(&cus, hipDeviceAttributeMultiprocessorCount, dev) != hipSuccess) { grid = -1; return; }
        if (hipFuncSetAttribute((const void*)fwd_kernel, hipFuncAttributeMaxDynamicSharedMemorySize, LDS_BYTES) != hipSuccess) { fprintf(stderr, "kernel_launch: hipFuncSetAttribute failed\n"); grid = -1; return; }
        if (hipOccupancyMaxActiveBlocksPerMultiprocessor(&per_cu, (const void*)fwd_kernel, NWAVES * 64, LDS_BYTES) != hipSuccess || per_cu < 1) { fprintf(stderr, "kernel_launch: occupancy query says %d blocks per CU\n", per_cu); }
        (void)hipGetLastError();
        grid = cus;
    }
    if (grid < 0) return;
    (void)hipMemsetAsync((char*)d_ws + WS_CTL, 0, CTL_ZERO_BYTES, stream);
    Args a{};
    for (int i = 0; i < 21; ++i) a.in[i] = (const float*)d_in[i];
    a.out = (float*)d_out; a.ws = (unsigned char*)d_ws;
#if MK_PER_PHASE
    for (int p = 0; p < NPH; ++p) {
        if (p >= 1) { const int L = (p - 1) >> 4, q = (p - 1) & 15; if ((L & 1) && q < 9) continue; }
        a.ph_lo = p; a.ph_hi = p + 1;
        hipLaunchKernelGGL(fwd_kernel, dim3(grid), dim3(NWAVES * 64), LDS_BYTES, stream, a);
    }
#else
    a.ph_lo = 0; a.ph_hi = NPH;
    hipLaunchKernelGGL(fwd_kernel, dim3(grid), dim3(NWAVES * 64), LDS_BYTES, stream, a);
#endif
}
```

```cpp
#define DBL_MASK 0u
#ifndef MK_PER_PHASE
#define MK_PER_PHASE 0
#endif
#include <hip/hip_runtime.h>
#include <cstdio>
#include <cstdint>
namespace pg8 {
#define PG8_LAS __attribute__((address_space(3)))
#define PG8_GAS __attribute__((address_space(1)))
typedef unsigned short bf16_t;
typedef short bf16x8 __attribute__((ext_vector_type(8)));
typedef float f32x4 __attribute__((ext_vector_type(4)));
typedef unsigned u32x4 __attribute__((ext_vector_type(4)));
typedef unsigned u32x2 __attribute__((ext_vector_type(2)));
constexpr int BM = 256, BK = 64, HALF = 128, HTB = HALF * BK * 2  , STAGE_BYTES = 8 * HTB, NXCD = 8, WGM = 8;

__host__ __device__ __forceinline__ int lds_byte(int r, int c) { const int st = (r >> 4) * 2 + (c >> 5), rr = r & 15, cc = c & 31, ob = rr * 64 + cc * 2; return st * 1024 + (ob ^ (((ob >> 9) & 1) << 5)); }
__host__ __device__ __forceinline__ void stage_rc(int b, int& R, int& C) { const int st = b / 1024, sb = b % 1024, swz = sb ^ (((sb >> 9) & 1) << 5); R = (st >> 1) * 16 + swz / 64; C = (st & 1) * 32 + (swz % 64) / 2; }
__host__ __device__ __forceinline__ int perm32(int rho) { const int n = rho >> 4, i = rho & 15; return 8 * (i >> 2) + 4 * n + (i & 3); }

struct Unit { int pm, pn; };

struct OrderBase {
    int nM, nN, nwg, G, c;
    __device__ __forceinline__ void init(int nM_, int nN_, int G_, int c_) { nM = nM_; nN = nN_; nwg = nM * nN; G = G_; c = c_; }
    __device__ __forceinline__ bool next(int i, Unit& u) const {
        const long L = (long)i * G + c; if (L >= nwg) return false;
        int wgid = (int)L; { const int q = nwg / NXCD, r = nwg % NXCD, xcd = wgid % NXCD, off = wgid / NXCD; wgid = (xcd < r ? xcd * (q + 1) : r * (q + 1) + (xcd - r) * q) + off; }
        const int nig = WGM * nN, gid = wgid / nig, fm = gid * WGM, gsz = (nM - fm) < WGM ? (nM - fm) : WGM;
        u.pm = fm + ((wgid % nig) % gsz); u.pn = (wgid % nig) / gsz; return true;
    }
    __device__ __forceinline__ void a_ready(const Unit&) const {}
    __device__ __forceinline__ void done(const Unit&) const {}
};
struct SchedPlain : OrderBase {
    const char* A; const char* B; int lda, ldb, K;
    __device__ __forceinline__ const char* a_ptr(const Unit& u) const { return A + (size_t)u.pm * 256 * lda * 2; }
    __device__ __forceinline__ const char* b_ptr(const Unit& u) const { return B + (size_t)u.pn * 256 * ldb * 2; }
};
struct SchedPlainOff : OrderBase {
    const char* A; const char* B; int lda, ldb, K, pm0;
    __device__ __forceinline__ bool next(int i, Unit& u) const { const bool r = OrderBase::next(i, u); u.pm += pm0; return r; }
    __device__ __forceinline__ const char* a_ptr(const Unit& u) const { return A + (size_t)u.pm * 256 * lda * 2; }
    __device__ __forceinline__ const char* b_ptr(const Unit& u) const { return B + (size_t)u.pn * 256 * ldb * 2; }
};
struct SchedBatch : OrderBase {
    const char* A; const char* B; int lda, ldb, K; size_t b_pm;
    __device__ __forceinline__ const char* a_ptr(const Unit& u) const { return A + (size_t)u.pm * 256 * lda * 2; }
    __device__ __forceinline__ const char* b_ptr(const Unit& u) const { return B + (size_t)u.pm * b_pm + (size_t)u.pn * 256 * ldb * 2; }
};
struct SchedQlat : OrderBase {
    const char* A; const char* B; int lda, ldb, K;
    __device__ __forceinline__ const char* a_ptr(const Unit& u) const { return A + ((size_t)(u.pm & 1) * 256 * lda + (size_t)(u.pm >> 1) * 192) * 2; }
    __device__ __forceinline__ const char* b_ptr(const Unit& u) const { return B + ((size_t)(u.pm >> 1) * 512 + (size_t)u.pn * 256) * ldb * 2; }
};
struct SchedOV : OrderBase {
    const char* A; const char* B; int lda, ldb, K;
    __device__ __forceinline__ const char* a_ptr(const Unit& u) const { return A + (size_t)u.pm * 256 * lda * 2; }
    __device__ __forceinline__ const char* b_ptr(const Unit& u) const { return B + (size_t)(u.pm >> 2) * 256 * ldb * 2; }
};
struct SchedPool : OrderBase {
    const char* A; const char* B; int lda, ldb, K;
    __device__ __forceinline__ const char* a_ptr(const Unit& u) const { return A + ((size_t)u.pm * 256 * lda + (size_t)(u.pn >> 1) * 512) * 2; }
    __device__ __forceinline__ const char* b_ptr(const Unit& u) const { return B + (size_t)u.pn * 256 * ldb * 2; }
};

struct SchedSplit : OrderBase {
    const char* A; const char* B; int lda, ldb, K;
    __device__ __forceinline__ const char* a_ptr(const Unit& u) const { return A + ((size_t)(u.pm & 1) * 256 * lda + (size_t)(u.pm >> 1) * K) * 2; }
    __device__ __forceinline__ const char* b_ptr(const Unit& u) const { return B + ((size_t)u.pn * 256 * ldb + (size_t)(u.pm >> 1) * K) * 2; }
};

__device__ __forceinline__ unsigned cvt_pk_bf16(float lo, float hi) { unsigned r; asm volatile("v_cvt_pk_bf16_f32 %0, %1, %2" : "=v"(r) : "v"(lo), "v"(hi)); return r; }

struct EpiF32 {
    static constexpr bool PERM = false, APERM = false, AFTER_DRAIN = false; static constexpr int NST = 32;
    float* C; int ldc;
    __device__ __forceinline__ void operator()(const f32x4 (&acc)[2][2][4][2], const Unit& u, int wr, int wc, int fr, int fq) const {
        const int row0 = u.pm * BM + wr * 64 + fr, col0 = u.pn * BM + wc * 32 + 4 * fq;
#pragma unroll
        for (int ai = 0; ai < 2; ++ai)
#pragma unroll
            for (int m = 0; m < 4; ++m) { float* rowp = C + (size_t)(row0 + ai * HALF + m * 16) * ldc + col0;
#pragma unroll
                for (int bj = 0; bj < 2; ++bj)
#pragma unroll
                    for (int n = 0; n < 2; ++n) *(PG8_GAS f32x4*)(rowp + bj * HALF + n * 16) = acc[ai][bj][m][n]; }
    }
};
struct EpiSlab {
    static constexpr bool PERM = true, APERM = false, AFTER_DRAIN = false; static constexpr int NST = 16;
    bf16_t* C;
    __device__ __forceinline__ void operator()(const f32x4 (&acc)[2][2][4][2], const Unit& u, int wr, int wc, int fr, int fq) const {
        bf16_t* base = C + ((size_t)(u.pm >> 1) * 512 + (u.pm & 1) * 256 + wr * 64 + fr) * 2048 + u.pn * BM + wc * 32 + 8 * fq;
#pragma unroll
        for (int ai = 0; ai < 2; ++ai)
#pragma unroll
            for (int m = 0; m < 4; ++m) { bf16_t* rowp = base + (size_t)(ai * HALF + m * 16) * 2048;
#pragma unroll
                for (int bj = 0; bj < 2; ++bj) { const f32x4 v0 = acc[ai][bj][m][0], v1 = acc[ai][bj][m][1];
                    u32x4 w; w.x = cvt_pk_bf16(v0[0], v0[1]); w.y = cvt_pk_bf16(v0[2], v0[3]); w.z = cvt_pk_bf16(v1[0], v1[1]); w.w = cvt_pk_bf16(v1[2], v1[3]);
                    *(PG8_GAS u32x4*)(rowp + bj * HALF) = w; } }
    }
};
template <int MODE> struct EpiB {
    static constexpr bool PERM = true, APERM = false, AFTER_DRAIN = false; static constexpr int NST = MODE == 3 ? 8 : 16;
    bf16_t* O; int ldc; const float* scale; const float* rsc;
    __device__ __forceinline__ void operator()(const f32x4 (&acc)[2][2][4][2], const Unit& u, int wr, int wc, int fr, int fq) const {
        f32x4 sv[2][2]; float rrow[2][4];
        if (MODE == 4) {
#pragma unroll
            for (int ai = 0; ai < 2; ++ai)
#pragma unroll
                for (int m = 0; m < 4; ++m) rrow[ai][m] = ((const PG8_GAS float*)rsc)[u.pm * BM + ai * HALF + wr * 64 + m * 16 + fr];
        }
        if (MODE == 0 || MODE == 4) {
#pragma unroll
            for (int bj = 0; bj < 2; ++bj)
#pragma unroll
                for (int n = 0; n < 2; ++n) sv[bj][n] = scale ? *(const PG8_GAS f32x4*)(scale + u.pn * BM + bj * HALF + wc * 32 + 8 * fq + 4 * n) : (f32x4){1.f, 1.f, 1.f, 1.f};
        }
#pragma unroll
        for (int ai = 0; ai < 2; ++ai)
#pragma unroll
            for (int m = 0; m < 4; ++m) {
                const int r = ai * HALF + wr * 64 + m * 16 + fr;
#pragma unroll
                for (int bj = 0; bj < 2; ++bj) {
                    const int c = bj * HALF + wc * 32 + 8 * fq;
                    bf16_t* p;
                    if (MODE == 0 || MODE == 4) p = O + (size_t)(u.pm * BM + r) * ldc + u.pn * BM + c;
                    else if (MODE == 1) { const int tok = 256 * (u.pm & 1) + r; p = O + (size_t)((tok >> 4) * 256 + (u.pm >> 1) * 16 + (tok & 15)) * 640 + u.pn * BM + c; }
                    else if (MODE == 2) { p = O + (size_t)((r >> 4) * 512 + 16 * u.pm + (r & 15)) * 512 + u.pn * BM + c; }
                    else { const int tok = 256 * (u.pm & 1) + r; p = O + (size_t)(32768 + tok) * 2048 + (u.pm >> 1) * 128 + (c & 127); }
                    if (MODE == 3 && bj != ((u.pm >> 1) & 1)) continue;
                    f32x4 v0 = acc[ai][bj][m][0], v1 = acc[ai][bj][m][1];
                    if (MODE == 0) { v0 = v0 * sv[bj][0]; v1 = v1 * sv[bj][1]; }
                    if (MODE == 4) { v0 = v0 * sv[bj][0] * rrow[ai][m]; v1 = v1 * sv[bj][1] * rrow[ai][m]; }
                    u32x4 w; w.x = cvt_pk_bf16(v0[0], v0[1]); w.y = cvt_pk_bf16(v0[2], v0[3]); w.z = cvt_pk_bf16(v1[0], v1[1]); w.w = cvt_pk_bf16(v1[2], v1[3]);
                    *(PG8_GAS u32x4*)p = w;
                }
            }
    }
};
struct EpiQRope {
    static constexpr bool PERM = true, APERM = false, AFTER_DRAIN = false; static constexpr int NST = 16;
    bf16_t* O; const float* ctab; const float* stab;
    __device__ __forceinline__ void operator()(const f32x4 (&acc)[2][2][4][2], const Unit& u, int wr, int wc, int fr, int fq) const {
        const int k0 = (u.pn * 8 + wc) % 6, k1 = (u.pn * 8 + 4 + wc) % 6;
        const int rbj = k0 >= 4 ? 0 : (k1 >= 4 ? 1 : -1);
        const int i0 = (((rbj == 0 ? k0 : k1) - 4) * 32 + 8 * fq) >> 1;
        f32x4 cs[2][4], sn[2][4];
        if (rbj >= 0) {
#pragma unroll
            for (int ai = 0; ai < 2; ++ai)
#pragma unroll
                for (int m = 0; m < 4; ++m) { const int t = u.pm * BM + ai * HALF + wr * 64 + m * 16 + fr; const int pos = t < 32768 ? (t & 4095) : 2048 + ((t - 32768) & 15);
                    cs[ai][m] = *(const PG8_GAS f32x4*)(ctab + pos * 32 + i0); sn[ai][m] = *(const PG8_GAS f32x4*)(stab + pos * 32 + i0); }
        }
#pragma unroll
        for (int bj = 0; bj < 2; ++bj) {
            const int c = u.pn * BM + bj * HALF + wc * 32 + 8 * fq;
            const bool rope = rbj == bj;
#pragma unroll
            for (int ai = 0; ai < 2; ++ai)
#pragma unroll
                for (int m = 0; m < 4; ++m) {
                    const int t = u.pm * BM + ai * HALF + wr * 64 + m * 16 + fr;
                    f32x4 v0 = acc[ai][bj][m][0], v1 = acc[ai][bj][m][1];
                    if (rope) {
                        const f32x4 c4 = cs[ai][m], s4 = sn[ai][m];
                        const float a0 = v0[0], b0 = v0[1], a1 = v0[2], b1 = v0[3], a2 = v1[0], b2 = v1[1], a3 = v1[2], b3 = v1[3];
                        v0[0] = a0 * c4[0] - b0 * s4[0]; v0[1] = a0 * s4[0] + b0 * c4[0];
                        v0[2] = a1 * c4[1] - b1 * s4[1]; v0[3] = a1 * s4[1] + b1 * c4[1];
                        v1[0] = a2 * c4[2] - b2 * s4[2]; v1[1] = a2 * s4[2] + b2 * c4[2];
                        v1[2] = a3 * c4[3] - b3 * s4[3]; v1[3] = a3 * s4[3] + b3 * c4[3];
                    }
                    u32x4 w; w.x = cvt_pk_bf16(v0[0], v0[1]); w.y = cvt_pk_bf16(v0[2], v0[3]); w.z = cvt_pk_bf16(v1[0], v1[1]); w.w = cvt_pk_bf16(v1[2], v1[3]);
                    *(PG8_GAS u32x4*)(O + (size_t)t * 3072 + c) = w;
                }
        }
    }
};
template <int CTRL> __device__ __forceinline__ float dppf(float x) { return __builtin_bit_cast(float, __builtin_amdgcn_update_dpp(0, __builtin_bit_cast(int, x), CTRL, 0xf, 0xf, false)); }
__device__ __forceinline__ f32x4 ror1(f32x4 x) { return (f32x4){dppf<0x121>(x[0]), dppf<0x121>(x[1]), dppf<0x121>(x[2]), dppf<0x121>(x[3])}; }
__device__ __forceinline__ f32x4 ror2(f32x4 x) { return (f32x4){dppf<0x122>(x[0]), dppf<0x122>(x[1]), dppf<0x122>(x[2]), dppf<0x122>(x[3])}; }
__device__ __forceinline__ f32x4 sel4(bool c, f32x4 a, f32x4 b) { return (f32x4){c ? a[0] : b[0], c ? a[1] : b[1], c ? a[2] : b[2], c ? a[3] : b[3]}; }
__device__ __forceinline__ float silu_mul(float g, float v) { const float e = __builtin_amdgcn_exp2f(g * -1.4426950408889634f); return g * __builtin_amdgcn_rcpf(1.0f + e) * v; }
__device__ __forceinline__ f32x4 silu_mul4s(f32x4 gs, f32x4 vs) {
    f32x4 e; e[0] = __builtin_amdgcn_exp2f(gs[0]); e[1] = __builtin_amdgcn_exp2f(gs[1]); e[2] = __builtin_amdgcn_exp2f(gs[2]); e[3] = __builtin_amdgcn_exp2f(gs[3]);
    const f32x4 d = e + 1.0f; const f32x4 p = gs * vs;
    f32x4 r; r[0] = __builtin_amdgcn_rcpf(d[0]); r[1] = __builtin_amdgcn_rcpf(d[1]); r[2] = __builtin_amdgcn_rcpf(d[2]); r[3] = __builtin_amdgcn_rcpf(d[3]);
    return p * r;
}
template <int CTRL> __device__ __forceinline__ float dpp_old(float old, float x) { return __builtin_bit_cast(float, __builtin_amdgcn_update_dpp(__builtin_bit_cast(int, old), __builtin_bit_cast(int, x), CTRL, 0xf, 0xf, false)); }
template <int CTRL> __device__ __forceinline__ float dpp_z(float x) { return __builtin_bit_cast(float, __builtin_amdgcn_update_dpp(0, __builtin_bit_cast(int, x), CTRL, 0xf, 0xf, true)); }
__device__ __forceinline__ f32x4 shr1_z(f32x4 x) { return (f32x4){dpp_z<0x111>(x[0]), dpp_z<0x111>(x[1]), dpp_z<0x111>(x[2]), dpp_z<0x111>(x[3])}; }
__device__ __forceinline__ f32x4 shr1_old(f32x4 old, f32x4 x) { return (f32x4){dpp_old<0x111>(old[0], x[0]), dpp_old<0x111>(old[1], x[1]), dpp_old<0x111>(old[2], x[2]), dpp_old<0x111>(old[3], x[3])}; }
struct EpiUpP {
    static constexpr bool PERM = true, APERM = true, AFTER_DRAIN = false; static constexpr int NST = 24;
    bf16_t* act; bf16_t* bnd_first; bf16_t* bnd_last; const float* cw; const float* cb; float* oconv_p; const float* rs;
    __device__ __forceinline__ void operator()(const f32x4 (&acc)[2][2][4][2], const Unit& u, int wr, int wc, int fr, int fq) const {
        const int colh = wc * 32 + 8 * fq, jg = u.pn * 128 + colh, np = u.pn * 256 + colh;
        const bool first = fr == 0, edge = fr == 0 || fr == 15;
        u32x2 stash[2][4], bst[2][4];
        const f32x4 zero4 = (f32x4){0.f, 0.f, 0.f, 0.f};
        f32x4 r4a[2];
#pragma unroll
        for (int ai = 0; ai < 2; ++ai) r4a[ai] = *(const PG8_GAS f32x4*)(rs + u.pm * BM + ai * HALF + wr * 64 + 4 * fr);
#pragma unroll
        for (int n = 0; n < 2; ++n) {
            const int jc = jg + 4 * n;
            constexpr float KG = -1.4426950408889634f, KV = -0.6931471805599453f;
            const f32x4 w0g = *(const PG8_GAS f32x4*)(cw + jc) * KG, w1g = *(const PG8_GAS f32x4*)(cw + 11264 + jc) * KG, w2g = *(const PG8_GAS f32x4*)(cw + 2 * 11264 + jc) * KG, bg = *(const PG8_GAS f32x4*)(cb + jc) * KG;
            const f32x4 w0v = *(const PG8_GAS f32x4*)(cw + 5632 + jc) * KV, w1v = *(const PG8_GAS f32x4*)(cw + 11264 + 5632 + jc) * KV, w2v = *(const PG8_GAS f32x4*)(cw + 2 * 11264 + 5632 + jc) * KV, bv = *(const PG8_GAS f32x4*)(cb + 5632 + jc) * KV;
#pragma unroll
            for (int ai = 0; ai < 2; ++ai) {
                const int strip = u.pm * 4 + ai * 2 + wr;
                const f32x4 r4 = r4a[ai];
                const f32x4 xg0 = acc[ai][0][0][n] * r4[0], xg1 = acc[ai][0][1][n] * r4[1], xg2 = acc[ai][0][2][n] * r4[2], xg3 = acc[ai][0][3][n] * r4[3];
                const f32x4 xv0 = acc[ai][1][0][n] * r4[0], xv1 = acc[ai][1][1][n] * r4[1], xv2 = acc[ai][1][2][n] * r4[2], xv3 = acc[ai][1][3][n] * r4[3];
                const f32x4 pg3 = shr1_z(xg3), pg2 = shr1_z(xg2), pv3 = shr1_z(xv3), pv2 = shr1_z(xv2);
                const f32x4 ga = first ? xg0 : xg2, gb = first ? xg1 : xg3, va = first ? xv0 : xv2, vb = first ? xv1 : xv3;
                u32x2 ba, bb, bc, bd; ba.x = cvt_pk_bf16(ga[0], ga[1]); ba.y = cvt_pk_bf16(ga[2], ga[3]); bb.x = cvt_pk_bf16(va[0], va[1]); bb.y = cvt_pk_bf16(va[2], va[3]);
                bc.x = cvt_pk_bf16(gb[0], gb[1]); bc.y = cvt_pk_bf16(gb[2], gb[3]); bd.x = cvt_pk_bf16(vb[0], vb[1]); bd.y = cvt_pk_bf16(vb[2], vb[3]);
                if (fr == 15 && (strip & 63) == 63) { float* op = oconv_p + (size_t)((strip >> 6) * 2) * 11264 + jc;
                    *(PG8_GAS f32x4*)op = xg2; *(PG8_GAS f32x4*)(op + 5632) = xv2; *(PG8_GAS f32x4*)(op + 11264) = xg3; *(PG8_GAS f32x4*)(op + 11264 + 5632) = xv3; }
                const f32x4 cg0 = bg + w0g * pg2 + w1g * pg3 + w2g * xg0, cv0 = bv + w0v * pv2 + w1v * pv3 + w2v * xv0;
                const f32x4 cg1 = bg + w0g * pg3 + w1g * xg0 + w2g * xg1, cv1 = bv + w0v * pv3 + w1v * xv0 + w2v * xv1;
                const f32x4 cg2 = bg + w0g * xg0 + w1g * xg1 + w2g * xg2, cv2 = bv + w0v * xv0 + w1v * xv1 + w2v * xv2;
                const f32x4 cg3 = bg + w0g * xg1 + w1g * xg2 + w2g * xg3, cv3 = bv + w0v * xv1 + w1v * xv2 + w2v * xv3;
                const f32x4 cgs[4] = {cg0, cg1, cg2, cg3}, cvs[4] = {cv0, cv1, cv2, cv3};
                if (n == 0) { bst[ai][0] = ba; bst[ai][1] = bb; bst[ai][2] = bc; bst[ai][3] = bd; }
#pragma unroll
                for (int m = 0; m < 4; ++m) {
                    const f32x4 sm = silu_mul4s(cgs[m], cvs[m]); u32x2 pk; pk.x = cvt_pk_bf16(sm[0], sm[1]); pk.y = cvt_pk_bf16(sm[2], sm[3]);
                    if (n == 0) stash[ai][m] = pk;
                    else if (m >= 2 || fr != 0) { const int t = u.pm * BM + ai * HALF + wr * 64 + 4 * fr + m;
                        u32x4 w; w.x = stash[ai][m].x; w.y = stash[ai][m].y; w.z = pk.x; w.w = pk.y; *(PG8_GAS u32x4*)(act + (size_t)t * 5632 + jg) = w; }
                }
                if (n == 1 && edge) { bf16_t* bp = (first ? bnd_first : bnd_last) + (size_t)(strip * 2) * 11264 + np;
                    u32x4 w; w.x = bst[ai][0].x; w.y = bst[ai][0].y; w.z = ba.x; w.w = ba.y; *(PG8_GAS u32x4*)bp = w;
                    w.x = bst[ai][1].x; w.y = bst[ai][1].y; w.z = bb.x; w.w = bb.y; *(PG8_GAS u32x4*)(bp + 128) = w;
                    w.x = bst[ai][2].x; w.y = bst[ai][2].y; w.z = bc.x; w.w = bc.y; *(PG8_GAS u32x4*)(bp + 11264) = w;
                    w.x = bst[ai][3].x; w.y = bst[ai][3].y; w.z = bd.x; w.w = bd.y; *(PG8_GAS u32x4*)(bp + 11264 + 128) = w; }
            }
        }
    }
};
struct EpiUpS {
    static constexpr bool PERM = true, APERM = true, AFTER_DRAIN = false; static constexpr int NST = 24;
    bf16_t* act; const float* cw; const float* cb; const float* hist; float* oconv_s; const float* rs;
    __device__ __forceinline__ void operator()(const f32x4 (&acc)[2][2][4][2], const Unit& u, int wr, int wc, int fr, int fq) const {
        const int colh = wc * 32 + 8 * fq, jg = u.pn * 128 + colh;
        u32x2 stash[2][4];
        const f32x4 zero4 = (f32x4){0.f, 0.f, 0.f, 0.f};
#pragma unroll
        for (int n = 0; n < 2; ++n) {
            const int jc = jg + 4 * n;
            const f32x4 w0g = *(const PG8_GAS f32x4*)(cw + jc), w1g = *(const PG8_GAS f32x4*)(cw + 11264 + jc), w2g = *(const PG8_GAS f32x4*)(cw + 2 * 11264 + jc), bg = *(const PG8_GAS f32x4*)(cb + jc);
            const f32x4 w0v = *(const PG8_GAS f32x4*)(cw + 5632 + jc), w1v = *(const PG8_GAS f32x4*)(cw + 11264 + 5632 + jc), w2v = *(const PG8_GAS f32x4*)(cw + 2 * 11264 + 5632 + jc), bv = *(const PG8_GAS f32x4*)(cb + 5632 + jc);
#pragma unroll
            for (int ai = 0; ai < 2; ++ai) {
                const f32x4 r4 = *(const PG8_GAS f32x4*)(rs + u.pm * BM + ai * HALF + wr * 64 + 4 * fr);
                const f32x4 xg0 = acc[ai][0][0][n] * r4[0], xg1 = acc[ai][0][1][n] * r4[1], xg2 = acc[ai][0][2][n] * r4[2], xg3 = acc[ai][0][3][n] * r4[3];
                const f32x4 xv0 = acc[ai][1][0][n] * r4[0], xv1 = acc[ai][1][1][n] * r4[1], xv2 = acc[ai][1][2][n] * r4[2], xv3 = acc[ai][1][3][n] * r4[3];
                f32x4 pg3 = shr1_old(zero4, xg3), pg2 = shr1_old(zero4, xg2), pv3 = shr1_old(zero4, xv3), pv2 = shr1_old(zero4, xv2);
                const int sb = (u.pm - 128) * 16 + ai * 8 + wr * 4 + (fr >> 2);
                if ((fr & 3) == 0) { const float* hp = hist + (size_t)sb * 2 * 11264 + jc;
                    pg2 = *(const PG8_GAS f32x4*)(hp); pg3 = *(const PG8_GAS f32x4*)(hp + 11264); pv2 = *(const PG8_GAS f32x4*)(hp + 5632); pv3 = *(const PG8_GAS f32x4*)(hp + 11264 + 5632); }
                if ((fr & 3) == 3) { float* op = oconv_s + (size_t)(sb * 2) * 11264 + jc; *(PG8_GAS f32x4*)op = xg2; *(PG8_GAS f32x4*)(op + 5632) = xv2; *(PG8_GAS f32x4*)(op + 11264) = xg3; *(PG8_GAS f32x4*)(op + 11264 + 5632) = xv3; }
                const f32x4 cg0 = bg + w0g * pg2 + w1g * pg3 + w2g * xg0, cv0 = bv + w0v * pv2 + w1v * pv3 + w2v * xv0;
                const f32x4 cg1 = bg + w0g * pg3 + w1g * xg0 + w2g * xg1, cv1 = bv + w0v * pv3 + w1v * xv0 + w2v * xv1;
                const f32x4 cg2 = bg + w0g * xg0 + w1g * xg1 + w2g * xg2, cv2 = bv + w0v * xv0 + w1v * xv1 + w2v * xv2;
                const f32x4 cg3 = bg + w0g * xg1 + w1g * xg2 + w2g * xg3, cv3 = bv + w0v * xv1 + w1v * xv2 + w2v * xv3;
                const f32x4 cgs[4] = {cg0, cg1, cg2, cg3}, cvs[4] = {cv0, cv1, cv2, cv3};
#pragma unroll
                for (int m = 0; m < 4; ++m) {
                    u32x2 pk; pk.x = cvt_pk_bf16(silu_mul(cgs[m][0], cvs[m][0]), silu_mul(cgs[m][1], cvs[m][1])); pk.y = cvt_pk_bf16(silu_mul(cgs[m][2], cvs[m][2]), silu_mul(cgs[m][3], cvs[m][3]));
                    if (n == 0) stash[ai][m] = pk;
                    else { const int t = u.pm * BM + ai * HALF + wr * 64 + 4 * fr + m;
                        u32x4 w; w.x = stash[ai][m].x; w.y = stash[ai][m].y; w.z = pk.x; w.w = pk.y; *(PG8_GAS u32x4*)(act + (size_t)t * 5632 + jg) = w; }
                }
            }
        }
    }
};

template <class Epi, class Sched, bool ALIGN_EPI = true>
__device__ __forceinline__ void gemm_phase(PG8_LAS unsigned char* lds, const Sched& S, const Epi& E) {
    int tid_ = threadIdx.x; asm volatile("" : "+v"(tid_));
    const int tid = tid_, wid = __builtin_amdgcn_readfirstlane(tid >> 6), lane = tid & 63, wr = wid >> 2, wc = wid & 3, fr = lane & 15, fq = lane >> 4;
    const int K = S.K, nt = K / BK, lda = S.lda, ldb = S.ldb;
    unsigned voffA[2], voffB[2];
#pragma unroll
    for (int i = 0; i < 2; ++i) { int R, C; stage_rc(tid * 16 + i * 8192, R, C); const int Rb = Epi::PERM ? ((R & ~31) + perm32(R & 31)) : R;
        const int Ra = Epi::APERM ? ((R & ~63) + 4 * (R & 15) + ((R >> 4) & 3)) : R;
        voffA[i] = (unsigned)(Ra * lda + C) * 2u; voffB[i] = (unsigned)(Rb * ldb + C) * 2u; }
    const size_t kstep = (size_t)(BK * 2);
    const size_t hA = (size_t)HALF * lda * 2, hB = (size_t)HALF * ldb * 2;
    const unsigned ldsw = (unsigned)wid * 1024u;
    const int aoff = lds_byte(wr * 64 + fr, fq * 8), boff = lds_byte(wc * 32 + fr, fq * 8);
#define PG8_SA(b, h) (((b) * 2 + (h)) * HTB)
#define PG8_SB(b, h) ((4 + (b) * 2 + (h)) * HTB)
#define PG8_STAGE(bufoff, gbase, voff) do { _Pragma("unroll") for (int _i = 0; _i < 2; ++_i) \
        __builtin_amdgcn_global_load_lds((const unsigned*)((const char*)(gbase) + (voff)[_i]), (PG8_LAS unsigned*)(lds + (bufoff) + ldsw + _i * 8192), 16, 0, 0); } while (0)
#define PG8_LDA(dst, b, h) do { _Pragma("unroll") for (int m = 0; m < 4; ++m) _Pragma("unroll") for (int k = 0; k < 2; ++k) dst[m][k] = *(const PG8_LAS bf16x8*)(lds + PG8_SA(b, h) + aoff + m * 2048 + k * 1024); } while (0)
#define PG8_LDB(dst, b, h) do { _Pragma("unroll") for (int n = 0; n < 2; ++n) _Pragma("unroll") for (int k = 0; k < 2; ++k) dst[n][k] = *(const PG8_LAS bf16x8*)(lds + PG8_SB(b, h) + boff + n * 2048 + k * 1024); } while (0)
#define PG8_MMA(ai, bj, At, Bt) do { __builtin_amdgcn_s_setprio(1); _Pragma("unroll") for (int m = 0; m < 4; ++m) _Pragma("unroll") for (int n = 0; n < 2; ++n) _Pragma("unroll") for (int k = 0; k < 2; ++k) \
        acc[ai][bj][m][n] = __builtin_amdgcn_mfma_f32_16x16x32_bf16(Bt[n][k], At[m][k], acc[ai][bj][m][n], 0, 0, 0); __builtin_amdgcn_s_setprio(0); } while (0)
#define PG8_WAIT_V(n) asm volatile("s_waitcnt vmcnt(" #n ")" ::: "memory")
#define PG8_WAIT_L(n) asm volatile("s_waitcnt lgkmcnt(" #n ")" ::: "memory")
#define PG8_WAIT_V8R(rlx) asm volatile("s_cmp_eq_u32 %0, 0\n\ts_cbranch_scc1 .Lw8a%=\n\ts_waitcnt vmcnt(%1)\n\ts_branch .Lw8b%=\n.Lw8a%=:\n\ts_waitcnt vmcnt(8)\n.Lw8b%=:" :: "s"(rlx), "n"(8 + Epi::NST) : "memory", "scc")
#define PG8_BAR __builtin_amdgcn_s_barrier()
#define PG8_SCHED __builtin_amdgcn_sched_barrier(0)
    Unit cur, nxt; int ui = 0;
    if (!S.next(0, cur)) return;
    f32x4 acc[2][2][4][2];
#pragma unroll
    for (int a = 0; a < 2; ++a)
#pragma unroll
        for (int b = 0; b < 2; ++b)
#pragma unroll
            for (int m = 0; m < 4; ++m)
#pragma unroll
                for (int n = 0; n < 2; ++n) acc[a][b][m][n] = (f32x4){0.f, 0.f, 0.f, 0.f};
    bf16x8 At[4][2], B0[2][2], B1[2][2];
    const char* cA = S.a_ptr(cur); const char* cB = S.b_ptr(cur);
    S.a_ready(cur);
    PG8_STAGE(PG8_SB(0, 0), cB, voffB); PG8_STAGE(PG8_SB(0, 1), cB + hB, voffB); PG8_STAGE(PG8_SA(0, 0), cA, voffA); PG8_STAGE(PG8_SA(0, 1), cA + hA, voffA);
    if (wr == 1) PG8_BAR;
    PG8_WAIT_V(2); PG8_BAR;
    PG8_STAGE(PG8_SB(1, 0), cB + kstep, voffB); PG8_STAGE(PG8_SA(1, 0), cA + kstep, voffA); PG8_STAGE(PG8_SB(1, 1), cB + hB + kstep, voffB);
    PG8_WAIT_V(6); PG8_BAR;
    for (;;) {
        const bool has_next = S.next(ui + 1, nxt);
        const char* nA = has_next ? S.a_ptr(nxt) : cA; const char* nB = has_next ? S.b_ptr(nxt) : cB;
        for (int t = 0; t < nt; t += 2) {
            const bool last = (t == nt - 2);
            const char* a1 = cA + (size_t)(t + 1) * kstep;
            const char* a2 = last ? nA : cA + (size_t)(t + 2) * kstep; const char* b2 = last ? nB : cB + (size_t)(t + 2) * kstep;
            const char* a3 = a2 + kstep; const char* b3 = b2 + kstep;
            if (last && has_next) S.a_ready(nxt);
            const int relax = __builtin_amdgcn_readfirstlane((t == 0 && ui > 0) ? 1 : 0);
            PG8_LDB(B0, 0, 0); PG8_LDB(B1, 0, 1); PG8_SCHED; PG8_LDA(At, 0, 0); PG8_STAGE(PG8_SA(1, 1), a1 + hA, voffA);
            PG8_WAIT_V8R(relax); PG8_WAIT_L(0); PG8_BAR; PG8_MMA(0, 0, At, B0); PG8_MMA(0, 1, At, B1); PG8_BAR; PG8_SCHED;
            PG8_LDA(At, 0, 1); PG8_STAGE(PG8_SB(0, 0), b2, voffB); PG8_STAGE(PG8_SB(0, 1), b2 + hB, voffB); PG8_STAGE(PG8_SA(0, 0), a2, voffA);
            PG8_WAIT_V8R(relax); PG8_WAIT_L(0); PG8_BAR; PG8_MMA(1, 0, At, B0); PG8_MMA(1, 1, At, B1); PG8_BAR; PG8_SCHED;
            PG8_LDB(B0, 1, 0); PG8_LDB(B1, 1, 1); PG8_SCHED; PG8_LDA(At, 1, 0); PG8_STAGE(PG8_SA(0, 1), a2 + hA, voffA);
            PG8_WAIT_V(8); PG8_WAIT_L(0); PG8_BAR; PG8_MMA(0, 0, At, B0); PG8_MMA(0, 1, At, B1); PG8_BAR; PG8_SCHED;
            PG8_LDA(At, 1, 1); PG8_STAGE(PG8_SB(1, 0), b3, voffB); PG8_STAGE(PG8_SB(1, 1), b3 + hB, voffB); PG8_STAGE(PG8_SA(1, 0), a3, voffA);
            PG8_WAIT_V(8); PG8_WAIT_L(0); PG8_BAR; PG8_MMA(1, 0, At, B0); PG8_MMA(1, 1, At, B1); PG8_BAR; PG8_SCHED;
        }
        if constexpr (ALIGN_EPI) { if (wr == 0) PG8_BAR; }
        E(acc, cur, wr, wc, fr, fq); S.done(cur);
        if (!has_next) break;
#pragma unroll
        for (int a = 0; a < 2; ++a)
#pragma unroll
            for (int b = 0; b < 2; ++b)
#pragma unroll
                for (int m = 0; m < 4; ++m)
#pragma unroll
                    for (int n = 0; n < 2; ++n) acc[a][b][m][n] = (f32x4){0.f, 0.f, 0.f, 0.f};
        cur = nxt; cA = nA; cB = nB; ++ui;
        if constexpr (ALIGN_EPI) { if (wr == 1) PG8_BAR; }
    }
    PG8_WAIT_V(0);
    if constexpr (!ALIGN_EPI) { if (wr == 0) PG8_BAR; }
    PG8_BAR;
#undef PG8_SA
#undef PG8_SB
#undef PG8_STAGE
#undef PG8_LDA
#undef PG8_LDB
#undef PG8_MMA
#undef PG8_WAIT_V
#undef PG8_WAIT_L
#undef PG8_WAIT_V8R
#undef PG8_BAR
#undef PG8_SCHED
}
}
namespace att {
#define ATT_LAS __attribute__((address_space(3)))
typedef unsigned short bf16;
using bf16x8 = __attribute__((ext_vector_type(8))) short;
using s16x4  = __attribute__((ext_vector_type(4))) short;
using f32x16 = __attribute__((ext_vector_type(16))) float;
using u32x4  = __attribute__((ext_vector_type(4))) unsigned;
constexpr int NW = 8, QBLK = 32, KVBLK = 64;
constexpr float SCALE = 0.07216878364870322f;
constexpr float THR = 8.f;
constexpr int LDQ = 3072, LDKV = 4096, LDKR = 64, LDO = 2048;
constexpr int SHM_V = KVBLK * 128 * 2, SHM_K = KVBLK * 192 * 2, SHM_QR0 = 2 * SHM_V + 2 * SHM_K + NW * 64 * 4, SHM_ATTN = SHM_QR0 + NW * 4 * 64 * 16;
#define KSWZ(row, colB) ((row) * 384 + ((colB) ^ (((row) & 7) << 4)))
#define SBAR() __builtin_amdgcn_sched_barrier(0)
__device__ __forceinline__ int crow(int r, int hi) { return (r & 3) + 8 * (r >> 2) + 4 * hi; }
__device__ __forceinline__ unsigned cvtpk(float lo, float hi) { unsigned r; asm volatile("v_cvt_pk_bf16_f32 %0, %1, %2" : "=v"(r) : "v"(lo), "v"(hi)); return r; }
__device__ __forceinline__ __amdgpu_buffer_rsrc_t mk_rsrc(const void* p) {
  const unsigned long a = (unsigned long)p; const unsigned lo = __builtin_amdgcn_readfirstlane((unsigned)a), hi = __builtin_amdgcn_readfirstlane((unsigned)(a >> 32));
  return __builtin_amdgcn_make_buffer_rsrc((void*)(((unsigned long)hi << 32) | lo), (short)0, 0x7fffffff, 0x00020000);
}
__device__ __forceinline__ bf16x8 ld8(const bf16* p) { return *(const __attribute__((address_space(1))) bf16x8*)p; }

__device__ __forceinline__ void partialSM(f32x16& p0, f32x16& p1, float& m_reg, float& mn, float& alpha, bool dead) {
  constexpr float C = SCALE * 1.4426950408889634f;
  if (dead) {
#pragma unroll
    for (int r = 0; r < 16; ++r) { p0[r] = -__builtin_inff(); p1[r] = -__builtin_inff(); }
  }
  float pmax = p0[0];
#pragma unroll
  for (int r = 1; r < 16; ++r) pmax = fmaxf(pmax, p0[r]);
#pragma unroll
  for (int r = 0; r < 16; ++r) pmax = fmaxf(pmax, p1[r]);
  { auto rr = __builtin_amdgcn_permlane32_swap(__float_as_uint(pmax), __float_as_uint(pmax), false, false);
    pmax = fmaxf(__uint_as_float(rr[0]), __uint_as_float(rr[1])); }
  if (__builtin_expect(__all(pmax - m_reg <= THR / SCALE), 1)) { mn = m_reg; alpha = 1.f; }
  else { mn = fmaxf(m_reg, pmax); alpha = __builtin_amdgcn_exp2f((m_reg - mn) * C); m_reg = mn; }
  float mnC = -mn * C;
#pragma unroll
  for (int r = 0; r < 16; ++r) p0[r] = fmaf(p0[r], C, mnC);
#pragma unroll
  for (int r = 0; r < 16; ++r) p1[r] = fmaf(p1[r], C, mnC);
#pragma unroll
  for (int r = 0; r < 16; ++r) p0[r] = __builtin_amdgcn_exp2f(p0[r]);
}
__device__ __forceinline__ void finishSM(f32x16& p0, f32x16& p1, float alpha, float& l_reg, bf16x8& pa0, bf16x8& pa1, bf16x8& pa2, bf16x8& pa3) {
#pragma unroll
  for (int r = 0; r < 16; ++r) p1[r] = __builtin_amdgcn_exp2f(p1[r]);
  float ps = 0;
#pragma unroll
  for (int r = 0; r < 16; ++r) ps += p0[r];
#pragma unroll
  for (int r = 0; r < 16; ++r) ps += p1[r];
  { auto rr = __builtin_amdgcn_permlane32_swap(__float_as_uint(ps), __float_as_uint(ps), false, false);
    ps = __uint_as_float(rr[0]) + __uint_as_float(rr[1]); }
  l_reg = l_reg * alpha + ps;
#define PK4(P, BASE, OUT) do { unsigned a0 = cvtpk(P[BASE + 0], P[BASE + 1]), a1 = cvtpk(P[BASE + 2], P[BASE + 3]);   \
    unsigned b0 = cvtpk(P[BASE + 4], P[BASE + 5]), b1 = cvtpk(P[BASE + 6], P[BASE + 7]);                              \
    auto r0 = __builtin_amdgcn_permlane32_swap(a0, b0, false, false); auto r1 = __builtin_amdgcn_permlane32_swap(a1, b1, false, false); \
    u32x4 w = {r0[0], r1[0], r0[1], r1[1]}; OUT = *reinterpret_cast<bf16x8*>(&w); } while (0)
  PK4(p0, 0, pa0); PK4(p0, 8, pa1); PK4(p1, 0, pa2); PK4(p1, 8, pa3);
#undef PK4
}
__device__ __forceinline__ void qkt(f32x16& p0, f32x16& p1, const ATT_LAS char* Ks, const bf16x8* qr, const ATT_LAS char* qrl, int r32, int hi) {
  p0 = f32x16{}; p1 = f32x16{};
#pragma unroll
  for (int d0 = 0; d0 < 12; ++d0) { const int cb = (d0 * 16 + hi * 8) * 2;
    bf16x8 b0 = *reinterpret_cast<const ATT_LAS bf16x8*>(Ks + KSWZ(r32, cb));
    bf16x8 b1 = *reinterpret_cast<const ATT_LAS bf16x8*>(Ks + KSWZ(32 + r32, cb));
    const bf16x8 q = d0 < 8 ? qr[d0 < 8 ? d0 : 0] : *reinterpret_cast<const ATT_LAS bf16x8*>(qrl + (d0 - 8) * 1024);
    p0 = __builtin_amdgcn_mfma_f32_32x32x16_bf16(b0, q, p0, 0, 0, 0);
    p1 = __builtin_amdgcn_mfma_f32_32x32x16_bf16(b1, q, p1, 0, 0, 0); }
}
__device__ __forceinline__ int v_st(int k, int c) { const int kk = (k & ~0xC) | ((k & 4) << 1) | ((k & 8) >> 1); return ((kk >> 3) * 4 + (c >> 5)) * 512 + ((kk & 7) * 32 + (c & 31)) * 2; }
__device__ __forceinline__ int v_rd_base(int lane) { return ((lane & 3) << 3) | (((lane >> 2) & 3) << 6) | (((lane >> 4) & 1) << 5) | (((lane >> 5) & 1) << 8); }
constexpr int v_rd_off(int d0, int ks, int half) { return d0 * 512 + ks * 4096 + half * 2048; }
template <int OFF> __device__ __forceinline__ s16x4 tr_read(int vb) {
  s16x4 r; asm volatile("ds_read_b64_tr_b16 %0, %1 offset:%2" : "=&v"(r) : "v"(vb), "i"(OFF) : "memory"); return r;
}
template <int D0> __device__ __forceinline__ void pv_one(f32x16& od, int vb, bf16x8 pa0, bf16x8 pa1, bf16x8 pa2, bf16x8 pa3) {
  s16x4 l0 = tr_read<v_rd_off(D0, 0, 0)>(vb), h0 = tr_read<v_rd_off(D0, 0, 1)>(vb), l1 = tr_read<v_rd_off(D0, 1, 0)>(vb), h1 = tr_read<v_rd_off(D0, 1, 1)>(vb);
  s16x4 l2 = tr_read<v_rd_off(D0, 2, 0)>(vb), h2 = tr_read<v_rd_off(D0, 2, 1)>(vb), l3 = tr_read<v_rd_off(D0, 3, 0)>(vb), h3 = tr_read<v_rd_off(D0, 3, 1)>(vb);
  asm volatile("s_waitcnt lgkmcnt(0)" : "+v"(l0), "+v"(h0), "+v"(l1), "+v"(h1), "+v"(l2), "+v"(h2), "+v"(l3), "+v"(h3) :: "memory");
#define PK(L, H) (bf16x8){L[0], L[1], L[2], L[3], H[0], H[1], H[2], H[3]}
  od = __builtin_amdgcn_mfma_f32_32x32x16_bf16(pa0, PK(l0, h0), od, 0, 0, 0);
  od = __builtin_amdgcn_mfma_f32_32x32x16_bf16(pa1, PK(l1, h1), od, 0, 0, 0);
  od = __builtin_amdgcn_mfma_f32_32x32x16_bf16(pa2, PK(l2, h2), od, 0, 0, 0);
  od = __builtin_amdgcn_mfma_f32_32x32x16_bf16(pa3, PK(l3, h3), od, 0, 0, 0);
#undef PK
}
__device__ __forceinline__ void pv_d0(f32x16* o, int vb, bf16x8 pa0, bf16x8 pa1, bf16x8 pa2, bf16x8 pa3) {
  pv_one<0>(o[0], vb, pa0, pa1, pa2, pa3); pv_one<1>(o[1], vb, pa0, pa1, pa2, pa3); pv_one<2>(o[2], vb, pa0, pa1, pa2, pa3); pv_one<3>(o[3], vb, pa0, pa1, pa2, pa3);
}

__device__ __forceinline__ void attn_unit(const bf16* __restrict__ Qb, const bf16* __restrict__ Kh, const bf16* __restrict__ Vh, const bf16* __restrict__ KRh,
                                          bf16* __restrict__ Ob, int NT, int qb, ATT_LAS char* lds, unsigned* qctr, volatile ATT_LAS int* qslot) {
  int tid_ = threadIdx.x; asm volatile("" : "+v"(tid_));
  const int tid = tid_, wid = __builtin_amdgcn_readfirstlane(tid >> 6), lane = tid & 63, r32 = lane & 31, hi = lane >> 5;
  unsigned qnext = 0u; if (tid == 0) qnext = __hip_atomic_fetch_add((__attribute__((address_space(1))) unsigned*)qctr, 1u, __ATOMIC_RELAXED, __HIP_MEMORY_SCOPE_AGENT);
  const int lim = 4 * qb + (wid >> 1);
  ATT_LAS char* V_lds = lds; ATT_LAS char* K_lds = lds + 2 * SHM_V;
  ATT_LAS float* ws = (ATT_LAS float*)(lds + 2 * SHM_V + 2 * SHM_K) + wid * 64; ATT_LAS float* li_l = ws; ATT_LAS float* al_l = ws + 32;
  float m_reg = -1e30f, l_reg = 0; f32x16 o[4] = {}; bf16x8 qr[8];
  ATT_LAS char* qrl = lds + SHM_QR0 + wid * 4096 + lane * 16;
  const bf16* Qw = Qb + (long)(wid * QBLK + r32) * LDQ + hi * 8;
#pragma unroll
  for (int d0 = 0; d0 < 8; ++d0) qr[d0] = ld8(Qw + d0 * 16);
#pragma unroll
  for (int d0 = 8; d0 < 12; ++d0) *reinterpret_cast<ATT_LAS bf16x8*>(qrl + (d0 - 8) * 1024) = ld8(Qw + d0 * 16);
  const int sr = tid >> 4, sc = (tid & 15) * 8, vst0 = v_st(sr, sc), vst1 = v_st(32 + sr, sc);
  const int kr_row = tid >> 3, kr_c = (tid & 7) * 8;
  const int vb0 = (int)(unsigned)(unsigned long)V_lds + v_rd_base(lane);
  const __amdgpu_buffer_rsrc_t rsK = mk_rsrc(Kh), rsV = mk_rsrc(Vh), rsR = mk_rsrc(KRh);
  const unsigned vo0 = (unsigned)(sr * LDKV + sc) * 2u, vo1 = (unsigned)((32 + sr) * LDKV + sc) * 2u, vor = (unsigned)(kr_row * LDKR + kr_c) * 2u;
  struct { bf16x8 vs0, vs1, ks0, ks1, kr; } sr_[1];
#define SLOAD(i, k0) do { const int so_ = (k0) * (LDKV * 2), sr2_ = (k0) * (LDKR * 2); \
    sr_[i].vs0 = __builtin_bit_cast(bf16x8, __builtin_amdgcn_raw_buffer_load_b128(rsV, (int)vo0, so_, 0)); sr_[i].vs1 = __builtin_bit_cast(bf16x8, __builtin_amdgcn_raw_buffer_load_b128(rsV, (int)vo1, so_, 0)); \
    sr_[i].ks0 = __builtin_bit_cast(bf16x8, __builtin_amdgcn_raw_buffer_load_b128(rsK, (int)vo0, so_, 0)); sr_[i].ks1 = __builtin_bit_cast(bf16x8, __builtin_amdgcn_raw_buffer_load_b128(rsK, (int)vo1, so_, 0)); \
    sr_[i].kr = __builtin_bit_cast(bf16x8, __builtin_amdgcn_raw_buffer_load_b128(rsR, (int)vor, sr2_, 0)); } while (0)
#define SWRITE(b, i) do { *(ATT_LAS bf16x8*)(V_lds + (b) * SHM_V + vst0) = sr_[i].vs0;          \
    *(ATT_LAS bf16x8*)(V_lds + (b) * SHM_V + vst1) = sr_[i].vs1; const int kc = sc * 2;               \
    *(ATT_LAS bf16x8*)(K_lds + (b) * SHM_K + KSWZ(sr, kc)) = sr_[i].ks0;                       \
    *(ATT_LAS bf16x8*)(K_lds + (b) * SHM_K + KSWZ(32 + sr, kc)) = sr_[i].ks1;                  \
    *(ATT_LAS bf16x8*)(K_lds + (b) * SHM_K + KSWZ(kr_row, 256 + kr_c * 2)) = sr_[i].kr; } while (0)
#define SWAIT() asm volatile("s_waitcnt vmcnt(0)" ::: "memory")
#define RESC(a) do { if (__any((a) < 1.f)) { if (hi == 0) al_l[r32] = (a); asm volatile("s_waitcnt lgkmcnt(0)" ::: "memory"); \
    _Pragma("unroll") for (int d = 0; d < 4; ++d) _Pragma("unroll") for (int r = 0; r < 16; ++r) o[d][r] *= al_l[crow(r, hi)]; } } while (0)
  f32x16 pA0, pA1, pB0, pB1; float mnA, mnB, alA, alB; bf16x8 pa0, pa1, pa2, pa3;
  constexpr int SE = 0, SO = 0;
  SLOAD(SE, 0); asm volatile("s_waitcnt vmcnt(0)" ::: "memory"); if (tid == 0) *qslot = (int)qnext; SWRITE(0, SE); __syncthreads();
  qkt(pA0, pA1, K_lds, qr, qrl, r32, hi); partialSM(pA0, pA1, m_reg, mnA, alA, false);
  SLOAD(SO, KVBLK);
  SWAIT(); SWRITE(1, SO); __syncthreads();
  for (int j = 1; j + 1 < NT; j += 2) {
    SBAR(); qkt(pB0, pB1, K_lds + SHM_K, qr, qrl, r32, hi);
    finishSM(pA0, pA1, alA, l_reg, pa0, pa1, pa2, pa3); SBAR();
    SLOAD(SO, (j + 1) * KVBLK); SBAR();
    pv_d0(o, vb0, pa0, pa1, pa2, pa3); partialSM(pB0, pB1, m_reg, mnB, alB, j > lim);
    __syncthreads(); SWAIT(); SWRITE(0, SE);
    RESC(alB); __syncthreads();
    SBAR(); qkt(pA0, pA1, K_lds, qr, qrl, r32, hi);
    finishSM(pB0, pB1, alB, l_reg, pa0, pa1, pa2, pa3); SBAR();
    SLOAD(SE, (j + 2) * KVBLK); SBAR();
    pv_d0(o, vb0 + SHM_V, pa0, pa1, pa2, pa3); partialSM(pA0, pA1, m_reg, mnA, alA, j + 1 > lim);
    __syncthreads(); SWAIT(); SWRITE(1, SO);
    RESC(alA); __syncthreads();
  }
  SBAR(); qkt(pB0, pB1, K_lds + SHM_K, qr, qrl, r32, hi);
  finishSM(pA0, pA1, alA, l_reg, pa0, pa1, pa2, pa3); SBAR();
  pv_d0(o, vb0, pa0, pa1, pa2, pa3); partialSM(pB0, pB1, m_reg, mnB, alB, NT - 1 > lim);
  __syncthreads(); RESC(alB);
  finishSM(pB0, pB1, alB, l_reg, pa0, pa1, pa2, pa3); SBAR();
  pv_d0(o, vb0 + SHM_V, pa0, pa1, pa2, pa3);
  if (hi == 0) li_l[r32] = l_reg; asm volatile("s_waitcnt lgkmcnt(0)" ::: "memory");
  float rli[16];
#pragma unroll
  for (int r = 0; r < 16; ++r) rli[r] = __builtin_amdgcn_rcpf(li_l[crow(r, hi)]);
  bf16* Ow = Ob + (long)(wid * QBLK) * LDO;
#pragma unroll
  for (int r = 0; r < 16; ++r) { const int orow = crow(r, hi);
#pragma unroll
    for (int d0 = 0; d0 < 4; ++d0) { const float v = o[d0][r] * rli[r]; unsigned u = __float_as_uint(v); u = (u + 0x7fffu + ((u >> 16) & 1u)) >> 16; ((__attribute__((address_space(1))) bf16*)Ow)[(long)orow * LDO + d0 * 32 + r32] = (bf16)u; } }
  __syncthreads();
#undef SLOAD
#undef SWRITE
#undef SWAIT
#undef RESC
}
#undef KSWZ
#undef SBAR
}
constexpr int NWAVES = 8;
constexpr int TP = 32768, TS = 512, T = TP + TS, DM = 2048, DFF = 5632, NUP = 2 * DFF, SEQ = 4096;
constexpr float EPS = 1e-6f;
static_assert((2048 + 16 - 1) / 64 == 2048 / 64, "all cache keys and new keys of a sample stream lie in chunks <= the query chunk: the chunk mask is all-true for the sample streams");
constexpr size_t O_Y = 0, O_CKV_P = O_Y + (size_t)T * DM, O_KR_P = O_CKV_P + (size_t)2 * TP * 512, O_POOL_P = O_KR_P + (size_t)2 * TP * 64, O_CONV_P = O_POOL_P + (size_t)2 * 8 * 15 * DM,
                 O_CKV_S = O_CONV_P + (size_t)4 * 8 * 2 * NUP, O_KR_S = O_CKV_S + (size_t)2 * TS * 512, O_POOL_S = O_KR_S + (size_t)2 * TS * 64, O_CONV_S = O_POOL_S + (size_t)2 * 32 * 15 * DM,
                 O_END = O_CONV_S + (size_t)4 * 32 * 2 * NUP;
static_assert(O_END == 112558080, "d_out size");
constexpr size_t MiB = 1u << 20;
constexpr size_t WS_CTL = 0, CTL_ZERO_BYTES = 1 * MiB;
constexpr size_t WS_ROPE = 1 * MiB;
constexpr size_t WS_RS = 2 * MiB;
constexpr size_t WS_W = 3 * MiB;
constexpr size_t W_MLA = 24 * MiB;
constexpr size_t WO_DQKV = 0, WO_UQ = 5 * MiB, WO_UKV = 8 * MiB, WO_UK2 = 12 * MiB, WO_O = 16 * MiB;
constexpr size_t WS_WPOOL = WS_W + 2 * W_MLA;
constexpr size_t WS_WFFN = WS_WPOOL + 4 * MiB, WO_UP = 0, WO_DOWN = 44 * MiB;
constexpr size_t WS_HB = WS_WFFN + 66 * MiB;
constexpr size_t WS_MB = WS_HB + 130 * MiB;
constexpr size_t WS_S = WS_MB, WS_P = WS_MB + 72 * MiB;
constexpr size_t WS_BND = WS_MB + 130 * MiB;
constexpr size_t WS_XB = WS_BND + 44 * MiB;
constexpr size_t WS_SLAB = WS_XB + 130 * MiB;
constexpr size_t WS_BIG = WS_SLAB + 44 * MiB;
constexpr size_t WS_ACT = WS_BIG;
constexpr size_t WS_Q = WS_BIG, WS_CQ = WS_BIG + 196 * MiB, WS_CKVB = WS_BIG + 229 * MiB, WS_KRB = WS_BIG + 261 * MiB, WS_KV = WS_BIG + 265 * MiB;
constexpr size_t WS_KALL = WS_KV + 256 * MiB, WS_VT = WS_KALL + 90 * MiB, WS_QLAT = WS_VT + 72 * MiB, WS_OL = WS_QLAT + 10 * MiB;
constexpr size_t WS_WPOOLH = WS_OL + 8 * MiB;
constexpr size_t WS_HS = WS_WPOOLH + 4 * MiB;
constexpr size_t WS_ZH = WS_HS + 4 * MiB;
constexpr size_t WS_WFFN2 = WS_ZH + 2 * MiB;
constexpr size_t WS_END = WS_WFFN2 + 66 * MiB;
static_assert(WS_HB == 121 * MiB && WS_END == 1376 * MiB, "ws map");
constexpr int FFN_EARLY = 8448;
static_assert((size_t)T * 1280 * 4 <= 174 * MiB && (size_t)T * 5632 * 2 <= WS_END - WS_BIG && (size_t)T * 3072 * 2 + 4096 <= 196 * MiB && (size_t)11 * 512 * 2048 * 4 <= 44 * MiB, "ws aliases");
constexpr int CW_BAR = 4096, CW_SUB = 8192  , CW_Q = 8192 + 1024  ;

#define GAS __attribute__((address_space(1)))
#define LAS __attribute__((address_space(3)))
typedef unsigned short bf16;
typedef unsigned v4u __attribute__((ext_vector_type(4)));
typedef unsigned v2u __attribute__((ext_vector_type(2)));
typedef float f32x4 __attribute__((ext_vector_type(4)));
typedef short bf16x8 __attribute__((ext_vector_type(8)));
#define LDS_WAIT() asm volatile("s_waitcnt lgkmcnt(0)" ::: "memory")
#define VM_WAIT() asm volatile("s_waitcnt vmcnt(0)" ::: "memory")
__device__ __forceinline__ unsigned f2bf(float f) { unsigned u = __builtin_bit_cast(unsigned, f); return (u + 0x7fffu + ((u >> 16) & 1u)) >> 16; }
__device__ __forceinline__ unsigned pk2(float lo, float hi) { return f2bf(lo) | (f2bf(hi) << 16); }
__device__ __forceinline__ float bflo(unsigned w) { return __builtin_bit_cast(float, w << 16); }
__device__ __forceinline__ float bfhi(unsigned w) { return __builtin_bit_cast(float, w & 0xffff0000u); }

#define XB_TMO      128
#define XB_XCNT(j)  (256  + 64 * (j))
#define XB_XSUB(j)  (1280 + 64 * (j))
#define XB_XGEN(j)  (2304 + 64 * (j))
#define XB_TOP      3328
#define XB_TOPGEN   3392
#define XCD_BAR_WORDS 3456
#define XB_SPIN_CAP (1u << 18)
__device__ __forceinline__ unsigned xb_ld(unsigned* p)              { return __hip_atomic_load(p, __ATOMIC_RELAXED, __HIP_MEMORY_SCOPE_AGENT); }
__device__ __forceinline__ unsigned xb_add(unsigned* p, unsigned v) { return __hip_atomic_fetch_add(p, v, __ATOMIC_RELAXED, __HIP_MEMORY_SCOPE_AGENT); }
__device__ __forceinline__ unsigned xb_xcc_id() { return (unsigned)__builtin_amdgcn_s_getreg((3 << 11) | 20) & 0xFu; }
#define XB_SPIN(cond, bar) do { unsigned _sp = 0; while (cond) { __builtin_amdgcn_s_sleep(1); \
    if ((++_sp & 255u) == 0u) { if (xb_ld(&(bar)[XB_TMO])) break; if (_sp > XB_SPIN_CAP) { atomicAdd(&(bar)[XB_TMO], 1u); break; } } } } while (0)
struct XcdBarrier { unsigned* bar; unsigned x; volatile LAS unsigned* st; };
__device__ __forceinline__ XcdBarrier xcd_barrier_post(unsigned* bar, volatile LAS unsigned* st) {
    XcdBarrier b; b.bar = bar; b.x = xb_xcc_id(); b.st = st;
    if (threadIdx.x == 0) (void)xb_add(&bar[XB_XCNT(b.x)], 1u);
    return b;
}
__device__ __forceinline__ void xcd_barrier_complete(unsigned* bar, unsigned x, unsigned& nloc, unsigned& nx) {
    const unsigned G = gridDim.x * gridDim.y * gridDim.z;
    unsigned sum, cnt, mine, sp = 0u;
    for (;;) {
        sum = 0u; cnt = 0u; mine = 0u;
#pragma unroll
        for (unsigned j = 0; j < 16; ++j) { const unsigned c = xb_ld(&bar[XB_XCNT(j)]); sum += c; cnt += (c > 0u) ? 1u : 0u; mine = (j == x) ? c : mine; }
        if (sum == G) break;
        __builtin_amdgcn_s_sleep(1);
        if ((++sp & 255u) == 0u) { if (xb_ld(&bar[XB_TMO])) break; if (sp > XB_SPIN_CAP) { atomicAdd(&bar[XB_TMO], 1u); break; } }
    }
    nloc = mine > 0u ? mine : 1u; nx = cnt > 0u ? cnt : 1u;
}
__device__ __forceinline__ void xcd_barrier(const XcdBarrier& b) {
    asm volatile("s_waitcnt vmcnt(0)" ::: "memory");
    __syncthreads();
    if (threadIdx.x == 0) {
        unsigned* bar = b.bar;
        __builtin_amdgcn_s_waitcnt(0);
        unsigned nloc = b.st[0], nx = b.st[1];
        if (nloc == 0u) { xcd_barrier_complete(bar, b.x, nloc, nx); b.st[0] = nloc; b.st[1] = nx; }
        const unsigned old = xb_add(&bar[XB_XSUB(b.x)], 1u);
        const unsigned gen = old / nloc;
        if (old + 1u == (gen + 1u) * nloc) {
            __builtin_amdgcn_fence(__ATOMIC_RELEASE, "agent");
            asm volatile("s_waitcnt vmcnt(0)" ::: "memory");
            const unsigned og = xb_add(&bar[XB_TOP], 1u);
            const unsigned tg = og / nx;
            if (og + 1u == (tg + 1u) * nx) xb_add(&bar[XB_TOPGEN], 1u);
            else XB_SPIN(xb_ld(&bar[XB_TOPGEN]) == tg, bar);
            __builtin_amdgcn_fence(__ATOMIC_ACQUIRE, "agent");
            xb_add(&bar[XB_XGEN(b.x)], 1u);
            asm volatile("s_waitcnt vmcnt(0)" ::: "memory");
        } else {
            XB_SPIN(xb_ld(&bar[XB_XGEN(b.x)]) == gen, bar);
            __builtin_amdgcn_fence(__ATOMIC_ACQUIRE, "agent");
            asm volatile("s_waitcnt vmcnt(0)" ::: "memory");
        }
    }
    __syncthreads();
}

__device__ __forceinline__ void sub_barrier(unsigned* cnt, unsigned n, unsigned* bar) {
    asm volatile("s_waitcnt vmcnt(0)" ::: "memory");
    __syncthreads();
    if (threadIdx.x == 0) {
        __builtin_amdgcn_fence(__ATOMIC_RELEASE, "agent");
        asm volatile("s_waitcnt vmcnt(0)" ::: "memory");
        (void)xb_add(cnt, 1u);
        XB_SPIN(xb_ld(cnt) < n, bar);
        __builtin_amdgcn_fence(__ATOMIC_ACQUIRE, "agent");
        asm volatile("s_waitcnt vmcnt(0)" ::: "memory");
    }
    __syncthreads();
}

constexpr int RING_OFF = 0, RING_BYTES = 131072;
constexpr int LDSCTL_OFF = RING_BYTES, MISC_OFF = LDSCTL_OFF + 320;
constexpr int LDS_BYTES = 147456;
static_assert(att::SHM_ATTN <= RING_BYTES, "attention scratch fits the ring");

struct Frame {
    LAS unsigned char* lds;
    int tid, lane, wave;
    int vcu, G;
    float* out; unsigned char* ws;
};
constexpr int PTR_OFF = MISC_OFF + 256;
__device__ __forceinline__ const float* inp(const Frame& F, int i) {
    int off = PTR_OFF + 8 * i; asm volatile("" : "+s"(off));
    const unsigned long long v = *(const LAS unsigned long long*)(F.lds + off);
    const unsigned lo = __builtin_amdgcn_readfirstlane((unsigned)v), hi = __builtin_amdgcn_readfirstlane((unsigned)(v >> 32));
    return (const float*)(((unsigned long long)hi << 32) | lo);
}
__device__ __forceinline__ void frame_lanes(Frame& F) {
    int t = threadIdx.x; asm volatile("" : "+v"(t)); F.tid = t; F.lane = t & 63; F.wave = __builtin_amdgcn_readfirstlane(t >> 6);
    unsigned long long w = (unsigned long long)F.ws, o = (unsigned long long)F.out; unsigned l = (unsigned)(unsigned long long)F.lds; int g = F.G, v = F.vcu;
    asm volatile("" : "+s"(w), "+s"(o), "+s"(l), "+s"(g), "+s"(v));
    F.ws = (unsigned char*)w; F.out = (float*)o; F.lds = (LAS unsigned char*)(unsigned long long)l; F.G = g; F.vcu = v;
}
__device__ __forceinline__ float shx(float v, int o, int lane) { return __builtin_bit_cast(float, __builtin_amdgcn_ds_bpermute((lane ^ o) << 2, __builtin_bit_cast(int, v))); }
__device__ __forceinline__ float wave_sum(float v, int lane) {
#pragma unroll
    for (int o = 1; o < 64; o <<= 1) v += shx(v, o, lane);
    return v;
}
__device__ __forceinline__ float wave_max(float v, int lane) {
#pragma unroll
    for (int o = 1; o < 64; o <<= 1) v = fmaxf(v, shx(v, o, lane));
    return v;
}

__device__ __forceinline__ int dest_row(int map, int row_off, int n) {
    if (map == 1) { return n < DFF ? ((n >> 7) * 256 + (n & 127)) : (((n - DFF) >> 7) * 256 + 128 + ((n - DFF) & 127)); }
    if (map == 2) { const int h = n / 192, d = n - h * 192; if (d < 128) return n; const int i = d - 128; return h * 192 + 128 + (i < 32 ? 2 * i : 2 * (i - 32) + 1); }
    return row_off + n;
}
struct TrJob { const float* W; int ldw; bf16* WT; int ldt, map, row_off; const float* ks; bf16* RM; int ldr; int k0, n0; };
__device__ __forceinline__ void tr_load(const TrJob& J, int lane, f32x4 (&v)[8]) {
#pragma unroll
    for (int i = 0; i < 8; ++i) { const int kk = 8 * i + (lane >> 3), c4 = (lane & 7) * 4; v[i] = *(const GAS f32x4*)(J.W + (size_t)(J.k0 + kk) * J.ldw + J.n0 + c4);
        if (J.ks) v[i] = v[i] * ((const GAS float*)J.ks)[J.k0 + kk]; }
}
__device__ __forceinline__ void tr_finish(const TrJob& J, const f32x4 (&v)[8], LAS float* scr, int lane) {
#pragma unroll
    for (int i = 0; i < 8; ++i) { const int kk = 8 * i + (lane >> 3), c4 = (lane & 7) * 4; LAS float* d = scr + kk * 33 + c4; d[0] = v[i].x; d[1] = v[i].y; d[2] = v[i].z; d[3] = v[i].w; }
    LDS_WAIT(); asm volatile("" ::: "memory");
    const int c = lane & 7;
#pragma unroll
    for (int j = 0; j < 4; ++j) { const int n = (lane >> 3) + 8 * j; const LAS float* p = scr + (8 * c) * 33 + n;
        v4u o; o.x = pk2(p[0 * 33], p[1 * 33]); o.y = pk2(p[2 * 33], p[3 * 33]); o.z = pk2(p[4 * 33], p[5 * 33]); o.w = pk2(p[6 * 33], p[7 * 33]);
        *(GAS v4u*)(J.WT + (size_t)dest_row(J.map, J.row_off, J.n0 + n) * J.ldt + J.k0 + 8 * c) = o; }
    if (J.RM) {
        const LAS float* p = scr + lane * 33;
#pragma unroll
        for (int q = 0; q < 4; ++q) { v4u o; o.x = pk2(p[8 * q], p[8 * q + 1]); o.y = pk2(p[8 * q + 2], p[8 * q + 3]); o.z = pk2(p[8 * q + 4], p[8 * q + 5]); o.w = pk2(p[8 * q + 6], p[8 * q + 7]);
            *(GAS v4u*)(J.RM + (size_t)(J.k0 + lane) * J.ldr + J.n0 + 8 * q) = o; }
    }
    LDS_WAIT(); asm volatile("" ::: "memory");
}
#define TR_LOOP(NITEMS, JOBEXPR) do { \
        f32x4 va_[8], vb_[8], na_[8], nb_[8]; TrJob ja_, jb_, nja_, njb_; bool hb_ = false, nhb_ = false; \
        int it_ = gw; \
        if (it_ < (NITEMS)) { int it = it_; ja_ = (JOBEXPR); hb_ = it_ + NGW < (NITEMS); it = hb_ ? it_ + NGW : it_; jb_ = (JOBEXPR); tr_load(ja_, lane, va_); if (hb_) tr_load(jb_, lane, vb_); } \
        while (it_ < (NITEMS)) { \
            const int nit_ = it_ + 2 * NGW; const bool hn_ = nit_ < (NITEMS); \
            if (hn_) { int it = nit_; nja_ = (JOBEXPR); nhb_ = nit_ + NGW < (NITEMS); it = nhb_ ? nit_ + NGW : nit_; njb_ = (JOBEXPR); tr_load(nja_, lane, na_); if (nhb_) tr_load(njb_, lane, nb_); } \
            tr_finish(ja_, va_, scr, lane); if (hb_) tr_finish(jb_, vb_, scr, lane); \
            if (hn_) { ja_ = nja_; jb_ = njb_; hb_ = nhb_; _Pragma("unroll") for (int q_ = 0; q_ < 8; ++q_) { va_[q_] = na_[q_]; vb_[q_] = nb_[q_]; } } \
            it_ = nit_; } } while (0)

constexpr int P0_I_DQ = 32 * 16, P0_I_DKV = 32 * 18, P0_I_UQ = 8 * 96, P0_I_UK = 8 * 64, P0_I_UV = 8 * 64, P0_I_O = 32 * 64, P0_I_MLA = P0_I_DQ + P0_I_DKV + P0_I_UQ + P0_I_UK + P0_I_UV + P0_I_O, P0_I_POOL = 4 * 8 * 16;
__device__ __forceinline__ TrJob p0_job(Frame& F, int it) {
    TrJob J; J.ks = nullptr; J.RM = nullptr; J.ldr = 0; J.map = 0; J.row_off = 0; int nnb, r;
    if (it < 2 * P0_I_MLA) {
        const int j = it / P0_I_MLA; r = it - j * P0_I_MLA; unsigned char* wb = F.ws + WS_W + j * W_MLA;
        if (r < P0_I_DQ) { J.W = inp(F, 7) + (size_t)j * 2048 * 512; J.ldw = 512; J.WT = (bf16*)(wb + WO_DQKV); J.ldt = 2048; nnb = 16; J.ks = inp(F, 6) + (size_t)(2 * j) * 4 * DM; }
        else if ((r -= P0_I_DQ) < P0_I_DKV) { J.W = inp(F, 10) + (size_t)j * 2048 * 576; J.ldw = 576; J.WT = (bf16*)(wb + WO_DQKV); J.ldt = 2048; nnb = 18; J.row_off = 512; J.ks = inp(F, 6) + (size_t)(2 * j) * 4 * DM; }
        else if ((r -= P0_I_DKV) < P0_I_UQ) { J.W = inp(F, 9) + (size_t)j * 512 * 3072; J.ldw = 3072; J.WT = (bf16*)(wb + WO_UQ); J.ldt = 512; nnb = 96; J.map = 2; }
        else if ((r -= P0_I_UQ) < P0_I_UK) { J.W = inp(F, 12) + (size_t)j * 512 * 2048; J.ldw = 2048; J.WT = (bf16*)(wb + WO_UKV); J.ldt = 512; nnb = 64; }
        else if ((r -= P0_I_UK) < P0_I_UV) { J.W = inp(F, 13) + (size_t)j * 512 * 2048; J.ldw = 2048; J.WT = (bf16*)(wb + WO_UKV); J.ldt = 512; nnb = 64; J.row_off = 2048; }
        else { r -= P0_I_UV; J.W = inp(F, 14) + (size_t)j * 2048 * 2048; J.ldw = 2048; J.WT = (bf16*)(wb + WO_O); J.ldt = 2048; nnb = 64; }
    } else {
        r = it - 2 * P0_I_MLA; const int jg2 = r / (8 * 16); r -= jg2 * (8 * 16); const int jg = jg2 & 7, unf = jg2 >> 3;
        J.W = inp(F, 15) + (size_t)jg * 512 * 512; J.ldw = 512; J.WT = (bf16*)(F.ws + (unf ? WS_WPOOLH : WS_WPOOL) + (size_t)(jg >> 2) * 2 * MiB); J.ldt = 512; nnb = 16; J.row_off = (jg & 3) * 512;
        if (!unf) J.ks = inp(F, 6) + (size_t)(2 * (jg >> 2) + 1) * 4 * DM + (jg & 3) * 512;
    }
    J.k0 = 64 * (r / nnb); J.n0 = 32 * (r % nnb); return J;
}
__device__ __forceinline__ void p0_prologue(Frame& F) {
    frame_lanes(F);
    LAS float* scr = (LAS float*)(F.lds + RING_OFF + F.wave * 16384);
    const int gw = F.vcu * NWAVES + F.wave, NGW = F.G * NWAVES;
    {
        float* ct = (float*)(F.ws + WS_ROPE); float* st = ct + 4096 * 32;
        for (int idx = (F.vcu * NWAVES + F.wave) * 64 + F.lane; idx < 4096 * 32; idx += NGW * 64) {
            const int pos = idx >> 5, i = idx & 31;
            double inv = 1.0; for (int k = 0; k < i; ++k) inv *= 0.7498942093324558273;
            double a = (double)pos * inv;
            const double twopi = 6.283185307179586476925287; a -= twopi * __builtin_rint(a / twopi);
            const double x = a * 0.125, x2 = x * x;
            double s = x * (1.0 + x2 * (-1.0 / 6 + x2 * (1.0 / 120 + x2 * (-1.0 / 5040 + x2 * (1.0 / 362880 + x2 * (-1.0 / 39916800))))));
            double c = 1.0 + x2 * (-0.5 + x2 * (1.0 / 24 + x2 * (-1.0 / 720 + x2 * (1.0 / 40320 + x2 * (-1.0 / 3628800 + x2 * (1.0 / 479001600))))));
#pragma unroll
            for (int k = 0; k < 3; ++k) { const double s2 = 2.0 * s * c, c2 = 1.0 - 2.0 * s * s; s = s2; c = c2; }
            ((GAS float*)ct)[idx] = (float)c; ((GAS float*)st)[idx] = (float)s;
        }
    }
    constexpr int NITEMS = 2 * P0_I_MLA + 4 * P0_I_POOL;
    { const int lane = F.lane; TR_LOOP(NITEMS, p0_job(F, it)); }
    for (int row = gw; row < 2 * 8192; row += NGW) {
        const int j = row >> 13, hc = row & 8191, h = hc >> 9, c = hc & 511;
        const GAS float* src = (const GAS float*)(inp(F, 12) + (size_t)j * 512 * 2048 + (size_t)c * 2048 + h * 128 + 2 * F.lane);
        GAS unsigned* dst = (GAS unsigned*)((unsigned*)(F.ws + WS_W + j * W_MLA + WO_UK2) + (size_t)hc * 128);
        dst[F.lane] = pk2(src[0], src[1]); dst[64 + F.lane] = 0u;
    }
    for (int row = gw; row < 2 * 512; row += NGW) {
        const int j = row >> 9, r = row & 511, sb = r >> 4, slot = r & 15;
        const float* src = inp(F, 4) + ((size_t)(j * 32 + sb) * 15 + (slot < 15 ? slot : 0)) * DM;
        bf16* dst = (bf16*)(F.ws + WS_HS) + (size_t)row * DM;
#pragma unroll
        for (int q = 0; q < 8; ++q) { const int c = (F.lane + 64 * q) * 4; f32x4 v = *(const GAS f32x4*)(src + c); if (slot == 15) v = (f32x4){0.f, 0.f, 0.f, 0.f};
            v2u w; w.x = pk2(v.x, v.y); w.y = pk2(v.z, v.w); *(GAS v2u*)(dst + c) = w; }
    }
}

__device__ __forceinline__ TrJob ffn_job(Frame& F, int it, const float* wu, const float* wd, const float* g2, unsigned char* wfb) {
    constexpr int I_UP = 32 * 352; TrJob J; J.RM = nullptr; J.ldr = 0; J.row_off = 0;
    if (it < I_UP) { J.W = wu; J.ldw = NUP; J.WT = (bf16*)(wfb + WO_UP); J.ldt = 2048; J.map = 1; J.ks = g2; J.k0 = 64 * (it / 352); J.n0 = 32 * (it % 352); }
    else { const int r = it - I_UP; J.W = wd; J.ldw = 2048; J.WT = (bf16*)(wfb + WO_DOWN); J.ldt = DFF; J.map = 0; J.ks = nullptr; J.k0 = 64 * (r / 64); J.n0 = 32 * (r % 64); }
    return J;
}
__device__ __forceinline__ unsigned char* ffn_buf(Frame& F, int L) { return F.ws + ((L & 1) ? WS_WFFN2 : WS_WFFN); }
__device__ __forceinline__ void convert_ffn(Frame& F, int L, int it0 = 0, int it1 = 32 * 352 + 88 * 64) {
    LAS float* scr = (LAS float*)(F.lds + RING_OFF + F.wave * 16384);
    const int gw = F.vcu * NWAVES + F.wave, NGW = F.G * NWAVES;
    unsigned char* wfb = ffn_buf(F, L);
    const float* wu = inp(F, 17) + (size_t)L * 2048 * NUP; const float* wd = inp(F, 20) + (size_t)L * DFF * 2048; const float* g2 = inp(F, 6) + (size_t)(L * 4 + 2) * DM;
    const int lane = F.lane;
    TR_LOOP(it1 - it0, ffn_job(F, it0 + it, wu, wd, g2, wfb));
}
__device__ __forceinline__ void norm0_phase(Frame& F) {
    frame_lanes(F);
    const int gw = F.vcu * NWAVES + F.wave, NGW = F.G * NWAVES;
    const float* xp = inp(F, 0); const float* xs = inp(F, 1);
    bf16* XB = (bf16*)(F.ws + WS_XB); float* RS = (float*)(F.ws + WS_RS);
    f32x4 nx[8];
#pragma unroll
    for (int j = 0; j < 8; ++j) nx[j] = (f32x4){0.f, 0.f, 0.f, 0.f};
    if (gw < T) { const float* xin = gw < TP ? xp + (size_t)gw * DM : xs + (size_t)(gw - TP) * DM;
#pragma unroll
        for (int j = 0; j < 8; ++j) nx[j] = *(const GAS f32x4*)(xin + (F.lane + 64 * j) * 4); }
    for (int row = gw; row < T; row += NGW) {
        f32x4 x[8]; float s2 = 0.f;
#pragma unroll
        for (int j = 0; j < 8; ++j) x[j] = nx[j];
        { const int nrow = row + NGW;
          if (nrow < T) { const float* xin = nrow < TP ? xp + (size_t)nrow * DM : xs + (size_t)(nrow - TP) * DM;
#pragma unroll
              for (int j = 0; j < 8; ++j) nx[j] = *(const GAS f32x4*)(xin + (F.lane + 64 * j) * 4); } }
#pragma unroll
        for (int j = 0; j < 8; ++j) s2 += (x[j].x * x[j].x + x[j].y * x[j].y) + (x[j].z * x[j].z + x[j].w * x[j].w);
        const float r2 = 1.0f / sqrtf(wave_sum(s2, F.lane) * (1.0f / DM) + EPS);
#pragma unroll
        for (int j = 0; j < 8; ++j) { v2u w; w.x = pk2(x[j].x, x[j].y); w.y = pk2(x[j].z, x[j].w); *(GAS v2u*)(XB + (size_t)row * DM + (F.lane + 64 * j) * 4) = w; }
        if (F.lane == 0) ((GAS float*)RS)[row] = r2;
    }
}
struct NormRows { int cnt, first, start, stride; };
__device__ __forceinline__ NormRows norm_rows(int gw, int NGW, int ns) {
    NormRows R;
    if (NGW == 2048 && ns > 0) { const int hp = 13, lp = 17;
        if (gw < 512) { R.cnt = 1 + hp; R.first = TP + gw; R.start = gw - 512; R.stride = 512; }
        else { R.cnt = lp; R.start = 512 * hp + (gw - 512); R.first = R.start; R.stride = 1536; } }
    else { R.cnt = gw < T ? (T - gw + NGW - 1) / NGW : 0; R.first = gw; R.start = gw; R.stride = NGW; }
    return R;
}
template <bool LAST, bool POOLST>
__device__ __forceinline__ void norm_phase(Frame& F, const bf16* mres, const bf16* slab, int ns, const float* g_post, const float* g_pre, float* pool_p, float* pool_s, bool poison, bool dry = false) {
    frame_lanes(F);
    const int gw = F.vcu * NWAVES + F.wave, NGW = F.G * NWAVES;
    const NormRows NR = norm_rows(gw, NGW, ns);
    bf16* XB = (bf16*)(F.ws + WS_XB); bf16* XBo = dry ? (bf16*)(F.ws + WS_BIG) : XB;
    float* RS = (float*)(F.ws + WS_RS);
    f32x4 gp[8];
#pragma unroll
    for (int j = 0; j < 8; ++j) gp[j] = *(const GAS f32x4*)(g_post + (F.lane + 64 * j) * 4);
    v2u nx[8], nm[8];
#pragma unroll
    for (int j = 0; j < 8; ++j) { nx[j] = (v2u){0u, 0u}; nm[j] = (v2u){0u, 0u}; }
    if (NR.cnt > 0) {
#pragma unroll
        for (int j = 0; j < 8; ++j) { nx[j] = *(const GAS v2u*)(XB + (size_t)NR.first * DM + (F.lane + 64 * j) * 4); nm[j] = *(const GAS v2u*)(mres + (size_t)NR.first * DM + (F.lane + 64 * j) * 4); } }
    for (int ri = 0; ri < NR.cnt; ++ri) {
        const int row = ri == 0 ? NR.first : NR.start + NR.stride * ri;
        f32x4 x[8], mv[8]; v2u cm[8];
#pragma unroll
        for (int j = 0; j < 8; ++j) { x[j] = (f32x4){bflo(nx[j].x), bfhi(nx[j].x), bflo(nx[j].y), bfhi(nx[j].y)}; cm[j] = nm[j]; }
        { const int nrow = NR.start + NR.stride * (ri + 1);
          if (ri + 1 < NR.cnt) {
#pragma unroll
              for (int j = 0; j < 8; ++j) { nx[j] = *(const GAS v2u*)(XB + (size_t)nrow * DM + (F.lane + 64 * j) * 4); nm[j] = *(const GAS v2u*)(mres + (size_t)nrow * DM + (F.lane + 64 * j) * 4); } } }
        if (ns > 0 && row >= TP) {
#pragma unroll
            for (int j = 0; j < 8; ++j) mv[j] = (f32x4){0.f, 0.f, 0.f, 0.f};
#pragma unroll 2
            for (int k = 0; k < ns; ++k) {
#pragma unroll
                for (int j = 0; j < 8; ++j) { const v2u w = *(const GAS v2u*)(slab + ((size_t)k * TS + (row - TP)) * DM + (F.lane + 64 * j) * 4); mv[j] = mv[j] + (f32x4){bflo(w.x), bfhi(w.x), bflo(w.y), bfhi(w.y)}; } }
        } else {
#pragma unroll
            for (int j = 0; j < 8; ++j) mv[j] = (f32x4){bflo(cm[j].x), bfhi(cm[j].x), bflo(cm[j].y), bfhi(cm[j].y)}; }
        float ss = 0.f;
#pragma unroll
        for (int j = 0; j < 8; ++j) ss += (mv[j].x * mv[j].x + mv[j].y * mv[j].y) + (mv[j].z * mv[j].z + mv[j].w * mv[j].w);
        const float r1 = 1.0f / sqrtf(wave_sum(ss, F.lane) * (1.0f / DM) + EPS);
#pragma unroll
        for (int j = 0; j < 8; ++j) x[j] = x[j] + mv[j] * r1 * gp[j];
        if (LAST) {
            if (poison) {
#pragma unroll
                for (int j = 0; j < 8; ++j) x[j] = x[j] * __builtin_nanf("");
            }
#pragma unroll
            for (int j = 0; j < 8; ++j) *(GAS f32x4*)(F.out + (size_t)row * DM + (F.lane + 64 * j) * 4) = x[j];
        } else {
#pragma unroll
            for (int j = 0; j < 8; ++j) { v2u w; w.x = pk2(x[j].x, x[j].y); w.y = pk2(x[j].z, x[j].w); *(GAS v2u*)(XBo + (size_t)row * DM + (F.lane + 64 * j) * 4) = w; }
            float s2 = 0.f;
#pragma unroll
            for (int j = 0; j < 8; ++j) s2 += (x[j].x * x[j].x + x[j].y * x[j].y) + (x[j].z * x[j].z + x[j].w * x[j].w);
            const float r2 = 1.0f / sqrtf(wave_sum(s2, F.lane) * (1.0f / DM) + EPS);
            if (F.lane == 0) ((GAS float*)RS)[row] = r2;
            if (POOLST) {
                float* ps = nullptr;
                if (row < TP) { const int s = row & (SEQ - 1); if (s >= SEQ - 15) ps = pool_p + ((size_t)(row >> 12) * 15 + (s - (SEQ - 15))) * DM; }
                else { const int qi = (row - TP) & 15; if (qi >= 1) ps = pool_s + ((size_t)((row - TP) >> 4) * 15 + (qi - 1)) * DM; }
                if (ps) {
#pragma unroll
                    for (int j = 0; j < 8; ++j) { const int c = (F.lane + 64 * j) * 4; *(GAS f32x4*)(ps + c) = x[j] * r2 * *(const GAS f32x4*)(g_pre + c); } }
            }
        }
    }
}

__device__ __forceinline__ TrJob vt_job(const float* cck, bf16* VT, bf16* KALL, int it) {
    const int b = it >> 9, r = it & 511; TrJob J; J.W = cck + (size_t)b * 2048 * 512; J.ldw = 512; J.WT = VT + (size_t)b * 512 * 2304; J.ldt = 2304; J.map = 0; J.row_off = 0; J.ks = nullptr;
    J.RM = KALL + (size_t)b * 2304 * 640; J.ldr = 640; J.k0 = 64 * (r >> 4); J.n0 = 32 * (r & 15); return J;
}
__device__ __forceinline__ void s1_phase(Frame& F, int j) {
    frame_lanes(F);
    const int gw = F.vcu * NWAVES + F.wave, NGW = F.G * NWAVES, lane = F.lane;
    const bf16* raw = (const bf16*)(F.ws + WS_MB);
    const float* qn = inp(F, 8) + j * 512; const float* kn = inp(F, 11) + j * 512;
    const float* ct = (const float*)(F.ws + WS_ROPE); const float* st = ct + 4096 * 32;
    bf16* CQ = (bf16*)(F.ws + WS_CQ); bf16* CKVB = (bf16*)(F.ws + WS_CKVB); bf16* KRB = (bf16*)(F.ws + WS_KRB);
    bf16* KALL = (bf16*)(F.ws + WS_KALL); bf16* VT = (bf16*)(F.ws + WS_VT);
    f32x4 gqn[2], gkn[2];
#pragma unroll
    for (int i = 0; i < 2; ++i) { gqn[i] = *(const GAS f32x4*)(qn + (lane + 64 * i) * 4); gkn[i] = *(const GAS f32x4*)(kn + (lane + 64 * i) * 4); }
    f32x4 na[2], nb[2]; float nkv = 0.f, nrs = 0.f, ncs = 0.f, nsn = 0.f;
#pragma unroll
    for (int i = 0; i < 2; ++i) { na[i] = (f32x4){0.f, 0.f, 0.f, 0.f}; nb[i] = na[i]; }
#define S1_LD4(p) ({ const v2u w_ = *(const GAS v2u*)(p); (f32x4){bflo(w_.x), bfhi(w_.x), bflo(w_.y), bfhi(w_.y)}; })
    if (gw < T) { const bf16* rr = raw + (size_t)gw * 1280;
#pragma unroll
        for (int i = 0; i < 2; ++i) { na[i] = S1_LD4(rr + (lane + 64 * i) * 4); nb[i] = S1_LD4(rr + 512 + (lane + 64 * i) * 4); }
        nkv = __builtin_bit_cast(float, (unsigned)((const GAS bf16*)rr)[1024 + lane] << 16); nrs = ((const GAS float*)(F.ws + WS_RS))[gw];
        { const int p0 = gw < TP ? (gw & (SEQ - 1)) : 2048 + ((gw - TP) & 15); ncs = ((const GAS float*)ct)[p0 * 32 + (lane & 31)]; nsn = ((const GAS float*)st)[p0 * 32 + (lane & 31)]; } }
    for (int row = gw; row < T; row += NGW) {
        f32x4 a[2], b[2]; float ssa = 0.f, ssb = 0.f;
        const float rs_row = nrs;
#pragma unroll
        for (int i = 0; i < 2; ++i) { a[i] = na[i] * rs_row; b[i] = nb[i] * rs_row;
            ssa += (a[i].x * a[i].x + a[i].y * a[i].y) + (a[i].z * a[i].z + a[i].w * a[i].w); ssb += (b[i].x * b[i].x + b[i].y * b[i].y) + (b[i].z * b[i].z + b[i].w * b[i].w); }
        const float kv = nkv * rs_row; const float cs = ncs, sn = nsn;
        { const int nrow = row + NGW;
          if (nrow < T) { const bf16* rn = raw + (size_t)nrow * 1280;
#pragma unroll
              for (int i = 0; i < 2; ++i) { na[i] = S1_LD4(rn + (lane + 64 * i) * 4); nb[i] = S1_LD4(rn + 512 + (lane + 64 * i) * 4); }
              nkv = __builtin_bit_cast(float, (unsigned)((const GAS bf16*)rn)[1024 + lane] << 16); nrs = ((const GAS float*)(F.ws + WS_RS))[nrow];
              const int p1 = nrow < TP ? (nrow & (SEQ - 1)) : 2048 + ((nrow - TP) & 15); ncs = ((const GAS float*)ct)[p1 * 32 + (lane & 31)]; nsn = ((const GAS float*)st)[p1 * 32 + (lane & 31)]; } }
        const float ra = 1.0f / sqrtf(wave_sum(ssa, lane) * (1.0f / 512) + EPS), rb = 1.0f / sqrtf(wave_sum(ssb, lane) * (1.0f / 512) + EPS);
        const bool prompt = row < TP;
        const int sb = (row - TP) >> 4, qi = (row - TP) & 15;
        float* o_ckv = prompt ? F.out + O_CKV_P + ((size_t)j * TP + row) * 512 : F.out + O_CKV_S + ((size_t)j * TS + (row - TP)) * 512;
        float* o_kr = prompt ? F.out + O_KR_P + ((size_t)j * TP + row) * 64 : F.out + O_KR_S + ((size_t)j * TS + (row - TP)) * 64;
#pragma unroll
        for (int i = 0; i < 2; ++i) {
            const int c = (lane + 64 * i) * 4;
            const f32x4 q = a[i] * ra * gqn[i]; v2u w; w.x = pk2(q.x, q.y); w.y = pk2(q.z, q.w); *(GAS v2u*)(CQ + (size_t)row * 512 + c) = w;
            const f32x4 k = b[i] * rb * gkn[i]; *(GAS f32x4*)(o_ckv + c) = k; v2u wk; wk.x = pk2(k.x, k.y); wk.y = pk2(k.z, k.w);
            if (prompt) *(GAS v2u*)(CKVB + (size_t)row * 512 + c) = wk;
            else { *(GAS v2u*)(KALL + ((size_t)sb * 2304 + 2048 + qi) * 640 + c) = wk;
                GAS bf16* vt = (GAS bf16*)(VT + ((size_t)sb * 512 + c) * 2304 + 2048 + qi); vt[0] = (bf16)(wk.x & 0xffff); vt[2304] = (bf16)(wk.x >> 16); vt[2 * 2304] = (bf16)(wk.y & 0xffff); vt[3 * 2304] = (bf16)(wk.y >> 16); }
        }
        const float other = shx(kv, 32, lane);
        const float rot = lane < 32 ? kv * cs - other * sn : other * sn + kv * cs;
        ((GAS float*)o_kr)[lane] = rot;
        const float rot_hi = shx(rot, 32, lane);
        if (lane < 32) { const unsigned w = pk2(rot, rot_hi);
            if (prompt) ((GAS unsigned*)(KRB + (size_t)row * 64))[lane] = w; else ((GAS unsigned*)(KALL + ((size_t)sb * 2304 + 2048 + qi) * 640 + 512))[lane] = w; }
        else if (!prompt) ((GAS unsigned*)(KALL + ((size_t)sb * 2304 + 2048 + qi) * 640 + 576))[lane - 32] = 0u;
    }
}
__device__ __forceinline__ void s1_cache_phase(Frame& F, int j) {
    frame_lanes(F);
    const int gw = F.vcu * NWAVES + F.wave, NGW = F.G * NWAVES, lane = F.lane;
    bf16* KALL = (bf16*)(F.ws + WS_KALL); bf16* VT = (bf16*)(F.ws + WS_VT);
    const float* cck = inp(F, 2) + (size_t)j * 32 * 2048 * 512; const float* ckr = inp(F, 3) + (size_t)j * 32 * 2048 * 64;
    { const int tg = (F.vcu * NWAVES + F.wave) * 64 + lane, NT_ = F.G * NWAVES * 64;
#pragma unroll 4
      for (int idx = tg; idx < 32 * 2048 * 32; idx += NT_) {
          const int rowc = idx >> 5, i = idx & 31, b = rowc >> 11, key = rowc & 2047;
          const GAS float* src = (const GAS float*)ckr + (size_t)rowc * 64;
          GAS unsigned* dst = (GAS unsigned*)(KALL + ((size_t)b * 2304 + key) * 640);
          dst[256 + i] = pk2(src[i], src[i + 32]); dst[288 + i] = 0u; }
      for (int idx = tg; idx < 32 * 240 * 320; idx += NT_) { const int rz = idx / 320, w = idx - rz * 320, b = rz / 240, key = 2064 + (rz - b * 240);
          ((GAS unsigned*)(KALL + ((size_t)b * 2304 + key) * 640))[w] = 0u; }
    }
    { LAS float* scr = (LAS float*)(F.lds + RING_OFF + F.wave * 16384);
      TR_LOOP(32 * 512, vt_job(cck, VT, KALL, it));
      for (int r = gw; r < 32 * 512; r += NGW) { GAS unsigned* dst = (GAS unsigned*)(VT + (size_t)r * 2304 + 2064); dst[lane] = 0u; if (lane < 56) dst[64 + lane] = 0u; }
    }
}

__device__ __forceinline__ void qlat_rope_copy(Frame& F) {
    frame_lanes(F);
    const bf16* Q = (const bf16*)(F.ws + WS_Q); bf16* QL = (bf16*)(F.ws + WS_QLAT);
    for (int idx = (F.vcu * NWAVES + F.wave) * 64 + F.lane; idx < 8192 * 16; idx += F.G * NWAVES * 64) {
        const int row = idx >> 4, ch = idx & 15, b = row >> 8, h = (row >> 4) & 15, qi = row & 15;
        v4u v = (v4u){0u, 0u, 0u, 0u};
        if (ch < 8) v = *(const GAS v4u*)(Q + (size_t)(TP + b * 16 + qi) * 3072 + h * 192 + 128 + ch * 8);
        *(GAS v4u*)(QL + (size_t)row * 640 + 512 + ch * 8) = v;
    }
}

__device__ __forceinline__ void softmax_phase(Frame& F) {
    frame_lanes(F);
    const float* S = (const float*)(F.ws + WS_S); bf16* P = (bf16*)(F.ws + WS_P);
    const int gw = F.vcu * NWAVES + F.wave, NGW = F.G * NWAVES, lane = F.lane;
    constexpr float C = att::SCALE * 1.4426950408889634f;
    for (int row = gw; row < 8192; row += NGW) {
        f32x4 v[9]; float mx = -1e30f;
#pragma unroll
        for (int j = 0; j < 9; ++j) { const int c = lane * 4 + 256 * j; v[j] = *(const GAS f32x4*)(S + (size_t)row * 2304 + c);
            if (c >= 2064) v[j] = (f32x4){-1e30f, -1e30f, -1e30f, -1e30f};
            mx = fmaxf(mx, fmaxf(fmaxf(v[j].x, v[j].y), fmaxf(v[j].z, v[j].w))); }
        mx = wave_max(mx, lane); float sum = 0.f;
#pragma unroll
        for (int j = 0; j < 9; ++j) { const int c = lane * 4 + 256 * j;
            v[j].x = __builtin_amdgcn_exp2f((v[j].x - mx) * C); v[j].y = __builtin_amdgcn_exp2f((v[j].y - mx) * C); v[j].z = __builtin_amdgcn_exp2f((v[j].z - mx) * C); v[j].w = __builtin_amdgcn_exp2f((v[j].w - mx) * C);
            if (c >= 2064) v[j] = (f32x4){0.f, 0.f, 0.f, 0.f};
            sum += (v[j].x + v[j].y) + (v[j].z + v[j].w); }
        const float inv = 1.0f / wave_sum(sum, lane);
#pragma unroll
        for (int j = 0; j < 9; ++j) { const int c = lane * 4 + 256 * j; v2u w; w.x = pk2(v[j].x * inv, v[j].y * inv); w.y = pk2(v[j].z * inv, v[j].w * inv); *(GAS v2u*)(P + (size_t)row * 2304 + c) = w; }
    }
}

template <int G> __device__ __forceinline__ void pool_group_prompt(const bf16* X, const GAS float* RS, bf16* Dd, const float* g0, int t0, int s0, int lane) {
    constexpr int W = 2 << G, H = W - 1;
    const int c = G * 512 + lane * 8;
    const bool hv = s0 > 0;
    const int rrow = t0 - 15 + lane; const float rsv = (lane < 31 && rrow >= 0) ? RS[rrow] : 0.f;
    v4u x[H + 16];
#pragma unroll
    for (int r = 0; r < H + 16; ++r) { x[r] = (v4u){0u, 0u, 0u, 0u}; if (r >= H || hv) x[r] = *(const GAS v4u*)(X + (size_t)(t0 - H + r) * DM + c); }
    const f32x4 ga = *(const GAS f32x4*)(g0 + c), gb = *(const GAS f32x4*)(g0 + c + 4);
    float S[8];
#pragma unroll
    for (int e = 0; e < 8; ++e) S[e] = 0.f;
#define PD_ROWF(v, rs, f) do { f[0] = bflo(v.x) * rs; f[1] = bfhi(v.x) * rs; f[2] = bflo(v.y) * rs; f[3] = bfhi(v.y) * rs; f[4] = bflo(v.z) * rs; f[5] = bfhi(v.z) * rs; f[6] = bflo(v.w) * rs; f[7] = bfhi(v.w) * rs; } while (0)
#pragma unroll
    for (int r = 0; r < H; ++r) { const float rs = __builtin_bit_cast(float, __builtin_amdgcn_readlane(__builtin_bit_cast(int, rsv), 15 - H + r)); float f[8]; PD_ROWF(x[r], rs, f);
#pragma unroll
        for (int e = 0; e < 8; ++e) S[e] += f[e]; }
#pragma unroll
    for (int i = 0; i < 16; ++i) {
        const float rs = __builtin_bit_cast(float, __builtin_amdgcn_readlane(__builtin_bit_cast(int, rsv), 15 + i)); float f[8]; PD_ROWF(x[H + i], rs, f);
#pragma unroll
        for (int e = 0; e < 8; ++e) S[e] += f[e];
        const int s = s0 + i; const float ic = 1.0f / (float)((s + 1) < W ? (s + 1) : W);
        v4u o; o.x = pk2((S[0] * ic - f[0]) * ga.x, (S[1] * ic - f[1]) * ga.y); o.y = pk2((S[2] * ic - f[2]) * ga.z, (S[3] * ic - f[3]) * ga.w);
        o.z = pk2((S[4] * ic - f[4]) * gb.x, (S[5] * ic - f[5]) * gb.y); o.w = pk2((S[6] * ic - f[6]) * gb.z, (S[7] * ic - f[7]) * gb.w);
        *(GAS v4u*)(Dd + (size_t)(t0 + i) * DM + c) = o;
        { const float rl = __builtin_bit_cast(float, __builtin_amdgcn_readlane(__builtin_bit_cast(int, rsv), 15 - H + i)); float fl[8]; PD_ROWF(x[i], rl, fl);
#pragma unroll
          for (int e = 0; e < 8; ++e) S[e] -= fl[e]; }
    }
#undef PD_ROWF
}
__device__ __forceinline__ void pool_d_phase(Frame& F, int j, const float* g0) {
    frame_lanes(F);
    const bf16* X = (const bf16*)(F.ws + WS_XB); bf16* Dd = (bf16*)(F.ws + WS_ACT); const GAS float* RS = (const GAS float*)(F.ws + WS_RS);
    const float* hist = inp(F, 4) + (size_t)j * 32 * 15 * DM;
    const int gw = F.vcu * NWAVES + F.wave, NGW = F.G * NWAVES, lane = F.lane;
    for (int ch = gw; ch < TP / 16; ch += NGW) {
        const int t0 = ch * 16, s0 = t0 & (SEQ - 1);
        pool_group_prompt<0>(X, RS, Dd, g0, t0, s0, lane); pool_group_prompt<1>(X, RS, Dd, g0, t0, s0, lane);
        pool_group_prompt<2>(X, RS, Dd, g0, t0, s0, lane); pool_group_prompt<3>(X, RS, Dd, g0, t0, s0, lane);
    }
    for (int row = TP + gw; row < T; row += NGW) {
        const int s = (row - TP) & 15; const int sb = (row - TP) >> 4;
#pragma unroll
        for (int g = 0; g < 4; ++g) {
            const int w = 2 << g, c = g * 512 + lane * 8;
            const f32x4 ga = *(const GAS f32x4*)(g0 + c), gb = *(const GAS f32x4*)(g0 + c + 4);
            const float gg[8] = {ga.x, ga.y, ga.z, ga.w, gb.x, gb.y, gb.z, gb.w};
            float acc[8], self[8];
#pragma unroll
            for (int e = 0; e < 8; ++e) { acc[e] = 0.f; self[e] = 0.f; }
            for (int k = 0; k < w; ++k) {
                const int sk = s - k;
                if (sk >= 0) { const v4u v = *(const GAS v4u*)(X + (size_t)(row - k) * DM + c); const float r = RS[row - k];
                    const float f[8] = {bflo(v.x), bfhi(v.x), bflo(v.y), bfhi(v.y), bflo(v.z), bfhi(v.z), bflo(v.w), bfhi(v.w)};
#pragma unroll
                    for (int e = 0; e < 8; ++e) { const float hv = f[e] * r * gg[e]; acc[e] += hv; if (k == 0) self[e] = hv; } }
                else { const float* hp = hist + ((size_t)sb * 15 + (15 + sk)) * DM + c; const f32x4 u0 = *(const GAS f32x4*)hp, u1 = *(const GAS f32x4*)(hp + 4);
                    acc[0] += u0.x; acc[1] += u0.y; acc[2] += u0.z; acc[3] += u0.w; acc[4] += u1.x; acc[5] += u1.y; acc[6] += u1.z; acc[7] += u1.w; }
            }
            const float ic = 1.0f / (float)w;
            v4u o; o.x = pk2(acc[0] * ic - self[0], acc[1] * ic - self[1]); o.y = pk2(acc[2] * ic - self[2], acc[3] * ic - self[3]);
            o.z = pk2(acc[4] * ic - self[4], acc[5] * ic - self[5]); o.w = pk2(acc[6] * ic - self[6], acc[7] * ic - self[7]);
            *(GAS v4u*)(Dd + (size_t)row * DM + c) = o;
        }
    }
}

constexpr int PNR = 4;
template <int G> __device__ __forceinline__ void pool_mix_group(const bf16* Z, const bf16* ZH, bool sample, int rowbase, int hbase, int p0, int lane, unsigned (&mp)[PNR][4], float (&ss)[PNR]) {
    constexpr int W = 2 << G, H = W - 1;
    const int c = G * 512 + lane * 8;
#define PM_LOAD(r) ({ const int p_ = p0 - H + (r); v4u v_ = (v4u){0u, 0u, 0u, 0u}; \
        if (p_ >= 0) v_ = *(const GAS v4u*)(Z + (size_t)(rowbase + p_) * DM + c); else if (sample) v_ = *(const GAS v4u*)(ZH + (size_t)(hbase + 15 + p_) * DM + c); v_; })
#define PM_ROWF(v, f) do { f[0] = bflo(v.x); f[1] = bfhi(v.x); f[2] = bflo(v.y); f[3] = bfhi(v.y); f[4] = bflo(v.z); f[5] = bfhi(v.z); f[6] = bflo(v.w); f[7] = bfhi(v.w); } while (0)
    float S[8];
#pragma unroll
    for (int e = 0; e < 8; ++e) S[e] = 0.f;
    v4u zk[PNR];
#pragma unroll
    for (int r = 0; r < PNR; ++r) zk[r] = (v4u){0u, 0u, 0u, 0u};
#pragma unroll
    for (int b = 0; b < H; b += 16) {
        v4u zb[16];
#pragma unroll
        for (int r = 0; r < 16; ++r) if (b + r < H) zb[r] = PM_LOAD(b + r);
#pragma unroll
        for (int r = 0; r < 16; ++r) if (b + r < H) { float f[8]; PM_ROWF(zb[r], f);
#pragma unroll
            for (int e = 0; e < 8; ++e) S[e] += f[e];
            if (b + r < PNR) zk[b + r < PNR ? b + r : 0] = zb[r]; }
    }
    v4u zc[PNR];
#pragma unroll
    for (int i = 0; i < PNR; ++i) zc[i] = PM_LOAD(H + i);
#pragma unroll
    for (int i = 0; i < PNR; ++i) {
        float f[8]; PM_ROWF(zc[i], f);
#pragma unroll
        for (int e = 0; e < 8; ++e) S[e] += f[e];
        const int pos = p0 + i; const float ic = 1.0f / (float)(sample ? W : ((pos + 1) < W ? (pos + 1) : W));
        float m[8];
#pragma unroll
        for (int e = 0; e < 8; ++e) { m[e] = S[e] * ic - f[e]; ss[i] += m[e] * m[e]; }
        mp[i][0] = pg8::cvt_pk_bf16(m[0], m[1]); mp[i][1] = pg8::cvt_pk_bf16(m[2], m[3]); mp[i][2] = pg8::cvt_pk_bf16(m[4], m[5]); mp[i][3] = pg8::cvt_pk_bf16(m[6], m[7]);
        { float fl[8]; const v4u lv = (i < H) ? zk[i < H ? i : 0] : zc[i >= H ? i - H : 0]; PM_ROWF(lv, fl);
#pragma unroll
          for (int e = 0; e < 8; ++e) S[e] -= fl[e]; }
    }
#undef PM_ROWF
#undef PM_LOAD
}
__device__ __forceinline__ void pool_norm_item(Frame& F, const float* g_post, bool sample, int rowbase, int hbase, int p0, int lane) {
    const bf16* Z = (const bf16*)(F.ws + WS_MB); const bf16* ZH = (const bf16*)(F.ws + WS_ZH);
    bf16* XB = (bf16*)(F.ws + WS_XB); float* RS = (float*)(F.ws + WS_RS);
    unsigned mp[4][PNR][4]; float ss[PNR];
#pragma unroll
    for (int i = 0; i < PNR; ++i) ss[i] = 0.f;
#define PM_FENCE() asm volatile("" ::: "memory")
    pool_mix_group<3>(Z, ZH, sample, rowbase, hbase, p0, lane, mp[3], ss); PM_FENCE(); pool_mix_group<2>(Z, ZH, sample, rowbase, hbase, p0, lane, mp[2], ss);
    pool_mix_group<1>(Z, ZH, sample, rowbase, hbase, p0, lane, mp[1], ss); pool_mix_group<0>(Z, ZH, sample, rowbase, hbase, p0, lane, mp[0], ss); PM_FENCE();
    float r1[PNR], s2[PNR];
#pragma unroll
    for (int i = 0; i < PNR; ++i) { r1[i] = 1.0f / sqrtf(wave_sum(ss[i], lane) * (1.0f / DM) + EPS); s2[i] = 0.f; }
#pragma unroll
    for (int g = 0; g < 4; ++g) {
        const int c = g * 512 + lane * 8;
        const f32x4 ga = *(const GAS f32x4*)(g_post + c), gb = *(const GAS f32x4*)(g_post + c + 4);
        const float gg[8] = {ga.x, ga.y, ga.z, ga.w, gb.x, gb.y, gb.z, gb.w};
        v4u xv[PNR];
#pragma unroll
        for (int i = 0; i < PNR; ++i) xv[i] = *(const GAS v4u*)(XB + (size_t)(rowbase + p0 + i) * DM + c);
#pragma unroll
        for (int i = 0; i < PNR; ++i) {
            const unsigned xw[4] = {xv[i].x, xv[i].y, xv[i].z, xv[i].w};
            float xn[8];
#pragma unroll
            for (int q = 0; q < 4; ++q) { xn[2 * q] = bflo(xw[q]) + bflo(mp[g][i][q]) * r1[i] * gg[2 * q]; xn[2 * q + 1] = bfhi(xw[q]) + bfhi(mp[g][i][q]) * r1[i] * gg[2 * q + 1]; }
#pragma unroll
            for (int e = 0; e < 8; ++e) s2[i] += xn[e] * xn[e];
            v4u o; o.x = pg8::cvt_pk_bf16(xn[0], xn[1]); o.y = pg8::cvt_pk_bf16(xn[2], xn[3]); o.z = pg8::cvt_pk_bf16(xn[4], xn[5]); o.w = pg8::cvt_pk_bf16(xn[6], xn[7]);
            *(GAS v4u*)(XB + (size_t)(rowbase + p0 + i) * DM + c) = o;
        }
        if (g & 1) PM_FENCE();
    }
#undef PM_FENCE
#pragma unroll
    for (int i = 0; i < PNR; ++i) { const float r2 = 1.0f / sqrtf(wave_sum(s2[i], lane) * (1.0f / DM) + EPS); if (lane == 0) ((GAS float*)RS)[rowbase + p0 + i] = r2; }
}
__device__ __forceinline__ void norm_pool_phase(Frame& F, const float* g_post) {
    frame_lanes(F);
    const int gw = F.vcu * NWAVES + F.wave, NGW = F.G * NWAVES, lane = F.lane;
    for (int ch = gw; ch < TP / 16; ch += NGW) {
        const int t0 = ch * 16, rowbase = t0 & ~(SEQ - 1), s0 = t0 & (SEQ - 1);
#pragma unroll 1
        for (int q = 0; q < 16 / PNR; ++q) pool_norm_item(F, g_post, false, rowbase, 0, s0 + PNR * q, lane);
    }
    for (int si = gw; si < 32 * (16 / PNR); si += NGW) { const int sb = si / (16 / PNR), q = si % (16 / PNR); pool_norm_item(F, g_post, true, TP + 16 * sb, 16 * sb, PNR * q, lane); }
}

__device__ __forceinline__ void fix_phase(Frame& F, int L, int b0) {
    frame_lanes(F);
    const int nb = F.G - b0, vb = (int)blockIdx.x - b0; if (vb < 0) return;
    const bf16* BF = (const bf16*)(F.ws + WS_BND); const bf16* BL = BF + (size_t)512 * 2 * NUP;
    const float* cw = inp(F, 18) + (size_t)L * 3 * NUP; const float* cb = inp(F, 19) + (size_t)L * NUP;
    bf16* act = (bf16*)(F.ws + WS_ACT);
    for (int idx = (vb * NWAVES + F.wave) * 64 + F.lane; idx < 512 * 2 * 704; idx += nb * NWAVES * 64) {
        const int cc = idx % 704, sj = idx / 704, s = sj >> 1, jr = sj & 1;
        const int jg = cc * 8, np = (jg >> 7) * 256 + (jg & 127);
        const bool seq0 = (s & 63) == 0;
        float u0[2][8], u1[2][8], u2[2][8];
#pragma unroll
        for (int gv = 0; gv < 2; ++gv) {
            const v4u zero = (v4u){0u, 0u, 0u, 0u};
            const v4u cur = *(const GAS v4u*)(BF + (size_t)(s * 2 + jr) * NUP + np + gv * 128);
            const v4u f0 = *(const GAS v4u*)(BF + (size_t)(s * 2) * NUP + np + gv * 128);
            const v4u l0 = seq0 ? zero : *(const GAS v4u*)(BL + (size_t)((s - 1) * 2) * NUP + np + gv * 128);
            const v4u l1 = seq0 ? zero : *(const GAS v4u*)(BL + (size_t)((s - 1) * 2 + 1) * NUP + np + gv * 128);
            const v4u p1 = jr ? f0 : l1, p2 = jr ? l1 : l0;
            const unsigned cu[4] = {cur.x, cur.y, cur.z, cur.w}, a1[4] = {p1.x, p1.y, p1.z, p1.w}, a2[4] = {p2.x, p2.y, p2.z, p2.w};
#pragma unroll
            for (int e = 0; e < 4; ++e) { u0[gv][2 * e] = bflo(cu[e]); u0[gv][2 * e + 1] = bfhi(cu[e]); u1[gv][2 * e] = bflo(a1[e]); u1[gv][2 * e + 1] = bfhi(a1[e]); u2[gv][2 * e] = bflo(a2[e]); u2[gv][2 * e + 1] = bfhi(a2[e]); }
        }
        float r[8];
#pragma unroll
        for (int e = 0; e < 8; ++e) {
            const int cg = jg + e, cv = DFF + jg + e;
            const GAS float* cwg = (const GAS float*)cw; const GAS float* cbg = (const GAS float*)cb;
            const float g = cbg[cg] + cwg[cg] * u2[0][e] + cwg[NUP + cg] * u1[0][e] + cwg[2 * NUP + cg] * u0[0][e];
            const float v = cbg[cv] + cwg[cv] * u2[1][e] + cwg[NUP + cv] * u1[1][e] + cwg[2 * NUP + cv] * u0[1][e];
            r[e] = pg8::silu_mul(g, v);
        }
        v4u o; o.x = pk2(r[0], r[1]); o.y = pk2(r[2], r[3]); o.z = pk2(r[4], r[5]); o.w = pk2(r[6], r[7]);
        *(GAS v4u*)(act + (size_t)(s * 64 + jr) * DFF + jg) = o;
    }
}

__device__ __forceinline__ int attn_fetch_any(unsigned* qc, int g0) {
    for (int tries = 0; tries < 8; ++tries) {
        unsigned c[8];
#pragma unroll
        for (int g = 0; g < 8; ++g) c[g] = xb_ld(qc + 64 * g);
        int best = 8, bg = 0;
#pragma unroll
        for (int g = 0; g < 8; ++g) { const int d = (g - g0) & 7; if (c[g] < 256u && d < best) { best = d; bg = g; } }
        if (best == 8) return -1;
        const unsigned u = xb_add(qc + 64 * bg, 1u);
        if (u < 256u) return (bg << 16) | (int)u;
    }
    return -1;
}
__device__ __forceinline__ void attn_phase(Frame& F, unsigned* qc) {
    frame_lanes(F);
    const bf16* Q = (const bf16*)(F.ws + WS_Q); const bf16* KV = (const bf16*)(F.ws + WS_KV); const bf16* KRB = (const bf16*)(F.ws + WS_KRB); bf16* O = (bf16*)(F.ws + WS_HB);
    volatile LAS int* slot = (volatile LAS int*)(F.lds + MISC_OFF + 64);
    const int g0 = (F.G % 8 == 0) ? (F.vcu / (F.G / 8)) & 7 : (F.vcu & 7);
    int par = 0;
    for (;;) {
        if (F.tid == 0) slot[par] = attn_fetch_any(qc, g0);
        __syncthreads();
        const int gu = __builtin_amdgcn_readfirstlane(slot[par]); par ^= 1;
        if (gu < 0) break;
        const int g = gu >> 16; int u = gu & 0xffff;
        unsigned* ctr = qc + 64 * g;
        while (u < 256) {
            const int k = u >> 6, r = u & 63, qb = 15 - (r >> 2), bh = 4 * g + (r & 3) + 32 * k, b = bh >> 4, h = bh & 15;
            const size_t row0 = (size_t)b * SEQ;
            att::attn_unit(Q + (row0 + 256 * qb) * 3072 + h * 192, KV + row0 * 4096 + h * 128, KV + row0 * 4096 + 2048 + h * 128, KRB + row0 * 64,
                           O + (row0 + 256 * qb) * DM + h * 128, 4 * qb + 4, qb, (ATT_LAS char*)(F.lds + RING_OFF), ctr, (volatile ATT_LAS int*)(slot + par));
            u = __builtin_amdgcn_readfirstlane(slot[par]); par ^= 1;
        }
    }
}

struct Args { const float* in[21]; float* out; unsigned char* ws; int ph_lo, ph_hi; };
constexpr int NPH = 1 + 4 * 16;
#ifndef PG8_ALIGN
#define PG8_ALIGN true
#endif
__global__ void __launch_bounds__(NWAVES * 64, 2) fwd_kernel(Args args) {
    extern __shared__ __attribute__((aligned(16))) unsigned char lds[];
    Frame F;
    F.lds = (LAS unsigned char*)lds;
    F.tid = threadIdx.x; F.lane = F.tid & 63; F.wave = __builtin_amdgcn_readfirstlane(F.tid >> 6);
    F.G = gridDim.x; { const int bx = blockIdx.x; F.vcu = (F.G % 8 == 0) ? (bx % 8) * (F.G / 8) + bx / 8 : bx; }
    F.out = args.out; F.ws = args.ws;
    unsigned* ctl = (unsigned*)(F.ws + WS_CTL);
    for (int u = F.tid; u < (LDS_BYTES - LDSCTL_OFF) / 4; u += NWAVES * 64) ((LAS unsigned*)(F.lds + LDSCTL_OFF))[u] = 0u;
    __syncthreads();
    if (F.tid == 0) {
#pragma unroll
        for (int i = 0; i < 21; ++i) ((LAS unsigned long long*)(F.lds + PTR_OFF))[i] = (unsigned long long)args.in[i];
    }
    __syncthreads();
    const int lo = args.ph_lo, hi = args.ph_hi;
    const bool one_launch = (hi - lo) > 1;
    XcdBarrier bar; bar.bar = ctl + CW_BAR; bar.x = 0; bar.st = nullptr;
    if (one_launch) bar = xcd_barrier_post(ctl + CW_BAR, (volatile LAS unsigned*)(F.lds + MISC_OFF) + 8);
#ifndef PH_MASK
#define PH_MASK 0x1ffffu
#endif
#define IN(k) (lo <= (k) && (k) < hi)
#define EN(p) (((PH_MASK) >> (p)) & 1u)
#ifndef DBL_MASK
#define DBL_MASK 0u
#endif
#define REPS(p) ((int)(((DBL_MASK) >> (p)) & 1u) + 1)
#define SEAM(k) do { if (IN((k) + 1)) { xcd_barrier(bar); if (REPS(17) > 1) xcd_barrier(bar); } } while (0)
    const int bid = (int)blockIdx.x;

    if (EN(16) && IN(0)) { for (int rep_ = 0; rep_ < REPS(16); ++rep_) { if (rep_) xcd_barrier(bar); p0_prologue(F); convert_ffn(F, 0); norm0_phase(F); } SEAM(0); }

    for (int L = 0; L < 4; ++L) {
        const int base = 1 + 16 * L, j = L >> 1;
        const float* ng = inp(F, 6) + (size_t)L * 4 * DM;
        if ((L & 1) == 0) {
            unsigned char* wb = F.ws + WS_W + j * W_MLA;
            if (EN(0) && IN(base + 0)) { for (int rep_ = 0; rep_ < REPS(0); ++rep_) { if (rep_) xcd_barrier(bar); frame_lanes(F); LAS unsigned char* ring = F.lds + RING_OFF;  pg8::SchedPlain S; S.init(130, 5, F.G, bid); S.A = (const char*)(F.ws + WS_XB); S.B = (const char*)(wb + WO_DQKV); S.lda = 2048; S.ldb = 2048; S.K = 2048;
                pg8::EpiB<0> E{(bf16*)(F.ws + WS_MB), 1280, nullptr}; pg8::gemm_phase<pg8::EpiB<0>, pg8::SchedPlain, PG8_ALIGN>(ring, S, E);  } SEAM(base + 0); }
            if (EN(1) && IN(base + 1)) { for (int rep_ = 0; rep_ < REPS(1); ++rep_) { if (rep_) xcd_barrier(bar); frame_lanes(F); LAS unsigned char* ring = F.lds + RING_OFF;  s1_phase(F, j); s1_cache_phase(F, j);  } SEAM(base + 1); }
            if (EN(2) && IN(base + 2)) { for (int rep_ = 0; rep_ < REPS(2); ++rep_) { if (rep_) xcd_barrier(bar); frame_lanes(F); LAS unsigned char* ring = F.lds + RING_OFF;  pg8::SchedPlain S; S.init(128, 12, F.G, bid); S.A = (const char*)(F.ws + WS_CQ); S.B = (const char*)(wb + WO_UQ); S.lda = 512; S.ldb = 512; S.K = 512;
                pg8::EpiQRope E{(bf16*)(F.ws + WS_Q), (const float*)(F.ws + WS_ROPE), (const float*)(F.ws + WS_ROPE) + 4096 * 32};
                pg8::gemm_phase<pg8::EpiQRope, pg8::SchedPlain, PG8_ALIGN>(ring, S, E);  } SEAM(base + 2); }
            if (EN(8) && IN(base + 3)) { for (int rep_ = 0; rep_ < REPS(8); ++rep_) { if (rep_) xcd_barrier(bar); frame_lanes(F); LAS unsigned char* ring = F.lds + RING_OFF;  pg8::SchedPlain S; S.init(128, 16, F.G, bid); S.A = (const char*)(F.ws + WS_CKVB); S.B = (const char*)(wb + WO_UKV); S.lda = 512; S.ldb = 512; S.K = 512;
                pg8::EpiB<0> E{(bf16*)(F.ws + WS_KV), 4096, nullptr}; pg8::gemm_phase<pg8::EpiB<0>, pg8::SchedPlain, PG8_ALIGN>(ring, S, E);  } SEAM(base + 3); }
            if (EN(9) && IN(base + 4)) {
                frame_lanes(F); LAS unsigned char* ring = F.lds + RING_OFF;
                if ((F.vcu & 7) == 0) {
                    Frame Fs = F; Fs.vcu = F.vcu >> 3; Fs.G = (F.G + 7) >> 3;
                    const int NS = Fs.G, sb = Fs.vcu;
                    unsigned* sc = ctl + CW_SUB + 512 * j;
                    { pg8::SchedPlainOff S; S.init(2, 12, NS, sb); S.pm0 = 128; S.A = (const char*)(F.ws + WS_CQ); S.B = (const char*)(wb + WO_UQ); S.lda = 512; S.ldb = 512; S.K = 512;
                      pg8::EpiQRope E{(bf16*)(F.ws + WS_Q), (const float*)(F.ws + WS_ROPE), (const float*)(F.ws + WS_ROPE) + 4096 * 32};
                      pg8::gemm_phase<pg8::EpiQRope, pg8::SchedPlainOff, PG8_ALIGN>(ring, S, E); }
                    sub_barrier(sc + 256, NS, ctl + CW_BAR);
                    qlat_rope_copy(Fs);
                    { pg8::SchedQlat S; S.init(32, 2, NS, sb); S.A = (const char*)(F.ws + WS_Q) + (size_t)TP * 3072 * 2; S.B = (const char*)(wb + WO_UK2); S.lda = 3072; S.ldb = 256; S.K = 256;
                      pg8::EpiB<1> E{(bf16*)(F.ws + WS_QLAT), 640, nullptr}; pg8::gemm_phase<pg8::EpiB<1>, pg8::SchedQlat, PG8_ALIGN>(ring, S, E); }
                    sub_barrier(sc, NS, ctl + CW_BAR);
                    { pg8::SchedBatch S; S.init(32, 9, NS, sb); S.A = (const char*)(F.ws + WS_QLAT); S.B = (const char*)(F.ws + WS_KALL); S.lda = 640; S.ldb = 640; S.K = 640; S.b_pm = (size_t)2304 * 640 * 2;
                      pg8::EpiF32 E{(float*)(F.ws + WS_S), 2304}; pg8::gemm_phase<pg8::EpiF32, pg8::SchedBatch, PG8_ALIGN>(ring, S, E); }
                    sub_barrier(sc + 64, NS, ctl + CW_BAR);
                    softmax_phase(Fs);
                    sub_barrier(sc + 128, NS, ctl + CW_BAR);
                    { pg8::SchedBatch S; S.init(32, 2, NS, sb); S.A = (const char*)(F.ws + WS_P); S.B = (const char*)(F.ws + WS_VT); S.lda = 2304; S.ldb = 2304; S.K = 2304; S.b_pm = (size_t)512 * 2304 * 2;
                      pg8::EpiB<2> E{(bf16*)(F.ws + WS_OL), 512, nullptr}; pg8::gemm_phase<pg8::EpiB<2>, pg8::SchedBatch, PG8_ALIGN>(ring, S, E); }
                    sub_barrier(sc + 192, NS, ctl + CW_BAR);
                    { pg8::SchedOV S; S.init(32, 1, NS, sb); S.A = (const char*)(F.ws + WS_OL); S.B = (const char*)(wb + WO_UKV) + (size_t)2048 * 512 * 2; S.lda = 512; S.ldb = 512; S.K = 512;
                      pg8::EpiB<3> E{(bf16*)(F.ws + WS_HB), 2048, nullptr}; pg8::gemm_phase<pg8::EpiB<3>, pg8::SchedOV, PG8_ALIGN>(ring, S, E); }
                    sub_barrier(sc + 320, NS, ctl + CW_BAR);
                    { pg8::SchedSplit S2; S2.init(2 * 4, 8, NS, sb); S2.A = (const char*)(F.ws + WS_HB) + (size_t)TP * 2048 * 2; S2.B = (const char*)(wb + WO_O); S2.lda = 2048; S2.ldb = 2048; S2.K = 512;
                      pg8::EpiSlab E2{(bf16*)(F.ws + WS_SLAB)}; pg8::gemm_phase<pg8::EpiSlab, pg8::SchedSplit, PG8_ALIGN>(ring, S2, E2); }
                    __syncthreads();
                }
                attn_phase(F, ctl + CW_Q + 512 * j);
                SEAM(base + 4);
            }
            if (EN(10) && IN(base + 10)) { for (int rep_ = 0; rep_ < REPS(10); ++rep_) { if (rep_) xcd_barrier(bar); frame_lanes(F); LAS unsigned char* ring = F.lds + RING_OFF;  pg8::SchedPlain S; S.init(128, 8, F.G, bid); S.A = (const char*)(F.ws + WS_HB); S.B = (const char*)(wb + WO_O); S.lda = 2048; S.ldb = 2048; S.K = 2048;
                pg8::EpiB<0> E{(bf16*)(F.ws + WS_MB), 2048, nullptr}; pg8::gemm_phase<pg8::EpiB<0>, pg8::SchedPlain, PG8_ALIGN>(ring, S, E);
  } SEAM(base + 10); }
        } else {
            if (EN(10) && IN(base + 10)) { for (int rep_ = 0; rep_ < REPS(10); ++rep_) { if (rep_) xcd_barrier(bar); frame_lanes(F); LAS unsigned char* ring = F.lds + RING_OFF;
                { pg8::SchedPool S; S.init(130, 8, F.G, bid); S.A = (const char*)(F.ws + WS_XB); S.B = (const char*)(F.ws + WS_WPOOL + (size_t)j * 2 * MiB); S.lda = 2048; S.ldb = 512; S.K = 512;
                  pg8::EpiB<4> E{(bf16*)(F.ws + WS_MB), 2048, inp(F, 16) + (size_t)j * DM, (const float*)(F.ws + WS_RS)}; pg8::gemm_phase<pg8::EpiB<4>, pg8::SchedPool, PG8_ALIGN>(ring, S, E); }
                { pg8::SchedPool S; S.init(2, 8, F.G, (bid + F.G - (F.G > 16 ? 16 : 0)) % F.G); S.A = (const char*)(F.ws + WS_HS + (size_t)j * 2 * MiB); S.B = (const char*)(F.ws + WS_WPOOLH + (size_t)j * 2 * MiB); S.lda = 2048; S.ldb = 512; S.K = 512;
                  pg8::EpiB<0> E{(bf16*)(F.ws + WS_ZH), 2048, inp(F, 16) + (size_t)j * DM, nullptr}; pg8::gemm_phase<pg8::EpiB<0>, pg8::SchedPool, PG8_ALIGN>(ring, S, E); }
                } SEAM(base + 10); }
        }
        unsigned char* wf = ffn_buf(F, L);
        if (EN(11) && IN(base + 11)) { for (int rep_ = 0; rep_ < REPS(11); ++rep_) { if (rep_) xcd_barrier(bar); frame_lanes(F); LAS unsigned char* ring = F.lds + RING_OFF;  const bool dry = rep_ + 1 < REPS(11); if (L & 1) norm_pool_phase(F, ng + DM); else norm_phase<false, false>(F, (const bf16*)(F.ws + WS_MB), (const bf16*)(F.ws + WS_SLAB), 4, ng + DM, nullptr, nullptr, nullptr, false, dry);  } SEAM(base + 11); }
        if (EN(12) && IN(base + 12)) { for (int rep_ = 0; rep_ < REPS(12); ++rep_) { if (rep_) xcd_barrier(bar); frame_lanes(F); LAS unsigned char* ring = F.lds + RING_OFF;
            { pg8::SchedPlain S; S.init(128, 44, F.G, bid); S.A = (const char*)(F.ws + WS_XB); S.B = (const char*)(wf + WO_UP); S.lda = 2048; S.ldb = 2048; S.K = 2048;
              pg8::EpiUpP E{(bf16*)(F.ws + WS_ACT), (bf16*)(F.ws + WS_BND), (bf16*)(F.ws + WS_BND) + (size_t)512 * 2 * NUP, inp(F, 18) + (size_t)L * 3 * NUP, inp(F, 19) + (size_t)L * NUP,
                             F.out + O_CONV_P + (size_t)L * 8 * 2 * NUP, (const float*)(F.ws + WS_RS)};
              pg8::gemm_phase<pg8::EpiUpP, pg8::SchedPlain, PG8_ALIGN>(ring, S, E); }
            } SEAM(base + 12); }
        if (EN(13) && IN(base + 13)) { for (int rep_ = 0; rep_ < REPS(13); ++rep_) { if (rep_) xcd_barrier(bar); frame_lanes(F); LAS unsigned char* ring = F.lds + RING_OFF;  { { pg8::SchedPlainOff S; S.init(2, 44, F.G, bid); S.pm0 = 128; S.A = (const char*)(F.ws + WS_XB); S.B = (const char*)(wf + WO_UP); S.lda = 2048; S.ldb = 2048; S.K = 2048;
              pg8::EpiUpS E{(bf16*)(F.ws + WS_ACT), inp(F, 18) + (size_t)L * 3 * NUP, inp(F, 19) + (size_t)L * NUP, inp(F, 5) + (size_t)L * 32 * 2 * NUP, F.out + O_CONV_S + (size_t)L * 32 * 2 * NUP, (const float*)(F.ws + WS_RS)};
              pg8::gemm_phase<pg8::EpiUpS, pg8::SchedPlainOff, PG8_ALIGN>(ring, S, E); } }
            fix_phase(F, L, F.G > 88 ? 88 : 0);
            if (L < 3 && F.G >= 176 && bid >= 88) { Frame Fs = F; Fs.vcu = bid - 88; Fs.G = F.G - 88; __syncthreads(); convert_ffn(Fs, L + 1, 0, FFN_EARLY); }
            } SEAM(base + 13); }
        if (EN(14) && IN(base + 14)) { for (int rep_ = 0; rep_ < REPS(14); ++rep_) { if (rep_) xcd_barrier(bar); frame_lanes(F); LAS unsigned char* ring = F.lds + RING_OFF;  pg8::SchedPlain S; S.init(128, 8, F.G, bid); S.A = (const char*)(F.ws + WS_ACT); S.B = (const char*)(wf + WO_DOWN); S.lda = DFF; S.ldb = DFF; S.K = DFF;
            pg8::EpiB<0> E{(bf16*)(F.ws + WS_MB), 2048, nullptr}; pg8::gemm_phase<pg8::EpiB<0>, pg8::SchedPlain, PG8_ALIGN>(ring, S, E);
            { pg8::SchedSplit S2; S2.init(2 * 11, 8, F.G, bid); S2.A = (const char*)(F.ws + WS_ACT) + (size_t)TP * DFF * 2; S2.B = (const char*)(wf + WO_DOWN); S2.lda = DFF; S2.ldb = DFF; S2.K = 512;
              pg8::EpiSlab E2{(bf16*)(F.ws + WS_SLAB)}; pg8::gemm_phase<pg8::EpiSlab, pg8::SchedSplit, PG8_ALIGN>(ring, S2, E2); }  } SEAM(base + 14); }
        if (EN(15) && IN(base + 15)) {
            const bool poison = one_launch && xb_ld(ctl + CW_BAR + XB_TMO) != 0u;
            frame_lanes(F);
            if (L < 3) convert_ffn(F, L + 1, F.G >= 176 ? FFN_EARLY : 0);
            const bf16* slab = (const bf16*)(F.ws + WS_SLAB);
            if (L == 3) norm_phase<true, false>(F, (const bf16*)(F.ws + WS_MB), slab, 11, ng + 3 * DM, nullptr, nullptr, nullptr, poison);
            else if ((L & 1) == 0) norm_phase<false, true>(F, (const bf16*)(F.ws + WS_MB), slab, 11, ng + 3 * DM, ng + 4 * DM, F.out + O_POOL_P + (size_t)j * 8 * 15 * DM, F.out + O_POOL_S + (size_t)j * 32 * 15 * DM, false);
            else norm_phase<false, false>(F, (const bf16*)(F.ws + WS_MB), slab, 11, ng + 3 * DM, nullptr, nullptr, nullptr, false);
            if (L < 3) SEAM(base + 15);
        }
    }
#undef IN
#undef SEAM
}

#ifndef MK_PER_PHASE
#define MK_PER_PHASE 0
#endif
extern "C" void kernel_launch(void* const* d_in, const int* in_sizes, int n_in, void* d_out, int out_size, void* d_ws, size_t ws_size, hipStream_t stream) {
    static int grid = 0;
    if (grid == 0) {
        if (n_in != 21 || (size_t)out_size != O_END || ws_size < WS_END) { fprintf(stderr, "kernel_launch: unexpected problem shape (n_in %d, out %d, ws %zu < %zu); nothing launched\n", n_in, out_size, ws_size, (size_t)WS_END); grid = -1; return; }
        int dev = 0, cus = 0, per_cu = 0;
        if (hipGetDevice(&dev) != hipSuccess || hipDeviceGetAttribute(&cus, hipDeviceAttributeMultiprocessorCount, dev) != hipSuccess) { grid = -1; return; }
        if (hipFuncSetAttribute((const void*)fwd_kernel, hipFuncAttributeMaxDynamicSharedMemorySize, LDS_BYTES) != hipSuccess) { fprintf(stderr, "kernel_launch: hipFuncSetAttribute failed\n"); grid = -1; return; }
        if (hipOccupancyMaxActiveBlocksPerMultiprocessor(&per_cu, (const void*)fwd_kernel, NWAVES * 64, LDS_BYTES) != hipSuccess || per_cu < 1) { fprintf(stderr, "kernel_launch: occupancy query says %d blocks per CU\n", per_cu); }
        (void)hipGetLastError();
        grid = cus;
    }
    if (grid < 0) return;
    (void)hipMemsetAsync((char*)d_ws + WS_CTL, 0, CTL_ZERO_BYTES, stream);
    Args a{};
    for (int i = 0; i < 21; ++i) a.in[i] = (const float*)d_in[i];
    a.out = (float*)d_out; a.ws = (unsigned char*)d_ws;
#if MK_PER_PHASE
    for (int p = 0; p < NPH; ++p) {
        if (p >= 1) { const int L = (p - 1) >> 4, q = (p - 1) & 15; if ((L & 1) && q < 9) continue; }
        a.ph_lo = p; a.ph_hi = p + 1;
        hipLaunchKernelGGL(fwd_kernel, dim3(grid), dim3(NWAVES * 64), LDS_BYTES, stream, a);
    }
#else
    a.ph_lo = 0; a.ph_hi = NPH;
    hipLaunchKernelGGL(fwd_kernel, dim3(grid), dim3(NWAVES * 64), LDS_BYTES, stream, a);
#endif
}
```
